# Optimizing an MI355X kernel written in HIP

```python
import math
import jax, jax.numpy as jnp
from jax import lax
import numpy as np

D_MODEL = 2048
BATCH = 2
SEQ = 8192
DEPTH = 1

CHUNK = 64
RET_WIDTH = D_MODEL // 2
RET_HEADS = 8
RET_HEAD_DIM = RET_WIDTH // RET_HEADS
SSM_WIDTH = D_MODEL - RET_WIDTH
SSM_GROUP = 16
SSM_GROUPS = SSM_WIDTH // SSM_GROUP
SSM_STATE = 64
D_FF = -(-8 * D_MODEL // (3 * 256)) * 256
IN_WIDTH = 4 * RET_WIDTH + SSM_WIDTH
ROPE_BASE = 10000.0
EPS = 1e-6

kernel_name = "hybrid_retention_s5_block"


def rmsnorm(x, g):
    xf = x.astype(jnp.float32)
    y = xf * lax.rsqrt(jnp.mean(xf * xf, axis=-1, keepdims=True) + EPS) * g.astype(jnp.float32)
    return y.astype(x.dtype)


def rope(x, pos):
    dh = x.shape[-1]
    half = dh // 2
    freqs = ROPE_BASE ** (-jnp.arange(half, dtype=jnp.float32) / half)
    ang = pos[:, None] * freqs[None, :]
    cos = jnp.cos(ang)[None, :, None, :]
    sin = jnp.sin(ang)[None, :, None, :]
    xf = x.astype(jnp.float32)
    x1, x2 = xf[..., :half], xf[..., half:]
    return jnp.concatenate([x1 * cos - x2 * sin, x2 * cos + x1 * sin], axis=-1)


def retention_group(q, k, v, g, gn_gain):
    b, s, h, dk = q.shape
    n_chunks = s // CHUNK
    hh = jnp.arange(h, dtype=jnp.float32)
    log_g = jnp.log1p(-(2.0 ** (-5.0 - hh)))
    q = q.reshape(b, n_chunks, CHUNK, h, dk)
    k = k.reshape(b, n_chunks, CHUNK, h, dk) * (dk ** -0.5)
    v = v.astype(jnp.float32).reshape(b, n_chunks, CHUNK, h, dk)
    idx = jnp.arange(CHUNK, dtype=jnp.float32)
    dist = jnp.abs(idx[:, None] - idx[None, :])
    intra_decay = jnp.exp(log_g[:, None, None] * dist)
    scores = jnp.einsum('bnqhd,bnkhd->bnhqk', q, k) * intra_decay
    intra = jnp.einsum('bnhqk,bnkhe->bnqhe', scores, v)
    k_dec = jnp.exp(log_g[None, :] * (CHUNK - 1 - idx)[:, None])
    kv = jnp.einsum('bnchd,bnche->nbhde', k * k_dec[..., None], v)
    chunk_dec = jnp.exp(log_g * CHUNK)[:, None, None]

    def step(state, kv_i):
        return state * chunk_dec + kv_i, state

    _, state_prev = lax.scan(step, jnp.zeros_like(kv[0]), kv)
    q_dec = jnp.exp(log_g[None, :] * (idx + 1.0)[:, None])
    inter = jnp.einsum('bnchd,nbhde->bnche', q * q_dec[..., None], state_prev)
    out = (intra + inter).reshape(b, s, h, dk)
    mu = jnp.mean(out, axis=-1, keepdims=True)
    var = jnp.mean(jnp.square(out - mu), axis=-1, keepdims=True)
    out = ((out - mu) * lax.rsqrt(var + EPS)).reshape(b, s, h * dk) * gn_gain.astype(jnp.float32)
    return jax.nn.silu(g.astype(jnp.float32)) * out


def s5_group(u, a_re, a_im, log_dt, b_re, b_im, c_re, c_im, d_skip, w_glu, b_glu, out_gain):
    b, s, _ = u.shape
    f32 = jnp.float32
    uf = u.astype(f32).reshape(b, s, SSM_GROUPS, SSM_GROUP)
    lam = lax.complex(a_re.astype(f32), a_im.astype(f32))
    dt = jnp.exp(log_dt.astype(f32))[:, None]
    lam_bar = jnp.exp(lam * dt)
    b_c = lax.complex(b_re.astype(f32), b_im.astype(f32))
    b_bar = ((lam_bar - 1.0) / lam)[..., None] * b_c
    bu = lax.complex(jnp.einsum('gpc,bsgc->bsgp', jnp.real(b_bar), uf),
                     jnp.einsum('gpc,bsgc->bsgp', jnp.imag(b_bar), uf))
    a = jnp.broadcast_to(lam_bar, bu.shape)

    def combine(left, right):
        a_l, b_l = left
        a_r, b_r = right
        return a_r * a_l, a_r * b_l + b_r

    _, states = lax.associative_scan(combine, (a, bu), axis=1)
    y = (jnp.einsum('gcp,bsgp->bsgc', c_re.astype(f32), jnp.real(states))
         - jnp.einsum('gcp,bsgp->bsgc', c_im.astype(f32), jnp.imag(states)))
    y = (y + d_skip.astype(f32).reshape(SSM_GROUPS, SSM_GROUP) * uf).reshape(b, s, SSM_WIDTH)
    y1 = jax.nn.gelu(y)
    y = y1 * jax.nn.sigmoid(y1 @ w_glu.astype(f32) + b_glu.astype(f32))
    return rmsnorm(y, out_gain)


def setup_inputs(seed: int = 0) -> dict:
    key = jax.random.key(seed)
    ks = jax.random.split(key, 24)
    f32 = jnp.float32
    L = DEPTH

    def nrm(k, shape, scale):
        return jax.random.normal(k, shape, f32) * scale

    def gain(k, shape):
        return 1.0 + 0.02 * jax.random.normal(k, shape, f32)

    n = jnp.arange(SSM_STATE, dtype=f32)
    return {
        "x": nrm(ks[0], (BATCH, SEQ, D_MODEL), 1.0),
        "norm_mix_g": gain(ks[1], (L, D_MODEL)),
        "w_in": nrm(ks[2], (L, D_MODEL, IN_WIDTH), D_MODEL ** -0.5),
        "ret_gn_g": gain(ks[3], (L, RET_WIDTH)),
        "ssm_a_re": -0.5 + 0.01 * nrm(ks[4], (L, SSM_GROUPS, SSM_STATE), 1.0),
        "ssm_a_im": math.pi * n + 0.01 * nrm(ks[5], (L, SSM_GROUPS, SSM_STATE), 1.0),
        "ssm_log_dt": jax.random.uniform(ks[6], (L, SSM_GROUPS), f32, math.log(1e-3), math.log(1e-1)),
        "ssm_b_re": nrm(ks[7], (L, SSM_GROUPS, SSM_STATE, SSM_GROUP), (2 * SSM_GROUP) ** -0.5),
        "ssm_b_im": nrm(ks[8], (L, SSM_GROUPS, SSM_STATE, SSM_GROUP), (2 * SSM_GROUP) ** -0.5),
        "ssm_c_re": nrm(ks[9], (L, SSM_GROUPS, SSM_GROUP, SSM_STATE), (2 * SSM_STATE) ** -0.5),
        "ssm_c_im": nrm(ks[10], (L, SSM_GROUPS, SSM_GROUP, SSM_STATE), (2 * SSM_STATE) ** -0.5),
        "ssm_d": nrm(ks[11], (L, SSM_WIDTH), 1.0),
        "ssm_w_glu": nrm(ks[12], (L, SSM_WIDTH, SSM_WIDTH), SSM_WIDTH ** -0.5),
        "ssm_b_glu": nrm(ks[13], (L, SSM_WIDTH), 0.01),
        "ssm_out_g": gain(ks[14], (L, SSM_WIDTH)),
        "w_out": nrm(ks[15], (L, D_MODEL, D_MODEL), D_MODEL ** -0.5),
        "norm_ffn_g": gain(ks[16], (L, D_MODEL)),
        "w_gate": nrm(ks[17], (L, D_MODEL, D_FF), D_MODEL ** -0.5),
        "w_up": nrm(ks[18], (L, D_MODEL, D_FF), D_MODEL ** -0.5),
        "w_down": nrm(ks[19], (L, D_FF, D_MODEL), D_FF ** -0.5),
        "norm_final_g": gain(ks[20], (D_MODEL,)),
    }


def reference(x, norm_mix_g, w_in, ret_gn_g, ssm_a_re, ssm_a_im, ssm_log_dt, ssm_b_re, ssm_b_im,
              ssm_c_re, ssm_c_im, ssm_d, ssm_w_glu, ssm_b_glu, ssm_out_g, w_out, norm_ffn_g,
              w_gate, w_up, w_down, norm_final_g):
    b, s, _ = x.shape
    pos = jnp.arange(s, dtype=jnp.float32)
    R = RET_WIDTH
    for l in range(DEPTH):
        h = rmsnorm(x, norm_mix_g[l])
        proj = h @ w_in[l]
        q = rope(proj[..., 0:R].reshape(b, s, RET_HEADS, RET_HEAD_DIM), pos)
        k = rope(proj[..., R:2 * R].reshape(b, s, RET_HEADS, RET_HEAD_DIM), pos)
        v = proj[..., 2 * R:3 * R].reshape(b, s, RET_HEADS, RET_HEAD_DIM)
        g = proj[..., 3 * R:4 * R]
        u = proj[..., 4 * R:]
        y_ret = retention_group(q, k, v, g, ret_gn_g[l])
        y_ssm = s5_group(u, ssm_a_re[l], ssm_a_im[l], ssm_log_dt[l], ssm_b_re[l], ssm_b_im[l],
                         ssm_c_re[l], ssm_c_im[l], ssm_d[l], ssm_w_glu[l], ssm_b_glu[l], ssm_out_g[l])
        mix = jnp.concatenate([y_ret, y_ssm.astype(jnp.float32)], axis=-1).astype(x.dtype)
        x = x + mix @ w_out[l]
        h = rmsnorm(x, norm_ffn_g[l])
        x = x + (jax.nn.silu(h @ w_gate[l]) * (h @ w_up[l])) @ w_down[l]
    return rmsnorm(x, norm_final_g)
```

```cpp
#include <hip/hip_runtime.h>
#include <hip/hip_cooperative_groups.h>
#include <cstdio>
#include <cstdint>
namespace cg = cooperative_groups;
namespace pg8 {
#define PG8_LAS __attribute__((address_space(3)))
typedef unsigned short bf16_t;
typedef short bf16x8 __attribute__((ext_vector_type(8)));
typedef float f32x4 __attribute__((ext_vector_type(4)));
typedef unsigned u32x4 __attribute__((ext_vector_type(4)));
constexpr int BM = 256, BK = 64, HALF = 128, HTB = HALF * BK * 2  , STAGE_BYTES = 8 * HTB, NXCD = 8, WGM = 8;

__host__ __device__ __forceinline__ int lds_byte(int r, int c) { const int st = (r >> 4) * 2 + (c >> 5), rr = r & 15, cc = c & 31, ob = rr * 64 + cc * 2; return st * 1024 + (ob ^ (((ob >> 9) & 1) << 5)); }
__host__ __device__ __forceinline__ void stage_rc(int b, int& R, int& C) { const int st = b / 1024, sb = b % 1024, swz = sb ^ (((sb >> 9) & 1) << 5); R = (st >> 1) * 16 + swz / 64; C = (st & 1) * 32 + (swz % 64) / 2; }
__host__ __device__ __forceinline__ int perm32(int rho) { const int n = rho >> 4, i = rho & 15; return 8 * (i >> 2) + 4 * n + (i & 3); }

struct Unit { int pm, pn; };
struct Gemm { const bf16_t* A; const bf16_t* Bt; int M, N, K; };

struct StaticOrder {
    int nM, nN, nwg, G, c;
    __host__ __device__ void init(int M, int N, int G_, int c_) { nM = M / BM; nN = N / BM; nwg = nM * nN; G = G_; c = c_; }
    __host__ __device__ bool next(int i, Unit& u) const {
        const long L = (long)i * G + c; if (L >= nwg) return false;
        int wgid = (int)L; { const int q = nwg / NXCD, r = nwg % NXCD, xcd = wgid % NXCD, off = wgid / NXCD; wgid = (xcd < r ? xcd * (q + 1) : r * (q + 1) + (xcd - r) * q) + off; }
        const int nig = WGM * nN, gid = wgid / nig, fm = gid * WGM, gsz = (nM - fm) < WGM ? (nM - fm) : WGM;
        u.pm = fm + ((wgid % nig) % gsz); u.pn = (wgid % nig) / gsz; return true;
    }
    __device__ __forceinline__ void a_ready(const Unit&) const {}
    __device__ __forceinline__ void done(const Unit&) const {}
};

typedef __bf16 bf16x2_t __attribute__((ext_vector_type(2)));
__device__ __forceinline__ unsigned cvt_pk_bf16(float lo, float hi) { bf16x2_t v = {(__bf16)lo, (__bf16)hi}; return __builtin_bit_cast(unsigned, v); }
__device__ __forceinline__ float bf_lo(unsigned w) { return __uint_as_float(w << 16); }
__device__ __forceinline__ float bf_hi(unsigned w) { return __uint_as_float(w & 0xffff0000u); }
typedef unsigned u32x2v __attribute__((ext_vector_type(2)));
__device__ __forceinline__ float sigmoid_f(float z) { return __builtin_amdgcn_rcpf(1.0f + __expf(-z)); }

struct EpiStoreBf16 {
    static constexpr bool PERM = true, AFTER_DRAIN = false;
    bf16_t* O; int ldc;
    __device__ __forceinline__ void operator()(const f32x4 (&acc)[2][2][4][2], const Unit& u, int wr, int wc, int fr, int fq) const {
        const int row0 = u.pm * BM + wr * 64 + fr, col0 = u.pn * BM + wc * 32 + 8 * fq;
#pragma unroll
        for (int ai = 0; ai < 2; ++ai)
#pragma unroll
            for (int m = 0; m < 4; ++m) { bf16_t* rowp = O + (size_t)(row0 + ai * HALF + m * 16) * ldc + col0;
#pragma unroll
                for (int bj = 0; bj < 2; ++bj) { const f32x4 v0 = acc[ai][bj][m][0], v1 = acc[ai][bj][m][1];
                    u32x4 w; w.x = cvt_pk_bf16(v0[0], v0[1]); w.y = cvt_pk_bf16(v0[2], v0[3]); w.z = cvt_pk_bf16(v1[0], v1[1]); w.w = cvt_pk_bf16(v1[2], v1[3]);
                    *(u32x4*)(rowp + bj * HALF) = w; } }
    }
};
struct EpiGlu {
    static constexpr bool PERM = true, AFTER_DRAIN = false;
    const bf16_t* Y1; const float* bias; const float* gain; bf16_t* Y2; float* rowsq; int ldc, ldo;
    __device__ __forceinline__ void operator()(const f32x4 (&acc)[2][2][4][2], const Unit& u, int wr, int wc, int fr, int fq) const {
        const int row0 = u.pm * BM + wr * 64 + fr, col0 = u.pn * BM + wc * 32 + 8 * fq;
        f32x4 bv[2][2], gv[2][2];
#pragma unroll
        for (int bj = 0; bj < 2; ++bj)
#pragma unroll
            for (int n = 0; n < 2; ++n) { bv[bj][n] = *(const f32x4*)(bias + col0 + bj * HALF + 4 * n); gv[bj][n] = *(const f32x4*)(gain + col0 + bj * HALF + 4 * n); }
#pragma unroll
        for (int ai = 0; ai < 2; ++ai) {
            u32x4 yv[4][2];
#pragma unroll
            for (int m = 0; m < 4; ++m)
#pragma unroll
                for (int bj = 0; bj < 2; ++bj) yv[m][bj] = *(const u32x4*)(Y1 + (size_t)(row0 + ai * HALF + m * 16) * ldc + col0 + bj * HALF);
#pragma unroll
            for (int m = 0; m < 4; ++m) { const int row = row0 + ai * HALF + m * 16; const size_t offo = (size_t)row * ldo + col0;
                float ss = 0.f;
#pragma unroll
                for (int bj = 0; bj < 2; ++bj) { const f32x4 z0 = acc[ai][bj][m][0] + bv[bj][0], z1 = acc[ai][bj][m][1] + bv[bj][1];
                    const u32x4 y = yv[m][bj];
                    f32x4 r0, r1;
                    r0[0] = bf_lo(y.x) * sigmoid_f(z0[0]); r0[1] = bf_hi(y.x) * sigmoid_f(z0[1]); r0[2] = bf_lo(y.y) * sigmoid_f(z0[2]); r0[3] = bf_hi(y.y) * sigmoid_f(z0[3]);
                    r1[0] = bf_lo(y.z) * sigmoid_f(z1[0]); r1[1] = bf_hi(y.z) * sigmoid_f(z1[1]); r1[2] = bf_lo(y.w) * sigmoid_f(z1[2]); r1[3] = bf_hi(y.w) * sigmoid_f(z1[3]);
                    ss += (r0[0] * r0[0] + r0[1] * r0[1]) + (r0[2] * r0[2] + r0[3] * r0[3]) + (r1[0] * r1[0] + r1[1] * r1[1]) + (r1[2] * r1[2] + r1[3] * r1[3]);
                    r0 = r0 * gv[bj][0]; r1 = r1 * gv[bj][1];
                    u32x4 w; w.x = cvt_pk_bf16(r0[0], r0[1]); w.y = cvt_pk_bf16(r0[2], r0[3]); w.z = cvt_pk_bf16(r1[0], r1[1]); w.w = cvt_pk_bf16(r1[2], r1[3]);
                    *(u32x4*)(Y2 + offo + bj * HALF) = w; }
                ss += __shfl_xor(ss, 16); ss += __shfl_xor(ss, 32);
                if (fq == 0) rowsq[(size_t)row * 16 + u.pn * 4 + wc] = ss; }
        }
    }
};
struct EpiResF32 {
    static constexpr bool PERM = false, AFTER_DRAIN = false;
    const float* X; float* O; int ldc; const float* insq; float inv_indim; bf16_t* OB; float* outsq;
    __device__ __forceinline__ void operator()(const f32x4 (&acc)[2][2][4][2], const Unit& u, int wr, int wc, int fr, int fq) const {
        const int row0 = u.pm * BM + wr * 64 + fr, col0 = u.pn * BM + wc * 32 + 4 * fq;
#pragma unroll
        for (int ai = 0; ai < 2; ++ai)
#pragma unroll
        for (int mh = 0; mh < 2; ++mh) {
            f32x4 xv[2][2][2]; f32x4 p4[2];
#pragma unroll
            for (int mm = 0; mm < 2; ++mm) { const int row = row0 + ai * HALF + (2 * mh + mm) * 16; const size_t off = (size_t)row * ldc + col0;
                p4[mm] = insq ? *(const f32x4*)(insq + (size_t)row * 16 + 4 * fq) : (f32x4){0.f, 0.f, 0.f, 0.f};
#pragma unroll
                for (int bj = 0; bj < 2; ++bj)
#pragma unroll
                    for (int n = 0; n < 2; ++n) xv[mm][bj][n] = *(const f32x4*)(X + off + bj * HALF + n * 16); }
#pragma unroll
            for (int mm = 0; mm < 2; ++mm) { const int m = 2 * mh + mm; const int row = row0 + ai * HALF + m * 16; const size_t off = (size_t)row * ldc + col0;
                float sc = 1.0f;
                if (insq) { float t = (p4[mm][0] + p4[mm][1]) + (p4[mm][2] + p4[mm][3]); t += __shfl_xor(t, 16); t += __shfl_xor(t, 32); sc = rsqrtf(t * inv_indim + 1e-6f); }
                float ss = 0.f;
#pragma unroll
                for (int bj = 0; bj < 2; ++bj)
#pragma unroll
                    for (int n = 0; n < 2; ++n) { const f32x4 o = xv[mm][bj][n] + acc[ai][bj][m][n] * sc;
                        *(f32x4*)(O + off + bj * HALF + n * 16) = o;
                        if (OB) { ss += (o[0] * o[0] + o[1] * o[1]) + (o[2] * o[2] + o[3] * o[3]); u32x2v w; w.x = cvt_pk_bf16(o[0], o[1]); w.y = cvt_pk_bf16(o[2], o[3]); *(u32x2v*)(OB + off + bj * HALF + n * 16) = w; } }
                if (OB) { ss += __shfl_xor(ss, 16); ss += __shfl_xor(ss, 32); if (fq == 0) outsq[(size_t)row * 32 + u.pn * 4 + wc] = ss; } }
        }
    }
};
struct EpiResB {
    static constexpr bool PERM = true, AFTER_DRAIN = false;
    const float* X; const bf16_t* XB; bf16_t* OB; int ldc; const float* insq; float inv_indim; float* outsq;
    __device__ __forceinline__ void operator()(const f32x4 (&acc)[2][2][4][2], const Unit& u, int wr, int wc, int fr, int fq) const {
        const int row0 = u.pm * BM + wr * 64 + fr, col0 = u.pn * BM + wc * 32 + 8 * fq;
#pragma unroll
        for (int ai = 0; ai < 2; ++ai)
#pragma unroll
        for (int mh = 0; mh < 2; ++mh) {
            f32x4 xv[2][2][2]; f32x4 p4[2];
#pragma unroll
            for (int mm = 0; mm < 2; ++mm) { const int row = row0 + ai * HALF + (2 * mh + mm) * 16; const size_t off = (size_t)row * ldc + col0;
                p4[mm] = insq ? *(const f32x4*)(insq + (size_t)row * 16 + 4 * fq) : (f32x4){0.f, 0.f, 0.f, 0.f};
#pragma unroll
                for (int bj = 0; bj < 2; ++bj) {
                    if (XB) { const u32x4 y = *(const u32x4*)(XB + off + bj * HALF); xv[mm][bj][0] = (f32x4){bf_lo(y.x), bf_hi(y.x), bf_lo(y.y), bf_hi(y.y)}; xv[mm][bj][1] = (f32x4){bf_lo(y.z), bf_hi(y.z), bf_lo(y.w), bf_hi(y.w)}; }
                    else { xv[mm][bj][0] = *(const f32x4*)(X + off + bj * HALF); xv[mm][bj][1] = *(const f32x4*)(X + off + bj * HALF + 4); } } }
#pragma unroll
            for (int mm = 0; mm < 2; ++mm) { const int m = 2 * mh + mm; const int row = row0 + ai * HALF + m * 16; const size_t off = (size_t)row * ldc + col0;
                float sc = 1.0f;
                if (insq) { float t = (p4[mm][0] + p4[mm][1]) + (p4[mm][2] + p4[mm][3]); t += __shfl_xor(t, 16); t += __shfl_xor(t, 32); sc = rsqrtf(t * inv_indim + 1e-6f); }
                float ss = 0.f;
#pragma unroll
                for (int bj = 0; bj < 2; ++bj) { const f32x4 o0 = xv[mm][bj][0] + acc[ai][bj][m][0] * sc, o1 = xv[mm][bj][1] + acc[ai][bj][m][1] * sc;
                    ss += ((o0[0] * o0[0] + o0[1] * o0[1]) + (o0[2] * o0[2] + o0[3] * o0[3])) + ((o1[0] * o1[0] + o1[1] * o1[1]) + (o1[2] * o1[2] + o1[3] * o1[3]));
                    u32x4 w; w.x = cvt_pk_bf16(o0[0], o0[1]); w.y = cvt_pk_bf16(o0[2], o0[3]); w.z = cvt_pk_bf16(o1[0], o1[1]); w.w = cvt_pk_bf16(o1[2], o1[3]);
                    *(u32x4*)(OB + off + bj * HALF) = w; }
                if (outsq) { ss += __shfl_xor(ss, 16); ss += __shfl_xor(ss, 32); if (fq == 0) outsq[(size_t)row * 32 + u.pn * 4 + wc] = ss; } }
        }
    }
};
struct EpiSwiGlu {
    static constexpr bool PERM = true, AFTER_DRAIN = false;
    bf16_t* O; int ldc; const float* insq; float inv_indim; const float* rs_lds; int pm_lds;
    __device__ __forceinline__ void operator()(const f32x4 (&acc)[2][2][4][2], const Unit& u, int wr, int wc, int fr, int fq) const {
        const int row0 = u.pm * BM + wr * 64 + fr, col0 = u.pn * HALF + wc * 32 + 8 * fq;
        float scv[2][4];
        if (u.pm == pm_lds) {
#pragma unroll
          for (int ai = 0; ai < 2; ++ai)
#pragma unroll
              for (int m = 0; m < 4; ++m) scv[ai][m] = rs_lds[wr * 64 + fr + ai * HALF + m * 16];
        } else { f32x4 pa[2][4], pb[2][4];
#pragma unroll
          for (int ai = 0; ai < 2; ++ai)
#pragma unroll
              for (int m = 0; m < 4; ++m) { const float* pp = insq + (size_t)(row0 + ai * HALF + m * 16) * 32 + 8 * fq; pa[ai][m] = *(const f32x4*)pp; pb[ai][m] = *(const f32x4*)(pp + 4); }
#pragma unroll
          for (int ai = 0; ai < 2; ++ai)
#pragma unroll
              for (int m = 0; m < 4; ++m) { float t = ((pa[ai][m][0] + pa[ai][m][1]) + (pa[ai][m][2] + pa[ai][m][3])) + ((pb[ai][m][0] + pb[ai][m][1]) + (pb[ai][m][2] + pb[ai][m][3]));
                  t += __shfl_xor(t, 16); t += __shfl_xor(t, 32); scv[ai][m] = rsqrtf(t * inv_indim + 1e-6f); } }
#pragma unroll
        for (int ai = 0; ai < 2; ++ai)
#pragma unroll
            for (int m = 0; m < 4; ++m) { const int row = row0 + ai * HALF + m * 16; bf16_t* rowp = O + (size_t)row * ldc + col0;
                const float sc = scv[ai][m];
                f32x4 r0, r1;
#pragma unroll
                for (int j = 0; j < 4; ++j) { const float g0 = acc[ai][0][m][0][j] * sc, g1 = acc[ai][0][m][1][j] * sc;
                    r0[j] = g0 * sigmoid_f(g0) * (acc[ai][1][m][0][j] * sc); r1[j] = g1 * sigmoid_f(g1) * (acc[ai][1][m][1][j] * sc); }
                u32x4 w; w.x = cvt_pk_bf16(r0[0], r0[1]); w.y = cvt_pk_bf16(r0[2], r0[3]); w.z = cvt_pk_bf16(r1[0], r1[1]); w.w = cvt_pk_bf16(r1[2], r1[3]);
                *(u32x4*)rowp = w; }
    }
};


template <class Epi, class Sched, bool ALIGN_EPI = false, bool SP2 = false>
__device__ __forceinline__ void gemm_phase(PG8_LAS unsigned char* lds, const Gemm g, const Sched& S, const Epi& E) {
    int tid_ = threadIdx.x; asm volatile("" : "+v"(tid_));
    const int tid = tid_, wid = __builtin_amdgcn_readfirstlane(tid >> 6), lane = tid & 63, wr = wid >> 2, wc = wid & 3, fr = lane & 15, fq = lane >> 4;
    const int K = g.K, nt = K / BK;
    unsigned voffA[2], voffB[2];
#pragma unroll
    for (int i = 0; i < 2; ++i) { int R, C; stage_rc(tid * 16 + i * 8192, R, C); const int Rb = Epi::PERM ? ((R & ~31) + perm32(R & 31)) : R;
        voffA[i] = (unsigned)(R * K + C) * 2u; voffB[i] = (unsigned)(Rb * K + C) * 2u; }
    const size_t kstep = (size_t)(BK * 2);
    const size_t hstep = (size_t)HALF * K * 2;
    const size_t tstep = 2 * hstep;
    const unsigned ldsw = (unsigned)wid * 1024u;
    const int aoff = lds_byte(wr * 64 + fr, fq * 8), boff = lds_byte(wc * 32 + fr, fq * 8);
#define PG8_SA(b, h) (((b) * 2 + (h)) * HTB)
#define PG8_SB(b, h) ((4 + (b) * 2 + (h)) * HTB)
#define PG8_STAGE(bufoff, gbase, voff) do { _Pragma("unroll") for (int _i = 0; _i < 2; ++_i) \
        __builtin_amdgcn_global_load_lds((const unsigned*)((const char*)(gbase) + (voff)[_i]), (PG8_LAS unsigned*)(lds + (bufoff) + ldsw + _i * 8192), 16, 0, 0); } while (0)
#define PG8_LDA(dst, b, h) do { _Pragma("unroll") for (int m = 0; m < 4; ++m) _Pragma("unroll") for (int k = 0; k < 2; ++k) dst[m][k] = *(const PG8_LAS bf16x8*)(lds + PG8_SA(b, h) + aoff + m * 2048 + k * 1024); } while (0)
#define PG8_LDB(dst, b, h) do { _Pragma("unroll") for (int n = 0; n < 2; ++n) _Pragma("unroll") for (int k = 0; k < 2; ++k) dst[n][k] = *(const PG8_LAS bf16x8*)(lds + PG8_SB(b, h) + boff + n * 2048 + k * 1024); } while (0)
#define PG8_MMA(ai, bj, At, Bt) do { __builtin_amdgcn_s_setprio(1); _Pragma("unroll") for (int m = 0; m < 4; ++m) _Pragma("unroll") for (int n = 0; n < 2; ++n) _Pragma("unroll") for (int k = 0; k < 2; ++k) \
        acc[ai][bj][m][n] = __builtin_amdgcn_mfma_f32_16x16x32_bf16(Bt[n][k], At[m][k], acc[ai][bj][m][n], 0, 0, 0); __builtin_amdgcn_s_setprio(0); } while (0)
#define PG8_WAIT_V(n) asm volatile("s_waitcnt vmcnt(" #n ")" ::: "memory")
#define PG8_WAIT_L(n) asm volatile("s_waitcnt lgkmcnt(" #n ")" ::: "memory")
#define PG8_BAR __builtin_amdgcn_s_barrier()
#define PG8_SCHED __builtin_amdgcn_sched_barrier(0)
    Unit cur, nxt; int ui = 0;
    if (!S.next(0, cur)) return;
    f32x4 acc[2][2][4][2];
#pragma unroll
    for (int a = 0; a < 2; ++a)
#pragma unroll
        for (int b = 0; b < 2; ++b)
#pragma unroll
            for (int m = 0; m < 4; ++m)
#pragma unroll
                for (int n = 0; n < 2; ++n) acc[a][b][m][n] = (f32x4){0.f, 0.f, 0.f, 0.f};
    bf16x8 At[4][2], B0[2][2], B1[2][2];
    const char* cA = (const char*)g.A + (size_t)cur.pm * tstep; const char* cB = (const char*)g.Bt + (size_t)cur.pn * tstep;
    S.a_ready(cur);
    if constexpr (SP2) {
        PG8_STAGE(PG8_SB(0, 0), cB, voffB); PG8_STAGE(PG8_SB(0, 1), cB + hstep, voffB); PG8_STAGE(PG8_SA(0, 0), cA, voffA); PG8_STAGE(PG8_SA(0, 1), cA + hstep, voffA);
        if (wr == 1) PG8_BAR;
        PG8_WAIT_V(2); PG8_BAR;
        PG8_STAGE(PG8_SB(1, 0), cB + kstep, voffB); PG8_STAGE(PG8_SA(1, 0), cA + kstep, voffA); PG8_STAGE(PG8_SB(1, 1), cB + hstep + kstep, voffB);
        PG8_WAIT_V(6); PG8_BAR;
    } else {
        PG8_STAGE(PG8_SB(0, 0), cB, voffB); PG8_STAGE(PG8_SA(0, 0), cA, voffA); PG8_STAGE(PG8_SB(0, 1), cB + hstep, voffB); PG8_STAGE(PG8_SA(0, 1), cA + hstep, voffA);
        if (wr == 1) PG8_BAR;
        PG8_WAIT_V(4); PG8_BAR;
        PG8_STAGE(PG8_SB(1, 0), cB + kstep, voffB); PG8_STAGE(PG8_SA(1, 0), cA + kstep, voffA); PG8_STAGE(PG8_SB(1, 1), cB + hstep + kstep, voffB);
        PG8_WAIT_V(6); PG8_BAR;
    }
    for (;;) {
        const bool has_next = S.next(ui + 1, nxt);
        const char* nA = has_next ? (const char*)g.A + (size_t)nxt.pm * tstep : cA; const char* nB = has_next ? (const char*)g.Bt + (size_t)nxt.pn * tstep : cB;
        for (int t = 0; t < nt; t += 2) {
            const bool last = (t == nt - 2);
            const char* a1 = cA + (size_t)(t + 1) * kstep;
            const char* a2 = last ? nA : cA + (size_t)(t + 2) * kstep; const char* b2 = last ? nB : cB + (size_t)(t + 2) * kstep;
            const char* a3 = a2 + kstep; const char* b3 = b2 + kstep;
            if (last && has_next) S.a_ready(nxt);
            if constexpr (SP2) {
            PG8_LDB(B0, 0, 0); PG8_LDB(B1, 0, 1); PG8_SCHED; PG8_LDA(At, 0, 0); PG8_STAGE(PG8_SA(1, 1), a1 + hstep, voffA);
            PG8_WAIT_V(8); PG8_WAIT_L(0); PG8_BAR; PG8_MMA(0, 0, At, B0); PG8_MMA(0, 1, At, B1); PG8_BAR; PG8_SCHED;
            PG8_LDA(At, 0, 1); PG8_STAGE(PG8_SB(0, 0), b2, voffB); PG8_STAGE(PG8_SB(0, 1), b2 + hstep, voffB); PG8_STAGE(PG8_SA(0, 0), a2, voffA);
            PG8_WAIT_V(8); PG8_WAIT_L(0); PG8_BAR; PG8_MMA(1, 0, At, B0); PG8_MMA(1, 1, At, B1); PG8_BAR; PG8_SCHED;
            PG8_LDB(B0, 1, 0); PG8_LDB(B1, 1, 1); PG8_SCHED; PG8_LDA(At, 1, 0); PG8_STAGE(PG8_SA(0, 1), a2 + hstep, voffA);
            PG8_WAIT_V(8); PG8_WAIT_L(0); PG8_BAR; PG8_MMA(0, 0, At, B0); PG8_MMA(0, 1, At, B1); PG8_BAR; PG8_SCHED;
            PG8_LDA(At, 1, 1); PG8_STAGE(PG8_SB(1, 0), b3, voffB); PG8_STAGE(PG8_SB(1, 1), b3 + hstep, voffB); PG8_STAGE(PG8_SA(1, 0), a3, voffA);
            PG8_WAIT_V(8); PG8_WAIT_L(0); PG8_BAR; PG8_MMA(1, 0, At, B0); PG8_MMA(1, 1, At, B1); PG8_BAR; PG8_SCHED;
            } else {
            PG8_LDB(B0, 0, 0); PG8_SCHED; PG8_LDA(At, 0, 0); PG8_STAGE(PG8_SA(1, 1), a1 + hstep, voffA);
            PG8_WAIT_L(8); PG8_BAR; PG8_WAIT_L(0); PG8_MMA(0, 0, At, B0); PG8_BAR; PG8_SCHED;
            PG8_LDB(B1, 0, 1); PG8_STAGE(PG8_SB(0, 0), b2, voffB);
            PG8_BAR; PG8_WAIT_L(0); PG8_MMA(0, 1, At, B1); PG8_BAR;
            PG8_LDA(At, 0, 1); PG8_STAGE(PG8_SA(0, 0), a2, voffA);
            PG8_BAR; PG8_WAIT_L(0); PG8_MMA(1, 0, At, B0); PG8_BAR; PG8_SCHED;
            PG8_STAGE(PG8_SB(0, 1), b2 + hstep, voffB);
            PG8_WAIT_V(6); PG8_BAR; PG8_MMA(1, 1, At, B1); PG8_BAR;
            PG8_LDB(B0, 1, 0); PG8_SCHED; PG8_LDA(At, 1, 0); PG8_STAGE(PG8_SA(0, 1), a2 + hstep, voffA);
            PG8_WAIT_L(8); PG8_BAR; PG8_WAIT_L(0); PG8_MMA(0, 0, At, B0); PG8_BAR; PG8_SCHED;
            PG8_LDB(B1, 1, 1); PG8_STAGE(PG8_SB(1, 0), b3, voffB);
            PG8_BAR; PG8_WAIT_L(0); PG8_MMA(0, 1, At, B1); PG8_BAR;
            PG8_LDA(At, 1, 1); PG8_STAGE(PG8_SA(1, 0), a3, voffA);
            PG8_BAR; PG8_WAIT_L(0); PG8_MMA(1, 0, At, B0); PG8_BAR; PG8_SCHED;
            PG8_STAGE(PG8_SB(1, 1), b3 + hstep, voffB);
            PG8_WAIT_V(6); PG8_BAR; PG8_MMA(1, 1, At, B1); PG8_BAR;
            }
        }
        if constexpr (ALIGN_EPI) { if (wr == 0) PG8_BAR; }
        if constexpr (!Epi::AFTER_DRAIN) { E(acc, cur, wr, wc, fr, fq); S.done(cur); }
        if (!has_next) break;
#pragma unroll
        for (int a = 0; a < 2; ++a)
#pragma unroll
            for (int b = 0; b < 2; ++b)
#pragma unroll
                for (int m = 0; m < 4; ++m)
#pragma unroll
                    for (int n = 0; n < 2; ++n) acc[a][b][m][n] = (f32x4){0.f, 0.f, 0.f, 0.f};
        cur = nxt; cA = nA; cB = nB; ++ui;
        if constexpr (ALIGN_EPI) { if (wr == 1) PG8_BAR; }
    }
    PG8_WAIT_V(0);
    if constexpr (!ALIGN_EPI) { if (wr == 0) PG8_BAR; }
    PG8_BAR;
    if constexpr (Epi::AFTER_DRAIN) { E.fused(acc, cur, wr, wc, fr, fq, lds, wid, lane); S.done(cur); }
#undef PG8_SA
#undef PG8_SB
#undef PG8_STAGE
#undef PG8_LDA
#undef PG8_LDB
#undef PG8_MMA
#undef PG8_WAIT_V
#undef PG8_WAIT_L
#undef PG8_BAR
#undef PG8_SCHED
}
}

typedef unsigned short bf16;
typedef short bf16x8 __attribute__((ext_vector_type(8)));
typedef float f32x4 __attribute__((ext_vector_type(4)));
typedef float f32x2 __attribute__((ext_vector_type(2)));
typedef float f32x16 __attribute__((ext_vector_type(16)));
typedef unsigned u32x4 __attribute__((ext_vector_type(4)));
typedef unsigned u32x2 __attribute__((ext_vector_type(2)));

constexpr int DM = 2048, SEQ = 8192, MTOK = 16384, INW = 5120, RW = 1024, NH = 8, HD = 128, SW = 1024, NG = 64, NP = 64, DFF = 5632;
constexpr float EPS = 1e-6f;
constexpr size_t MiB = 1u << 20;
constexpr size_t WS_WIN = 0, WS_WGLU = 20 * MiB, WS_WOUT = 22 * MiB, WS_WGU = 30 * MiB, WS_WD = 74 * MiB, WS_ROPE = 96 * MiB, WS_S5P = 100 * MiB, WS_S5ST = 101 * MiB,
                 WS_BUFA = 102 * MiB, WS_PROJ = 166 * MiB, WS_KV = 326 * MiB, WS_Y1 = 390 * MiB, WS_Y2 = 422 * MiB, WS_CTL = 454 * MiB, WS_SQ1 = 455 * MiB, WS_SQ2 = 457 * MiB, WS_TOT = 458 * MiB, WS_END = 466 * MiB, WS_ACT = WS_PROJ, WS_X1B = WS_Y1;
constexpr size_t CTL_XID = 16384, CTL_GRP = 32768, CTL_ZERO = 131072;
constexpr size_t S5P_BBT = 0, S5P_CMT = 256 * 1024, S5P_LAM = 512 * 1024, S5P_LAML = 544 * 1024;
constexpr int LDS_BYTES = 137216, LDS_KEEP = 135168, S5_WLDS = 16896;
constexpr int NPHASE = 12;

__device__ __forceinline__ int panel_of(int c) { return 8 * (c & 7) + ((c >> 3) & 7); }

struct Params { const float* in[21]; float* out; unsigned char* ws; };

#define MFMA32(a, b, c) __builtin_amdgcn_mfma_f32_32x32x16_bf16((a), (b), (c), 0, 0, 0)
#define MFMA16(a, b, c) __builtin_amdgcn_mfma_f32_16x16x32_bf16((a), (b), (c), 0, 0, 0)
#define LDS_FENCE() asm volatile("s_waitcnt lgkmcnt(0)" ::: "memory")

__device__ __forceinline__ float bflo(unsigned w) { return __uint_as_float(w << 16); }
__device__ __forceinline__ float bfhi(unsigned w) { return __uint_as_float(w & 0xffff0000u); }
__device__ __forceinline__ unsigned pk2(float lo, float hi) { return pg8::cvt_pk_bf16(lo, hi); }
__device__ __forceinline__ float wave_sum(float v) {
#pragma unroll
    for (int o = 1; o < 64; o <<= 1) v += __shfl_xor(v, o);
    return v;
}
__device__ __forceinline__ void sincos_d(double x, double& s, double& c) {
    const double k = rint(x * 0.63661977236758134308);
    double r = fma(-k, 1.57079632679489655800e+00, x); r = fma(-k, 6.12323399573676603587e-17, r);
    const int q = ((int)(long long)k) & 3;
    const double r2 = r * r;
    const double sn = r * (1.0 + r2 * (-1.0 / 6.0 + r2 * (1.0 / 120.0 + r2 * (-1.0 / 5040.0 + r2 * (1.0 / 362880.0 + r2 * (-1.0 / 39916800.0 + r2 * (1.0 / 6227020800.0 + r2 * (-1.0 / 1307674368000.0))))))));
    const double cs = 1.0 + r2 * (-0.5 + r2 * (1.0 / 24.0 + r2 * (-1.0 / 720.0 + r2 * (1.0 / 40320.0 + r2 * (-1.0 / 3628800.0 + r2 * (1.0 / 479001600.0 + r2 * (-1.0 / 87178291200.0 + r2 * (1.0 / 20922789888000.0))))))));
    s = (q == 0) ? sn : (q == 1) ? cs : (q == 2) ? -sn : -cs;
    c = (q == 0) ? cs : (q == 1) ? -sn : (q == 2) ? -cs : sn;
}

__device__ __forceinline__ void p0_transpose_item(const float* W, int K, int N, bf16* WT, int k0, int n0, int dst_row0, float* scr, int lane, const float* kscale = nullptr) {
#pragma unroll 8
    for (int i = 0; i < 32; ++i) { const int kk = 2 * i + (lane >> 5); scr[kk * 33 + (lane & 31)] = W[(size_t)(k0 + kk) * N + n0 + (lane & 31)]; }
    const int c = lane & 7;
    f32x4 ks0 = (f32x4){1.f, 1.f, 1.f, 1.f}, ks1 = ks0;
    if (kscale) { ks0 = *(const f32x4*)(kscale + k0 + 8 * c); ks1 = *(const f32x4*)(kscale + k0 + 8 * c + 4); }
    LDS_FENCE();
#pragma unroll
    for (int j = 0; j < 4; ++j) { const int n = (lane >> 3) + 8 * j; const float* s = scr + (8 * c) * 33 + n;
        u32x4 o; o.x = pk2(s[0 * 33] * ks0.x, s[1 * 33] * ks0.y); o.y = pk2(s[2 * 33] * ks0.z, s[3 * 33] * ks0.w); o.z = pk2(s[4 * 33] * ks1.x, s[5 * 33] * ks1.y); o.w = pk2(s[6 * 33] * ks1.z, s[7 * 33] * ks1.w);
        *(u32x4*)(WT + (size_t)(dst_row0 + n) * K + k0 + 8 * c) = o; }
    LDS_FENCE();
}
__device__ __forceinline__ void rms_row_to_bf16(const float* xrow, const float* g, bf16* orow, int lane) {
    const f32x4* xr = (const f32x4*)xrow + lane; const f32x4* gr = (const f32x4*)g + lane;
    f32x4 v[8]; float s = 0.f;
#pragma unroll
    for (int j = 0; j < 8; ++j) { v[j] = xr[64 * j]; s += (v[j].x * v[j].x + v[j].y * v[j].y) + (v[j].z * v[j].z + v[j].w * v[j].w); }
    const float r = rsqrtf(wave_sum(s) * (1.f / DM) + EPS);
    u32x2* o8 = (u32x2*)orow + lane;
#pragma unroll
    for (int j = 0; j < 8; ++j) { const f32x4 gg = gr[64 * j]; u32x2 w; w.x = pk2(v[j].x * r * gg.x, v[j].y * r * gg.y); w.y = pk2(v[j].z * r * gg.z, v[j].w * r * gg.w); o8[64 * j] = w; }
}
__device__ __forceinline__ void p0_phase(const Params& P, unsigned char* lds, int tid, int lane, int wave) {
    unsigned char* ws = P.ws;
    const int gw = blockIdx.x * 8 + wave, NGW = gridDim.x * 8;
    float* scr = (float*)(lds + wave * 16384);
    constexpr int I_IN = 32 * 160;
    for (int it = gw; it < I_IN; it += NGW) { const int kb = it / 160, nb = it % 160; p0_transpose_item(P.in[2], DM, INW, (bf16*)(ws + WS_WIN), kb * 64, nb * 32, nb * 32, scr, lane); }
    for (int m = gw; m < MTOK; m += NGW) rms_row_to_bf16(P.in[0] + (size_t)m * DM, P.in[1], (bf16*)(ws + WS_BUFA) + (size_t)m * DM, lane);
    const int gt = blockIdx.x * 512 + tid, NGT = gridDim.x * 512;
    for (int idx = gt; idx < SEQ * 64; idx += NGT) {
        const int pos = idx >> 6, i = idx & 63;
        const double freq = exp(-(double)i * (9.210340371976184 / 64.0));
        double s, c; sincos_d((double)pos * freq, s, c);
        ((f32x2*)(ws + WS_ROPE))[idx] = (f32x2){(float)c, (float)s};
    }
    if (gt < NG * NP) {
        const int g = gt >> 6, p = gt & 63;
        const double dt = exp((double)P.in[6][g]);
        const double ar = (double)P.in[4][gt], ai = (double)P.in[5][gt];
        double sn, cs; sincos_d(ai * dt, sn, cs);
        const double mag = exp(ar * dt), lbr = mag * cs, lbi = mag * sn;
        const double d2 = ar * ar + ai * ai, nr = lbr - 1.0, ni = lbi;
        const double cr = (nr * ar + ni * ai) / d2, ci = (ni * ar - nr * ai) / d2;
        bf16* BbT = (bf16*)(ws + WS_S5P + S5P_BBT); bf16* CmT = (bf16*)(ws + WS_S5P + S5P_CMT);
        const float* bre = P.in[7] + (size_t)gt * 16; const float* bim = P.in[8] + (size_t)gt * 16;
#pragma unroll
        for (int c2 = 0; c2 < 16; c2 += 2) {
            const double br0 = bre[c2], bi0 = bim[c2], br1 = bre[c2 + 1], bi1 = bim[c2 + 1];
            *(unsigned*)(BbT + ((size_t)g * 128 + p) * 16 + c2) = pk2((float)(cr * br0 - ci * bi0), (float)(cr * br1 - ci * bi1));
            *(unsigned*)(BbT + ((size_t)g * 128 + 64 + p) * 16 + c2) = pk2((float)(cr * bi0 + ci * br0), (float)(cr * bi1 + ci * br1));
        }
        ((f32x2*)(ws + WS_S5P + S5P_LAM))[gt] = (f32x2){(float)lbr, (float)lbi};
        double sL, cL; sincos_d(ai * dt * 512.0, sL, cL); const double mL = exp(ar * dt * 512.0);
        ((f32x2*)(ws + WS_S5P + S5P_LAML))[gt] = (f32x2){(float)(mL * cL), (float)(mL * sL)};
        const int n = p & 31, blk = p >> 5;
#pragma unroll
        for (int c = 0; c < 16; ++c) {
            const float cre = P.in[9][((size_t)g * 16 + c) * 64 + p], cim = P.in[10][((size_t)g * 16 + c) * 64 + p];
            *(unsigned*)(CmT + ((size_t)g * 16 + c) * 128 + 4 * n + 2 * blk) = pk2(cre, -cim);
        }
    }
}

constexpr int RA_KT = 0, RA_VT = 16384;
constexpr int RC_QS = 0, RC_KS = 17408, RC_VT = 34816, RC_PS = 53248, RC_OS = 62464;

__device__ __forceinline__ float head_lg2(int h) { const float t[8] = {-4.5803689613e-02f, -2.2720076500e-02f, -1.1315313228e-02f, -5.6465631411e-03f, -2.8205190624e-03f, -1.4095702547e-03f, -7.0461297659e-04f, -3.5226347163e-04f}; float r = t[0];
#pragma unroll
    for (int i = 1; i < 8; ++i) r = (h == i) ? t[i] : r;
    return r; }

__device__ __forceinline__ int tsw(int r, int tok) { return r * 64 + ((((tok >> 3) ^ ((r ^ (r >> 3)) & 7)) << 3) | (tok & 7)); }
__device__ __forceinline__ int sidx(int e, int d) { return ((((e >> 5) * 8 + (d >> 4)) * 32 + (e & 31)) << 4) + (d & 15); }
__device__ __forceinline__ void rope8(const u32x4 a, const u32x4 b, const f32x2* cs, float (&o1)[8], float (&o2)[8]) {
    const unsigned aw[4] = {a.x, a.y, a.z, a.w}, bw[4] = {b.x, b.y, b.z, b.w};
#pragma unroll
    for (int j = 0; j < 4; ++j) {
        const f32x2 c0 = cs[2 * j], c1 = cs[2 * j + 1];
        const float x1a = bflo(aw[j]), x1b = bfhi(aw[j]), x2a = bflo(bw[j]), x2b = bfhi(bw[j]);
        o1[2 * j] = x1a * c0.x - x2a * c0.y; o2[2 * j] = x2a * c0.x + x1a * c0.y;
        o1[2 * j + 1] = x1b * c1.x - x2b * c1.y; o2[2 * j + 1] = x2b * c1.x + x1b * c1.y;
    }
}

__device__ __forceinline__ void ret_pass_a(const Params& P, unsigned char* lds, int tid, int lane, int wave) {
    unsigned char* ws = P.ws;
    const bf16* proj = (const bf16*)(ws + WS_PROJ); const u32x4* rope = (const u32x4*)(ws + WS_ROPE); bf16* KV = (bf16*)(ws + WS_KV);
    const int tok = tid >> 3, dg = tid & 7;
    u32x4 k1, k2, v1, v2, c0, c1, c2, c3;
#define RA_LOAD(uu) do { const int bh_ = (uu) >> 7, n_ = (uu) & 127; const size_t row_ = (size_t)(bh_ >> 3) * SEQ + n_ * 64 + tok; \
        const bf16* kp_ = proj + row_ * INW + RW + (bh_ & 7) * HD + dg * 8; const u32x4* cp_ = rope + ((size_t)(n_ * 64 + tok) * 64 + dg * 8) / 2; \
        k1 = *(const u32x4*)kp_; k2 = *(const u32x4*)(kp_ + 64); v1 = *(const u32x4*)(kp_ + RW); v2 = *(const u32x4*)(kp_ + RW + 64); c0 = cp_[0]; c1 = cp_[1]; c2 = cp_[2]; c3 = cp_[3]; } while (0)
#define RA_STAGE(bsel, lg2_) do { bf16* KT_ = (bf16*)(lds + (bsel) * 32768 + RA_KT); bf16* VT_ = (bf16*)(lds + (bsel) * 32768 + RA_VT); \
        const f32x2 cs_[8] = {(f32x2){__uint_as_float(c0.x), __uint_as_float(c0.y)}, (f32x2){__uint_as_float(c0.z), __uint_as_float(c0.w)}, (f32x2){__uint_as_float(c1.x), __uint_as_float(c1.y)}, (f32x2){__uint_as_float(c1.z), __uint_as_float(c1.w)}, \
                              (f32x2){__uint_as_float(c2.x), __uint_as_float(c2.y)}, (f32x2){__uint_as_float(c2.z), __uint_as_float(c2.w)}, (f32x2){__uint_as_float(c3.x), __uint_as_float(c3.y)}, (f32x2){__uint_as_float(c3.z), __uint_as_float(c3.w)}}; \
        float o1_[8], o2_[8]; rope8(k1, k2, cs_, o1_, o2_); \
        const float ksc_ = 0.08838834764831845f * __builtin_amdgcn_exp2f((lg2_) * (float)(63 - tok)); \
        _Pragma("unroll") for (int j_ = 0; j_ < 8; ++j_) { const unsigned w_ = pk2(o1_[j_] * ksc_, o2_[j_] * ksc_); KT_[tsw(dg * 8 + j_, tok)] = (bf16)(w_ & 0xffffu); KT_[tsw(64 + dg * 8 + j_, tok)] = (bf16)(w_ >> 16); } \
        const unsigned vw1_[4] = {v1.x, v1.y, v1.z, v1.w}, vw2_[4] = {v2.x, v2.y, v2.z, v2.w}; \
        _Pragma("unroll") for (int j_ = 0; j_ < 4; ++j_) { \
            VT_[tsw(dg * 8 + 2 * j_, tok)] = (bf16)(vw1_[j_] & 0xffffu); VT_[tsw(dg * 8 + 2 * j_ + 1, tok)] = (bf16)(vw1_[j_] >> 16); \
            VT_[tsw(64 + dg * 8 + 2 * j_, tok)] = (bf16)(vw2_[j_] & 0xffffu); VT_[tsw(64 + dg * 8 + 2 * j_ + 1, tok)] = (bf16)(vw2_[j_] >> 16); } } while (0)
    f32x16 R0, R1;
#pragma unroll
    for (int i = 0; i < 16; ++i) { R0[i] = 0.f; R1[i] = 0.f; }
    const int u0 = (int)blockIdx.x * 8, h = (u0 >> 7) & 7;
    const float lg2 = head_lg2(h), cdec = __builtin_amdgcn_exp2f(lg2 * 64.f);
    const int dt = wave & 3, et0 = (wave >> 2) * 2, l31 = lane & 31, hh = lane >> 5;
    RA_LOAD(u0);
    RA_STAGE(0, lg2);
    RA_LOAD(u0 + 1);
    for (int ui = 0; ui < 8; ++ui) {
        const int u = u0 + ui;
        __syncthreads();
        if (ui < 7) { RA_STAGE((ui + 1) & 1, lg2); if (ui < 6) RA_LOAD(u + 2); }
        const bf16* KT = (const bf16*)(lds + (ui & 1) * 32768 + RA_KT); const bf16* VT = (const bf16*)(lds + (ui & 1) * 32768 + RA_VT);
        f32x16 acc0, acc1;
#pragma unroll
        for (int i = 0; i < 16; ++i) { acc0[i] = 0.f; acc1[i] = 0.f; }
#pragma unroll
        for (int ks = 0; ks < 4; ++ks) {
            const bf16x8 a = *(const bf16x8*)(KT + tsw(dt * 32 + l31, ks * 16 + 8 * hh));
            const bf16x8 b0 = *(const bf16x8*)(VT + tsw(et0 * 32 + l31, ks * 16 + 8 * hh));
            const bf16x8 b1 = *(const bf16x8*)(VT + tsw((et0 + 1) * 32 + l31, ks * 16 + 8 * hh));
            acc0 = MFMA32(a, b0, acc0); acc1 = MFMA32(a, b1, acc1);
        }
        bf16* kvu = KV + (size_t)u * 16384;
        if (ui > 0)
#pragma unroll
        for (int q = 0; q < 4; ++q) {
            const int d0 = dt * 32 + 8 * q + 4 * hh;
            u32x2 w0; w0.x = pk2(R0[4 * q], R0[4 * q + 1]); w0.y = pk2(R0[4 * q + 2], R0[4 * q + 3]);
            u32x2 w1; w1.x = pk2(R1[4 * q], R1[4 * q + 1]); w1.y = pk2(R1[4 * q + 2], R1[4 * q + 3]);
            *(u32x2*)(kvu + sidx(et0 * 32 + l31, d0)) = w0; *(u32x2*)(kvu + sidx((et0 + 1) * 32 + l31, d0)) = w1;
        }
#pragma unroll
        for (int i = 0; i < 16; ++i) { R0[i] = fmaf(R0[i], cdec, acc0[i]); R1[i] = fmaf(R1[i], cdec, acc1[i]); }
    }
    {
        bf16* tot = (bf16*)(ws + WS_TOT) + (size_t)blockIdx.x * 16384;
#pragma unroll
        for (int q = 0; q < 4; ++q) {
            const int d0 = dt * 32 + 8 * q + 4 * hh;
            u32x2 w0; w0.x = pk2(R0[4 * q], R0[4 * q + 1]); w0.y = pk2(R0[4 * q + 2], R0[4 * q + 3]);
            u32x2 w1; w1.x = pk2(R1[4 * q], R1[4 * q + 1]); w1.y = pk2(R1[4 * q + 2], R1[4 * q + 3]);
            *(u32x2*)(tot + sidx(et0 * 32 + l31, d0)) = w0; *(u32x2*)(tot + sidx((et0 + 1) * 32 + l31, d0)) = w1;
        }
    }
    __syncthreads();
#undef RA_LOAD
#undef RA_STAGE
}

__device__ __forceinline__ void ret_pass_c(const Params& P, unsigned char* lds, int tid, int lane, int wave) {
    unsigned char* ws = P.ws;
    const bf16* proj = (const bf16*)(ws + WS_PROJ); const u32x4* rope = (const u32x4*)(ws + WS_ROPE); const bf16* KV = (const bf16*)(ws + WS_KV);
    bf16* mix = (bf16*)(ws + WS_BUFA);
    bf16* Qs = (bf16*)(lds + RC_QS); bf16* Ks = (bf16*)(lds + RC_KS); bf16* VT = (bf16*)(lds + RC_VT); bf16* Ps = (bf16*)(lds + RC_PS); float* Os = (float*)(lds + RC_OS);
    const int tok = tid >> 3, dg = tid & 7, l31 = lane & 31, hh = lane >> 5, l15 = lane & 15, l4 = lane >> 4;
    const int rt = wave & 1, ct = wave >> 1;
    u32x4 q1, q2, k1, k2, v1, v2, c0, c1, c2, c3;
    bf16x8 st[8];
#define RC_LOAD(uu) do { const int bh_ = (uu) >> 7, n_ = (uu) & 127; const size_t row_ = (size_t)(bh_ >> 3) * SEQ + n_ * 64 + tok; \
        const bf16* qp_ = proj + row_ * INW + (bh_ & 7) * HD + dg * 8; const u32x4* cp_ = rope + ((size_t)(n_ * 64 + tok) * 64 + dg * 8) / 2; \
        q1 = *(const u32x4*)qp_; q2 = *(const u32x4*)(qp_ + 64); k1 = *(const u32x4*)(qp_ + RW); k2 = *(const u32x4*)(qp_ + RW + 64); \
        c0 = cp_[0]; c1 = cp_[1]; c2 = cp_[2]; c3 = cp_[3]; } while (0)
#define RC_LOAD_ST(uu) do { const bf16* sp_ = KV + (size_t)(uu) * 16384 + sidx(ct * 32 + l31, 8 * hh); _Pragma("unroll") for (int ks_ = 0; ks_ < 8; ++ks_) st[ks_] = *(const bf16x8*)(sp_ + ks_ * 512); } while (0)
    const int rowb = panel_of((int)blockIdx.x) * 256 + ((int)blockIdx.x >> 6) * 64, ub = ((rowb >> 13) * 8) * 128 + ((rowb & 8191) >> 6);
    int u = ub;
    RC_LOAD(u);
    for (int hi = 0; hi < 8; ++hi, u += 128) {
        const int bh = u >> 7, n = u & 127, b = bh >> 3, h = bh & 7;
        const int un = (hi < 7) ? u + 128 : u;
        const float lg2 = head_lg2(h);
        { const bf16* cp_ = (const bf16*)(ws + WS_TOT) + ((size_t)bh * 16 + (n >> 3)) * 16384 + sidx(ct * 32 + l31, 8 * hh);
#pragma unroll
          for (int ks = 0; ks < 8; ++ks) st[ks] = *(const bf16x8*)(cp_ + ks * 512); }
        const int t3 = tid >> 3, part = tid & 7;
        const size_t row3 = (size_t)b * SEQ + n * 64 + t3;
        const bf16* gp = proj + row3 * INW + 3 * RW + h * HD + part * 16;
        { const bf16* vp_ = proj + ((size_t)b * SEQ + n * 64 + tok) * INW + 2 * RW + h * HD + dg * 8; v1 = *(const u32x4*)vp_; v2 = *(const u32x4*)(vp_ + 64); }
        u32x4 g0, g1; f32x2 sq2p;
        {
            const f32x2 cs[8] = {(f32x2){__uint_as_float(c0.x), __uint_as_float(c0.y)}, (f32x2){__uint_as_float(c0.z), __uint_as_float(c0.w)}, (f32x2){__uint_as_float(c1.x), __uint_as_float(c1.y)}, (f32x2){__uint_as_float(c1.z), __uint_as_float(c1.w)},
                                 (f32x2){__uint_as_float(c2.x), __uint_as_float(c2.y)}, (f32x2){__uint_as_float(c2.z), __uint_as_float(c2.w)}, (f32x2){__uint_as_float(c3.x), __uint_as_float(c3.y)}, (f32x2){__uint_as_float(c3.z), __uint_as_float(c3.w)}};
            float o1[8], o2[8]; u32x4 w;
            rope8(q1, q2, cs, o1, o2);
            w.x = pk2(o1[0], o1[1]); w.y = pk2(o1[2], o1[3]); w.z = pk2(o1[4], o1[5]); w.w = pk2(o1[6], o1[7]); *(u32x4*)(Qs + tok * 136 + dg * 8) = w;
            w.x = pk2(o2[0], o2[1]); w.y = pk2(o2[2], o2[3]); w.z = pk2(o2[4], o2[5]); w.w = pk2(o2[6], o2[7]); *(u32x4*)(Qs + tok * 136 + 64 + dg * 8) = w;
            rope8(k1, k2, cs, o1, o2);
            w.x = pk2(o1[0], o1[1]); w.y = pk2(o1[2], o1[3]); w.z = pk2(o1[4], o1[5]); w.w = pk2(o1[6], o1[7]); *(u32x4*)(Ks + tok * 136 + dg * 8) = w;
            w.x = pk2(o2[0], o2[1]); w.y = pk2(o2[2], o2[3]); w.z = pk2(o2[4], o2[5]); w.w = pk2(o2[6], o2[7]); *(u32x4*)(Ks + tok * 136 + 64 + dg * 8) = w;
            const unsigned vw1[4] = {v1.x, v1.y, v1.z, v1.w}, vw2[4] = {v2.x, v2.y, v2.z, v2.w};
#pragma unroll
            for (int j = 0; j < 4; ++j) {
                VT[tsw(dg * 8 + 2 * j, tok)] = (bf16)(vw1[j] & 0xffffu); VT[tsw(dg * 8 + 2 * j + 1, tok)] = (bf16)(vw1[j] >> 16);
                VT[tsw(64 + dg * 8 + 2 * j, tok)] = (bf16)(vw2[j] & 0xffffu); VT[tsw(64 + dg * 8 + 2 * j + 1, tok)] = (bf16)(vw2[j] >> 16);
            }
        }
        RC_LOAD(un);
        __syncthreads();
#pragma unroll
        for (int tt = 0; tt < 2; ++tt) {
            const int T = wave * 2 + tt, kt = T & 3, qt = T >> 2;
            f32x4 acc = (f32x4){0.f, 0.f, 0.f, 0.f};
#pragma unroll
            for (int ks = 0; ks < 4; ++ks) {
                const bf16x8 a = *(const bf16x8*)(Ks + (kt * 16 + l15) * 136 + ks * 32 + 8 * l4);
                const bf16x8 bq = *(const bf16x8*)(Qs + (qt * 16 + l15) * 136 + ks * 32 + 8 * l4);
                acc = MFMA16(a, bq, acc);
            }
            const int q = qt * 16 + l15, key0 = kt * 16 + 4 * l4;
            float v[4];
#pragma unroll
            for (int r = 0; r < 4; ++r) { const int dist = q - (key0 + r); v[r] = acc[r] * 0.08838834764831845f * __builtin_amdgcn_exp2f(lg2 * (float)(dist < 0 ? -dist : dist)); }
            u32x2 w; w.x = pk2(v[0], v[1]); w.y = pk2(v[2], v[3]);
            *(u32x2*)(Ps + q * 72 + key0) = w;
        }
        asm volatile("" ::: "memory");
        f32x16 acc;
#pragma unroll
        for (int i = 0; i < 16; ++i) acc[i] = 0.f;
#pragma unroll
        for (int ks = 0; ks < 8; ++ks) { const bf16x8 a = *(const bf16x8*)(Qs + (rt * 32 + l31) * 136 + ks * 16 + 8 * hh); acc = MFMA32(a, st[ks], acc); }
        { const float dj = __builtin_amdgcn_exp2f(lg2 * (float)(64 * (n & 7)));
#pragma unroll
          for (int i = 0; i < 16; ++i) acc[i] *= dj; }
        if (n & 7) RC_LOAD_ST(u);
        __syncthreads();
        {
            if (n & 7) {
#pragma unroll
            for (int ks = 0; ks < 8; ++ks) { const bf16x8 a = *(const bf16x8*)(Qs + (rt * 32 + l31) * 136 + ks * 16 + 8 * hh); acc = MFMA32(a, st[ks], acc); }
            }
#pragma unroll
            for (int i = 0; i < 16; ++i) { const int c = rt * 32 + 8 * (i >> 2) + 4 * hh + (i & 3); acc[i] *= __builtin_amdgcn_exp2f(lg2 * (float)(c + 1)); }
#pragma unroll
            for (int ks = 0; ks < 4; ++ks) {
                const bf16x8 a = *(const bf16x8*)(Ps + (rt * 32 + l31) * 72 + ks * 16 + 8 * hh);
                const bf16x8 bv = *(const bf16x8*)(VT + tsw(ct * 32 + l31, ks * 16 + 8 * hh));
                acc = MFMA32(a, bv, acc);
            }
            g0 = *(const u32x4*)gp; g1 = *(const u32x4*)(gp + 8); sq2p = *(const f32x2*)((const float*)(ws + WS_SQ2) + row3 * 16 + part * 2);
#pragma unroll
            for (int i = 0; i < 16; ++i) { const int c = rt * 32 + 8 * (i >> 2) + 4 * hh + (i & 3); Os[c * 132 + ct * 32 + l31] = acc[i]; }
        }
        __syncthreads();
        {
            const f32x4* op = (const f32x4*)(Os + t3 * 132 + part * 16);
            f32x4 x[4]; float s = 0.f;
#pragma unroll
            for (int j = 0; j < 4; ++j) { x[j] = op[j]; s += (x[j].x + x[j].y) + (x[j].z + x[j].w); }
            s += __shfl_xor(s, 1); s += __shfl_xor(s, 2); s += __shfl_xor(s, 4);
            const float mu = s * (1.f / 128.f); float q2s = 0.f;
#pragma unroll
            for (int j = 0; j < 4; ++j) { x[j] = x[j] - mu; q2s += (x[j].x * x[j].x + x[j].y * x[j].y) + (x[j].z * x[j].z + x[j].w * x[j].w); }
            q2s += __shfl_xor(q2s, 1); q2s += __shfl_xor(q2s, 2); q2s += __shfl_xor(q2s, 4);
            float sq2 = sq2p.x + sq2p.y; sq2 += __shfl_xor(sq2, 1); sq2 += __shfl_xor(sq2, 2); sq2 += __shfl_xor(sq2, 4);
            const float rstd = rsqrtf(q2s * (1.f / 128.f) + EPS) * sqrtf(sq2 * (1.f / SW) + EPS);
            const unsigned gw[8] = {g0.x, g0.y, g0.z, g0.w, g1.x, g1.y, g1.z, g1.w};
            const f32x4* gn = (const f32x4*)(P.in[3] + h * HD + part * 16);
            unsigned ow[8];
#pragma unroll
            for (int j = 0; j < 4; ++j) {
                const f32x4 gg = gn[j];
                const float ga = bflo(gw[2 * j]), gb = bfhi(gw[2 * j]), gc = bflo(gw[2 * j + 1]), gd = bfhi(gw[2 * j + 1]);
                const float ya = ga * pg8::sigmoid_f(ga) * (x[j].x * rstd * gg.x), yb = gb * pg8::sigmoid_f(gb) * (x[j].y * rstd * gg.y);
                const float yc = gc * pg8::sigmoid_f(gc) * (x[j].z * rstd * gg.z), yd = gd * pg8::sigmoid_f(gd) * (x[j].w * rstd * gg.w);
                ow[2 * j] = pk2(ya, yb); ow[2 * j + 1] = pk2(yc, yd);
            }
            bf16* mp = mix + row3 * DM + h * HD + part * 16;
            *(u32x4*)mp = (u32x4){ow[0], ow[1], ow[2], ow[3]}; *(u32x4*)(mp + 8) = (u32x4){ow[4], ow[5], ow[6], ow[7]};
        }
    }
    __syncthreads();
#undef RC_LOAD
#undef RC_LOAD_ST
}

struct ConvItem { const float* W; bf16* WT; const float* ks; int K, N, k0, n0, dst0; };
constexpr int CONV_ITEMS = 16 * 32 + 32 * 64 + 2 * 32 * 176 + 88 * 64;
__device__ __forceinline__ bool conv_decode(const Params& P, int id, ConvItem& c) {
    unsigned char* ws = P.ws;
    constexpr int I_GLU = 16 * 32, I_OUT = 32 * 64, I_GATE = 32 * 176, I_DOWN = 88 * 64;
    int r = id, kb, nb; c.ks = nullptr;
    if (r < 0 || r >= CONV_ITEMS) return false;
    if (r < I_GLU) { c.W = P.in[12]; c.WT = (bf16*)(ws + WS_WGLU); c.K = SW; c.N = SW; kb = r / 32; nb = r % 32; c.dst0 = nb * 32; }
    else if ((r -= I_GLU) < I_OUT) { c.W = P.in[15]; c.WT = (bf16*)(ws + WS_WOUT); c.K = DM; c.N = DM; kb = r / 64; nb = r % 64; c.dst0 = nb * 32; }
    else if ((r -= I_OUT) < I_GATE) { c.W = P.in[17]; c.WT = (bf16*)(ws + WS_WGU); c.K = DM; c.N = DFF; kb = r / 176; nb = r % 176; c.dst0 = ((nb * 32) >> 7) * 256 + ((nb * 32) & 127); c.ks = P.in[16]; }
    else if ((r -= I_GATE) < I_GATE) { c.W = P.in[18]; c.WT = (bf16*)(ws + WS_WGU); c.K = DM; c.N = DFF; kb = r / 176; nb = r % 176; c.dst0 = ((nb * 32) >> 7) * 256 + 128 + ((nb * 32) & 127); c.ks = P.in[16]; }
    else { r -= I_GATE; c.W = P.in[19]; c.WT = (bf16*)(ws + WS_WD); c.K = DFF; c.N = DM; kb = r / 64; nb = r % 64; c.dst0 = nb * 32; }
    c.k0 = kb * 64; c.n0 = nb * 32; return true;
}
__device__ __forceinline__ void conv_issue(const ConvItem& c, unsigned char* scr, int lane) {
    const int kr = lane >> 3, p = lane & 7;
    const float* src = c.W + (size_t)(c.k0 + kr) * c.N + c.n0;
#pragma unroll
    for (int i = 0; i < 8; ++i) { const int sc = p ^ ((kr ^ i) & 7);
        __builtin_amdgcn_global_load_lds((const unsigned*)(src + (size_t)(8 * i) * c.N + 4 * sc), (PG8_LAS unsigned*)(scr + i * 1024), 16, 0, 0); }
}
__device__ __forceinline__ void conv_consume(const ConvItem& c, const unsigned char* scr, int lane) {
    asm volatile("s_waitcnt vmcnt(0)" ::: "memory");
    const int cc = lane & 7;
    f32x4 ks0 = (f32x4){1.f, 1.f, 1.f, 1.f}, ks1 = ks0;
    if (c.ks) { ks0 = *(const f32x4*)(c.ks + c.k0 + 8 * cc); ks1 = *(const f32x4*)(c.ks + c.k0 + 8 * cc + 4); }
#pragma unroll
    for (int j = 0; j < 4; ++j) { const int n = (lane >> 3) + 8 * j; float v[8];
#pragma unroll
        for (int t = 0; t < 8; ++t) v[t] = *(const float*)(scr + (8 * cc + t) * 128 + (((n >> 2) ^ ((t ^ cc) & 7)) * 16) + (n & 3) * 4);
        u32x4 o; o.x = pk2(v[0] * ks0.x, v[1] * ks0.y); o.y = pk2(v[2] * ks0.z, v[3] * ks0.w); o.z = pk2(v[4] * ks1.x, v[5] * ks1.y); o.w = pk2(v[6] * ks1.z, v[7] * ks1.w);
        *(u32x4*)(c.WT + (size_t)(c.dst0 + n) * c.K + c.k0 + 8 * cc) = o; }
    LDS_FENCE();
}

#define CMUL_ADD(or_, oi_, ar_, ai_, br_, bi_, cr_, ci_) do { const float _r = fmaf((ar_), (br_), fmaf(-(ai_), (bi_), (cr_))); const float _i = fmaf((ar_), (bi_), fmaf((ai_), (br_), (ci_))); (or_) = _r; (oi_) = _i; } while (0)
template <bool FULL>
__device__ __forceinline__ void s5_wave(const Params& P, unsigned char* wlds, int b, int g, int ch, int lane, int gw) {
    unsigned char* ws = P.ws;
    const bf16* proj = (const bf16*)(ws + WS_PROJ);
    const bf16* BbT = (const bf16*)(ws + WS_S5P + S5P_BBT); const bf16* CmT = (const bf16*)(ws + WS_S5P + S5P_CMT);
    const f32x2* lamp = (const f32x2*)(ws + WS_S5P + S5P_LAM);
    f32x2* ST = (f32x2*)(ws + WS_S5ST);
    const int n = lane & 31, hh = lane >> 5, l15 = lane & 15, l4 = lane >> 4;
    bf16x8 Bb[4];
#pragma unroll
    for (int v = 0; v < 4; ++v) Bb[v] = *(const bf16x8*)(BbT + ((size_t)g * 128 + (v & 1) * 64 + (v >> 1) * 32 + n) * 16 + 8 * hh);
    float lr[2][4], li[2][4];
#pragma unroll
    for (int k = 0; k < 2; ++k) {
        const f32x2 l1 = lamp[g * 64 + k * 32 + n]; lr[k][0] = l1.x; li[k][0] = l1.y;
#pragma unroll
        for (int e = 1; e < 4; ++e) { lr[k][e] = lr[k][e - 1] * l1.x - li[k][e - 1] * l1.y; li[k][e] = lr[k][e - 1] * l1.y + li[k][e - 1] * l1.x; }
    }
    float car[2], cai[2];
    const size_t stbase = (((size_t)b * 16 + ch) * 64 + g) * 64;
    car[0] = cai[0] = car[1] = cai[1] = 0.f;
    if (FULL) {
        const f32x2* lamL = (const f32x2*)(ws + WS_S5P + S5P_LAML);
        const f32x2 L0 = lamL[g * 64 + n], L1 = lamL[g * 64 + 32 + n];
        for (int c = 0; c < ch; ++c) { const size_t eb = (((size_t)b * 16 + c) * 64 + g) * 64; const f32x2 e0 = ST[eb + n], e1 = ST[eb + 32 + n];
            CMUL_ADD(car[0], cai[0], L0.x, L0.y, car[0], cai[0], e0.x, e0.y); CMUL_ADD(car[1], cai[1], L1.x, L1.y, car[1], cai[1], e1.x, e1.y); }
    }
    bf16x8 Cm[4];
    f32x4 dsk = (f32x4){0.f, 0.f, 0.f, 0.f};
    if (FULL) {
#pragma unroll
        for (int ks = 0; ks < 4; ++ks) Cm[ks] = *(const bf16x8*)(CmT + ((size_t)g * 16 + l15) * 128 + ks * 32 + 8 * l4);
        dsk = *(const f32x4*)(P.in[11] + g * 16 + 4 * l4);
    }
    bf16* y1 = (bf16*)(ws + WS_Y1);
    for (int sb = 0; sb < 16; ++sb) {
        const size_t row0 = (size_t)b * SEQ + ch * 512 + sb * 32;
        const bf16x8 U = *(const bf16x8*)(proj + (row0 + n) * INW + 4 * RW + g * 16 + 8 * hh);
        f32x16 bu[4];
#pragma unroll
        for (int v = 0; v < 4; ++v) {
#pragma unroll
            for (int i = 0; i < 16; ++i) bu[v][i] = 0.f;
            bu[v] = MFMA32(U, Bb[v], bu[v]);
        }
        ConvItem cvi; bool cvok = false;
        if (FULL && sb < 10) { cvok = conv_decode(P, sb * 2048 + gw, cvi); if (cvok) conv_issue(cvi, wlds + 8704, lane); }
        float er[2][4], ei[2][4];
#pragma unroll
        for (int k = 0; k < 2; ++k)
#pragma unroll
            for (int q = 0; q < 4; ++q) {
                float sr = bu[2 * k][4 * q], si = bu[2 * k + 1][4 * q];
#pragma unroll
                for (int j = 1; j < 4; ++j) { CMUL_ADD(sr, si, lr[k][0], li[k][0], sr, si, bu[2 * k][4 * q + j], bu[2 * k + 1][4 * q + j]); bu[2 * k][4 * q + j] = sr; bu[2 * k + 1][4 * q + j] = si; }
                er[k][q] = sr; ei[k][q] = si;
            }
        float mr[2][4], mi[2][4];
#pragma unroll
        for (int k = 0; k < 2; ++k) {
            float cr = car[k], ci = cai[k];
#pragma unroll
            for (int q = 0; q < 4; ++q) {
                const float pr = __shfl_xor(er[k][q], 32), pi = __shfl_xor(ei[k][q], 32);
                const float ear = hh ? pr : er[k][q], eai = hh ? pi : ei[k][q];
                const float ebr = hh ? er[k][q] : pr, ebi = hh ? ei[k][q] : pi;
                float c1r, c1i, c2r, c2i;
                CMUL_ADD(c1r, c1i, lr[k][3], li[k][3], cr, ci, ear, eai);
                CMUL_ADD(c2r, c2i, lr[k][3], li[k][3], c1r, c1i, ebr, ebi);
                mr[k][q] = hh ? c1r : cr; mi[k][q] = hh ? c1i : ci;
                cr = c2r; ci = c2i;
            }
            car[k] = cr; cai[k] = ci;
        }
        if (FULL) {
#pragma unroll
            for (int q = 0; q < 4; ++q)
#pragma unroll
                for (int j = 0; j < 4; ++j) {
                    float s0r, s0i, s1r, s1i;
                    CMUL_ADD(s0r, s0i, lr[0][j], li[0][j], mr[0][q], mi[0][q], bu[0][4 * q + j], bu[1][4 * q + j]);
                    CMUL_ADD(s1r, s1i, lr[1][j], li[1][j], mr[1][q], mi[1][q], bu[2][4 * q + j], bu[3][4 * q + j]);
                    u32x2 w; w.x = pk2(s0r, s0i); w.y = pk2(s1r, s1i);
                    *(u32x2*)(wlds + (8 * q + 4 * hh + j) * 272 + n * 8) = w;
                }
            LDS_FENCE();
            f32x4 yt[2];
#pragma unroll
            for (int tt = 0; tt < 2; ++tt) {
                yt[tt] = (f32x4){0.f, 0.f, 0.f, 0.f};
#pragma unroll
                for (int ks = 0; ks < 4; ++ks) { const bf16x8 sv = *(const bf16x8*)(wlds + (tt * 16 + l15) * 272 + (ks * 32 + 8 * l4) * 2); yt[tt] = MFMA16(Cm[ks], sv, yt[tt]); }
            }
            LDS_FENCE();
#pragma unroll
            for (int tt = 0; tt < 2; ++tt) {
                const size_t row = row0 + tt * 16 + l15;
                const u32x2 uw = *(const u32x2*)(proj + row * INW + 4 * RW + g * 16 + 4 * l4);
                const float uu[4] = {bflo(uw.x), bfhi(uw.x), bflo(uw.y), bfhi(uw.y)};
                float o[4];
#pragma unroll
                for (int r = 0; r < 4; ++r) { const float y = yt[tt][r] + dsk[r] * uu[r]; const float z = 1.5957691216057308f * (y + 0.044715f * y * y * y); o[r] = y * pg8::sigmoid_f(z); }
                u32x2 w; w.x = pk2(o[0], o[1]); w.y = pk2(o[2], o[3]);
                *(u32x2*)(y1 + row * SW + g * 16 + 4 * l4) = w;
            }
            if (cvok) conv_consume(cvi, wlds + 8704, lane);
        }
    }
    if (!FULL) { if (hh == 0) { ST[stbase + n] = (f32x2){car[0], cai[0]}; ST[stbase + 32 + n] = (f32x2){car[1], cai[1]}; } }
}

__device__ __forceinline__ void scan_phase(const Params& P, int tid) {
    unsigned char* ws = P.ws;
    const int gt = blockIdx.x * 512 + tid, NGT = gridDim.x * 512;
    for (int e = gt; e < 16 * 8192; e += NGT) {
        const int bh = e >> 13, off = (e & 8191) * 2, h = bh & 7;
        const float dec = __builtin_amdgcn_exp2f(head_lg2(h) * 512.f);
        unsigned* p = (unsigned*)((bf16*)(ws + WS_TOT) + (size_t)bh * 16 * 16384 + off);
        unsigned kv[16];
#pragma unroll
        for (int j = 0; j < 16; ++j) kv[j] = p[(size_t)j * 8192];
        float s0 = 0.f, s1 = 0.f;
#pragma unroll
        for (int j = 0; j < 16; ++j) { p[(size_t)j * 8192] = pk2(s0, s1); s0 = fmaf(s0, dec, bflo(kv[j])); s1 = fmaf(s1, dec, bfhi(kv[j])); }
    }
}

__device__ __forceinline__ void ssm_norm_phase(const Params& P, int lane, int wave) {
    unsigned char* ws = P.ws; const bf16* y2 = (const bf16*)(ws + WS_Y2); bf16* mix = (bf16*)(ws + WS_BUFA);
    const int gw = blockIdx.x * 8 + wave, NGW = gridDim.x * 8;
    for (int m = gw; m < MTOK; m += NGW) {
        const u32x4 a = *(const u32x4*)(y2 + (size_t)m * SW + lane * 8), c = *(const u32x4*)(y2 + (size_t)m * SW + 512 + lane * 8);
        const unsigned w[8] = {a.x, a.y, a.z, a.w, c.x, c.y, c.z, c.w};
        float v[16]; float s = 0.f;
#pragma unroll
        for (int j = 0; j < 8; ++j) { v[2 * j] = bflo(w[j]); v[2 * j + 1] = bfhi(w[j]); s += v[2 * j] * v[2 * j] + v[2 * j + 1] * v[2 * j + 1]; }
        const float r = rsqrtf(wave_sum(s) * (1.f / SW) + EPS);
        const f32x4* g0 = (const f32x4*)(P.in[14] + lane * 8); const f32x4* g1 = (const f32x4*)(P.in[14] + 512 + lane * 8);
        const f32x4 ga = g0[0], gb = g0[1], gc = g1[0], gd = g1[1];
        u32x4 o0, o1;
        o0.x = pk2(v[0] * r * ga.x, v[1] * r * ga.y); o0.y = pk2(v[2] * r * ga.z, v[3] * r * ga.w); o0.z = pk2(v[4] * r * gb.x, v[5] * r * gb.y); o0.w = pk2(v[6] * r * gb.z, v[7] * r * gb.w);
        o1.x = pk2(v[8] * r * gc.x, v[9] * r * gc.y); o1.y = pk2(v[10] * r * gc.z, v[11] * r * gc.w); o1.z = pk2(v[12] * r * gd.x, v[13] * r * gd.y); o1.w = pk2(v[14] * r * gd.z, v[15] * r * gd.w);
        *(u32x4*)(mix + (size_t)m * DM + RW + lane * 8) = o0; *(u32x4*)(mix + (size_t)m * DM + RW + 512 + lane * 8) = o1;
    }
}
__device__ __forceinline__ void final_norm_phase(const Params& P, int lane, int wave) {
    const bf16* x2 = (const bf16*)(P.ws + WS_BUFA);
    const int mb = panel_of((int)blockIdx.x) * 256 + ((int)blockIdx.x >> 6) * 64 + wave * 8;
    for (int m = mb; m < mb + 8; ++m) {
        const bf16* xr = x2 + (size_t)m * DM + lane * 8;
        u32x4 w[4]; float s = 0.f;
#pragma unroll
        for (int j = 0; j < 4; ++j) w[j] = *(const u32x4*)(xr + 512 * j);
        float v[4][8];
#pragma unroll
        for (int j = 0; j < 4; ++j) { const unsigned ww[4] = {w[j].x, w[j].y, w[j].z, w[j].w};
#pragma unroll
            for (int k = 0; k < 4; ++k) { v[j][2 * k] = bflo(ww[k]); v[j][2 * k + 1] = bfhi(ww[k]); s += v[j][2 * k] * v[j][2 * k] + v[j][2 * k + 1] * v[j][2 * k + 1]; } }
        const float r = rsqrtf(wave_sum(s) * (1.f / DM) + EPS);
        float* orow = P.out + (size_t)m * DM + lane * 8; const float* gr = P.in[20] + lane * 8;
#pragma unroll
        for (int j = 0; j < 4; ++j) { const f32x4 g0 = *(const f32x4*)(gr + 512 * j), g1 = *(const f32x4*)(gr + 512 * j + 4);
            *(f32x4*)(orow + 512 * j) = (f32x4){v[j][0] * r * g0.x, v[j][1] * r * g0.y, v[j][2] * r * g0.z, v[j][3] * r * g0.w};
            *(f32x4*)(orow + 512 * j + 4) = (f32x4){v[j][4] * r * g1.x, v[j][5] * r * g1.y, v[j][6] * r * g1.z, v[j][7] * r * g1.w}; }
    }
}

#define LAS __attribute__((address_space(3)))
#define XB_TMO      128
#define XB_XCNT(j)  (256  + 64 * (j))
#define XB_XSUB(j)  (1280 + 64 * (j))
#define XB_XGEN(j)  (2304 + 64 * (j))
#define XB_TOP      3328
#define XB_TOPGEN   3392
#define XCD_BAR_WORDS 3456
#define XB_SPIN_CAP (1u << 18)

__device__ __forceinline__ unsigned xb_ld(unsigned* p)              { return __hip_atomic_load(p, __ATOMIC_RELAXED, __HIP_MEMORY_SCOPE_AGENT); }
__device__ __forceinline__ unsigned xb_add(unsigned* p, unsigned v) { return __hip_atomic_fetch_add(p, v, __ATOMIC_RELAXED, __HIP_MEMORY_SCOPE_AGENT); }
__device__ __forceinline__ unsigned xb_xcc_id() { return (unsigned)__builtin_amdgcn_s_getreg((3 << 11) | 20) & 0xFu; }
#define XB_SPIN(cond, bar) do { unsigned _sp = 0; while (cond) { __builtin_amdgcn_s_sleep(1); \
    if ((++_sp & 255u) == 0u) { if (xb_ld(&(bar)[XB_TMO])) break; if (_sp > XB_SPIN_CAP) { atomicAdd(&(bar)[XB_TMO], 1u); break; } } } } while (0)

struct XcdBarrier {
    unsigned* bar; unsigned x;
    volatile LAS unsigned* st;
};

__device__ __forceinline__ XcdBarrier xcd_barrier_post(unsigned* bar, volatile LAS unsigned* st) {
    XcdBarrier b; b.bar = bar; b.x = xb_xcc_id(); b.st = st;
    if (threadIdx.x == 0) (void)xb_add(&bar[XB_XCNT(b.x)], 1u);
    return b;
}
__device__ __forceinline__ void xcd_barrier_complete(unsigned* bar, unsigned x, unsigned& nloc, unsigned& nx) {
    const unsigned G = gridDim.x * gridDim.y * gridDim.z;
    unsigned sum, cnt, mine, sp = 0u;
    for (;;) {
        sum = 0u; cnt = 0u; mine = 0u;
#pragma unroll
        for (unsigned j = 0; j < 16; ++j) { const unsigned c = xb_ld(&bar[XB_XCNT(j)]); sum += c; cnt += (c > 0u) ? 1u : 0u; mine = (j == x) ? c : mine; }
        if (sum == G) break;
        __builtin_amdgcn_s_sleep(1);
        if ((++sp & 255u) == 0u) { if (xb_ld(&bar[XB_TMO])) break; if (sp > XB_SPIN_CAP) { atomicAdd(&bar[XB_TMO], 1u); break; } }
    }
    nloc = mine > 0u ? mine : 1u; nx = cnt > 0u ? cnt : 1u;
}

__device__ __forceinline__ void xcd_barrier(const XcdBarrier& b) {
    asm volatile("s_waitcnt vmcnt(0)" ::: "memory");
    __syncthreads();
    if (threadIdx.x == 0) {
        unsigned* bar = b.bar;
        __builtin_amdgcn_s_waitcnt(0);
        unsigned nloc = b.st[0], nx = b.st[1];
        if (nloc == 0u) { xcd_barrier_complete(bar, b.x, nloc, nx); b.st[0] = nloc; b.st[1] = nx; }
        const unsigned old = xb_add(&bar[XB_XSUB(b.x)], 1u);
        const unsigned gen = old / nloc;
        if (old + 1u == (gen + 1u) * nloc) {
            __builtin_amdgcn_fence(__ATOMIC_RELEASE, "agent");
            asm volatile("s_waitcnt vmcnt(0)" ::: "memory");
            const unsigned og = xb_add(&bar[XB_TOP], 1u);
            const unsigned tg = og / nx;
            if (og + 1u == (tg + 1u) * nx) xb_add(&bar[XB_TOPGEN], 1u);
            else XB_SPIN(xb_ld(&bar[XB_TOPGEN]) == tg, bar);
            __builtin_amdgcn_fence(__ATOMIC_ACQUIRE, "agent");
            xb_add(&bar[XB_XGEN(b.x)], 1u);
            asm volatile("s_waitcnt vmcnt(0)" ::: "memory");
        } else {
            XB_SPIN(xb_ld(&bar[XB_XGEN(b.x)]) == gen, bar);
            __builtin_amdgcn_fence(__ATOMIC_ACQUIRE, "agent");
            asm volatile("s_waitcnt vmcnt(0)" ::: "memory");
        }
    }
    __syncthreads();
}

__device__ __forceinline__ void group_barrier(unsigned* ctl, int seam, int pm, bool samex) {
    asm volatile("s_waitcnt vmcnt(0)" ::: "memory");
    __syncthreads();
    if (threadIdx.x == 0) {
        unsigned* cnt = ctl + (CTL_GRP / 4) + (seam * 64 + pm) * 64;
        if (!samex) { __builtin_amdgcn_fence(__ATOMIC_RELEASE, "agent"); asm volatile("s_waitcnt vmcnt(0)" ::: "memory"); }
        xb_add(cnt, 1u);
        unsigned sp = 0u;
        while (xb_ld(cnt) < 4u) { __builtin_amdgcn_s_sleep(1); if (++sp > (1u << 22)) break; }
        __builtin_amdgcn_fence(__ATOMIC_ACQUIRE, "agent");
        asm volatile("s_waitcnt vmcnt(0)" ::: "memory");
    }
    __syncthreads();
}
template <int PH>
__device__ __forceinline__ void run_phase(const Params& P, unsigned char* lds, int tid, int lane, int wave) {
    unsigned char* ws = P.ws;
    PG8_LAS unsigned char* glds = (PG8_LAS unsigned char*)lds;
    if constexpr (PH == 0) p0_phase(P, lds, tid, lane, wave);
    if constexpr (PH == 1) {
        pg8::Gemm g{(const bf16*)(ws + WS_BUFA), (const bf16*)(ws + WS_WIN), MTOK, INW, DM}; pg8::StaticOrder S; S.init(MTOK, INW, gridDim.x, blockIdx.x);
        pg8::EpiStoreBf16 E{(bf16*)(ws + WS_PROJ), INW};
        pg8::gemm_phase<pg8::EpiStoreBf16, pg8::StaticOrder, true, true>(glds, g, S, E);
    }
    if constexpr (PH == 2) {
        ret_pass_a(P, lds, tid, lane, wave);
        { const int id = blockIdx.x * 8 + wave; if (id < 2048) s5_wave<false>(P, lds + wave * S5_WLDS, id >> 10, id & 63, (id >> 6) & 15, lane, id); }
    }
    if constexpr (PH == 3) {
        scan_phase(P, tid);
        const int id = blockIdx.x * 8 + wave; if (id < 2048) s5_wave<true>(P, lds + wave * S5_WLDS, id >> 10, id & 63, (id >> 6) & 15, lane, id);
    }
    if constexpr (PH == 5) {
        pg8::Gemm g{(const bf16*)(ws + WS_Y1), (const bf16*)(ws + WS_WGLU), MTOK, SW, SW}; pg8::StaticOrder S; S.init(MTOK, SW, gridDim.x, blockIdx.x);
        pg8::EpiGlu E{(const bf16*)(ws + WS_Y1), P.in[13], P.in[14], (bf16*)(ws + WS_BUFA) + RW, (float*)(ws + WS_SQ2), SW, DM};
        pg8::gemm_phase<pg8::EpiGlu, pg8::StaticOrder, false, true>(glds, g, S, E);
    }
    if constexpr (PH == 6) ret_pass_c(P, lds, tid, lane, wave);
    if constexpr (PH == 7) {
        pg8::Gemm g{(const bf16*)(ws + WS_BUFA), (const bf16*)(ws + WS_WOUT), MTOK, DM, DM}; pg8::StaticOrder S; S.init(MTOK, DM, gridDim.x, blockIdx.x);
        pg8::EpiResB E{P.in[0], nullptr, (bf16*)(ws + WS_X1B), DM, (const float*)(ws + WS_SQ2), 1.f / SW, (float*)(ws + WS_SQ1)};
        pg8::gemm_phase<pg8::EpiResB, pg8::StaticOrder, false, true>(glds, g, S, E);
    }
    if constexpr (PH == 9) {
        pg8::Gemm g{(const bf16*)(ws + WS_X1B), (const bf16*)(ws + WS_WGU), MTOK, 2 * DFF, DM}; pg8::StaticOrder S; S.init(MTOK, 2 * DFF, gridDim.x, blockIdx.x);
        pg8::Unit u0; int pm0 = -1; if (S.next(0, u0)) pm0 = u0.pm;
        float* rsl = (float*)(lds + LDS_KEEP + 64);
        if (pm0 >= 0 && tid < 256) { const f32x4* pp = (const f32x4*)((const float*)(ws + WS_SQ1) + (size_t)(pm0 * 256 + tid) * 32); float t = 0.f;
#pragma unroll
            for (int j = 0; j < 8; ++j) { const f32x4 p4 = pp[j]; t += (p4[0] + p4[1]) + (p4[2] + p4[3]); }
            rsl[tid] = rsqrtf(t * (1.f / DM) + EPS); }
        __syncthreads();
        pg8::EpiSwiGlu E{(bf16*)(ws + WS_ACT), DFF, (const float*)(ws + WS_SQ1), 1.f / DM, rsl, pm0};
        pg8::gemm_phase<pg8::EpiSwiGlu, pg8::StaticOrder, true, true>(glds, g, S, E);
    }
    if constexpr (PH == 10) {
        pg8::Gemm g{(const bf16*)(ws + WS_ACT), (const bf16*)(ws + WS_WD), MTOK, DM, DFF}; pg8::StaticOrder S; S.init(MTOK, DM, gridDim.x, blockIdx.x);
        pg8::EpiResB E{nullptr, (const bf16*)(ws + WS_X1B), (bf16*)(ws + WS_BUFA), DM, nullptr, 0.f, nullptr};
        pg8::gemm_phase<pg8::EpiResB, pg8::StaticOrder, false, true>(glds, g, S, E);
    }
    if constexpr (PH == 11) final_norm_phase(P, lane, wave);
}
#define R(k) { int t_ = threadIdx.x; asm volatile("" : "+v"(t_)); run_phase<k>(P, lds, t_, t_ & 63, __builtin_amdgcn_readfirstlane(t_ >> 6)); }
#define BST ((volatile LAS unsigned*)((LAS unsigned char*)lds + LDS_KEEP))
#define S { XcdBarrier b_; b_.bar = (unsigned*)(P.ws + WS_CTL); b_.x = xb_xcc_id(); b_.st = BST; xcd_barrier(b_); }
#define G(k) group_barrier((unsigned*)(P.ws + WS_CTL), k, panel_of((int)blockIdx.x), BST[2] != 0u);
#define PHASE_PROGRAM R(0) S R(1) S R(2) S R(3) S GROUP_CHECK R(5) G(0) R(6) S R(7) G(1) R(9) G(2) R(10) G(3) R(11)
__global__ void __launch_bounds__(512, 2) hybrid_fwd(Params P) {
    extern __shared__ __attribute__((aligned(16))) unsigned char lds[];
    cg::grid_group grid = cg::this_grid();
    const int tid = threadIdx.x, lane = tid & 63, wave = __builtin_amdgcn_readfirstlane(tid >> 6);
    if (P.ws == nullptr) grid.sync();
    if (tid < 3) BST[tid] = 0u;
    __syncthreads();
    { XcdBarrier bar = xcd_barrier_post((unsigned*)(P.ws + WS_CTL), BST); (void)bar; }
    if (tid == 0) __hip_atomic_store((unsigned*)(P.ws + WS_CTL + CTL_XID) + blockIdx.x, xb_xcc_id() + 1u, __ATOMIC_RELAXED, __HIP_MEMORY_SCOPE_AGENT);
#define GROUP_CHECK { unsigned ok_ = 1u; const unsigned* xid_ = (const unsigned*)(P.ws + WS_CTL + CTL_XID); _Pragma("unroll") for (int k_ = 0; k_ < 4; ++k_) ok_ &= (xb_ld((unsigned*)xid_ + ((blockIdx.x & 63) + 64 * k_)) == xb_xcc_id() + 1u) ? 1u : 0u; if (threadIdx.x == 0) BST[2] = ok_; __syncthreads(); }
    PHASE_PROGRAM
}
#undef R
#undef S

extern "C" void kernel_launch(void* const* d_in, const int* in_sizes, int n_in, void* d_out, int out_size, void* d_ws, size_t ws_size, hipStream_t stream) {
    static int grid = 0;
    if (grid == 0) {
        if (n_in != 21 || out_size != MTOK * DM || ws_size < WS_END) { fprintf(stderr, "kernel_launch: unexpected shapes (n_in %d out %d ws %zu)\n", n_in, out_size, ws_size); grid = -1; return; }
        int dev = 0, cus = 0, per_cu = 0;
        (void)hipGetDevice(&dev); (void)hipDeviceGetAttribute(&cus, hipDeviceAttributeMultiprocessorCount, dev);
        if (hipFuncSetAttribute((const void*)hybrid_fwd, hipFuncAttributeMaxDynamicSharedMemorySize, LDS_BYTES) != hipSuccess) { fprintf(stderr, "kernel_launch: hipFuncSetAttribute failed\n"); grid = -1; return; }
        if (hipOccupancyMaxActiveBlocksPerMultiprocessor(&per_cu, (const void*)hybrid_fwd, 512, LDS_BYTES) != hipSuccess || per_cu < 1) { fprintf(stderr, "kernel_launch: occupancy query says %d\n", per_cu); per_cu = 1; }
        (void)hipGetLastError();
        grid = cus * 1;
        if (grid != 256) { fprintf(stderr, "kernel_launch: built for a 256-CU device (got %d)\n", cus); grid = -1; return; }
    }
    if (grid < 0) return;
    Params p{};
    for (int i = 0; i < 21; ++i) p.in[i] = (const float*)d_in[i];
    p.out = (float*)d_out; p.ws = (unsigned char*)d_ws;
    if (hipMemsetAsync((unsigned char*)d_ws + WS_CTL, 0, CTL_ZERO, stream) != hipSuccess) { fprintf(stderr, "kernel_launch: memset of the barrier words failed\n"); return; }
    void* args[] = {&p};
    hipError_t e = hipLaunchCooperativeKernel((const void*)hybrid_fwd, dim3(grid), dim3(512), args, LDS_BYTES, stream);
    if (e != hipSuccess) fprintf(stderr, "cooperative launch failed: %s (grid %d)\n", hipGetErrorString(e), grid);
}
```

```cpp
#include <hip/hip_runtime.h>
#include <hip/hip_cooperative_groups.h>
#include <cstdio>
#include <cstdint>
namespace cg = cooperative_groups;
namespace pg8 {
#define PG8_LAS __attribute__((address_space(3)))
typedef unsigned short bf16_t;
typedef short bf16x8 __attribute__((ext_vector_type(8)));
typedef float f32x4 __attribute__((ext_vector_type(4)));
typedef unsigned u32x4 __attribute__((ext_vector_type(4)));
constexpr int BM = 256, BK = 64, HALF = 128, HTB = HALF * BK * 2  , STAGE_BYTES = 8 * HTB, NXCD = 8, WGM = 8;

__host__ __device__ __forceinline__ int lds_byte(int r, int c) { const int st = (r >> 4) * 2 + (c >> 5), rr = r & 15, cc = c & 31, ob = rr * 64 + cc * 2; return st * 1024 + (ob ^ (((ob >> 9) & 1) << 5)); }
__host__ __device__ __forceinline__ void stage_rc(int b, int& R, int& C) { const int st = b / 1024, sb = b % 1024, swz = sb ^ (((sb >> 9) & 1) << 5); R = (st >> 1) * 16 + swz / 64; C = (st & 1) * 32 + (swz % 64) / 2; }
__host__ __device__ __forceinline__ int perm32(int rho) { const int n = rho >> 4, i = rho & 15; return 8 * (i >> 2) + 4 * n + (i & 3); }

struct Unit { int pm, pn; };
struct Gemm { const bf16_t* A; const bf16_t* Bt; int M, N, K; };

struct StaticOrder {
    int nM, nN, nwg, G, c;
    __host__ __device__ void init(int M, int N, int G_, int c_) { nM = M / BM; nN = N / BM; nwg = nM * nN; G = G_; c = c_; }
    __host__ __device__ bool next(int i, Unit& u) const {
        const long L = (long)i * G + c; if (L >= nwg) return false;
        int wgid = (int)L; { const int q = nwg / NXCD, r = nwg % NXCD, xcd = wgid % NXCD, off = wgid / NXCD; wgid = (xcd < r ? xcd * (q + 1) : r * (q + 1) + (xcd - r) * q) + off; }
        const int nig = WGM * nN, gid = wgid / nig, fm = gid * WGM, gsz = (nM - fm) < WGM ? (nM - fm) : WGM;
        u.pm = fm + ((wgid % nig) % gsz); u.pn = (wgid % nig) / gsz; return true;
    }
    __device__ __forceinline__ void a_ready(const Unit&) const {}
    __device__ __forceinline__ void done(const Unit&) const {}
};

typedef __bf16 bf16x2_t __attribute__((ext_vector_type(2)));
__device__ __forceinline__ unsigned cvt_pk_bf16(float lo, float hi) { bf16x2_t v = {(__bf16)lo, (__bf16)hi}; return __builtin_bit_cast(unsigned, v); }
__device__ __forceinline__ float bf_lo(unsigned w) { return __uint_as_float(w << 16); }
__device__ __forceinline__ float bf_hi(unsigned w) { return __uint_as_float(w & 0xffff0000u); }
typedef unsigned u32x2v __attribute__((ext_vector_type(2)));
__device__ __forceinline__ float sigmoid_f(float z) { return __builtin_amdgcn_rcpf(1.0f + __expf(-z)); }

struct EpiStoreBf16 {
    static constexpr bool PERM = true, AFTER_DRAIN = false;
    bf16_t* O; int ldc; const float* rs;
    __device__ __forceinline__ void operator()(const f32x4 (&acc)[2][2][4][2], const Unit& u, int wr, int wc, int fr, int fq) const {
        const int row0 = u.pm * BM + wr * 64 + fr, col0 = u.pn * BM + wc * 32 + 8 * fq;
        float rv[2][4];
#pragma unroll
        for (int ai = 0; ai < 2; ++ai)
#pragma unroll
            for (int m = 0; m < 4; ++m) rv[ai][m] = rs[row0 + ai * HALF + m * 16];
#pragma unroll
        for (int ai = 0; ai < 2; ++ai)
#pragma unroll
            for (int m = 0; m < 4; ++m) { bf16_t* rowp = O + (size_t)(row0 + ai * HALF + m * 16) * ldc + col0;
#pragma unroll
                for (int bj = 0; bj < 2; ++bj) { const f32x4 v0 = acc[ai][bj][m][0] * rv[ai][m], v1 = acc[ai][bj][m][1] * rv[ai][m];
                    u32x4 w; w.x = cvt_pk_bf16(v0[0], v0[1]); w.y = cvt_pk_bf16(v0[2], v0[3]); w.z = cvt_pk_bf16(v1[0], v1[1]); w.w = cvt_pk_bf16(v1[2], v1[3]);
                    *(u32x4*)(rowp + bj * HALF) = w; } }
    }
};
struct EpiGlu {
    static constexpr bool PERM = true, AFTER_DRAIN = false;
    const bf16_t* Y1; const float* bias; const float* gain; bf16_t* Y2; float* rowsq; int ldc, ldo;
    __device__ __forceinline__ void operator()(const f32x4 (&acc)[2][2][4][2], const Unit& u, int wr, int wc, int fr, int fq) const {
        const int row0 = u.pm * BM + wr * 64 + fr, col0 = u.pn * BM + wc * 32 + 8 * fq;
        f32x4 bv[2][2], gv[2][2];
#pragma unroll
        for (int bj = 0; bj < 2; ++bj)
#pragma unroll
            for (int n = 0; n < 2; ++n) { bv[bj][n] = *(const f32x4*)(bias + col0 + bj * HALF + 4 * n); gv[bj][n] = *(const f32x4*)(gain + col0 + bj * HALF + 4 * n); }
#pragma unroll
        for (int ai = 0; ai < 2; ++ai) {
            u32x4 yv[4][2];
#pragma unroll
            for (int m = 0; m < 4; ++m)
#pragma unroll
                for (int bj = 0; bj < 2; ++bj) yv[m][bj] = *(const u32x4*)(Y1 + (size_t)(row0 + ai * HALF + m * 16) * ldc + col0 + bj * HALF);
#pragma unroll
            for (int m = 0; m < 4; ++m) { const int row = row0 + ai * HALF + m * 16; const size_t offo = (size_t)row * ldo + col0;
                float ss = 0.f;
#pragma unroll
                for (int bj = 0; bj < 2; ++bj) { const f32x4 z0 = acc[ai][bj][m][0] + bv[bj][0], z1 = acc[ai][bj][m][1] + bv[bj][1];
                    const u32x4 y = yv[m][bj];
                    f32x4 r0, r1;
                    r0[0] = bf_lo(y.x) * sigmoid_f(z0[0]); r0[1] = bf_hi(y.x) * sigmoid_f(z0[1]); r0[2] = bf_lo(y.y) * sigmoid_f(z0[2]); r0[3] = bf_hi(y.y) * sigmoid_f(z0[3]);
                    r1[0] = bf_lo(y.z) * sigmoid_f(z1[0]); r1[1] = bf_hi(y.z) * sigmoid_f(z1[1]); r1[2] = bf_lo(y.w) * sigmoid_f(z1[2]); r1[3] = bf_hi(y.w) * sigmoid_f(z1[3]);
                    ss += (r0[0] * r0[0] + r0[1] * r0[1]) + (r0[2] * r0[2] + r0[3] * r0[3]) + (r1[0] * r1[0] + r1[1] * r1[1]) + (r1[2] * r1[2] + r1[3] * r1[3]);
                    r0 = r0 * gv[bj][0]; r1 = r1 * gv[bj][1];
                    u32x4 w; w.x = cvt_pk_bf16(r0[0], r0[1]); w.y = cvt_pk_bf16(r0[2], r0[3]); w.z = cvt_pk_bf16(r1[0], r1[1]); w.w = cvt_pk_bf16(r1[2], r1[3]);
                    *(u32x4*)(Y2 + offo + bj * HALF) = w; }
                ss += __shfl_xor(ss, 16); ss += __shfl_xor(ss, 32);
                if (fq == 0) rowsq[(size_t)row * 16 + u.pn * 4 + wc] = ss; }
        }
    }
};
struct EpiResF32 {
    static constexpr bool PERM = false, AFTER_DRAIN = false;
    const float* X; float* O; int ldc; const float* insq; float inv_indim; bf16_t* OB; float* outsq;
    __device__ __forceinline__ void operator()(const f32x4 (&acc)[2][2][4][2], const Unit& u, int wr, int wc, int fr, int fq) const {
        const int row0 = u.pm * BM + wr * 64 + fr, col0 = u.pn * BM + wc * 32 + 4 * fq;
#pragma unroll
        for (int ai = 0; ai < 2; ++ai)
#pragma unroll
        for (int mh = 0; mh < 2; ++mh) {
            f32x4 xv[2][2][2]; f32x4 p4[2];
#pragma unroll
            for (int mm = 0; mm < 2; ++mm) { const int row = row0 + ai * HALF + (2 * mh + mm) * 16; const size_t off = (size_t)row * ldc + col0;
                p4[mm] = insq ? *(const f32x4*)(insq + (size_t)row * 16 + 4 * fq) : (f32x4){0.f, 0.f, 0.f, 0.f};
#pragma unroll
                for (int bj = 0; bj < 2; ++bj)
#pragma unroll
                    for (int n = 0; n < 2; ++n) xv[mm][bj][n] = *(const f32x4*)(X + off + bj * HALF + n * 16); }
#pragma unroll
            for (int mm = 0; mm < 2; ++mm) { const int m = 2 * mh + mm; const int row = row0 + ai * HALF + m * 16; const size_t off = (size_t)row * ldc + col0;
                float sc = 1.0f;
                if (insq) { float t = (p4[mm][0] + p4[mm][1]) + (p4[mm][2] + p4[mm][3]); t += __shfl_xor(t, 16); t += __shfl_xor(t, 32); sc = rsqrtf(t * inv_indim + 1e-6f); }
                float ss = 0.f;
#pragma unroll
                for (int bj = 0; bj < 2; ++bj)
#pragma unroll
                    for (int n = 0; n < 2; ++n) { const f32x4 o = xv[mm][bj][n] + acc[ai][bj][m][n] * sc;
                        *(f32x4*)(O + off + bj * HALF + n * 16) = o;
                        if (OB) { ss += (o[0] * o[0] + o[1] * o[1]) + (o[2] * o[2] + o[3] * o[3]); u32x2v w; w.x = cvt_pk_bf16(o[0], o[1]); w.y = cvt_pk_bf16(o[2], o[3]); *(u32x2v*)(OB + off + bj * HALF + n * 16) = w; } }
                if (OB) { ss += __shfl_xor(ss, 16); ss += __shfl_xor(ss, 32); if (fq == 0) outsq[(size_t)row * 32 + u.pn * 4 + wc] = ss; } }
        }
    }
};
struct EpiResB {
    static constexpr bool PERM = true, AFTER_DRAIN = false;
    const float* X; const bf16_t* XB; bf16_t* OB; int ldc; const float* insq; float inv_indim; float* outsq;
    __device__ __forceinline__ void operator()(const f32x4 (&acc)[2][2][4][2], const Unit& u, int wr, int wc, int fr, int fq) const {
        const int row0 = u.pm * BM + wr * 64 + fr, col0 = u.pn * BM + wc * 32 + 8 * fq;
#pragma unroll
        for (int ai = 0; ai < 2; ++ai)
#pragma unroll
        for (int mh = 0; mh < 2; ++mh) {
            f32x4 xv[2][2][2]; f32x4 p4[2];
#pragma unroll
            for (int mm = 0; mm < 2; ++mm) { const int row = row0 + ai * HALF + (2 * mh + mm) * 16; const size_t off = (size_t)row * ldc + col0;
                p4[mm] = insq ? *(const f32x4*)(insq + (size_t)row * 16 + 4 * fq) : (f32x4){0.f, 0.f, 0.f, 0.f};
#pragma unroll
                for (int bj = 0; bj < 2; ++bj) {
                    if (XB) { const u32x4 y = *(const u32x4*)(XB + off + bj * HALF); xv[mm][bj][0] = (f32x4){bf_lo(y.x), bf_hi(y.x), bf_lo(y.y), bf_hi(y.y)}; xv[mm][bj][1] = (f32x4){bf_lo(y.z), bf_hi(y.z), bf_lo(y.w), bf_hi(y.w)}; }
                    else { xv[mm][bj][0] = *(const f32x4*)(X + off + bj * HALF); xv[mm][bj][1] = *(const f32x4*)(X + off + bj * HALF + 4); } } }
#pragma unroll
            for (int mm = 0; mm < 2; ++mm) { const int m = 2 * mh + mm; const int row = row0 + ai * HALF + m * 16; const size_t off = (size_t)row * ldc + col0;
                float sc = 1.0f;
                if (insq) { float t = (p4[mm][0] + p4[mm][1]) + (p4[mm][2] + p4[mm][3]); t += __shfl_xor(t, 16); t += __shfl_xor(t, 32); sc = rsqrtf(t * inv_indim + 1e-6f); }
                float ss = 0.f;
#pragma unroll
                for (int bj = 0; bj < 2; ++bj) { const f32x4 o0 = xv[mm][bj][0] + acc[ai][bj][m][0] * sc, o1 = xv[mm][bj][1] + acc[ai][bj][m][1] * sc;
                    ss += ((o0[0] * o0[0] + o0[1] * o0[1]) + (o0[2] * o0[2] + o0[3] * o0[3])) + ((o1[0] * o1[0] + o1[1] * o1[1]) + (o1[2] * o1[2] + o1[3] * o1[3]));
                    u32x4 w; w.x = cvt_pk_bf16(o0[0], o0[1]); w.y = cvt_pk_bf16(o0[2], o0[3]); w.z = cvt_pk_bf16(o1[0], o1[1]); w.w = cvt_pk_bf16(o1[2], o1[3]);
                    *(u32x4*)(OB + off + bj * HALF) = w; }
                if (outsq) { ss += __shfl_xor(ss, 16); ss += __shfl_xor(ss, 32); if (fq == 0) outsq[(size_t)row * 32 + u.pn * 4 + wc] = ss; } }
        }
    }
};
struct EpiSwiGlu {
    static constexpr bool PERM = true, AFTER_DRAIN = false;
    bf16_t* O; int ldc; const float* insq; float inv_indim; const float* rs_lds; int pm_lds;
    __device__ __forceinline__ void operator()(const f32x4 (&acc)[2][2][4][2], const Unit& u, int wr, int wc, int fr, int fq) const {
        const int row0 = u.pm * BM + wr * 64 + fr, col0 = u.pn * HALF + wc * 32 + 8 * fq;
        float scv[2][4];
        if (u.pm == pm_lds) {
#pragma unroll
          for (int ai = 0; ai < 2; ++ai)
#pragma unroll
              for (int m = 0; m < 4; ++m) scv[ai][m] = rs_lds[wr * 64 + fr + ai * HALF + m * 16];
        } else { f32x4 pa[2][4], pb[2][4];
#pragma unroll
          for (int ai = 0; ai < 2; ++ai)
#pragma unroll
              for (int m = 0; m < 4; ++m) { const float* pp = insq + (size_t)(row0 + ai * HALF + m * 16) * 32 + 8 * fq; pa[ai][m] = *(const f32x4*)pp; pb[ai][m] = *(const f32x4*)(pp + 4); }
#pragma unroll
          for (int ai = 0; ai < 2; ++ai)
#pragma unroll
              for (int m = 0; m < 4; ++m) { float t = ((pa[ai][m][0] + pa[ai][m][1]) + (pa[ai][m][2] + pa[ai][m][3])) + ((pb[ai][m][0] + pb[ai][m][1]) + (pb[ai][m][2] + pb[ai][m][3]));
                  t += __shfl_xor(t, 16); t += __shfl_xor(t, 32); scv[ai][m] = rsqrtf(t * inv_indim + 1e-6f); } }
#pragma unroll
        for (int ai = 0; ai < 2; ++ai)
#pragma unroll
            for (int m = 0; m < 4; ++m) { const int row = row0 + ai * HALF + m * 16; bf16_t* rowp = O + (size_t)row * ldc + col0;
                const float sc = scv[ai][m];
                f32x4 r0, r1;
#pragma unroll
                for (int j = 0; j < 4; ++j) { const float g0 = acc[ai][0][m][0][j] * sc, g1 = acc[ai][0][m][1][j] * sc;
                    r0[j] = g0 * sigmoid_f(g0) * (acc[ai][1][m][0][j] * sc); r1[j] = g1 * sigmoid_f(g1) * (acc[ai][1][m][1][j] * sc); }
                u32x4 w; w.x = cvt_pk_bf16(r0[0], r0[1]); w.y = cvt_pk_bf16(r0[2], r0[3]); w.z = cvt_pk_bf16(r1[0], r1[1]); w.w = cvt_pk_bf16(r1[2], r1[3]);
                *(u32x4*)rowp = w; }
    }
};


template <class Epi, class Sched, bool ALIGN_EPI = false, bool SP2 = false>
__device__ __forceinline__ void gemm_phase(PG8_LAS unsigned char* lds, const Gemm g, const Sched& S, const Epi& E) {
    int tid_ = threadIdx.x; asm volatile("" : "+v"(tid_));
    const int tid = tid_, wid = __builtin_amdgcn_readfirstlane(tid >> 6), lane = tid & 63, wr = wid >> 2, wc = wid & 3, fr = lane & 15, fq = lane >> 4;
    const int K = g.K, nt = K / BK;
    unsigned voffA[2], voffB[2];
#pragma unroll
    for (int i = 0; i < 2; ++i) { int R, C; stage_rc(tid * 16 + i * 8192, R, C); const int Rb = Epi::PERM ? ((R & ~31) + perm32(R & 31)) : R;
        voffA[i] = (unsigned)(R * K + C) * 2u; voffB[i] = (unsigned)(Rb * K + C) * 2u; }
    const size_t kstep = (size_t)(BK * 2);
    const size_t hstep = (size_t)HALF * K * 2;
    const size_t tstep = 2 * hstep;
    const unsigned ldsw = (unsigned)wid * 1024u;
    const int aoff = lds_byte(wr * 64 + fr, fq * 8), boff = lds_byte(wc * 32 + fr, fq * 8);
#define PG8_SA(b, h) (((b) * 2 + (h)) * HTB)
#define PG8_SB(b, h) ((4 + (b) * 2 + (h)) * HTB)
#define PG8_STAGE(bufoff, gbase, voff) do { _Pragma("unroll") for (int _i = 0; _i < 2; ++_i) \
        __builtin_amdgcn_global_load_lds((const unsigned*)((const char*)(gbase) + (voff)[_i]), (PG8_LAS unsigned*)(lds + (bufoff) + ldsw + _i * 8192), 16, 0, 0); } while (0)
#define PG8_LDA(dst, b, h) do { _Pragma("unroll") for (int m = 0; m < 4; ++m) _Pragma("unroll") for (int k = 0; k < 2; ++k) dst[m][k] = *(const PG8_LAS bf16x8*)(lds + PG8_SA(b, h) + aoff + m * 2048 + k * 1024); } while (0)
#define PG8_LDB(dst, b, h) do { _Pragma("unroll") for (int n = 0; n < 2; ++n) _Pragma("unroll") for (int k = 0; k < 2; ++k) dst[n][k] = *(const PG8_LAS bf16x8*)(lds + PG8_SB(b, h) + boff + n * 2048 + k * 1024); } while (0)
#define PG8_MMA(ai, bj, At, Bt) do { __builtin_amdgcn_s_setprio(1); _Pragma("unroll") for (int m = 0; m < 4; ++m) _Pragma("unroll") for (int n = 0; n < 2; ++n) _Pragma("unroll") for (int k = 0; k < 2; ++k) \
        acc[ai][bj][m][n] = __builtin_amdgcn_mfma_f32_16x16x32_bf16(Bt[n][k], At[m][k], acc[ai][bj][m][n], 0, 0, 0); __builtin_amdgcn_s_setprio(0); } while (0)
#define PG8_WAIT_V(n) asm volatile("s_waitcnt vmcnt(" #n ")" ::: "memory")
#define PG8_WAIT_L(n) asm volatile("s_waitcnt lgkmcnt(" #n ")" ::: "memory")
#define PG8_BAR __builtin_amdgcn_s_barrier()
#define PG8_SCHED __builtin_amdgcn_sched_barrier(0)
    Unit cur, nxt; int ui = 0;
    if (!S.next(0, cur)) return;
    f32x4 acc[2][2][4][2];
#pragma unroll
    for (int a = 0; a < 2; ++a)
#pragma unroll
        for (int b = 0; b < 2; ++b)
#pragma unroll
            for (int m = 0; m < 4; ++m)
#pragma unroll
                for (int n = 0; n < 2; ++n) acc[a][b][m][n] = (f32x4){0.f, 0.f, 0.f, 0.f};
    bf16x8 At[4][2], B0[2][2], B1[2][2];
    const char* cA = (const char*)g.A + (size_t)cur.pm * tstep; const char* cB = (const char*)g.Bt + (size_t)cur.pn * tstep;
    S.a_ready(cur);
    if constexpr (SP2) {
        PG8_STAGE(PG8_SB(0, 0), cB, voffB); PG8_STAGE(PG8_SB(0, 1), cB + hstep, voffB); PG8_STAGE(PG8_SA(0, 0), cA, voffA); PG8_STAGE(PG8_SA(0, 1), cA + hstep, voffA);
        if (wr == 1) PG8_BAR;
        PG8_WAIT_V(2); PG8_BAR;
        PG8_STAGE(PG8_SB(1, 0), cB + kstep, voffB); PG8_STAGE(PG8_SA(1, 0), cA + kstep, voffA); PG8_STAGE(PG8_SB(1, 1), cB + hstep + kstep, voffB);
        PG8_WAIT_V(6); PG8_BAR;
    } else {
        PG8_STAGE(PG8_SB(0, 0), cB, voffB); PG8_STAGE(PG8_SA(0, 0), cA, voffA); PG8_STAGE(PG8_SB(0, 1), cB + hstep, voffB); PG8_STAGE(PG8_SA(0, 1), cA + hstep, voffA);
        if (wr == 1) PG8_BAR;
        PG8_WAIT_V(4); PG8_BAR;
        PG8_STAGE(PG8_SB(1, 0), cB + kstep, voffB); PG8_STAGE(PG8_SA(1, 0), cA + kstep, voffA); PG8_STAGE(PG8_SB(1, 1), cB + hstep + kstep, voffB);
        PG8_WAIT_V(6); PG8_BAR;
    }
    for (;;) {
        const bool has_next = S.next(ui + 1, nxt);
        const char* nA = has_next ? (const char*)g.A + (size_t)nxt.pm * tstep : cA; const char* nB = has_next ? (const char*)g.Bt + (size_t)nxt.pn * tstep : cB;
        for (int t = 0; t < nt; t += 2) {
            const bool last = (t == nt - 2);
            const char* a1 = cA + (size_t)(t + 1) * kstep;
            const char* a2 = last ? nA : cA + (size_t)(t + 2) * kstep; const char* b2 = last ? nB : cB + (size_t)(t + 2) * kstep;
            const char* a3 = a2 + kstep; const char* b3 = b2 + kstep;
            if (last && has_next) S.a_ready(nxt);
            if constexpr (SP2) {
            PG8_LDB(B0, 0, 0); PG8_LDB(B1, 0, 1); PG8_SCHED; PG8_LDA(At, 0, 0); PG8_STAGE(PG8_SA(1, 1), a1 + hstep, voffA);
            PG8_WAIT_V(8); PG8_WAIT_L(0); PG8_BAR; PG8_MMA(0, 0, At, B0); PG8_MMA(0, 1, At, B1); PG8_BAR; PG8_SCHED;
            PG8_LDA(At, 0, 1); PG8_STAGE(PG8_SB(0, 0), b2, voffB); PG8_STAGE(PG8_SB(0, 1), b2 + hstep, voffB); PG8_STAGE(PG8_SA(0, 0), a2, voffA);
            PG8_WAIT_V(8); PG8_WAIT_L(0); PG8_BAR; PG8_MMA(1, 0, At, B0); PG8_MMA(1, 1, At, B1); PG8_BAR; PG8_SCHED;
            PG8_LDB(B0, 1, 0); PG8_LDB(B1, 1, 1); PG8_SCHED; PG8_LDA(At, 1, 0); PG8_STAGE(PG8_SA(0, 1), a2 + hstep, voffA);
            PG8_WAIT_V(8); PG8_WAIT_L(0); PG8_BAR; PG8_MMA(0, 0, At, B0); PG8_MMA(0, 1, At, B1); PG8_BAR; PG8_SCHED;
            PG8_LDA(At, 1, 1); PG8_STAGE(PG8_SB(1, 0), b3, voffB); PG8_STAGE(PG8_SB(1, 1), b3 + hstep, voffB); PG8_STAGE(PG8_SA(1, 0), a3, voffA);
            PG8_WAIT_V(8); PG8_WAIT_L(0); PG8_BAR; PG8_MMA(1, 0, At, B0); PG8_MMA(1, 1, At, B1); PG8_BAR; PG8_SCHED;
            } else {
            PG8_LDB(B0, 0, 0); PG8_SCHED; PG8_LDA(At, 0, 0); PG8_STAGE(PG8_SA(1, 1), a1 + hstep, voffA);
            PG8_WAIT_L(8); PG8_BAR; PG8_WAIT_L(0); PG8_MMA(0, 0, At, B0); PG8_BAR; PG8_SCHED;
            PG8_LDB(B1, 0, 1); PG8_STAGE(PG8_SB(0, 0), b2, voffB);
            PG8_BAR; PG8_WAIT_L(0); PG8_MMA(0, 1, At, B1); PG8_BAR;
            PG8_LDA(At, 0, 1); PG8_STAGE(PG8_SA(0, 0), a2, voffA);
            PG8_BAR; PG8_WAIT_L(0); PG8_MMA(1, 0, At, B0); PG8_BAR; PG8_SCHED;
            PG8_STAGE(PG8_SB(0, 1), b2 + hstep, voffB);
            PG8_WAIT_V(6); PG8_BAR; PG8_MMA(1, 1, At, B1); PG8_BAR;
            PG8_LDB(B0, 1, 0); PG8_SCHED; PG8_LDA(At, 1, 0); PG8_STAGE(PG8_SA(0, 1), a2 + hstep, voffA);
            PG8_WAIT_L(8); PG8_BAR; PG8_WAIT_L(0); PG8_MMA(0, 0, At, B0); PG8_BAR; PG8_SCHED;
            PG8_LDB(B1, 1, 1); PG8_STAGE(PG8_SB(1, 0), b3, voffB);
            PG8_BAR; PG8_WAIT_L(0); PG8_MMA(0, 1, At, B1); PG8_BAR;
            PG8_LDA(At, 1, 1); PG8_STAGE(PG8_SA(1, 0), a3, voffA);
            PG8_BAR; PG8_WAIT_L(0); PG8_MMA(1, 0, At, B0); PG8_BAR; PG8_SCHED;
            PG8_STAGE(PG8_SB(1, 1), b3 + hstep, voffB);
            PG8_WAIT_V(6); PG8_BAR; PG8_MMA(1, 1, At, B1); PG8_BAR;
            }
        }
        if constexpr (ALIGN_EPI) { if (wr == 0) PG8_BAR; }
        if constexpr (!Epi::AFTER_DRAIN) { E(acc, cur, wr, wc, fr, fq); S.done(cur); }
        if (!has_next) break;
#pragma unroll
        for (int a = 0; a < 2; ++a)
#pragma unroll
            for (int b = 0; b < 2; ++b)
#pragma unroll
                for (int m = 0; m < 4; ++m)
#pragma unroll
                    for (int n = 0; n < 2; ++n) acc[a][b][m][n] = (f32x4){0.f, 0.f, 0.f, 0.f};
        cur = nxt; cA = nA; cB = nB; ++ui;
        if constexpr (ALIGN_EPI) { if (wr == 1) PG8_BAR; }
    }
    PG8_WAIT_V(0);
    if constexpr (!ALIGN_EPI) { if (wr == 0) PG8_BAR; }
    PG8_BAR;
    if constexpr (Epi::AFTER_DRAIN) { E.fused(acc, cur, wr, wc, fr, fq, lds, wid, lane); S.done(cur); }
#undef PG8_SA
#undef PG8_SB
#undef PG8_STAGE
#undef PG8_LDA
#undef PG8_LDB
#undef PG8_MMA
#undef PG8_WAIT_V
#undef PG8_WAIT_L
#undef PG8_BAR
#undef PG8_SCHED
}
}

typedef unsigned short bf16;
typedef short bf16x8 __attribute__((ext_vector_type(8)));
typedef float f32x4 __attribute__((ext_vector_type(4)));
typedef float f32x2 __attribute__((ext_vector_type(2)));
typedef float f32x16 __attribute__((ext_vector_type(16)));
typedef unsigned u32x4 __attribute__((ext_vector_type(4)));
typedef unsigned u32x2 __attribute__((ext_vector_type(2)));

constexpr int DM = 2048, SEQ = 8192, MTOK = 16384, INW = 5120, RW = 1024, NH = 8, HD = 128, SW = 1024, NG = 64, NP = 64, DFF = 5632;
constexpr float EPS = 1e-6f;
constexpr size_t MiB = 1u << 20;
constexpr size_t WS_WIN = 0, WS_WGLU = 20 * MiB, WS_WOUT = 22 * MiB, WS_WGU = 30 * MiB, WS_WD = 74 * MiB, WS_ROPE = 96 * MiB, WS_S5P = 100 * MiB, WS_S5ST = 101 * MiB,
                 WS_BUFA = 102 * MiB, WS_PROJ = 166 * MiB, WS_KV = 326 * MiB, WS_XB = 390 * MiB, WS_CTL = 454 * MiB, WS_SQ1 = 455 * MiB, WS_SQ2 = 457 * MiB, WS_TOT = 458 * MiB, WS_Y1 = 466 * MiB, WS_RS0 = 498 * MiB, WS_END = 499 * MiB, WS_ACT = WS_PROJ, WS_X1B = WS_XB, WS_Y2 = WS_Y1;
constexpr size_t CTL_XID = 16384, CTL_GRP = 32768, CTL_ZERO = 131072;
constexpr size_t S5P_BBT = 0, S5P_CMT = 256 * 1024, S5P_LAM = 512 * 1024, S5P_LAML = 544 * 1024;
constexpr int LDS_BYTES = 137216, LDS_KEEP = 135168, S5_WLDS = 16896;
constexpr int NPHASE = 12;

__device__ __forceinline__ int panel_of(int c) { return 8 * (c & 7) + ((c >> 3) & 7); }

struct Params { const float* in[21]; float* out; unsigned char* ws; };

#define MFMA32(a, b, c) __builtin_amdgcn_mfma_f32_32x32x16_bf16((a), (b), (c), 0, 0, 0)
#define MFMA16(a, b, c) __builtin_amdgcn_mfma_f32_16x16x32_bf16((a), (b), (c), 0, 0, 0)
#define LDS_FENCE() asm volatile("s_waitcnt lgkmcnt(0)" ::: "memory")

__device__ __forceinline__ float bflo(unsigned w) { return __uint_as_float(w << 16); }
__device__ __forceinline__ float bfhi(unsigned w) { return __uint_as_float(w & 0xffff0000u); }
__device__ __forceinline__ unsigned pk2(float lo, float hi) { return pg8::cvt_pk_bf16(lo, hi); }
__device__ __forceinline__ float wave_sum(float v) {
#pragma unroll
    for (int o = 1; o < 64; o <<= 1) v += __shfl_xor(v, o);
    return v;
}
__device__ __forceinline__ void sincos_d(double x, double& s, double& c) {
    const double k = rint(x * 0.63661977236758134308);
    double r = fma(-k, 1.57079632679489655800e+00, x); r = fma(-k, 6.12323399573676603587e-17, r);
    const int q = ((int)(long long)k) & 3;
    const double r2 = r * r;
    const double sn = r * (1.0 + r2 * (-1.0 / 6.0 + r2 * (1.0 / 120.0 + r2 * (-1.0 / 5040.0 + r2 * (1.0 / 362880.0 + r2 * (-1.0 / 39916800.0 + r2 * (1.0 / 6227020800.0 + r2 * (-1.0 / 1307674368000.0))))))));
    const double cs = 1.0 + r2 * (-0.5 + r2 * (1.0 / 24.0 + r2 * (-1.0 / 720.0 + r2 * (1.0 / 40320.0 + r2 * (-1.0 / 3628800.0 + r2 * (1.0 / 479001600.0 + r2 * (-1.0 / 87178291200.0 + r2 * (1.0 / 20922789888000.0))))))));
    s = (q == 0) ? sn : (q == 1) ? cs : (q == 2) ? -sn : -cs;
    c = (q == 0) ? cs : (q == 1) ? -sn : (q == 2) ? -cs : sn;
}

__device__ __forceinline__ void p0_transpose_item(const float* W, int K, int N, bf16* WT, int k0, int n0, int dst_row0, float* scr, int lane, const float* kscale = nullptr) {
#pragma unroll 8
    for (int i = 0; i < 32; ++i) { const int kk = 2 * i + (lane >> 5); scr[kk * 33 + (lane & 31)] = W[(size_t)(k0 + kk) * N + n0 + (lane & 31)]; }
    const int c = lane & 7;
    f32x4 ks0 = (f32x4){1.f, 1.f, 1.f, 1.f}, ks1 = ks0;
    if (kscale) { ks0 = *(const f32x4*)(kscale + k0 + 8 * c); ks1 = *(const f32x4*)(kscale + k0 + 8 * c + 4); }
    LDS_FENCE();
#pragma unroll
    for (int j = 0; j < 4; ++j) { const int n = (lane >> 3) + 8 * j; const float* s = scr + (8 * c) * 33 + n;
        u32x4 o; o.x = pk2(s[0 * 33] * ks0.x, s[1 * 33] * ks0.y); o.y = pk2(s[2 * 33] * ks0.z, s[3 * 33] * ks0.w); o.z = pk2(s[4 * 33] * ks1.x, s[5 * 33] * ks1.y); o.w = pk2(s[6 * 33] * ks1.z, s[7 * 33] * ks1.w);
        *(u32x4*)(WT + (size_t)(dst_row0 + n) * K + k0 + 8 * c) = o; }
    LDS_FENCE();
}
__device__ __forceinline__ void rms_row_to_bf16(const float* xrow, const float* g, bf16* orow, int lane) {
    const f32x4* xr = (const f32x4*)xrow + lane; const f32x4* gr = (const f32x4*)g + lane;
    f32x4 v[8]; float s = 0.f;
#pragma unroll
    for (int j = 0; j < 8; ++j) { v[j] = xr[64 * j]; s += (v[j].x * v[j].x + v[j].y * v[j].y) + (v[j].z * v[j].z + v[j].w * v[j].w); }
    const float r = rsqrtf(wave_sum(s) * (1.f / DM) + EPS);
    u32x2* o8 = (u32x2*)orow + lane;
#pragma unroll
    for (int j = 0; j < 8; ++j) { const f32x4 gg = gr[64 * j]; u32x2 w; w.x = pk2(v[j].x * r * gg.x, v[j].y * r * gg.y); w.y = pk2(v[j].z * r * gg.z, v[j].w * r * gg.w); o8[64 * j] = w; }
}
__device__ __forceinline__ void p0_phase(const Params& P, unsigned char* lds, int tid, int lane, int wave) {
    unsigned char* ws = P.ws;
    const int gw = blockIdx.x * 8 + wave, NGW = gridDim.x * 8;
    float* scr = (float*)(lds + wave * 16384);
    constexpr int I_IN = 32 * 160;
    for (int it = gw; it < I_IN; it += NGW) { const int kb = it / 160, nb = it % 160; p0_transpose_item(P.in[2], DM, INW, (bf16*)(ws + WS_WIN), kb * 64, nb * 32, nb * 32, scr, lane, P.in[1]); }
    for (int m = gw; m < MTOK; m += NGW) {
        const f32x4* xr = (const f32x4*)(P.in[0] + (size_t)m * DM) + lane; u32x2* o8 = (u32x2*)((bf16*)(ws + WS_XB) + (size_t)m * DM) + lane;
        f32x4 v[8]; float ss = 0.f;
#pragma unroll
        for (int j = 0; j < 8; ++j) { v[j] = xr[64 * j]; ss += (v[j].x * v[j].x + v[j].y * v[j].y) + (v[j].z * v[j].z + v[j].w * v[j].w); }
#pragma unroll
        for (int j = 0; j < 8; ++j) { u32x2 w; w.x = pk2(v[j].x, v[j].y); w.y = pk2(v[j].z, v[j].w); o8[64 * j] = w; }
        ss = wave_sum(ss);
        if (lane == 0) ((float*)(ws + WS_RS0))[m] = rsqrtf(ss * (1.f / DM) + EPS);
    }
    const int gt = blockIdx.x * 512 + tid, NGT = gridDim.x * 512;
    for (int idx = gt; idx < SEQ * 64; idx += NGT) {
        const int pos = idx >> 6, i = idx & 63;
        const double freq = exp(-(double)i * (9.210340371976184 / 64.0));
        double s, c; sincos_d((double)pos * freq, s, c);
        ((f32x2*)(ws + WS_ROPE))[idx] = (f32x2){(float)c, (float)s};
    }
    if (gt < NG * NP) {
        const int g = gt >> 6, p = gt & 63;
        const double dt = exp((double)P.in[6][g]);
        const double ar = (double)P.in[4][gt], ai = (double)P.in[5][gt];
        double sn, cs; sincos_d(ai * dt, sn, cs);
        const double mag = exp(ar * dt), lbr = mag * cs, lbi = mag * sn;
        const double d2 = ar * ar + ai * ai, nr = lbr - 1.0, ni = lbi;
        const double cr = (nr * ar + ni * ai) / d2, ci = (ni * ar - nr * ai) / d2;
        bf16* BbT = (bf16*)(ws + WS_S5P + S5P_BBT); bf16* CmT = (bf16*)(ws + WS_S5P + S5P_CMT);
        const float* bre = P.in[7] + (size_t)gt * 16; const float* bim = P.in[8] + (size_t)gt * 16;
#pragma unroll
        for (int c2 = 0; c2 < 16; c2 += 2) {
            const double br0 = bre[c2], bi0 = bim[c2], br1 = bre[c2 + 1], bi1 = bim[c2 + 1];
            *(unsigned*)(BbT + ((size_t)g * 128 + p) * 16 + c2) = pk2((float)(cr * br0 - ci * bi0), (float)(cr * br1 - ci * bi1));
            *(unsigned*)(BbT + ((size_t)g * 128 + 64 + p) * 16 + c2) = pk2((float)(cr * bi0 + ci * br0), (float)(cr * bi1 + ci * br1));
        }
        ((f32x2*)(ws + WS_S5P + S5P_LAM))[gt] = (f32x2){(float)lbr, (float)lbi};
        double sL, cL; sincos_d(ai * dt * 512.0, sL, cL); const double mL = exp(ar * dt * 512.0);
        ((f32x2*)(ws + WS_S5P + S5P_LAML))[gt] = (f32x2){(float)(mL * cL), (float)(mL * sL)};
        const int n = p & 31, blk = p >> 5;
#pragma unroll
        for (int c = 0; c < 16; ++c) {
            const float cre = P.in[9][((size_t)g * 16 + c) * 64 + p], cim = P.in[10][((size_t)g * 16 + c) * 64 + p];
            *(unsigned*)(CmT + ((size_t)g * 16 + c) * 128 + 4 * n + 2 * blk) = pk2(cre, -cim);
        }
    }
}

constexpr int RA_KT = 0, RA_VT = 16384;
constexpr int RC_QS = 0, RC_KS = 17408, RC_VT = 34816, RC_PS = 53248, RC_OS = 62464;

__device__ __forceinline__ float head_lg2(int h) { const float t[8] = {-4.5803689613e-02f, -2.2720076500e-02f, -1.1315313228e-02f, -5.6465631411e-03f, -2.8205190624e-03f, -1.4095702547e-03f, -7.0461297659e-04f, -3.5226347163e-04f}; float r = t[0];
#pragma unroll
    for (int i = 1; i < 8; ++i) r = (h == i) ? t[i] : r;
    return r; }

__device__ __forceinline__ int tsw(int r, int tok) { return r * 64 + ((((tok >> 3) ^ ((r ^ (r >> 3)) & 7)) << 3) | (tok & 7)); }
__device__ __forceinline__ int sidx(int e, int d) { return ((((e >> 5) * 8 + (d >> 4)) * 32 + (e & 31)) << 4) + (d & 15); }
__device__ __forceinline__ void rope8(const u32x4 a, const u32x4 b, const f32x2* cs, float (&o1)[8], float (&o2)[8]) {
    const unsigned aw[4] = {a.x, a.y, a.z, a.w}, bw[4] = {b.x, b.y, b.z, b.w};
#pragma unroll
    for (int j = 0; j < 4; ++j) {
        const f32x2 c0 = cs[2 * j], c1 = cs[2 * j + 1];
        const float x1a = bflo(aw[j]), x1b = bfhi(aw[j]), x2a = bflo(bw[j]), x2b = bfhi(bw[j]);
        o1[2 * j] = x1a * c0.x - x2a * c0.y; o2[2 * j] = x2a * c0.x + x1a * c0.y;
        o1[2 * j + 1] = x1b * c1.x - x2b * c1.y; o2[2 * j + 1] = x2b * c1.x + x1b * c1.y;
    }
}

__device__ __forceinline__ void ret_pass_a(const Params& P, unsigned char* lds, int tid, int lane, int wave) {
    unsigned char* ws = P.ws;
    const bf16* proj = (const bf16*)(ws + WS_PROJ); const u32x4* rope = (const u32x4*)(ws + WS_ROPE); bf16* KV = (bf16*)(ws + WS_KV);
    bf16* KT = (bf16*)(lds + RA_KT); bf16* VT = (bf16*)(lds + RA_VT);
    const int tok = tid >> 3, dg = tid & 7;
    u32x4 k1, k2, v1, v2, c0, c1, c2, c3;
#define RA_LOAD(uu) do { const int bh_ = (uu) >> 7, n_ = (uu) & 127; const size_t row_ = (size_t)(bh_ >> 3) * SEQ + n_ * 64 + tok; \
        const bf16* kp_ = proj + row_ * INW + RW + (bh_ & 7) * HD + dg * 8; const u32x4* cp_ = rope + ((size_t)(n_ * 64 + tok) * 64 + dg * 8) / 2; \
        k1 = *(const u32x4*)kp_; k2 = *(const u32x4*)(kp_ + 64); v1 = *(const u32x4*)(kp_ + RW); v2 = *(const u32x4*)(kp_ + RW + 64); c0 = cp_[0]; c1 = cp_[1]; c2 = cp_[2]; c3 = cp_[3]; } while (0)
    f32x16 R0, R1;
#pragma unroll
    for (int i = 0; i < 16; ++i) { R0[i] = 0.f; R1[i] = 0.f; }
    int u = (int)blockIdx.x * 8;
    RA_LOAD(u);
    for (int ui = 0; ui < 8; ++ui, ++u) {
        const int bh = u >> 7, h = bh & 7;
        const float lg2 = head_lg2(h);
        const f32x2 cs[8] = {(f32x2){__uint_as_float(c0.x), __uint_as_float(c0.y)}, (f32x2){__uint_as_float(c0.z), __uint_as_float(c0.w)}, (f32x2){__uint_as_float(c1.x), __uint_as_float(c1.y)}, (f32x2){__uint_as_float(c1.z), __uint_as_float(c1.w)},
                             (f32x2){__uint_as_float(c2.x), __uint_as_float(c2.y)}, (f32x2){__uint_as_float(c2.z), __uint_as_float(c2.w)}, (f32x2){__uint_as_float(c3.x), __uint_as_float(c3.y)}, (f32x2){__uint_as_float(c3.z), __uint_as_float(c3.w)}};
        float o1[8], o2[8]; rope8(k1, k2, cs, o1, o2);
        const float ksc = 0.08838834764831845f * __builtin_amdgcn_exp2f(lg2 * (float)(63 - tok));
#pragma unroll
        for (int j = 0; j < 8; ++j) { KT[tsw(dg * 8 + j, tok)] = (bf16)(pk2(o1[j] * ksc, 0.f) & 0xffffu); KT[tsw(64 + dg * 8 + j, tok)] = (bf16)(pk2(o2[j] * ksc, 0.f) & 0xffffu); }
        const unsigned vw1[4] = {v1.x, v1.y, v1.z, v1.w}, vw2[4] = {v2.x, v2.y, v2.z, v2.w};
#pragma unroll
        for (int j = 0; j < 4; ++j) {
            VT[tsw(dg * 8 + 2 * j, tok)] = (bf16)(vw1[j] & 0xffffu); VT[tsw(dg * 8 + 2 * j + 1, tok)] = (bf16)(vw1[j] >> 16);
            VT[tsw(64 + dg * 8 + 2 * j, tok)] = (bf16)(vw2[j] & 0xffffu); VT[tsw(64 + dg * 8 + 2 * j + 1, tok)] = (bf16)(vw2[j] >> 16);
        }
        if (ui < 7) RA_LOAD(u + 1);
        __syncthreads();
        const int dt = wave & 3, et0 = (wave >> 2) * 2, l31 = lane & 31, hh = lane >> 5;
        f32x16 acc0, acc1;
#pragma unroll
        for (int i = 0; i < 16; ++i) { acc0[i] = 0.f; acc1[i] = 0.f; }
#pragma unroll
        for (int ks = 0; ks < 4; ++ks) {
            const bf16x8 a = *(const bf16x8*)(KT + tsw(dt * 32 + l31, ks * 16 + 8 * hh));
            const bf16x8 b0 = *(const bf16x8*)(VT + tsw(et0 * 32 + l31, ks * 16 + 8 * hh));
            const bf16x8 b1 = *(const bf16x8*)(VT + tsw((et0 + 1) * 32 + l31, ks * 16 + 8 * hh));
            acc0 = MFMA32(a, b0, acc0); acc1 = MFMA32(a, b1, acc1);
        }
        bf16* kvu = KV + (size_t)u * 16384;
        const float cdec = __builtin_amdgcn_exp2f(lg2 * 64.f);
        if (ui > 0)
#pragma unroll
        for (int q = 0; q < 4; ++q) {
            const int d0 = dt * 32 + 8 * q + 4 * hh;
            u32x2 w0; w0.x = pk2(R0[4 * q], R0[4 * q + 1]); w0.y = pk2(R0[4 * q + 2], R0[4 * q + 3]);
            u32x2 w1; w1.x = pk2(R1[4 * q], R1[4 * q + 1]); w1.y = pk2(R1[4 * q + 2], R1[4 * q + 3]);
            *(u32x2*)(kvu + sidx(et0 * 32 + l31, d0)) = w0; *(u32x2*)(kvu + sidx((et0 + 1) * 32 + l31, d0)) = w1;
        }
#pragma unroll
        for (int i = 0; i < 16; ++i) { R0[i] = fmaf(R0[i], cdec, acc0[i]); R1[i] = fmaf(R1[i], cdec, acc1[i]); }
        if (ui == 7) {
            bf16* tot = (bf16*)(ws + WS_TOT) + (size_t)blockIdx.x * 16384;
#pragma unroll
            for (int q = 0; q < 4; ++q) {
                const int d0 = dt * 32 + 8 * q + 4 * hh;
                u32x2 w0; w0.x = pk2(R0[4 * q], R0[4 * q + 1]); w0.y = pk2(R0[4 * q + 2], R0[4 * q + 3]);
                u32x2 w1; w1.x = pk2(R1[4 * q], R1[4 * q + 1]); w1.y = pk2(R1[4 * q + 2], R1[4 * q + 3]);
                *(u32x2*)(tot + sidx(et0 * 32 + l31, d0)) = w0; *(u32x2*)(tot + sidx((et0 + 1) * 32 + l31, d0)) = w1;
            }
        }
        __syncthreads();
    }
#undef RA_LOAD
}

__device__ __forceinline__ void ret_pass_c(const Params& P, unsigned char* lds, int tid, int lane, int wave) {
    unsigned char* ws = P.ws;
    const bf16* proj = (const bf16*)(ws + WS_PROJ); const u32x4* rope = (const u32x4*)(ws + WS_ROPE); const bf16* KV = (const bf16*)(ws + WS_KV);
    bf16* mix = (bf16*)(ws + WS_BUFA);
    bf16* Qs = (bf16*)(lds + RC_QS); bf16* Ks = (bf16*)(lds + RC_KS); bf16* VT = (bf16*)(lds + RC_VT); bf16* Ps = (bf16*)(lds + RC_PS); float* Os = (float*)(lds + RC_OS);
    const int tok = tid >> 3, dg = tid & 7, l31 = lane & 31, hh = lane >> 5, l15 = lane & 15, l4 = lane >> 4;
    const int rt = wave & 1, ct = wave >> 1;
    u32x4 q1, q2, k1, k2, v1, v2, c0, c1, c2, c3;
    bf16x8 st[8];
#define RC_LOAD(uu) do { const int bh_ = (uu) >> 7, n_ = (uu) & 127; const size_t row_ = (size_t)(bh_ >> 3) * SEQ + n_ * 64 + tok; \
        const bf16* qp_ = proj + row_ * INW + (bh_ & 7) * HD + dg * 8; const u32x4* cp_ = rope + ((size_t)(n_ * 64 + tok) * 64 + dg * 8) / 2; \
        q1 = *(const u32x4*)qp_; q2 = *(const u32x4*)(qp_ + 64); k1 = *(const u32x4*)(qp_ + RW); k2 = *(const u32x4*)(qp_ + RW + 64); \
        c0 = cp_[0]; c1 = cp_[1]; c2 = cp_[2]; c3 = cp_[3]; } while (0)
#define RC_LOAD_ST(uu) do { const bf16* sp_ = KV + (size_t)(uu) * 16384 + sidx(ct * 32 + l31, 8 * hh); _Pragma("unroll") for (int ks_ = 0; ks_ < 8; ++ks_) st[ks_] = *(const bf16x8*)(sp_ + ks_ * 512); } while (0)
    const int rowb = panel_of((int)blockIdx.x) * 256 + ((int)blockIdx.x >> 6) * 64, ub = ((rowb >> 13) * 8) * 128 + ((rowb & 8191) >> 6);
    int u = ub;
    RC_LOAD(u);
    for (int hi = 0; hi < 8; ++hi, u += 128) {
        const int bh = u >> 7, n = u & 127, b = bh >> 3, h = bh & 7;
        const int un = (hi < 7) ? u + 128 : u;
        const float lg2 = head_lg2(h);
        { const bf16* cp_ = (const bf16*)(ws + WS_TOT) + ((size_t)bh * 16 + (n >> 3)) * 16384 + sidx(ct * 32 + l31, 8 * hh);
#pragma unroll
          for (int ks = 0; ks < 8; ++ks) st[ks] = *(const bf16x8*)(cp_ + ks * 512); }
        const int t3 = tid >> 3, part = tid & 7;
        const size_t row3 = (size_t)b * SEQ + n * 64 + t3;
        const bf16* gp = proj + row3 * INW + 3 * RW + h * HD + part * 16;
        { const bf16* vp_ = proj + ((size_t)b * SEQ + n * 64 + tok) * INW + 2 * RW + h * HD + dg * 8; v1 = *(const u32x4*)vp_; v2 = *(const u32x4*)(vp_ + 64); }
        u32x4 g0, g1; f32x2 sq2p;
        {
            const f32x2 cs[8] = {(f32x2){__uint_as_float(c0.x), __uint_as_float(c0.y)}, (f32x2){__uint_as_float(c0.z), __uint_as_float(c0.w)}, (f32x2){__uint_as_float(c1.x), __uint_as_float(c1.y)}, (f32x2){__uint_as_float(c1.z), __uint_as_float(c1.w)},
                                 (f32x2){__uint_as_float(c2.x), __uint_as_float(c2.y)}, (f32x2){__uint_as_float(c2.z), __uint_as_float(c2.w)}, (f32x2){__uint_as_float(c3.x), __uint_as_float(c3.y)}, (f32x2){__uint_as_float(c3.z), __uint_as_float(c3.w)}};
            float o1[8], o2[8]; u32x4 w;
            rope8(q1, q2, cs, o1, o2);
            w.x = pk2(o1[0], o1[1]); w.y = pk2(o1[2], o1[3]); w.z = pk2(o1[4], o1[5]); w.w = pk2(o1[6], o1[7]); *(u32x4*)(Qs + tok * 136 + dg * 8) = w;
            w.x = pk2(o2[0], o2[1]); w.y = pk2(o2[2], o2[3]); w.z = pk2(o2[4], o2[5]); w.w = pk2(o2[6], o2[7]); *(u32x4*)(Qs + tok * 136 + 64 + dg * 8) = w;
            rope8(k1, k2, cs, o1, o2);
            w.x = pk2(o1[0], o1[1]); w.y = pk2(o1[2], o1[3]); w.z = pk2(o1[4], o1[5]); w.w = pk2(o1[6], o1[7]); *(u32x4*)(Ks + tok * 136 + dg * 8) = w;
            w.x = pk2(o2[0], o2[1]); w.y = pk2(o2[2], o2[3]); w.z = pk2(o2[4], o2[5]); w.w = pk2(o2[6], o2[7]); *(u32x4*)(Ks + tok * 136 + 64 + dg * 8) = w;
            const unsigned vw1[4] = {v1.x, v1.y, v1.z, v1.w}, vw2[4] = {v2.x, v2.y, v2.z, v2.w};
#pragma unroll
            for (int j = 0; j < 4; ++j) {
                VT[tsw(dg * 8 + 2 * j, tok)] = (bf16)(vw1[j] & 0xffffu); VT[tsw(dg * 8 + 2 * j + 1, tok)] = (bf16)(vw1[j] >> 16);
                VT[tsw(64 + dg * 8 + 2 * j, tok)] = (bf16)(vw2[j] & 0xffffu); VT[tsw(64 + dg * 8 + 2 * j + 1, tok)] = (bf16)(vw2[j] >> 16);
            }
        }
        RC_LOAD(un);
        __syncthreads();
#pragma unroll
        for (int tt = 0; tt < 2; ++tt) {
            const int T = wave * 2 + tt, kt = T & 3, qt = T >> 2;
            f32x4 acc = (f32x4){0.f, 0.f, 0.f, 0.f};
#pragma unroll
            for (int ks = 0; ks < 4; ++ks) {
                const bf16x8 a = *(const bf16x8*)(Ks + (kt * 16 + l15) * 136 + ks * 32 + 8 * l4);
                const bf16x8 bq = *(const bf16x8*)(Qs + (qt * 16 + l15) * 136 + ks * 32 + 8 * l4);
                acc = MFMA16(a, bq, acc);
            }
            const int q = qt * 16 + l15, key0 = kt * 16 + 4 * l4;
            float v[4];
#pragma unroll
            for (int r = 0; r < 4; ++r) { const int dist = q - (key0 + r); v[r] = acc[r] * 0.08838834764831845f * __builtin_amdgcn_exp2f(lg2 * (float)(dist < 0 ? -dist : dist)); }
            u32x2 w; w.x = pk2(v[0], v[1]); w.y = pk2(v[2], v[3]);
            *(u32x2*)(Ps + q * 72 + key0) = w;
        }
        asm volatile("" ::: "memory");
        f32x16 acc;
#pragma unroll
        for (int i = 0; i < 16; ++i) acc[i] = 0.f;
#pragma unroll
        for (int ks = 0; ks < 8; ++ks) { const bf16x8 a = *(const bf16x8*)(Qs + (rt * 32 + l31) * 136 + ks * 16 + 8 * hh); acc = MFMA32(a, st[ks], acc); }
        { const float dj = __builtin_amdgcn_exp2f(lg2 * (float)(64 * (n & 7)));
#pragma unroll
          for (int i = 0; i < 16; ++i) acc[i] *= dj; }
        if (n & 7) RC_LOAD_ST(u);
        __syncthreads();
        {
            if (n & 7) {
#pragma unroll
            for (int ks = 0; ks < 8; ++ks) { const bf16x8 a = *(const bf16x8*)(Qs + (rt * 32 + l31) * 136 + ks * 16 + 8 * hh); acc = MFMA32(a, st[ks], acc); }
            }
#pragma unroll
            for (int i = 0; i < 16; ++i) { const int c = rt * 32 + 8 * (i >> 2) + 4 * hh + (i & 3); acc[i] *= __builtin_amdgcn_exp2f(lg2 * (float)(c + 1)); }
#pragma unroll
            for (int ks = 0; ks < 4; ++ks) {
                const bf16x8 a = *(const bf16x8*)(Ps + (rt * 32 + l31) * 72 + ks * 16 + 8 * hh);
                const bf16x8 bv = *(const bf16x8*)(VT + tsw(ct * 32 + l31, ks * 16 + 8 * hh));
                acc = MFMA32(a, bv, acc);
            }
            g0 = *(const u32x4*)gp; g1 = *(const u32x4*)(gp + 8); sq2p = *(const f32x2*)((const float*)(ws + WS_SQ2) + row3 * 16 + part * 2);
#pragma unroll
            for (int i = 0; i < 16; ++i) { const int c = rt * 32 + 8 * (i >> 2) + 4 * hh + (i & 3); Os[c * 132 + ct * 32 + l31] = acc[i]; }
        }
        __syncthreads();
        {
            const f32x4* op = (const f32x4*)(Os + t3 * 132 + part * 16);
            f32x4 x[4]; float s = 0.f;
#pragma unroll
            for (int j = 0; j < 4; ++j) { x[j] = op[j]; s += (x[j].x + x[j].y) + (x[j].z + x[j].w); }
            s += __shfl_xor(s, 1); s += __shfl_xor(s, 2); s += __shfl_xor(s, 4);
            const float mu = s * (1.f / 128.f); float q2s = 0.f;
#pragma unroll
            for (int j = 0; j < 4; ++j) { x[j] = x[j] - mu; q2s += (x[j].x * x[j].x + x[j].y * x[j].y) + (x[j].z * x[j].z + x[j].w * x[j].w); }
            q2s += __shfl_xor(q2s, 1); q2s += __shfl_xor(q2s, 2); q2s += __shfl_xor(q2s, 4);
            float sq2 = sq2p.x + sq2p.y; sq2 += __shfl_xor(sq2, 1); sq2 += __shfl_xor(sq2, 2); sq2 += __shfl_xor(sq2, 4);
            const float rstd = rsqrtf(q2s * (1.f / 128.f) + EPS) * sqrtf(sq2 * (1.f / SW) + EPS);
            const unsigned gw[8] = {g0.x, g0.y, g0.z, g0.w, g1.x, g1.y, g1.z, g1.w};
            const f32x4* gn = (const f32x4*)(P.in[3] + h * HD + part * 16);
            unsigned ow[8];
#pragma unroll
            for (int j = 0; j < 4; ++j) {
                const f32x4 gg = gn[j];
                const float ga = bflo(gw[2 * j]), gb = bfhi(gw[2 * j]), gc = bflo(gw[2 * j + 1]), gd = bfhi(gw[2 * j + 1]);
                const float ya = ga * pg8::sigmoid_f(ga) * (x[j].x * rstd * gg.x), yb = gb * pg8::sigmoid_f(gb) * (x[j].y * rstd * gg.y);
                const float yc = gc * pg8::sigmoid_f(gc) * (x[j].z * rstd * gg.z), yd = gd * pg8::sigmoid_f(gd) * (x[j].w * rstd * gg.w);
                ow[2 * j] = pk2(ya, yb); ow[2 * j + 1] = pk2(yc, yd);
            }
            bf16* mp = mix + row3 * DM + h * HD + part * 16;
            *(u32x4*)mp = (u32x4){ow[0], ow[1], ow[2], ow[3]}; *(u32x4*)(mp + 8) = (u32x4){ow[4], ow[5], ow[6], ow[7]};
        }
    }
    __syncthreads();
#undef RC_LOAD
#undef RC_LOAD_ST
}

struct ConvItem { const float* W; bf16* WT; const float* ks; int K, N, k0, n0, dst0; };
constexpr int CONV_ITEMS = 16 * 32 + 32 * 64 + 2 * 32 * 176 + 88 * 64;
__device__ __forceinline__ bool conv_decode(const Params& P, int id, ConvItem& c) {
    unsigned char* ws = P.ws;
    constexpr int I_GLU = 16 * 32, I_OUT = 32 * 64, I_GATE = 32 * 176, I_DOWN = 88 * 64;
    int r = id, kb, nb; c.ks = nullptr;
    if (r < 0 || r >= CONV_ITEMS) return false;
    if (r < I_GLU) { c.W = P.in[12]; c.WT = (bf16*)(ws + WS_WGLU); c.K = SW; c.N = SW; kb = r / 32; nb = r % 32; c.dst0 = nb * 32; }
    else if ((r -= I_GLU) < I_OUT) { c.W = P.in[15]; c.WT = (bf16*)(ws + WS_WOUT); c.K = DM; c.N = DM; kb = r / 64; nb = r % 64; c.dst0 = nb * 32; }
    else if ((r -= I_OUT) < I_GATE) { c.W = P.in[17]; c.WT = (bf16*)(ws + WS_WGU); c.K = DM; c.N = DFF; kb = r / 176; nb = r % 176; c.dst0 = ((nb * 32) >> 7) * 256 + ((nb * 32) & 127); c.ks = P.in[16]; }
    else if ((r -= I_GATE) < I_GATE) { c.W = P.in[18]; c.WT = (bf16*)(ws + WS_WGU); c.K = DM; c.N = DFF; kb = r / 176; nb = r % 176; c.dst0 = ((nb * 32) >> 7) * 256 + 128 + ((nb * 32) & 127); c.ks = P.in[16]; }
    else { r -= I_GATE; c.W = P.in[19]; c.WT = (bf16*)(ws + WS_WD); c.K = DFF; c.N = DM; kb = r / 64; nb = r % 64; c.dst0 = nb * 32; }
    c.k0 = kb * 64; c.n0 = nb * 32; return true;
}
__device__ __forceinline__ void conv_issue(const ConvItem& c, unsigned char* scr, int lane) {
    const int kr = lane >> 3, p = lane & 7;
    const float* src = c.W + (size_t)(c.k0 + kr) * c.N + c.n0;
#pragma unroll
    for (int i = 0; i < 8; ++i) { const int sc = p ^ ((kr ^ i) & 7);
        __builtin_amdgcn_global_load_lds((const unsigned*)(src + (size_t)(8 * i) * c.N + 4 * sc), (PG8_LAS unsigned*)(scr + i * 1024), 16, 0, 0); }
}
__device__ __forceinline__ void conv_consume(const ConvItem& c, const unsigned char* scr, int lane) {
    asm volatile("s_waitcnt vmcnt(0)" ::: "memory");
    const int cc = lane & 7;
    f32x4 ks0 = (f32x4){1.f, 1.f, 1.f, 1.f}, ks1 = ks0;
    if (c.ks) { ks0 = *(const f32x4*)(c.ks + c.k0 + 8 * cc); ks1 = *(const f32x4*)(c.ks + c.k0 + 8 * cc + 4); }
#pragma unroll
    for (int j = 0; j < 4; ++j) { const int n = (lane >> 3) + 8 * j; float v[8];
#pragma unroll
        for (int t = 0; t < 8; ++t) v[t] = *(const float*)(scr + (8 * cc + t) * 128 + (((n >> 2) ^ ((t ^ cc) & 7)) * 16) + (n & 3) * 4);
        u32x4 o; o.x = pk2(v[0] * ks0.x, v[1] * ks0.y); o.y = pk2(v[2] * ks0.z, v[3] * ks0.w); o.z = pk2(v[4] * ks1.x, v[5] * ks1.y); o.w = pk2(v[6] * ks1.z, v[7] * ks1.w);
        *(u32x4*)(c.WT + (size_t)(c.dst0 + n) * c.K + c.k0 + 8 * cc) = o; }
    LDS_FENCE();
}

#define CMUL_ADD(or_, oi_, ar_, ai_, br_, bi_, cr_, ci_) do { const float _r = fmaf((ar_), (br_), fmaf(-(ai_), (bi_), (cr_))); const float _i = fmaf((ar_), (bi_), fmaf((ai_), (br_), (ci_))); (or_) = _r; (oi_) = _i; } while (0)
template <bool FULL>
__device__ __forceinline__ void s5_wave(const Params& P, unsigned char* wlds, int b, int g, int ch, int lane, int gw) {
    unsigned char* ws = P.ws;
    const bf16* proj = (const bf16*)(ws + WS_PROJ);
    const bf16* BbT = (const bf16*)(ws + WS_S5P + S5P_BBT); const bf16* CmT = (const bf16*)(ws + WS_S5P + S5P_CMT);
    const f32x2* lamp = (const f32x2*)(ws + WS_S5P + S5P_LAM);
    f32x2* ST = (f32x2*)(ws + WS_S5ST);
    const int n = lane & 31, hh = lane >> 5, l15 = lane & 15, l4 = lane >> 4;
    bf16x8 Bb[4];
#pragma unroll
    for (int v = 0; v < 4; ++v) Bb[v] = *(const bf16x8*)(BbT + ((size_t)g * 128 + (v & 1) * 64 + (v >> 1) * 32 + n) * 16 + 8 * hh);
    float lr[2][4], li[2][4];
#pragma unroll
    for (int k = 0; k < 2; ++k) {
        const f32x2 l1 = lamp[g * 64 + k * 32 + n]; lr[k][0] = l1.x; li[k][0] = l1.y;
#pragma unroll
        for (int e = 1; e < 4; ++e) { lr[k][e] = lr[k][e - 1] * l1.x - li[k][e - 1] * l1.y; li[k][e] = lr[k][e - 1] * l1.y + li[k][e - 1] * l1.x; }
    }
    float car[2], cai[2];
    const size_t stbase = (((size_t)b * 16 + ch) * 64 + g) * 64;
    car[0] = cai[0] = car[1] = cai[1] = 0.f;
    if (FULL) {
        const f32x2* lamL = (const f32x2*)(ws + WS_S5P + S5P_LAML);
        const f32x2 L0 = lamL[g * 64 + n], L1 = lamL[g * 64 + 32 + n];
        for (int c = 0; c < ch; ++c) { const size_t eb = (((size_t)b * 16 + c) * 64 + g) * 64; const f32x2 e0 = ST[eb + n], e1 = ST[eb + 32 + n];
            CMUL_ADD(car[0], cai[0], L0.x, L0.y, car[0], cai[0], e0.x, e0.y); CMUL_ADD(car[1], cai[1], L1.x, L1.y, car[1], cai[1], e1.x, e1.y); }
    }
    bf16x8 Cm[4];
    f32x4 dsk = (f32x4){0.f, 0.f, 0.f, 0.f};
    if (FULL) {
#pragma unroll
        for (int ks = 0; ks < 4; ++ks) Cm[ks] = *(const bf16x8*)(CmT + ((size_t)g * 16 + l15) * 128 + ks * 32 + 8 * l4);
        dsk = *(const f32x4*)(P.in[11] + g * 16 + 4 * l4);
    }
    bf16* y1 = (bf16*)(ws + WS_Y1);
    for (int sb = 0; sb < 16; ++sb) {
        const size_t row0 = (size_t)b * SEQ + ch * 512 + sb * 32;
        const bf16x8 U = *(const bf16x8*)(proj + (row0 + n) * INW + 4 * RW + g * 16 + 8 * hh);
        f32x16 bu[4];
#pragma unroll
        for (int v = 0; v < 4; ++v) {
#pragma unroll
            for (int i = 0; i < 16; ++i) bu[v][i] = 0.f;
            bu[v] = MFMA32(U, Bb[v], bu[v]);
        }
        ConvItem cvi; bool cvok = false;
        if (FULL && sb < 10) { cvok = conv_decode(P, sb * 2048 + gw, cvi); if (cvok) conv_issue(cvi, wlds + 8704, lane); }
        float er[2][4], ei[2][4];
#pragma unroll
        for (int k = 0; k < 2; ++k)
#pragma unroll
            for (int q = 0; q < 4; ++q) {
                float sr = bu[2 * k][4 * q], si = bu[2 * k + 1][4 * q];
#pragma unroll
                for (int j = 1; j < 4; ++j) { CMUL_ADD(sr, si, lr[k][0], li[k][0], sr, si, bu[2 * k][4 * q + j], bu[2 * k + 1][4 * q + j]); bu[2 * k][4 * q + j] = sr; bu[2 * k + 1][4 * q + j] = si; }
                er[k][q] = sr; ei[k][q] = si;
            }
        float mr[2][4], mi[2][4];
#pragma unroll
        for (int k = 0; k < 2; ++k) {
            float cr = car[k], ci = cai[k];
#pragma unroll
            for (int q = 0; q < 4; ++q) {
                const float pr = __shfl_xor(er[k][q], 32), pi = __shfl_xor(ei[k][q], 32);
                const float ear = hh ? pr : er[k][q], eai = hh ? pi : ei[k][q];
                const float ebr = hh ? er[k][q] : pr, ebi = hh ? ei[k][q] : pi;
                float c1r, c1i, c2r, c2i;
                CMUL_ADD(c1r, c1i, lr[k][3], li[k][3], cr, ci, ear, eai);
                CMUL_ADD(c2r, c2i, lr[k][3], li[k][3], c1r, c1i, ebr, ebi);
                mr[k][q] = hh ? c1r : cr; mi[k][q] = hh ? c1i : ci;
                cr = c2r; ci = c2i;
            }
            car[k] = cr; cai[k] = ci;
        }
        if (FULL) {
#pragma unroll
            for (int q = 0; q < 4; ++q)
#pragma unroll
                for (int j = 0; j < 4; ++j) {
                    float s0r, s0i, s1r, s1i;
                    CMUL_ADD(s0r, s0i, lr[0][j], li[0][j], mr[0][q], mi[0][q], bu[0][4 * q + j], bu[1][4 * q + j]);
                    CMUL_ADD(s1r, s1i, lr[1][j], li[1][j], mr[1][q], mi[1][q], bu[2][4 * q + j], bu[3][4 * q + j]);
                    u32x2 w; w.x = pk2(s0r, s0i); w.y = pk2(s1r, s1i);
                    *(u32x2*)(wlds + (8 * q + 4 * hh + j) * 272 + n * 8) = w;
                }
            LDS_FENCE();
            f32x4 yt[2];
#pragma unroll
            for (int tt = 0; tt < 2; ++tt) {
                yt[tt] = (f32x4){0.f, 0.f, 0.f, 0.f};
#pragma unroll
                for (int ks = 0; ks < 4; ++ks) { const bf16x8 sv = *(const bf16x8*)(wlds + (tt * 16 + l15) * 272 + (ks * 32 + 8 * l4) * 2); yt[tt] = MFMA16(Cm[ks], sv, yt[tt]); }
            }
            LDS_FENCE();
#pragma unroll
            for (int tt = 0; tt < 2; ++tt) {
                const size_t row = row0 + tt * 16 + l15;
                const u32x2 uw = *(const u32x2*)(proj + row * INW + 4 * RW + g * 16 + 4 * l4);
                const float uu[4] = {bflo(uw.x), bfhi(uw.x), bflo(uw.y), bfhi(uw.y)};
                float o[4];
#pragma unroll
                for (int r = 0; r < 4; ++r) { const float y = yt[tt][r] + dsk[r] * uu[r]; const float z = 1.5957691216057308f * (y + 0.044715f * y * y * y); o[r] = y * pg8::sigmoid_f(z); }
                u32x2 w; w.x = pk2(o[0], o[1]); w.y = pk2(o[2], o[3]);
                *(u32x2*)(y1 + row * SW + g * 16 + 4 * l4) = w;
            }
            if (cvok) conv_consume(cvi, wlds + 8704, lane);
        }
    }
    if (!FULL) { if (hh == 0) { ST[stbase + n] = (f32x2){car[0], cai[0]}; ST[stbase + 32 + n] = (f32x2){car[1], cai[1]}; } }
}

__device__ __forceinline__ void scan_phase(const Params& P, int tid) {
    unsigned char* ws = P.ws;
    const int gt = blockIdx.x * 512 + tid, NGT = gridDim.x * 512;
    for (int e = gt; e < 16 * 8192; e += NGT) {
        const int bh = e >> 13, off = (e & 8191) * 2, h = bh & 7;
        const float dec = __builtin_amdgcn_exp2f(head_lg2(h) * 512.f);
        unsigned* p = (unsigned*)((bf16*)(ws + WS_TOT) + (size_t)bh * 16 * 16384 + off);
        unsigned kv[16];
#pragma unroll
        for (int j = 0; j < 16; ++j) kv[j] = p[(size_t)j * 8192];
        float s0 = 0.f, s1 = 0.f;
#pragma unroll
        for (int j = 0; j < 16; ++j) { p[(size_t)j * 8192] = pk2(s0, s1); s0 = fmaf(s0, dec, bflo(kv[j])); s1 = fmaf(s1, dec, bfhi(kv[j])); }
    }
}

__device__ __forceinline__ void ssm_norm_phase(const Params& P, int lane, int wave) {
    unsigned char* ws = P.ws; const bf16* y2 = (const bf16*)(ws + WS_Y2); bf16* mix = (bf16*)(ws + WS_BUFA);
    const int gw = blockIdx.x * 8 + wave, NGW = gridDim.x * 8;
    for (int m = gw; m < MTOK; m += NGW) {
        const u32x4 a = *(const u32x4*)(y2 + (size_t)m * SW + lane * 8), c = *(const u32x4*)(y2 + (size_t)m * SW + 512 + lane * 8);
        const unsigned w[8] = {a.x, a.y, a.z, a.w, c.x, c.y, c.z, c.w};
        float v[16]; float s = 0.f;
#pragma unroll
        for (int j = 0; j < 8; ++j) { v[2 * j] = bflo(w[j]); v[2 * j + 1] = bfhi(w[j]); s += v[2 * j] * v[2 * j] + v[2 * j + 1] * v[2 * j + 1]; }
        const float r = rsqrtf(wave_sum(s) * (1.f / SW) + EPS);
        const f32x4* g0 = (const f32x4*)(P.in[14] + lane * 8); const f32x4* g1 = (const f32x4*)(P.in[14] + 512 + lane * 8);
        const f32x4 ga = g0[0], gb = g0[1], gc = g1[0], gd = g1[1];
        u32x4 o0, o1;
        o0.x = pk2(v[0] * r * ga.x, v[1] * r * ga.y); o0.y = pk2(v[2] * r * ga.z, v[3] * r * ga.w); o0.z = pk2(v[4] * r * gb.x, v[5] * r * gb.y); o0.w = pk2(v[6] * r * gb.z, v[7] * r * gb.w);
        o1.x = pk2(v[8] * r * gc.x, v[9] * r * gc.y); o1.y = pk2(v[10] * r * gc.z, v[11] * r * gc.w); o1.z = pk2(v[12] * r * gd.x, v[13] * r * gd.y); o1.w = pk2(v[14] * r * gd.z, v[15] * r * gd.w);
        *(u32x4*)(mix + (size_t)m * DM + RW + lane * 8) = o0; *(u32x4*)(mix + (size_t)m * DM + RW + 512 + lane * 8) = o1;
    }
}
__device__ __forceinline__ void final_norm_phase(const Params& P, int lane, int wave) {
    const bf16* x2 = (const bf16*)(P.ws + WS_BUFA);
    const int mb = panel_of((int)blockIdx.x) * 256 + ((int)blockIdx.x >> 6) * 64 + wave * 8;
    for (int m = mb; m < mb + 8; ++m) {
        const bf16* xr = x2 + (size_t)m * DM + lane * 8;
        u32x4 w[4]; float s = 0.f;
#pragma unroll
        for (int j = 0; j < 4; ++j) w[j] = *(const u32x4*)(xr + 512 * j);
        float v[4][8];
#pragma unroll
        for (int j = 0; j < 4; ++j) { const unsigned ww[4] = {w[j].x, w[j].y, w[j].z, w[j].w};
#pragma unroll
            for (int k = 0; k < 4; ++k) { v[j][2 * k] = bflo(ww[k]); v[j][2 * k + 1] = bfhi(ww[k]); s += v[j][2 * k] * v[j][2 * k] + v[j][2 * k + 1] * v[j][2 * k + 1]; } }
        const float r = rsqrtf(wave_sum(s) * (1.f / DM) + EPS);
        float* orow = P.out + (size_t)m * DM + lane * 8; const float* gr = P.in[20] + lane * 8;
#pragma unroll
        for (int j = 0; j < 4; ++j) { const f32x4 g0 = *(const f32x4*)(gr + 512 * j), g1 = *(const f32x4*)(gr + 512 * j + 4);
            *(f32x4*)(orow + 512 * j) = (f32x4){v[j][0] * r * g0.x, v[j][1] * r * g0.y, v[j][2] * r * g0.z, v[j][3] * r * g0.w};
            *(f32x4*)(orow + 512 * j + 4) = (f32x4){v[j][4] * r * g1.x, v[j][5] * r * g1.y, v[j][6] * r * g1.z, v[j][7] * r * g1.w}; }
    }
}

#define LAS __attribute__((address_space(3)))
#define XB_TMO      128
#define XB_XCNT(j)  (256  + 64 * (j))
#define XB_XSUB(j)  (1280 + 64 * (j))
#define XB_XGEN(j)  (2304 + 64 * (j))
#define XB_TOP      3328
#define XB_TOPGEN   3392
#define XCD_BAR_WORDS 3456
#define XB_SPIN_CAP (1u << 18)

__device__ __forceinline__ unsigned xb_ld(unsigned* p)              { return __hip_atomic_load(p, __ATOMIC_RELAXED, __HIP_MEMORY_SCOPE_AGENT); }
__device__ __forceinline__ unsigned xb_add(unsigned* p, unsigned v) { return __hip_atomic_fetch_add(p, v, __ATOMIC_RELAXED, __HIP_MEMORY_SCOPE_AGENT); }
__device__ __forceinline__ unsigned xb_xcc_id() { return (unsigned)__builtin_amdgcn_s_getreg((3 << 11) | 20) & 0xFu; }
#define XB_SPIN(cond, bar) do { unsigned _sp = 0; while (cond) { __builtin_amdgcn_s_sleep(1); \
    if ((++_sp & 255u) == 0u) { if (xb_ld(&(bar)[XB_TMO])) break; if (_sp > XB_SPIN_CAP) { atomicAdd(&(bar)[XB_TMO], 1u); break; } } } } while (0)

struct XcdBarrier {
    unsigned* bar; unsigned x;
    volatile LAS unsigned* st;
};

__device__ __forceinline__ XcdBarrier xcd_barrier_post(unsigned* bar, volatile LAS unsigned* st) {
    XcdBarrier b; b.bar = bar; b.x = xb_xcc_id(); b.st = st;
    if (threadIdx.x == 0) (void)xb_add(&bar[XB_XCNT(b.x)], 1u);
    return b;
}
__device__ __forceinline__ void xcd_barrier_complete(unsigned* bar, unsigned x, unsigned& nloc, unsigned& nx) {
    const unsigned G = gridDim.x * gridDim.y * gridDim.z;
    unsigned sum, cnt, mine, sp = 0u;
    for (;;) {
        sum = 0u; cnt = 0u; mine = 0u;
#pragma unroll
        for (unsigned j = 0; j < 16; ++j) { const unsigned c = xb_ld(&bar[XB_XCNT(j)]); sum += c; cnt += (c > 0u) ? 1u : 0u; mine = (j == x) ? c : mine; }
        if (sum == G) break;
        __builtin_amdgcn_s_sleep(1);
        if ((++sp & 255u) == 0u) { if (xb_ld(&bar[XB_TMO])) break; if (sp > XB_SPIN_CAP) { atomicAdd(&bar[XB_TMO], 1u); break; } }
    }
    nloc = mine > 0u ? mine : 1u; nx = cnt > 0u ? cnt : 1u;
}

__device__ __forceinline__ void xcd_barrier(const XcdBarrier& b) {
    asm volatile("s_waitcnt vmcnt(0)" ::: "memory");
    __syncthreads();
    if (threadIdx.x == 0) {
        unsigned* bar = b.bar;
        __builtin_amdgcn_s_waitcnt(0);
        unsigned nloc = b.st[0], nx = b.st[1];
        if (nloc == 0u) { xcd_barrier_complete(bar, b.x, nloc, nx); b.st[0] = nloc; b.st[1] = nx; }
        const unsigned old = xb_add(&bar[XB_XSUB(b.x)], 1u);
        const unsigned gen = old / nloc;
        if (old + 1u == (gen + 1u) * nloc) {
            __builtin_amdgcn_fence(__ATOMIC_RELEASE, "agent");
            asm volatile("s_waitcnt vmcnt(0)" ::: "memory");
            const unsigned og = xb_add(&bar[XB_TOP], 1u);
            const unsigned tg = og / nx;
            if (og + 1u == (tg + 1u) * nx) xb_add(&bar[XB_TOPGEN], 1u);
            else XB_SPIN(xb_ld(&bar[XB_TOPGEN]) == tg, bar);
            __builtin_amdgcn_fence(__ATOMIC_ACQUIRE, "agent");
            xb_add(&bar[XB_XGEN(b.x)], 1u);
            asm volatile("s_waitcnt vmcnt(0)" ::: "memory");
        } else {
            XB_SPIN(xb_ld(&bar[XB_XGEN(b.x)]) == gen, bar);
            __builtin_amdgcn_fence(__ATOMIC_ACQUIRE, "agent");
            asm volatile("s_waitcnt vmcnt(0)" ::: "memory");
        }
    }
    __syncthreads();
}

__device__ __forceinline__ void group_barrier(unsigned* ctl, int seam, int pm, bool samex) {
    asm volatile("s_waitcnt vmcnt(0)" ::: "memory");
    __syncthreads();
    if (threadIdx.x == 0) {
        unsigned* cnt = ctl + (CTL_GRP / 4) + (seam * 64 + pm) * 64;
        if (!samex) { __builtin_amdgcn_fence(__ATOMIC_RELEASE, "agent"); asm volatile("s_waitcnt vmcnt(0)" ::: "memory"); }
        xb_add(cnt, 1u);
        unsigned sp = 0u;
        while (xb_ld(cnt) < 4u) { __builtin_amdgcn_s_sleep(1); if (++sp > (1u << 22)) break; }
        __builtin_amdgcn_fence(__ATOMIC_ACQUIRE, "agent");
        asm volatile("s_waitcnt vmcnt(0)" ::: "memory");
    }
    __syncthreads();
}
template <int PH>
__device__ __forceinline__ void run_phase(const Params& P, unsigned char* lds, int tid, int lane, int wave) {
    unsigned char* ws = P.ws;
    PG8_LAS unsigned char* glds = (PG8_LAS unsigned char*)lds;
    if constexpr (PH == 0) p0_phase(P, lds, tid, lane, wave);
    if constexpr (PH == 1) {
        pg8::Gemm g{(const bf16*)(ws + WS_XB), (const bf16*)(ws + WS_WIN), MTOK, INW, DM}; pg8::StaticOrder S; S.init(MTOK, INW, gridDim.x, blockIdx.x);
        pg8::EpiStoreBf16 E{(bf16*)(ws + WS_PROJ), INW, (const float*)(ws + WS_RS0)};
        pg8::gemm_phase<pg8::EpiStoreBf16, pg8::StaticOrder, true, true>(glds, g, S, E);
    }
    if constexpr (PH == 2) {
        ret_pass_a(P, lds, tid, lane, wave);
        { const int id = blockIdx.x * 8 + wave; if (id < 2048) s5_wave<false>(P, lds + wave * S5_WLDS, id >> 10, id & 63, (id >> 6) & 15, lane, id); }
    }
    if constexpr (PH == 3) {
        scan_phase(P, tid);
        const int id = blockIdx.x * 8 + wave; if (id < 2048) s5_wave<true>(P, lds + wave * S5_WLDS, id >> 10, id & 63, (id >> 6) & 15, lane, id);
    }
    if constexpr (PH == 5) {
        pg8::Gemm g{(const bf16*)(ws + WS_Y1), (const bf16*)(ws + WS_WGLU), MTOK, SW, SW}; pg8::StaticOrder S; S.init(MTOK, SW, gridDim.x, blockIdx.x);
        pg8::EpiGlu E{(const bf16*)(ws + WS_Y1), P.in[13], P.in[14], (bf16*)(ws + WS_BUFA) + RW, (float*)(ws + WS_SQ2), SW, DM};
        pg8::gemm_phase<pg8::EpiGlu, pg8::StaticOrder, false, true>(glds, g, S, E);
    }
    if constexpr (PH == 6) ret_pass_c(P, lds, tid, lane, wave);
    if constexpr (PH == 7) {
        pg8::Gemm g{(const bf16*)(ws + WS_BUFA), (const bf16*)(ws + WS_WOUT), MTOK, DM, DM}; pg8::StaticOrder S; S.init(MTOK, DM, gridDim.x, blockIdx.x);
        pg8::EpiResB E{nullptr, (const bf16*)(ws + WS_XB), (bf16*)(ws + WS_X1B), DM, (const float*)(ws + WS_SQ2), 1.f / SW, (float*)(ws + WS_SQ1)};
        pg8::gemm_phase<pg8::EpiResB, pg8::StaticOrder, false, true>(glds, g, S, E);
    }
    if constexpr (PH == 9) {
        pg8::Gemm g{(const bf16*)(ws + WS_X1B), (const bf16*)(ws + WS_WGU), MTOK, 2 * DFF, DM}; pg8::StaticOrder S; S.init(MTOK, 2 * DFF, gridDim.x, blockIdx.x);
        pg8::Unit u0; int pm0 = -1; if (S.next(0, u0)) pm0 = u0.pm;
        float* rsl = (float*)(lds + LDS_KEEP + 64);
        if (pm0 >= 0 && tid < 256) { const f32x4* pp = (const f32x4*)((const float*)(ws + WS_SQ1) + (size_t)(pm0 * 256 + tid) * 32); float t = 0.f;
#pragma unroll
            for (int j = 0; j < 8; ++j) { const f32x4 p4 = pp[j]; t += (p4[0] + p4[1]) + (p4[2] + p4[3]); }
            rsl[tid] = rsqrtf(t * (1.f / DM) + EPS); }
        __syncthreads();
        pg8::EpiSwiGlu E{(bf16*)(ws + WS_ACT), DFF, (const float*)(ws + WS_SQ1), 1.f / DM, rsl, pm0};
        pg8::gemm_phase<pg8::EpiSwiGlu, pg8::StaticOrder, true, true>(glds, g, S, E);
    }
    if constexpr (PH == 10) {
        pg8::Gemm g{(const bf16*)(ws + WS_ACT), (const bf16*)(ws + WS_WD), MTOK, DM, DFF}; pg8::StaticOrder S; S.init(MTOK, DM, gridDim.x, blockIdx.x);
        pg8::EpiResB E{nullptr, (const bf16*)(ws + WS_X1B), (bf16*)(ws + WS_BUFA), DM, nullptr, 0.f, nullptr};
        pg8::gemm_phase<pg8::EpiResB, pg8::StaticOrder, false, true>(glds, g, S, E);
    }
    if constexpr (PH == 11) final_norm_phase(P, lane, wave);
}
#define R(k) { int t_ = threadIdx.x; asm volatile("" : "+v"(t_)); run_phase<k>(P, lds, t_, t_ & 63, __builtin_amdgcn_readfirstlane(t_ >> 6)); }
#define BST ((volatile LAS unsigned*)((LAS unsigned char*)lds + LDS_KEEP))
#define S { XcdBarrier b_; b_.bar = (unsigned*)(P.ws + WS_CTL); b_.x = xb_xcc_id(); b_.st = BST; xcd_barrier(b_); }
#define G(k) group_barrier((unsigned*)(P.ws + WS_CTL), k, panel_of((int)blockIdx.x), BST[2] != 0u);
#define PHASE_PROGRAM R(0) S R(1) S R(2) S R(3) S GROUP_CHECK R(5) G(0) R(6) S R(7) G(1) R(9) G(2) R(10) G(3) R(11)
__global__ void __launch_bounds__(512, 2) hybrid_fwd(Params P) {
    extern __shared__ __attribute__((aligned(16))) unsigned char lds[];
    cg::grid_group grid = cg::this_grid();
    const int tid = threadIdx.x, lane = tid & 63, wave = __builtin_amdgcn_readfirstlane(tid >> 6);
    if (P.ws == nullptr) grid.sync();
    if (tid < 3) BST[tid] = 0u;
    __syncthreads();
    { XcdBarrier bar = xcd_barrier_post((unsigned*)(P.ws + WS_CTL), BST); (void)bar; }
    if (tid == 0) __hip_atomic_store((unsigned*)(P.ws + WS_CTL + CTL_XID) + blockIdx.x, xb_xcc_id() + 1u, __ATOMIC_RELAXED, __HIP_MEMORY_SCOPE_AGENT);
#define GROUP_CHECK { unsigned ok_ = 1u; const unsigned* xid_ = (const unsigned*)(P.ws + WS_CTL + CTL_XID); _Pragma("unroll") for (int k_ = 0; k_ < 4; ++k_) ok_ &= (xb_ld((unsigned*)xid_ + ((blockIdx.x & 63) + 64 * k_)) == xb_xcc_id() + 1u) ? 1u : 0u; if (threadIdx.x == 0) BST[2] = ok_; __syncthreads(); }
    PHASE_PROGRAM
}
#undef R
#undef S

extern "C" void kernel_launch(void* const* d_in, const int* in_sizes, int n_in, void* d_out, int out_size, void* d_ws, size_t ws_size, hipStream_t stream) {
    static int grid = 0;
    if (grid == 0) {
        if (n_in != 21 || out_size != MTOK * DM || ws_size < WS_END) { fprintf(stderr, "kernel_launch: unexpected shapes (n_in %d out %d ws %zu)\n", n_in, out_size, ws_size); grid = -1; return; }
        int dev = 0, cus = 0, per_cu = 0;
        (void)hipGetDevice(&dev); (void)hipDeviceGetAttribute(&cus, hipDeviceAttributeMultiprocessorCount, dev);
        if (hipFuncSetAttribute((const void*)hybrid_fwd, hipFuncAttributeMaxDynamicSharedMemorySize, LDS_BYTES) != hipSuccess) { fprintf(stderr, "kernel_launch: hipFuncSetAttribute failed\n"); grid = -1; return; }
        if (hipOccupancyMaxActiveBlocksPerMultiprocessor(&per_cu, (const void*)hybrid_fwd, 512, LDS_BYTES) != hipSuccess || per_cu < 1) { fprintf(stderr, "kernel_launch: occupancy query says %d\n", per_cu); per_cu = 1; }
        (void)hipGetLastError();
        grid = cus * 1;
        if (grid != 256) { fprintf(stderr, "kernel_launch: built for a 256-CU device (got %d)\n", cus); grid = -1; return; }
    }
    if (grid < 0) return;
    Params p{};
    for (int i = 0; i < 21; ++i) p.in[i] = (const float*)d_in[i];
    p.out = (float*)d_out; p.ws = (unsigned char*)d_ws;
    if (hipMemsetAsync((unsigned char*)d_ws + WS_CTL, 0, CTL_ZERO, stream) != hipSuccess) { fprintf(stderr, "kernel_launch: memset of the barrier words failed\n"); return; }
    void* args[] = {&p};
    hipError_t e = hipLaunchCooperativeKernel((const void*)hybrid_fwd, dim3(grid), dim3(512), args, LDS_BYTES, stream);
    if (e != hipSuccess) fprintf(stderr, "cooperative launch failed: %s (grid %d)\n", hipGetErrorString(e), grid);
}
```

```cpp
#include <hip/hip_runtime.h>
#include <hip/hip_cooperative_groups.h>
#include <cstdio>
#include <cstdint>
namespace cg = cooperative_groups;
namespace pg8 {
#define PG8_LAS __attribute__((address_space(3)))
typedef unsigned short bf16_t;
typedef short bf16x8 __attribute__((ext_vector_type(8)));
typedef float f32x4 __attribute__((ext_vector_type(4)));
typedef unsigned u32x4 __attribute__((ext_vector_type(4)));
constexpr int BM = 256, BK = 64, HALF = 128, HTB = HALF * BK * 2  , STAGE_BYTES = 8 * HTB, NXCD = 8, WGM = 8;

__host__ __device__ __forceinline__ int lds_byte(int r, int c) { const int st = (r >> 4) * 2 + (c >> 5), rr = r & 15, cc = c & 31, ob = rr * 64 + cc * 2; return st * 1024 + (ob ^ (((ob >> 9) & 1) << 5)); }
__host__ __device__ __forceinline__ void stage_rc(int b, int& R, int& C) { const int st = b / 1024, sb = b % 1024, swz = sb ^ (((sb >> 9) & 1) << 5); R = (st >> 1) * 16 + swz / 64; C = (st & 1) * 32 + (swz % 64) / 2; }
__host__ __device__ __forceinline__ int perm32(int rho) { const int n = rho >> 4, i = rho & 15; return 8 * (i >> 2) + 4 * n + (i & 3); }

struct Unit { int pm, pn; };
struct Gemm { const bf16_t* A; const bf16_t* Bt; int M, N, K; };

struct StaticOrder {
    int nM, nN, nwg, G, c;
    __host__ __device__ void init(int M, int N, int G_, int c_) { nM = M / BM; nN = N / BM; nwg = nM * nN; G = G_; c = c_; }
    __host__ __device__ bool next(int i, Unit& u) const {
        const long L = (long)i * G + c; if (L >= nwg) return false;
        int wgid = (int)L; { const int q = nwg / NXCD, r = nwg % NXCD, xcd = wgid % NXCD, off = wgid / NXCD; wgid = (xcd < r ? xcd * (q + 1) : r * (q + 1) + (xcd - r) * q) + off; }
        const int nig = WGM * nN, gid = wgid / nig, fm = gid * WGM, gsz = (nM - fm) < WGM ? (nM - fm) : WGM;
        u.pm = fm + ((wgid % nig) % gsz); u.pn = (wgid % nig) / gsz; return true;
    }
    __device__ __forceinline__ void a_ready(const Unit&) const {}
    __device__ __forceinline__ void done(const Unit&) const {}
};

typedef __bf16 bf16x2_t __attribute__((ext_vector_type(2)));
__device__ __forceinline__ unsigned cvt_pk_bf16(float lo, float hi) { bf16x2_t v = {(__bf16)lo, (__bf16)hi}; return __builtin_bit_cast(unsigned, v); }
__device__ __forceinline__ float bf_lo(unsigned w) { return __uint_as_float(w << 16); }
__device__ __forceinline__ float bf_hi(unsigned w) { return __uint_as_float(w & 0xffff0000u); }
typedef unsigned u32x2v __attribute__((ext_vector_type(2)));
__device__ __forceinline__ float sigmoid_f(float z) { return __builtin_amdgcn_rcpf(1.0f + __expf(-z)); }

struct EpiStoreBf16 {
    static constexpr bool PERM = true, AFTER_DRAIN = false;
    bf16_t* O; int ldc; const float* rs;
    __device__ __forceinline__ void operator()(const f32x4 (&acc)[2][2][4][2], const Unit& u, int wr, int wc, int fr, int fq) const {
        const int row0 = u.pm * BM + wr * 64 + fr, col0 = u.pn * BM + wc * 32 + 8 * fq;
        float rv[2][4];
#pragma unroll
        for (int ai = 0; ai < 2; ++ai)
#pragma unroll
            for (int m = 0; m < 4; ++m) rv[ai][m] = rs[row0 + ai * HALF + m * 16];
#pragma unroll
        for (int ai = 0; ai < 2; ++ai)
#pragma unroll
            for (int m = 0; m < 4; ++m) { bf16_t* rowp = O + (size_t)(row0 + ai * HALF + m * 16) * ldc + col0;
#pragma unroll
                for (int bj = 0; bj < 2; ++bj) { const f32x4 v0 = acc[ai][bj][m][0] * rv[ai][m], v1 = acc[ai][bj][m][1] * rv[ai][m];
                    u32x4 w; w.x = cvt_pk_bf16(v0[0], v0[1]); w.y = cvt_pk_bf16(v0[2], v0[3]); w.z = cvt_pk_bf16(v1[0], v1[1]); w.w = cvt_pk_bf16(v1[2], v1[3]);
                    *(u32x4*)(rowp + bj * HALF) = w; } }
    }
};
struct EpiGlu {
    static constexpr bool PERM = true, AFTER_DRAIN = false;
    const bf16_t* Y1; const float* bias; const float* gain; bf16_t* Y2; float* rowsq; int ldc, ldo;
    __device__ __forceinline__ void operator()(const f32x4 (&acc)[2][2][4][2], const Unit& u, int wr, int wc, int fr, int fq) const {
        const int row0 = u.pm * BM + wr * 64 + fr, col0 = u.pn * BM + wc * 32 + 8 * fq;
        f32x4 bv[2][2], gv[2][2];
#pragma unroll
        for (int bj = 0; bj < 2; ++bj)
#pragma unroll
            for (int n = 0; n < 2; ++n) { bv[bj][n] = *(const f32x4*)(bias + col0 + bj * HALF + 4 * n); gv[bj][n] = *(const f32x4*)(gain + col0 + bj * HALF + 4 * n); }
#pragma unroll
        for (int ai = 0; ai < 2; ++ai) {
            u32x4 yv[4][2];
#pragma unroll
            for (int m = 0; m < 4; ++m)
#pragma unroll
                for (int bj = 0; bj < 2; ++bj) yv[m][bj] = *(const u32x4*)(Y1 + (size_t)(row0 + ai * HALF + m * 16) * ldc + col0 + bj * HALF);
#pragma unroll
            for (int m = 0; m < 4; ++m) { const int row = row0 + ai * HALF + m * 16; const size_t offo = (size_t)row * ldo + col0;
                float ss = 0.f;
#pragma unroll
                for (int bj = 0; bj < 2; ++bj) { const f32x4 z0 = acc[ai][bj][m][0] + bv[bj][0], z1 = acc[ai][bj][m][1] + bv[bj][1];
                    const u32x4 y = yv[m][bj];
                    f32x4 r0, r1;
                    r0[0] = bf_lo(y.x) * sigmoid_f(z0[0]); r0[1] = bf_hi(y.x) * sigmoid_f(z0[1]); r0[2] = bf_lo(y.y) * sigmoid_f(z0[2]); r0[3] = bf_hi(y.y) * sigmoid_f(z0[3]);
                    r1[0] = bf_lo(y.z) * sigmoid_f(z1[0]); r1[1] = bf_hi(y.z) * sigmoid_f(z1[1]); r1[2] = bf_lo(y.w) * sigmoid_f(z1[2]); r1[3] = bf_hi(y.w) * sigmoid_f(z1[3]);
                    ss += (r0[0] * r0[0] + r0[1] * r0[1]) + (r0[2] * r0[2] + r0[3] * r0[3]) + (r1[0] * r1[0] + r1[1] * r1[1]) + (r1[2] * r1[2] + r1[3] * r1[3]);
                    r0 = r0 * gv[bj][0]; r1 = r1 * gv[bj][1];
                    u32x4 w; w.x = cvt_pk_bf16(r0[0], r0[1]); w.y = cvt_pk_bf16(r0[2], r0[3]); w.z = cvt_pk_bf16(r1[0], r1[1]); w.w = cvt_pk_bf16(r1[2], r1[3]);
                    *(u32x4*)(Y2 + offo + bj * HALF) = w; }
                ss += __shfl_xor(ss, 16); ss += __shfl_xor(ss, 32);
                if (fq == 0) rowsq[(size_t)row * 16 + u.pn * 4 + wc] = ss; }
        }
    }
};
struct EpiResF32 {
    static constexpr bool PERM = false, AFTER_DRAIN = false;
    const float* X; float* O; int ldc; const float* insq; float inv_indim; bf16_t* OB; float* outsq;
    __device__ __forceinline__ void operator()(const f32x4 (&acc)[2][2][4][2], const Unit& u, int wr, int wc, int fr, int fq) const {
        const int row0 = u.pm * BM + wr * 64 + fr, col0 = u.pn * BM + wc * 32 + 4 * fq;
#pragma unroll
        for (int ai = 0; ai < 2; ++ai)
#pragma unroll
        for (int mh = 0; mh < 2; ++mh) {
            f32x4 xv[2][2][2]; f32x4 p4[2];
#pragma unroll
            for (int mm = 0; mm < 2; ++mm) { const int row = row0 + ai * HALF + (2 * mh + mm) * 16; const size_t off = (size_t)row * ldc + col0;
                p4[mm] = insq ? *(const f32x4*)(insq + (size_t)row * 16 + 4 * fq) : (f32x4){0.f, 0.f, 0.f, 0.f};
#pragma unroll
                for (int bj = 0; bj < 2; ++bj)
#pragma unroll
                    for (int n = 0; n < 2; ++n) xv[mm][bj][n] = *(const f32x4*)(X + off + bj * HALF + n * 16); }
#pragma unroll
            for (int mm = 0; mm < 2; ++mm) { const int m = 2 * mh + mm; const int row = row0 + ai * HALF + m * 16; const size_t off = (size_t)row * ldc + col0;
                float sc = 1.0f;
                if (insq) { float t = (p4[mm][0] + p4[mm][1]) + (p4[mm][2] + p4[mm][3]); t += __shfl_xor(t, 16); t += __shfl_xor(t, 32); sc = rsqrtf(t * inv_indim + 1e-6f); }
                float ss = 0.f;
#pragma unroll
                for (int bj = 0; bj < 2; ++bj)
#pragma unroll
                    for (int n = 0; n < 2; ++n) { const f32x4 o = xv[mm][bj][n] + acc[ai][bj][m][n] * sc;
                        *(f32x4*)(O + off + bj * HALF + n * 16) = o;
                        if (OB) { ss += (o[0] * o[0] + o[1] * o[1]) + (o[2] * o[2] + o[3] * o[3]); u32x2v w; w.x = cvt_pk_bf16(o[0], o[1]); w.y = cvt_pk_bf16(o[2], o[3]); *(u32x2v*)(OB + off + bj * HALF + n * 16) = w; } }
                if (OB) { ss += __shfl_xor(ss, 16); ss += __shfl_xor(ss, 32); if (fq == 0) outsq[(size_t)row * 32 + u.pn * 4 + wc] = ss; } }
        }
    }
};
struct EpiResB {
    static constexpr bool PERM = true, AFTER_DRAIN = false;
    const float* X; const bf16_t* XB; bf16_t* OB; int ldc; const float* insq; float inv_indim; float* outsq;
    __device__ __forceinline__ void operator()(const f32x4 (&acc)[2][2][4][2], const Unit& u, int wr, int wc, int fr, int fq) const {
        const int row0 = u.pm * BM + wr * 64 + fr, col0 = u.pn * BM + wc * 32 + 8 * fq;
#pragma unroll
        for (int ai = 0; ai < 2; ++ai)
#pragma unroll
        for (int mh = 0; mh < 2; ++mh) {
            f32x4 xv[2][2][2]; f32x4 p4[2];
#pragma unroll
            for (int mm = 0; mm < 2; ++mm) { const int row = row0 + ai * HALF + (2 * mh + mm) * 16; const size_t off = (size_t)row * ldc + col0;
                p4[mm] = insq ? *(const f32x4*)(insq + (size_t)row * 16 + 4 * fq) : (f32x4){0.f, 0.f, 0.f, 0.f};
#pragma unroll
                for (int bj = 0; bj < 2; ++bj) {
                    if (XB) { const u32x4 y = *(const u32x4*)(XB + off + bj * HALF); xv[mm][bj][0] = (f32x4){bf_lo(y.x), bf_hi(y.x), bf_lo(y.y), bf_hi(y.y)}; xv[mm][bj][1] = (f32x4){bf_lo(y.z), bf_hi(y.z), bf_lo(y.w), bf_hi(y.w)}; }
                    else { xv[mm][bj][0] = *(const f32x4*)(X + off + bj * HALF); xv[mm][bj][1] = *(const f32x4*)(X + off + bj * HALF + 4); } } }
#pragma unroll
            for (int mm = 0; mm < 2; ++mm) { const int m = 2 * mh + mm; const int row = row0 + ai * HALF + m * 16; const size_t off = (size_t)row * ldc + col0;
                float sc = 1.0f;
                if (insq) { float t = (p4[mm][0] + p4[mm][1]) + (p4[mm][2] + p4[mm][3]); t += __shfl_xor(t, 16); t += __shfl_xor(t, 32); sc = rsqrtf(t * inv_indim + 1e-6f); }
                float ss = 0.f;
#pragma unroll
                for (int bj = 0; bj < 2; ++bj) { const f32x4 o0 = xv[mm][bj][0] + acc[ai][bj][m][0] * sc, o1 = xv[mm][bj][1] + acc[ai][bj][m][1] * sc;
                    ss += ((o0[0] * o0[0] + o0[1] * o0[1]) + (o0[2] * o0[2] + o0[3] * o0[3])) + ((o1[0] * o1[0] + o1[1] * o1[1]) + (o1[2] * o1[2] + o1[3] * o1[3]));
                    u32x4 w; w.x = cvt_pk_bf16(o0[0], o0[1]); w.y = cvt_pk_bf16(o0[2], o0[3]); w.z = cvt_pk_bf16(o1[0], o1[1]); w.w = cvt_pk_bf16(o1[2], o1[3]);
                    *(u32x4*)(OB + off + bj * HALF) = w; }
                if (outsq) { ss += __shfl_xor(ss, 16); ss += __shfl_xor(ss, 32); if (fq == 0) outsq[(size_t)row * 32 + u.pn * 4 + wc] = ss; } }
        }
    }
};
struct EpiSwiGlu {
    static constexpr bool PERM = true, AFTER_DRAIN = false;
    bf16_t* O; int ldc; const float* insq; float inv_indim; const float* rs_lds; int pm_lds;
    __device__ __forceinline__ void operator()(const f32x4 (&acc)[2][2][4][2], const Unit& u, int wr, int wc, int fr, int fq) const {
        const int row0 = u.pm * BM + wr * 64 + fr, col0 = u.pn * HALF + wc * 32 + 8 * fq;
        float scv[2][4];
        if (u.pm == pm_lds) {
#pragma unroll
          for (int ai = 0; ai < 2; ++ai)
#pragma unroll
              for (int m = 0; m < 4; ++m) scv[ai][m] = rs_lds[wr * 64 + fr + ai * HALF + m * 16];
        } else { f32x4 pa[2][4], pb[2][4];
#pragma unroll
          for (int ai = 0; ai < 2; ++ai)
#pragma unroll
              for (int m = 0; m < 4; ++m) { const float* pp = insq + (size_t)(row0 + ai * HALF + m * 16) * 32 + 8 * fq; pa[ai][m] = *(const f32x4*)pp; pb[ai][m] = *(const f32x4*)(pp + 4); }
#pragma unroll
          for (int ai = 0; ai < 2; ++ai)
#pragma unroll
              for (int m = 0; m < 4; ++m) { float t = ((pa[ai][m][0] + pa[ai][m][1]) + (pa[ai][m][2] + pa[ai][m][3])) + ((pb[ai][m][0] + pb[ai][m][1]) + (pb[ai][m][2] + pb[ai][m][3]));
                  t += __shfl_xor(t, 16); t += __shfl_xor(t, 32); scv[ai][m] = rsqrtf(t * inv_indim + 1e-6f); } }
#pragma unroll
        for (int ai = 0; ai < 2; ++ai)
#pragma unroll
            for (int m = 0; m < 4; ++m) { const int row = row0 + ai * HALF + m * 16; bf16_t* rowp = O + (size_t)row * ldc + col0;
                const float sc = scv[ai][m];
                f32x4 r0, r1;
#pragma unroll
                for (int j = 0; j < 4; ++j) { const float g0 = acc[ai][0][m][0][j] * sc, g1 = acc[ai][0][m][1][j] * sc;
                    r0[j] = g0 * sigmoid_f(g0) * (acc[ai][1][m][0][j] * sc); r1[j] = g1 * sigmoid_f(g1) * (acc[ai][1][m][1][j] * sc); }
                u32x4 w; w.x = cvt_pk_bf16(r0[0], r0[1]); w.y = cvt_pk_bf16(r0[2], r0[3]); w.z = cvt_pk_bf16(r1[0], r1[1]); w.w = cvt_pk_bf16(r1[2], r1[3]);
                *(u32x4*)rowp = w; }
    }
};


template <class Epi, class Sched, bool ALIGN_EPI = false, bool SP2 = false>
__device__ __forceinline__ void gemm_phase(PG8_LAS unsigned char* lds, const Gemm g, const Sched& S, const Epi& E) {
    int tid_ = threadIdx.x; asm volatile("" : "+v"(tid_));
    const int tid = tid_, wid = __builtin_amdgcn_readfirstlane(tid >> 6), lane = tid & 63, wr = wid >> 2, wc = wid & 3, fr = lane & 15, fq = lane >> 4;
    const int K = g.K, nt = K / BK;
    unsigned voffA[2], voffB[2];
#pragma unroll
    for (int i = 0; i < 2; ++i) { int R, C; stage_rc(tid * 16 + i * 8192, R, C); const int Rb = Epi::PERM ? ((R & ~31) + perm32(R & 31)) : R;
        voffA[i] = (unsigned)(R * K + C) * 2u; voffB[i] = (unsigned)(Rb * K + C) * 2u; }
    const size_t kstep = (size_t)(BK * 2);
    const size_t hstep = (size_t)HALF * K * 2;
    const size_t tstep = 2 * hstep;
    const unsigned ldsw = (unsigned)wid * 1024u;
    const int aoff = lds_byte(wr * 64 + fr, fq * 8), boff = lds_byte(wc * 32 + fr, fq * 8);
#define PG8_SA(b, h) (((b) * 2 + (h)) * HTB)
#define PG8_SB(b, h) ((4 + (b) * 2 + (h)) * HTB)
#define PG8_STAGE(bufoff, gbase, voff) do { _Pragma("unroll") for (int _i = 0; _i < 2; ++_i) \
        __builtin_amdgcn_global_load_lds((const unsigned*)((const char*)(gbase) + (voff)[_i]), (PG8_LAS unsigned*)(lds + (bufoff) + ldsw + _i * 8192), 16, 0, 0); } while (0)
#define PG8_LDA(dst, b, h) do { _Pragma("unroll") for (int m = 0; m < 4; ++m) _Pragma("unroll") for (int k = 0; k < 2; ++k) dst[m][k] = *(const PG8_LAS bf16x8*)(lds + PG8_SA(b, h) + aoff + m * 2048 + k * 1024); } while (0)
#define PG8_LDB(dst, b, h) do { _Pragma("unroll") for (int n = 0; n < 2; ++n) _Pragma("unroll") for (int k = 0; k < 2; ++k) dst[n][k] = *(const PG8_LAS bf16x8*)(lds + PG8_SB(b, h) + boff + n * 2048 + k * 1024); } while (0)
#define PG8_MMA(ai, bj, At, Bt) do { __builtin_amdgcn_s_setprio(1); _Pragma("unroll") for (int m = 0; m < 4; ++m) _Pragma("unroll") for (int n = 0; n < 2; ++n) _Pragma("unroll") for (int k = 0; k < 2; ++k) \
        acc[ai][bj][m][n] = __builtin_amdgcn_mfma_f32_16x16x32_bf16(Bt[n][k], At[m][k], acc[ai][bj][m][n], 0, 0, 0); __builtin_amdgcn_s_setprio(0); } while (0)
#define PG8_WAIT_V(n) asm volatile("s_waitcnt vmcnt(" #n ")" ::: "memory")
#define PG8_WAIT_L(n) asm volatile("s_waitcnt lgkmcnt(" #n ")" ::: "memory")
#define PG8_BAR __builtin_amdgcn_s_barrier()
#define PG8_SCHED __builtin_amdgcn_sched_barrier(0)
    Unit cur, nxt; int ui = 0;
    if (!S.next(0, cur)) return;
    f32x4 acc[2][2][4][2];
#pragma unroll
    for (int a = 0; a < 2; ++a)
#pragma unroll
        for (int b = 0; b < 2; ++b)
#pragma unroll
            for (int m = 0; m < 4; ++m)
#pragma unroll
                for (int n = 0; n < 2; ++n) acc[a][b][m][n] = (f32x4){0.f, 0.f, 0.f, 0.f};
    bf16x8 At[4][2], B0[2][2], B1[2][2];
    const char* cA = (const char*)g.A + (size_t)cur.pm * tstep; const char* cB = (const char*)g.Bt + (size_t)cur.pn * tstep;
    S.a_ready(cur);
    if constexpr (SP2) {
        PG8_STAGE(PG8_SB(0, 0), cB, voffB); PG8_STAGE(PG8_SB(0, 1), cB + hstep, voffB); PG8_STAGE(PG8_SA(0, 0), cA, voffA); PG8_STAGE(PG8_SA(0, 1), cA + hstep, voffA);
        if (wr == 1) PG8_BAR;
        PG8_WAIT_V(2); PG8_BAR;
        PG8_STAGE(PG8_SB(1, 0), cB + kstep, voffB); PG8_STAGE(PG8_SA(1, 0), cA + kstep, voffA); PG8_STAGE(PG8_SB(1, 1), cB + hstep + kstep, voffB);
        PG8_WAIT_V(6); PG8_BAR;
    } else {
        PG8_STAGE(PG8_SB(0, 0), cB, voffB); PG8_STAGE(PG8_SA(0, 0), cA, voffA); PG8_STAGE(PG8_SB(0, 1), cB + hstep, voffB); PG8_STAGE(PG8_SA(0, 1), cA + hstep, voffA);
        if (wr == 1) PG8_BAR;
        PG8_WAIT_V(4); PG8_BAR;
        PG8_STAGE(PG8_SB(1, 0), cB + kstep, voffB); PG8_STAGE(PG8_SA(1, 0), cA + kstep, voffA); PG8_STAGE(PG8_SB(1, 1), cB + hstep + kstep, voffB);
        PG8_WAIT_V(6); PG8_BAR;
    }
    for (;;) {
        const bool has_next = S.next(ui + 1, nxt);
        const char* nA = has_next ? (const char*)g.A + (size_t)nxt.pm * tstep : cA; const char* nB = has_next ? (const char*)g.Bt + (size_t)nxt.pn * tstep : cB;
        for (int t = 0; t < nt; t += 2) {
            const bool last = (t == nt - 2);
            const char* a1 = cA + (size_t)(t + 1) * kstep;
            const char* a2 = last ? nA : cA + (size_t)(t + 2) * kstep; const char* b2 = last ? nB : cB + (size_t)(t + 2) * kstep;
            const char* a3 = a2 + kstep; const char* b3 = b2 + kstep;
            if (last && has_next) S.a_ready(nxt);
            if constexpr (SP2) {
            PG8_LDB(B0, 0, 0); PG8_LDB(B1, 0, 1); PG8_SCHED; PG8_LDA(At, 0, 0); PG8_STAGE(PG8_SA(1, 1), a1 + hstep, voffA);
            PG8_WAIT_V(8); PG8_WAIT_L(0); PG8_BAR; PG8_MMA(0, 0, At, B0); PG8_MMA(0, 1, At, B1); PG8_BAR; PG8_SCHED;
            PG8_LDA(At, 0, 1); PG8_STAGE(PG8_SB(0, 0), b2, voffB); PG8_STAGE(PG8_SB(0, 1), b2 + hstep, voffB); PG8_STAGE(PG8_SA(0, 0), a2, voffA);
            PG8_WAIT_V(8); PG8_WAIT_L(0); PG8_BAR; PG8_MMA(1, 0, At, B0); PG8_MMA(1, 1, At, B1); PG8_BAR; PG8_SCHED;
            PG8_LDB(B0, 1, 0); PG8_LDB(B1, 1, 1); PG8_SCHED; PG8_LDA(At, 1, 0); PG8_STAGE(PG8_SA(0, 1), a2 + hstep, voffA);
            PG8_WAIT_V(8); PG8_WAIT_L(0); PG8_BAR; PG8_MMA(0, 0, At, B0); PG8_MMA(0, 1, At, B1); PG8_BAR; PG8_SCHED;
            PG8_LDA(At, 1, 1); PG8_STAGE(PG8_SB(1, 0), b3, voffB); PG8_STAGE(PG8_SB(1, 1), b3 + hstep, voffB); PG8_STAGE(PG8_SA(1, 0), a3, voffA);
            PG8_WAIT_V(8); PG8_WAIT_L(0); PG8_BAR; PG8_MMA(1, 0, At, B0); PG8_MMA(1, 1, At, B1); PG8_BAR; PG8_SCHED;
            } else {
            PG8_LDB(B0, 0, 0); PG8_SCHED; PG8_LDA(At, 0, 0); PG8_STAGE(PG8_SA(1, 1), a1 + hstep, voffA);
            PG8_WAIT_L(8); PG8_BAR; PG8_WAIT_L(0); PG8_MMA(0, 0, At, B0); PG8_BAR; PG8_SCHED;
            PG8_LDB(B1, 0, 1); PG8_STAGE(PG8_SB(0, 0), b2, voffB);
            PG8_BAR; PG8_WAIT_L(0); PG8_MMA(0, 1, At, B1); PG8_BAR;
            PG8_LDA(At, 0, 1); PG8_STAGE(PG8_SA(0, 0), a2, voffA);
            PG8_BAR; PG8_WAIT_L(0); PG8_MMA(1, 0, At, B0); PG8_BAR; PG8_SCHED;
            PG8_STAGE(PG8_SB(0, 1), b2 + hstep, voffB);
            PG8_WAIT_V(6); PG8_BAR; PG8_MMA(1, 1, At, B1); PG8_BAR;
            PG8_LDB(B0, 1, 0); PG8_SCHED; PG8_LDA(At, 1, 0); PG8_STAGE(PG8_SA(0, 1), a2 + hstep, voffA);
            PG8_WAIT_L(8); PG8_BAR; PG8_WAIT_L(0); PG8_MMA(0, 0, At, B0); PG8_BAR; PG8_SCHED;
            PG8_LDB(B1, 1, 1); PG8_STAGE(PG8_SB(1, 0), b3, voffB);
            PG8_BAR; PG8_WAIT_L(0); PG8_MMA(0, 1, At, B1); PG8_BAR;
            PG8_LDA(At, 1, 1); PG8_STAGE(PG8_SA(1, 0), a3, voffA);
            PG8_BAR; PG8_WAIT_L(0); PG8_MMA(1, 0, At, B0); PG8_BAR; PG8_SCHED;
            PG8_STAGE(PG8_SB(1, 1), b3 + hstep, voffB);
            PG8_WAIT_V(6); PG8_BAR; PG8_MMA(1, 1, At, B1); PG8_BAR;
            }
        }
        if constexpr (ALIGN_EPI) { if (wr == 0) PG8_BAR; }
        if constexpr (!Epi::AFTER_DRAIN) { E(acc, cur, wr, wc, fr, fq); S.done(cur); }
        if (!has_next) break;
#pragma unroll
        for (int a = 0; a < 2; ++a)
#pragma unroll
            for (int b = 0; b < 2; ++b)
#pragma unroll
                for (int m = 0; m < 4; ++m)
#pragma unroll
                    for (int n = 0; n < 2; ++n) acc[a][b][m][n] = (f32x4){0.f, 0.f, 0.f, 0.f};
        cur = nxt; cA = nA; cB = nB; ++ui;
        if constexpr (ALIGN_EPI) { if (wr == 1) PG8_BAR; }
    }
    PG8_WAIT_V(0);
    if constexpr (!ALIGN_EPI) { if (wr == 0) PG8_BAR; }
    PG8_BAR;
    if constexpr (Epi::AFTER_DRAIN) { E.fused(acc, cur, wr, wc, fr, fq, lds, wid, lane); S.done(cur); }
#undef PG8_SA
#undef PG8_SB
#undef PG8_STAGE
#undef PG8_LDA
#undef PG8_LDB
#undef PG8_MMA
#undef PG8_WAIT_V
#undef PG8_WAIT_L
#undef PG8_BAR
#undef PG8_SCHED
}
}

typedef unsigned short bf16;
typedef short bf16x8 __attribute__((ext_vector_type(8)));
typedef float f32x4 __attribute__((ext_vector_type(4)));
typedef float f32x2 __attribute__((ext_vector_type(2)));
typedef float f32x16 __attribute__((ext_vector_type(16)));
typedef unsigned u32x4 __attribute__((ext_vector_type(4)));
typedef unsigned u32x2 __attribute__((ext_vector_type(2)));

constexpr int DM = 2048, SEQ = 8192, MTOK = 16384, INW = 5120, RW = 1024, NH = 8, HD = 128, SW = 1024, NG = 64, NP = 64, DFF = 5632;
constexpr float EPS = 1e-6f;
constexpr size_t MiB = 1u << 20;
constexpr size_t WS_WIN = 0, WS_WGLU = 20 * MiB, WS_WOUT = 22 * MiB, WS_WGU = 30 * MiB, WS_WD = 74 * MiB, WS_ROPE = 96 * MiB, WS_S5P = 100 * MiB, WS_S5ST = 101 * MiB,
                 WS_BUFA = 102 * MiB, WS_PROJ = 166 * MiB, WS_KV = 326 * MiB, WS_XB = 390 * MiB, WS_CTL = 454 * MiB, WS_SQ1 = 455 * MiB, WS_SQ2 = 457 * MiB, WS_TOT = 458 * MiB, WS_Y1 = 466 * MiB, WS_RS0 = 498 * MiB, WS_END = 499 * MiB, WS_ACT = WS_PROJ, WS_X1B = WS_XB, WS_Y2 = WS_Y1;
constexpr size_t CTL_XID = 16384, CTL_GRP = 32768, CTL_ZERO = 131072;
constexpr size_t S5P_BBT = 0, S5P_CMT = 256 * 1024, S5P_LAM = 512 * 1024, S5P_LAML = 544 * 1024;
constexpr int LDS_BYTES = 137216, LDS_KEEP = 135168, S5_WLDS = 16896;
constexpr int NPHASE = 12;

__device__ __forceinline__ int panel_of(int c) { return 8 * (c & 7) + ((c >> 3) & 7); }

struct Params { const float* in[21]; float* out; unsigned char* ws; };

#define MFMA32(a, b, c) __builtin_amdgcn_mfma_f32_32x32x16_bf16((a), (b), (c), 0, 0, 0)
#define MFMA16(a, b, c) __builtin_amdgcn_mfma_f32_16x16x32_bf16((a), (b), (c), 0, 0, 0)
#define LDS_FENCE() asm volatile("s_waitcnt lgkmcnt(0)" ::: "memory")

__device__ __forceinline__ float bflo(unsigned w) { return __uint_as_float(w << 16); }
__device__ __forceinline__ float bfhi(unsigned w) { return __uint_as_float(w & 0xffff0000u); }
__device__ __forceinline__ unsigned pk2(float lo, float hi) { return pg8::cvt_pk_bf16(lo, hi); }
__device__ __forceinline__ float wave_sum(float v) {
#pragma unroll
    for (int o = 1; o < 64; o <<= 1) v += __shfl_xor(v, o);
    return v;
}
__device__ __forceinline__ void sincos_d(double x, double& s, double& c) {
    const double k = rint(x * 0.63661977236758134308);
    double r = fma(-k, 1.57079632679489655800e+00, x); r = fma(-k, 6.12323399573676603587e-17, r);
    const int q = ((int)(long long)k) & 3;
    const double r2 = r * r;
    const double sn = r * (1.0 + r2 * (-1.0 / 6.0 + r2 * (1.0 / 120.0 + r2 * (-1.0 / 5040.0 + r2 * (1.0 / 362880.0 + r2 * (-1.0 / 39916800.0 + r2 * (1.0 / 6227020800.0 + r2 * (-1.0 / 1307674368000.0))))))));
    const double cs = 1.0 + r2 * (-0.5 + r2 * (1.0 / 24.0 + r2 * (-1.0 / 720.0 + r2 * (1.0 / 40320.0 + r2 * (-1.0 / 3628800.0 + r2 * (1.0 / 479001600.0 + r2 * (-1.0 / 87178291200.0 + r2 * (1.0 / 20922789888000.0))))))));
    s = (q == 0) ? sn : (q == 1) ? cs : (q == 2) ? -sn : -cs;
    c = (q == 0) ? cs : (q == 1) ? -sn : (q == 2) ? -cs : sn;
}

__device__ __forceinline__ void p0_transpose_item(const float* W, int K, int N, bf16* WT, int k0, int n0, int dst_row0, float* scr, int lane, const float* kscale = nullptr) {
#pragma unroll 8
    for (int i = 0; i < 32; ++i) { const int kk = 2 * i + (lane >> 5); scr[kk * 33 + (lane & 31)] = __builtin_nontemporal_load(W + (size_t)(k0 + kk) * N + n0 + (lane & 31)); }
    const int c = lane & 7;
    f32x4 ks0 = (f32x4){1.f, 1.f, 1.f, 1.f}, ks1 = ks0;
    if (kscale) { ks0 = *(const f32x4*)(kscale + k0 + 8 * c); ks1 = *(const f32x4*)(kscale + k0 + 8 * c + 4); }
    LDS_FENCE();
#pragma unroll
    for (int j = 0; j < 4; ++j) { const int n = (lane >> 3) + 8 * j; const float* s = scr + (8 * c) * 33 + n;
        u32x4 o; o.x = pk2(s[0 * 33] * ks0.x, s[1 * 33] * ks0.y); o.y = pk2(s[2 * 33] * ks0.z, s[3 * 33] * ks0.w); o.z = pk2(s[4 * 33] * ks1.x, s[5 * 33] * ks1.y); o.w = pk2(s[6 * 33] * ks1.z, s[7 * 33] * ks1.w);
        *(u32x4*)(WT + (size_t)(dst_row0 + n) * K + k0 + 8 * c) = o; }
    LDS_FENCE();
}
__device__ __forceinline__ void rms_row_to_bf16(const float* xrow, const float* g, bf16* orow, int lane) {
    const f32x4* xr = (const f32x4*)xrow + lane; const f32x4* gr = (const f32x4*)g + lane;
    f32x4 v[8]; float s = 0.f;
#pragma unroll
    for (int j = 0; j < 8; ++j) { v[j] = xr[64 * j]; s += (v[j].x * v[j].x + v[j].y * v[j].y) + (v[j].z * v[j].z + v[j].w * v[j].w); }
    const float r = rsqrtf(wave_sum(s) * (1.f / DM) + EPS);
    u32x2* o8 = (u32x2*)orow + lane;
#pragma unroll
    for (int j = 0; j < 8; ++j) { const f32x4 gg = gr[64 * j]; u32x2 w; w.x = pk2(v[j].x * r * gg.x, v[j].y * r * gg.y); w.y = pk2(v[j].z * r * gg.z, v[j].w * r * gg.w); o8[64 * j] = w; }
}
__device__ __forceinline__ void p0_phase(const Params& P, unsigned char* lds, int tid, int lane, int wave) {
    unsigned char* ws = P.ws;
    const int gw = blockIdx.x * 8 + wave, NGW = gridDim.x * 8;
    float* scr = (float*)(lds + wave * 16384);
    constexpr int I_IN = 32 * 160;
    for (int it = gw; it < I_IN; it += NGW) { const int kb = it / 160, nb = it % 160; p0_transpose_item(P.in[2], DM, INW, (bf16*)(ws + WS_WIN), kb * 64, nb * 32, nb * 32, scr, lane, P.in[1]); }
    for (int m = gw; m < MTOK; m += NGW) {
        const f32x4* xr = (const f32x4*)(P.in[0] + (size_t)m * DM) + lane; u32x2* o8 = (u32x2*)((bf16*)(ws + WS_XB) + (size_t)m * DM) + lane;
        f32x4 v[8]; float ss = 0.f;
#pragma unroll
        for (int j = 0; j < 8; ++j) { v[j] = __builtin_nontemporal_load(xr + 64 * j); ss += (v[j].x * v[j].x + v[j].y * v[j].y) + (v[j].z * v[j].z + v[j].w * v[j].w); }
#pragma unroll
        for (int j = 0; j < 8; ++j) { u32x2 w; w.x = pk2(v[j].x, v[j].y); w.y = pk2(v[j].z, v[j].w); o8[64 * j] = w; }
        ss = wave_sum(ss);
        if (lane == 0) ((float*)(ws + WS_RS0))[m] = rsqrtf(ss * (1.f / DM) + EPS);
    }
    const int gt = blockIdx.x * 512 + tid, NGT = gridDim.x * 512;
    for (int idx = gt; idx < SEQ * 64; idx += NGT) {
        const int pos = idx >> 6, i = idx & 63;
        const double freq = exp(-(double)i * (9.210340371976184 / 64.0));
        double s, c; sincos_d((double)pos * freq, s, c);
        ((f32x2*)(ws + WS_ROPE))[idx] = (f32x2){(float)c, (float)s};
    }
    if (gt < NG * NP) {
        const int g = gt >> 6, p = gt & 63;
        const double dt = exp((double)P.in[6][g]);
        const double ar = (double)P.in[4][gt], ai = (double)P.in[5][gt];
        double sn, cs; sincos_d(ai * dt, sn, cs);
        const double mag = exp(ar * dt), lbr = mag * cs, lbi = mag * sn;
        const double d2 = ar * ar + ai * ai, nr = lbr - 1.0, ni = lbi;
        const double cr = (nr * ar + ni * ai) / d2, ci = (ni * ar - nr * ai) / d2;
        bf16* BbT = (bf16*)(ws + WS_S5P + S5P_BBT); bf16* CmT = (bf16*)(ws + WS_S5P + S5P_CMT);
        const float* bre = P.in[7] + (size_t)gt * 16; const float* bim = P.in[8] + (size_t)gt * 16;
#pragma unroll
        for (int c2 = 0; c2 < 16; c2 += 2) {
            const double br0 = bre[c2], bi0 = bim[c2], br1 = bre[c2 + 1], bi1 = bim[c2 + 1];
            *(unsigned*)(BbT + ((size_t)g * 128 + p) * 16 + c2) = pk2((float)(cr * br0 - ci * bi0), (float)(cr * br1 - ci * bi1));
            *(unsigned*)(BbT + ((size_t)g * 128 + 64 + p) * 16 + c2) = pk2((float)(cr * bi0 + ci * br0), (float)(cr * bi1 + ci * br1));
        }
        ((f32x2*)(ws + WS_S5P + S5P_LAM))[gt] = (f32x2){(float)lbr, (float)lbi};
        double sL, cL; sincos_d(ai * dt * 512.0, sL, cL); const double mL = exp(ar * dt * 512.0);
        ((f32x2*)(ws + WS_S5P + S5P_LAML))[gt] = (f32x2){(float)(mL * cL), (float)(mL * sL)};
        const int n = p & 31, blk = p >> 5;
#pragma unroll
        for (int c = 0; c < 16; ++c) {
            const float cre = P.in[9][((size_t)g * 16 + c) * 64 + p], cim = P.in[10][((size_t)g * 16 + c) * 64 + p];
            *(unsigned*)(CmT + ((size_t)g * 16 + c) * 128 + 4 * n + 2 * blk) = pk2(cre, -cim);
        }
    }
}

constexpr int RA_KT = 0, RA_VT = 16384;
constexpr int RC_QS = 0, RC_KS = 17408, RC_VT = 34816, RC_PS = 53248, RC_OS = 62464;

__device__ __forceinline__ float head_lg2(int h) { const float t[8] = {-4.5803689613e-02f, -2.2720076500e-02f, -1.1315313228e-02f, -5.6465631411e-03f, -2.8205190624e-03f, -1.4095702547e-03f, -7.0461297659e-04f, -3.5226347163e-04f}; float r = t[0];
#pragma unroll
    for (int i = 1; i < 8; ++i) r = (h == i) ? t[i] : r;
    return r; }

__device__ __forceinline__ int tsw(int r, int tok) { return r * 64 + ((((tok >> 3) ^ ((r ^ (r >> 3)) & 7)) << 3) | (tok & 7)); }
__device__ __forceinline__ int sidx(int e, int d) { return ((((e >> 5) * 8 + (d >> 4)) * 32 + (e & 31)) << 4) + (d & 15); }
__device__ __forceinline__ void rope8(const u32x4 a, const u32x4 b, const f32x2* cs, float (&o1)[8], float (&o2)[8]) {
    const unsigned aw[4] = {a.x, a.y, a.z, a.w}, bw[4] = {b.x, b.y, b.z, b.w};
#pragma unroll
    for (int j = 0; j < 4; ++j) {
        const f32x2 c0 = cs[2 * j], c1 = cs[2 * j + 1];
        const float x1a = bflo(aw[j]), x1b = bfhi(aw[j]), x2a = bflo(bw[j]), x2b = bfhi(bw[j]);
        o1[2 * j] = x1a * c0.x - x2a * c0.y; o2[2 * j] = x2a * c0.x + x1a * c0.y;
        o1[2 * j + 1] = x1b * c1.x - x2b * c1.y; o2[2 * j + 1] = x2b * c1.x + x1b * c1.y;
    }
}

__device__ __forceinline__ void ret_pass_a(const Params& P, unsigned char* lds, int tid, int lane, int wave) {
    unsigned char* ws = P.ws;
    const bf16* proj = (const bf16*)(ws + WS_PROJ); const u32x4* rope = (const u32x4*)(ws + WS_ROPE); bf16* KV = (bf16*)(ws + WS_KV);
    bf16* KT = (bf16*)(lds + RA_KT); bf16* VT = (bf16*)(lds + RA_VT);
    const int tok = tid >> 3, dg = tid & 7;
    u32x4 k1, k2, v1, v2, c0, c1, c2, c3;
#define RA_LOAD(uu) do { const int bh_ = (uu) >> 7, n_ = (uu) & 127; const size_t row_ = (size_t)(bh_ >> 3) * SEQ + n_ * 64 + tok; \
        const bf16* kp_ = proj + row_ * INW + RW + (bh_ & 7) * HD + dg * 8; const u32x4* cp_ = rope + ((size_t)(n_ * 64 + tok) * 64 + dg * 8) / 2; \
        k1 = *(const u32x4*)kp_; k2 = *(const u32x4*)(kp_ + 64); v1 = *(const u32x4*)(kp_ + RW); v2 = *(const u32x4*)(kp_ + RW + 64); c0 = cp_[0]; c1 = cp_[1]; c2 = cp_[2]; c3 = cp_[3]; } while (0)
    f32x16 R0, R1;
#pragma unroll
    for (int i = 0; i < 16; ++i) { R0[i] = 0.f; R1[i] = 0.f; }
    int u = (int)blockIdx.x * 8;
    RA_LOAD(u);
    for (int ui = 0; ui < 8; ++ui, ++u) {
        const int bh = u >> 7, h = bh & 7;
        const float lg2 = head_lg2(h);
        const f32x2 cs[8] = {(f32x2){__uint_as_float(c0.x), __uint_as_float(c0.y)}, (f32x2){__uint_as_float(c0.z), __uint_as_float(c0.w)}, (f32x2){__uint_as_float(c1.x), __uint_as_float(c1.y)}, (f32x2){__uint_as_float(c1.z), __uint_as_float(c1.w)},
                             (f32x2){__uint_as_float(c2.x), __uint_as_float(c2.y)}, (f32x2){__uint_as_float(c2.z), __uint_as_float(c2.w)}, (f32x2){__uint_as_float(c3.x), __uint_as_float(c3.y)}, (f32x2){__uint_as_float(c3.z), __uint_as_float(c3.w)}};
        float o1[8], o2[8]; rope8(k1, k2, cs, o1, o2);
        const float ksc = 0.08838834764831845f * __builtin_amdgcn_exp2f(lg2 * (float)(63 - tok));
#pragma unroll
        for (int j = 0; j < 8; ++j) { KT[tsw(dg * 8 + j, tok)] = (bf16)(pk2(o1[j] * ksc, 0.f) & 0xffffu); KT[tsw(64 + dg * 8 + j, tok)] = (bf16)(pk2(o2[j] * ksc, 0.f) & 0xffffu); }
        const unsigned vw1[4] = {v1.x, v1.y, v1.z, v1.w}, vw2[4] = {v2.x, v2.y, v2.z, v2.w};
#pragma unroll
        for (int j = 0; j < 4; ++j) {
            VT[tsw(dg * 8 + 2 * j, tok)] = (bf16)(vw1[j] & 0xffffu); VT[tsw(dg * 8 + 2 * j + 1, tok)] = (bf16)(vw1[j] >> 16);
            VT[tsw(64 + dg * 8 + 2 * j, tok)] = (bf16)(vw2[j] & 0xffffu); VT[tsw(64 + dg * 8 + 2 * j + 1, tok)] = (bf16)(vw2[j] >> 16);
        }
        if (ui < 7) RA_LOAD(u + 1);
        __syncthreads();
        const int dt = wave & 3, et0 = (wave >> 2) * 2, l31 = lane & 31, hh = lane >> 5;
        f32x16 acc0, acc1;
#pragma unroll
        for (int i = 0; i < 16; ++i) { acc0[i] = 0.f; acc1[i] = 0.f; }
#pragma unroll
        for (int ks = 0; ks < 4; ++ks) {
            const bf16x8 a = *(const bf16x8*)(KT + tsw(dt * 32 + l31, ks * 16 + 8 * hh));
            const bf16x8 b0 = *(const bf16x8*)(VT + tsw(et0 * 32 + l31, ks * 16 + 8 * hh));
            const bf16x8 b1 = *(const bf16x8*)(VT + tsw((et0 + 1) * 32 + l31, ks * 16 + 8 * hh));
            acc0 = MFMA32(a, b0, acc0); acc1 = MFMA32(a, b1, acc1);
        }
        bf16* kvu = KV + (size_t)u * 16384;
        const float cdec = __builtin_amdgcn_exp2f(lg2 * 64.f);
        if (ui > 0)
#pragma unroll
        for (int q = 0; q < 4; ++q) {
            const int d0 = dt * 32 + 8 * q + 4 * hh;
            u32x2 w0; w0.x = pk2(R0[4 * q], R0[4 * q + 1]); w0.y = pk2(R0[4 * q + 2], R0[4 * q + 3]);
            u32x2 w1; w1.x = pk2(R1[4 * q], R1[4 * q + 1]); w1.y = pk2(R1[4 * q + 2], R1[4 * q + 3]);
            *(u32x2*)(kvu + sidx(et0 * 32 + l31, d0)) = w0; *(u32x2*)(kvu + sidx((et0 + 1) * 32 + l31, d0)) = w1;
        }
#pragma unroll
        for (int i = 0; i < 16; ++i) { R0[i] = fmaf(R0[i], cdec, acc0[i]); R1[i] = fmaf(R1[i], cdec, acc1[i]); }
        if (ui == 7) {
            bf16* tot = (bf16*)(ws + WS_TOT) + (size_t)blockIdx.x * 16384;
#pragma unroll
            for (int q = 0; q < 4; ++q) {
                const int d0 = dt * 32 + 8 * q + 4 * hh;
                u32x2 w0; w0.x = pk2(R0[4 * q], R0[4 * q + 1]); w0.y = pk2(R0[4 * q + 2], R0[4 * q + 3]);
                u32x2 w1; w1.x = pk2(R1[4 * q], R1[4 * q + 1]); w1.y = pk2(R1[4 * q + 2], R1[4 * q + 3]);
                *(u32x2*)(tot + sidx(et0 * 32 + l31, d0)) = w0; *(u32x2*)(tot + sidx((et0 + 1) * 32 + l31, d0)) = w1;
            }
        }
        __syncthreads();
    }
#undef RA_LOAD
}

__device__ __forceinline__ void ret_pass_c(const Params& P, unsigned char* lds, int tid, int lane, int wave) {
    unsigned char* ws = P.ws;
    const bf16* proj = (const bf16*)(ws + WS_PROJ); const u32x4* rope = (const u32x4*)(ws + WS_ROPE); const bf16* KV = (const bf16*)(ws + WS_KV);
    bf16* mix = (bf16*)(ws + WS_BUFA);
    bf16* Qs = (bf16*)(lds + RC_QS); bf16* Ks = (bf16*)(lds + RC_KS); bf16* VT = (bf16*)(lds + RC_VT); bf16* Ps = (bf16*)(lds + RC_PS); float* Os = (float*)(lds + RC_OS);
    const int tok = tid >> 3, dg = tid & 7, l31 = lane & 31, hh = lane >> 5, l15 = lane & 15, l4 = lane >> 4;
    const int rt = wave & 1, ct = wave >> 1;
    u32x4 q1, q2, k1, k2, v1, v2, c0, c1, c2, c3;
    bf16x8 st[8];
#define RC_LOAD(uu) do { const int bh_ = (uu) >> 7, n_ = (uu) & 127; const size_t row_ = (size_t)(bh_ >> 3) * SEQ + n_ * 64 + tok; \
        const bf16* qp_ = proj + row_ * INW + (bh_ & 7) * HD + dg * 8; const u32x4* cp_ = rope + ((size_t)(n_ * 64 + tok) * 64 + dg * 8) / 2; \
        q1 = *(const u32x4*)qp_; q2 = *(const u32x4*)(qp_ + 64); k1 = *(const u32x4*)(qp_ + RW); k2 = *(const u32x4*)(qp_ + RW + 64); \
        c0 = cp_[0]; c1 = cp_[1]; c2 = cp_[2]; c3 = cp_[3]; } while (0)
#define RC_LOAD_ST(uu) do { const bf16* sp_ = KV + (size_t)(uu) * 16384 + sidx(ct * 32 + l31, 8 * hh); _Pragma("unroll") for (int ks_ = 0; ks_ < 8; ++ks_) st[ks_] = *(const bf16x8*)(sp_ + ks_ * 512); } while (0)
    const int rowb = panel_of((int)blockIdx.x) * 256 + ((int)blockIdx.x >> 6) * 64, ub = ((rowb >> 13) * 8) * 128 + ((rowb & 8191) >> 6);
    int u = ub;
    RC_LOAD(u);
    for (int hi = 0; hi < 8; ++hi, u += 128) {
        const int bh = u >> 7, n = u & 127, b = bh >> 3, h = bh & 7;
        const int un = (hi < 7) ? u + 128 : u;
        const float lg2 = head_lg2(h);
        { const bf16* cp_ = (const bf16*)(ws + WS_TOT) + ((size_t)bh * 16 + (n >> 3)) * 16384 + sidx(ct * 32 + l31, 8 * hh);
#pragma unroll
          for (int ks = 0; ks < 8; ++ks) st[ks] = *(const bf16x8*)(cp_ + ks * 512); }
        const int t3 = tid >> 3, part = tid & 7;
        const size_t row3 = (size_t)b * SEQ + n * 64 + t3;
        const bf16* gp = proj + row3 * INW + 3 * RW + h * HD + part * 16;
        { const bf16* vp_ = proj + ((size_t)b * SEQ + n * 64 + tok) * INW + 2 * RW + h * HD + dg * 8; v1 = *(const u32x4*)vp_; v2 = *(const u32x4*)(vp_ + 64); }
        u32x4 g0, g1; f32x2 sq2p;
        {
            const f32x2 cs[8] = {(f32x2){__uint_as_float(c0.x), __uint_as_float(c0.y)}, (f32x2){__uint_as_float(c0.z), __uint_as_float(c0.w)}, (f32x2){__uint_as_float(c1.x), __uint_as_float(c1.y)}, (f32x2){__uint_as_float(c1.z), __uint_as_float(c1.w)},
                                 (f32x2){__uint_as_float(c2.x), __uint_as_float(c2.y)}, (f32x2){__uint_as_float(c2.z), __uint_as_float(c2.w)}, (f32x2){__uint_as_float(c3.x), __uint_as_float(c3.y)}, (f32x2){__uint_as_float(c3.z), __uint_as_float(c3.w)}};
            float o1[8], o2[8]; u32x4 w;
            rope8(q1, q2, cs, o1, o2);
            w.x = pk2(o1[0], o1[1]); w.y = pk2(o1[2], o1[3]); w.z = pk2(o1[4], o1[5]); w.w = pk2(o1[6], o1[7]); *(u32x4*)(Qs + tok * 136 + dg * 8) = w;
            w.x = pk2(o2[0], o2[1]); w.y = pk2(o2[2], o2[3]); w.z = pk2(o2[4], o2[5]); w.w = pk2(o2[6], o2[7]); *(u32x4*)(Qs + tok * 136 + 64 + dg * 8) = w;
            rope8(k1, k2, cs, o1, o2);
            w.x = pk2(o1[0], o1[1]); w.y = pk2(o1[2], o1[3]); w.z = pk2(o1[4], o1[5]); w.w = pk2(o1[6], o1[7]); *(u32x4*)(Ks + tok * 136 + dg * 8) = w;
            w.x = pk2(o2[0], o2[1]); w.y = pk2(o2[2], o2[3]); w.z = pk2(o2[4], o2[5]); w.w = pk2(o2[6], o2[7]); *(u32x4*)(Ks + tok * 136 + 64 + dg * 8) = w;
            const unsigned vw1[4] = {v1.x, v1.y, v1.z, v1.w}, vw2[4] = {v2.x, v2.y, v2.z, v2.w};
#pragma unroll
            for (int j = 0; j < 4; ++j) {
                VT[tsw(dg * 8 + 2 * j, tok)] = (bf16)(vw1[j] & 0xffffu); VT[tsw(dg * 8 + 2 * j + 1, tok)] = (bf16)(vw1[j] >> 16);
                VT[tsw(64 + dg * 8 + 2 * j, tok)] = (bf16)(vw2[j] & 0xffffu); VT[tsw(64 + dg * 8 + 2 * j + 1, tok)] = (bf16)(vw2[j] >> 16);
            }
        }
        RC_LOAD(un);
        __syncthreads();
#pragma unroll
        for (int tt = 0; tt < 2; ++tt) {
            const int T = wave * 2 + tt, kt = T & 3, qt = T >> 2;
            f32x4 acc = (f32x4){0.f, 0.f, 0.f, 0.f};
#pragma unroll
            for (int ks = 0; ks < 4; ++ks) {
                const bf16x8 a = *(const bf16x8*)(Ks + (kt * 16 + l15) * 136 + ks * 32 + 8 * l4);
                const bf16x8 bq = *(const bf16x8*)(Qs + (qt * 16 + l15) * 136 + ks * 32 + 8 * l4);
                acc = MFMA16(a, bq, acc);
            }
            const int q = qt * 16 + l15, key0 = kt * 16 + 4 * l4;
            float v[4];
#pragma unroll
            for (int r = 0; r < 4; ++r) { const int dist = q - (key0 + r); v[r] = acc[r] * 0.08838834764831845f * __builtin_amdgcn_exp2f(lg2 * (float)(dist < 0 ? -dist : dist)); }
            u32x2 w; w.x = pk2(v[0], v[1]); w.y = pk2(v[2], v[3]);
            *(u32x2*)(Ps + q * 72 + key0) = w;
        }
        asm volatile("" ::: "memory");
        f32x16 acc;
#pragma unroll
        for (int i = 0; i < 16; ++i) acc[i] = 0.f;
#pragma unroll
        for (int ks = 0; ks < 8; ++ks) { const bf16x8 a = *(const bf16x8*)(Qs + (rt * 32 + l31) * 136 + ks * 16 + 8 * hh); acc = MFMA32(a, st[ks], acc); }
        { const float dj = __builtin_amdgcn_exp2f(lg2 * (float)(64 * (n & 7)));
#pragma unroll
          for (int i = 0; i < 16; ++i) acc[i] *= dj; }
        if (n & 7) RC_LOAD_ST(u);
        __syncthreads();
        {
            if (n & 7) {
#pragma unroll
            for (int ks = 0; ks < 8; ++ks) { const bf16x8 a = *(const bf16x8*)(Qs + (rt * 32 + l31) * 136 + ks * 16 + 8 * hh); acc = MFMA32(a, st[ks], acc); }
            }
#pragma unroll
            for (int i = 0; i < 16; ++i) { const int c = rt * 32 + 8 * (i >> 2) + 4 * hh + (i & 3); acc[i] *= __builtin_amdgcn_exp2f(lg2 * (float)(c + 1)); }
#pragma unroll
            for (int ks = 0; ks < 4; ++ks) {
                const bf16x8 a = *(const bf16x8*)(Ps + (rt * 32 + l31) * 72 + ks * 16 + 8 * hh);
                const bf16x8 bv = *(const bf16x8*)(VT + tsw(ct * 32 + l31, ks * 16 + 8 * hh));
                acc = MFMA32(a, bv, acc);
            }
            g0 = *(const u32x4*)gp; g1 = *(const u32x4*)(gp + 8); sq2p = *(const f32x2*)((const float*)(ws + WS_SQ2) + row3 * 16 + part * 2);
#pragma unroll
            for (int i = 0; i < 16; ++i) { const int c = rt * 32 + 8 * (i >> 2) + 4 * hh + (i & 3); Os[c * 132 + ct * 32 + l31] = acc[i]; }
        }
        __syncthreads();
        {
            const f32x4* op = (const f32x4*)(Os + t3 * 132 + part * 16);
            f32x4 x[4]; float s = 0.f;
#pragma unroll
            for (int j = 0; j < 4; ++j) { x[j] = op[j]; s += (x[j].x + x[j].y) + (x[j].z + x[j].w); }
            s += __shfl_xor(s, 1); s += __shfl_xor(s, 2); s += __shfl_xor(s, 4);
            const float mu = s * (1.f / 128.f); float q2s = 0.f;
#pragma unroll
            for (int j = 0; j < 4; ++j) { x[j] = x[j] - mu; q2s += (x[j].x * x[j].x + x[j].y * x[j].y) + (x[j].z * x[j].z + x[j].w * x[j].w); }
            q2s += __shfl_xor(q2s, 1); q2s += __shfl_xor(q2s, 2); q2s += __shfl_xor(q2s, 4);
            float sq2 = sq2p.x + sq2p.y; sq2 += __shfl_xor(sq2, 1); sq2 += __shfl_xor(sq2, 2); sq2 += __shfl_xor(sq2, 4);
            const float rstd = rsqrtf(q2s * (1.f / 128.f) + EPS) * sqrtf(sq2 * (1.f / SW) + EPS);
            const unsigned gw[8] = {g0.x, g0.y, g0.z, g0.w, g1.x, g1.y, g1.z, g1.w};
            const f32x4* gn = (const f32x4*)(P.in[3] + h * HD + part * 16);
            unsigned ow[8];
#pragma unroll
            for (int j = 0; j < 4; ++j) {
                const f32x4 gg = gn[j];
                const float ga = bflo(gw[2 * j]), gb = bfhi(gw[2 * j]), gc = bflo(gw[2 * j + 1]), gd = bfhi(gw[2 * j + 1]);
                const float ya = ga * pg8::sigmoid_f(ga) * (x[j].x * rstd * gg.x), yb = gb * pg8::sigmoid_f(gb) * (x[j].y * rstd * gg.y);
                const float yc = gc * pg8::sigmoid_f(gc) * (x[j].z * rstd * gg.z), yd = gd * pg8::sigmoid_f(gd) * (x[j].w * rstd * gg.w);
                ow[2 * j] = pk2(ya, yb); ow[2 * j + 1] = pk2(yc, yd);
            }
            bf16* mp = mix + row3 * DM + h * HD + part * 16;
            *(u32x4*)mp = (u32x4){ow[0], ow[1], ow[2], ow[3]}; *(u32x4*)(mp + 8) = (u32x4){ow[4], ow[5], ow[6], ow[7]};
        }
    }
    __syncthreads();
#undef RC_LOAD
#undef RC_LOAD_ST
}

struct ConvItem { const float* W; bf16* WT; const float* ks; int K, N, k0, n0, dst0; };
constexpr int CONV_ITEMS = 16 * 32 + 32 * 64 + 2 * 32 * 176 + 88 * 64;
__device__ __forceinline__ bool conv_decode(const Params& P, int id, ConvItem& c) {
    unsigned char* ws = P.ws;
    constexpr int I_GLU = 16 * 32, I_OUT = 32 * 64, I_GATE = 32 * 176, I_DOWN = 88 * 64;
    int r = id, kb, nb; c.ks = nullptr;
    if (r < 0 || r >= CONV_ITEMS) return false;
    if (r < I_GLU) { c.W = P.in[12]; c.WT = (bf16*)(ws + WS_WGLU); c.K = SW; c.N = SW; kb = r / 32; nb = r % 32; c.dst0 = nb * 32; }
    else if ((r -= I_GLU) < I_OUT) { c.W = P.in[15]; c.WT = (bf16*)(ws + WS_WOUT); c.K = DM; c.N = DM; kb = r / 64; nb = r % 64; c.dst0 = nb * 32; }
    else if ((r -= I_OUT) < I_GATE) { c.W = P.in[17]; c.WT = (bf16*)(ws + WS_WGU); c.K = DM; c.N = DFF; kb = r / 176; nb = r % 176; c.dst0 = ((nb * 32) >> 7) * 256 + ((nb * 32) & 127); c.ks = P.in[16]; }
    else if ((r -= I_GATE) < I_GATE) { c.W = P.in[18]; c.WT = (bf16*)(ws + WS_WGU); c.K = DM; c.N = DFF; kb = r / 176; nb = r % 176; c.dst0 = ((nb * 32) >> 7) * 256 + 128 + ((nb * 32) & 127); c.ks = P.in[16]; }
    else { r -= I_GATE; c.W = P.in[19]; c.WT = (bf16*)(ws + WS_WD); c.K = DFF; c.N = DM; kb = r / 64; nb = r % 64; c.dst0 = nb * 32; }
    c.k0 = kb * 64; c.n0 = nb * 32; return true;
}
__device__ __forceinline__ void conv_issue(const ConvItem& c, unsigned char* scr, int lane) {
    const int kr = lane >> 3, p = lane & 7;
    const float* src = c.W + (size_t)(c.k0 + kr) * c.N + c.n0;
#pragma unroll
    for (int i = 0; i < 8; ++i) { const int sc = p ^ ((kr ^ i) & 7);
        __builtin_amdgcn_global_load_lds((const unsigned*)(src + (size_t)(8 * i) * c.N + 4 * sc), (PG8_LAS unsigned*)(scr + i * 1024), 16, 0, 2); }
}
__device__ __forceinline__ void conv_consume(const ConvItem& c, const unsigned char* scr, int lane) {
    asm volatile("s_waitcnt vmcnt(0)" ::: "memory");
    const int cc = lane & 7;
    f32x4 ks0 = (f32x4){1.f, 1.f, 1.f, 1.f}, ks1 = ks0;
    if (c.ks) { ks0 = *(const f32x4*)(c.ks + c.k0 + 8 * cc); ks1 = *(const f32x4*)(c.ks + c.k0 + 8 * cc + 4); }
#pragma unroll
    for (int j = 0; j < 4; ++j) { const int n = (lane >> 3) + 8 * j; float v[8];
#pragma unroll
        for (int t = 0; t < 8; ++t) v[t] = *(const float*)(scr + (8 * cc + t) * 128 + (((n >> 2) ^ ((t ^ cc) & 7)) * 16) + (n & 3) * 4);
        u32x4 o; o.x = pk2(v[0] * ks0.x, v[1] * ks0.y); o.y = pk2(v[2] * ks0.z, v[3] * ks0.w); o.z = pk2(v[4] * ks1.x, v[5] * ks1.y); o.w = pk2(v[6] * ks1.z, v[7] * ks1.w);
        *(u32x4*)(c.WT + (size_t)(c.dst0 + n) * c.K + c.k0 + 8 * cc) = o; }
    LDS_FENCE();
}

#define CMUL_ADD(or_, oi_, ar_, ai_, br_, bi_, cr_, ci_) do { const float _r = fmaf((ar_), (br_), fmaf(-(ai_), (bi_), (cr_))); const float _i = fmaf((ar_), (bi_), fmaf((ai_), (br_), (ci_))); (or_) = _r; (oi_) = _i; } while (0)
template <bool FULL>
__device__ __forceinline__ void s5_wave(const Params& P, unsigned char* wlds, int b, int g, int ch, int lane, int gw) {
    unsigned char* ws = P.ws;
    const bf16* proj = (const bf16*)(ws + WS_PROJ);
    const bf16* BbT = (const bf16*)(ws + WS_S5P + S5P_BBT); const bf16* CmT = (const bf16*)(ws + WS_S5P + S5P_CMT);
    const f32x2* lamp = (const f32x2*)(ws + WS_S5P + S5P_LAM);
    f32x2* ST = (f32x2*)(ws + WS_S5ST);
    const int n = lane & 31, hh = lane >> 5, l15 = lane & 15, l4 = lane >> 4;
    bf16x8 Bb[4];
#pragma unroll
    for (int v = 0; v < 4; ++v) Bb[v] = *(const bf16x8*)(BbT + ((size_t)g * 128 + (v & 1) * 64 + (v >> 1) * 32 + n) * 16 + 8 * hh);
    float lr[2][4], li[2][4];
#pragma unroll
    for (int k = 0; k < 2; ++k) {
        const f32x2 l1 = lamp[g * 64 + k * 32 + n]; lr[k][0] = l1.x; li[k][0] = l1.y;
#pragma unroll
        for (int e = 1; e < 4; ++e) { lr[k][e] = lr[k][e - 1] * l1.x - li[k][e - 1] * l1.y; li[k][e] = lr[k][e - 1] * l1.y + li[k][e - 1] * l1.x; }
    }
    float car[2], cai[2];
    const size_t stbase = (((size_t)b * 16 + ch) * 64 + g) * 64;
    car[0] = cai[0] = car[1] = cai[1] = 0.f;
    if (FULL) {
        const f32x2* lamL = (const f32x2*)(ws + WS_S5P + S5P_LAML);
        const f32x2 L0 = lamL[g * 64 + n], L1 = lamL[g * 64 + 32 + n];
        for (int c = 0; c < ch; ++c) { const size_t eb = (((size_t)b * 16 + c) * 64 + g) * 64; const f32x2 e0 = ST[eb + n], e1 = ST[eb + 32 + n];
            CMUL_ADD(car[0], cai[0], L0.x, L0.y, car[0], cai[0], e0.x, e0.y); CMUL_ADD(car[1], cai[1], L1.x, L1.y, car[1], cai[1], e1.x, e1.y); }
    }
    bf16x8 Cm[4];
    f32x4 dsk = (f32x4){0.f, 0.f, 0.f, 0.f};
    if (FULL) {
#pragma unroll
        for (int ks = 0; ks < 4; ++ks) Cm[ks] = *(const bf16x8*)(CmT + ((size_t)g * 16 + l15) * 128 + ks * 32 + 8 * l4);
        dsk = *(const f32x4*)(P.in[11] + g * 16 + 4 * l4);
    }
    bf16* y1 = (bf16*)(ws + WS_Y1);
    for (int sb = 0; sb < 16; ++sb) {
        const size_t row0 = (size_t)b * SEQ + ch * 512 + sb * 32;
        const bf16x8 U = *(const bf16x8*)(proj + (row0 + n) * INW + 4 * RW + g * 16 + 8 * hh);
        f32x16 bu[4];
#pragma unroll
        for (int v = 0; v < 4; ++v) {
#pragma unroll
            for (int i = 0; i < 16; ++i) bu[v][i] = 0.f;
            bu[v] = MFMA32(U, Bb[v], bu[v]);
        }
        ConvItem cvi; bool cvok = false;
        if (FULL && sb < 10) { cvok = conv_decode(P, sb * 2048 + gw, cvi); if (cvok) conv_issue(cvi, wlds + 8704, lane); }
        float er[2][4], ei[2][4];
#pragma unroll
        for (int k = 0; k < 2; ++k)
#pragma unroll
            for (int q = 0; q < 4; ++q) {
                float sr = bu[2 * k][4 * q], si = bu[2 * k + 1][4 * q];
#pragma unroll
                for (int j = 1; j < 4; ++j) { CMUL_ADD(sr, si, lr[k][0], li[k][0], sr, si, bu[2 * k][4 * q + j], bu[2 * k + 1][4 * q + j]); bu[2 * k][4 * q + j] = sr; bu[2 * k + 1][4 * q + j] = si; }
                er[k][q] = sr; ei[k][q] = si;
            }
        float mr[2][4], mi[2][4];
#pragma unroll
        for (int k = 0; k < 2; ++k) {
            float cr = car[k], ci = cai[k];
#pragma unroll
            for (int q = 0; q < 4; ++q) {
                const float pr = __shfl_xor(er[k][q], 32), pi = __shfl_xor(ei[k][q], 32);
                const float ear = hh ? pr : er[k][q], eai = hh ? pi : ei[k][q];
                const float ebr = hh ? er[k][q] : pr, ebi = hh ? ei[k][q] : pi;
                float c1r, c1i, c2r, c2i;
                CMUL_ADD(c1r, c1i, lr[k][3], li[k][3], cr, ci, ear, eai);
                CMUL_ADD(c2r, c2i, lr[k][3], li[k][3], c1r, c1i, ebr, ebi);
                mr[k][q] = hh ? c1r : cr; mi[k][q] = hh ? c1i : ci;
                cr = c2r; ci = c2i;
            }
            car[k] = cr; cai[k] = ci;
        }
        if (FULL) {
#pragma unroll
            for (int q = 0; q < 4; ++q)
#pragma unroll
                for (int j = 0; j < 4; ++j) {
                    float s0r, s0i, s1r, s1i;
                    CMUL_ADD(s0r, s0i, lr[0][j], li[0][j], mr[0][q], mi[0][q], bu[0][4 * q + j], bu[1][4 * q + j]);
                    CMUL_ADD(s1r, s1i, lr[1][j], li[1][j], mr[1][q], mi[1][q], bu[2][4 * q + j], bu[3][4 * q + j]);
                    u32x2 w; w.x = pk2(s0r, s0i); w.y = pk2(s1r, s1i);
                    *(u32x2*)(wlds + (8 * q + 4 * hh + j) * 272 + n * 8) = w;
                }
            LDS_FENCE();
            f32x4 yt[2];
#pragma unroll
            for (int tt = 0; tt < 2; ++tt) {
                yt[tt] = (f32x4){0.f, 0.f, 0.f, 0.f};
#pragma unroll
                for (int ks = 0; ks < 4; ++ks) { const bf16x8 sv = *(const bf16x8*)(wlds + (tt * 16 + l15) * 272 + (ks * 32 + 8 * l4) * 2); yt[tt] = MFMA16(Cm[ks], sv, yt[tt]); }
            }
            LDS_FENCE();
#pragma unroll
            for (int tt = 0; tt < 2; ++tt) {
                const size_t row = row0 + tt * 16 + l15;
                const u32x2 uw = *(const u32x2*)(proj + row * INW + 4 * RW + g * 16 + 4 * l4);
                const float uu[4] = {bflo(uw.x), bfhi(uw.x), bflo(uw.y), bfhi(uw.y)};
                float o[4];
#pragma unroll
                for (int r = 0; r < 4; ++r) { const float y = yt[tt][r] + dsk[r] * uu[r]; const float z = 1.5957691216057308f * (y + 0.044715f * y * y * y); o[r] = y * pg8::sigmoid_f(z); }
                u32x2 w; w.x = pk2(o[0], o[1]); w.y = pk2(o[2], o[3]);
                *(u32x2*)(y1 + row * SW + g * 16 + 4 * l4) = w;
            }
            if (cvok) conv_consume(cvi, wlds + 8704, lane);
        }
    }
    if (!FULL) { if (hh == 0) { ST[stbase + n] = (f32x2){car[0], cai[0]}; ST[stbase + 32 + n] = (f32x2){car[1], cai[1]}; } }
}

__device__ __forceinline__ void scan_phase(const Params& P, int tid) {
    unsigned char* ws = P.ws;
    const int gt = blockIdx.x * 512 + tid, NGT = gridDim.x * 512;
    for (int e = gt; e < 16 * 8192; e += NGT) {
        const int bh = e >> 13, off = (e & 8191) * 2, h = bh & 7;
        const float dec = __builtin_amdgcn_exp2f(head_lg2(h) * 512.f);
        unsigned* p = (unsigned*)((bf16*)(ws + WS_TOT) + (size_t)bh * 16 * 16384 + off);
        unsigned kv[16];
#pragma unroll
        for (int j = 0; j < 16; ++j) kv[j] = p[(size_t)j * 8192];
        float s0 = 0.f, s1 = 0.f;
#pragma unroll
        for (int j = 0; j < 16; ++j) { p[(size_t)j * 8192] = pk2(s0, s1); s0 = fmaf(s0, dec, bflo(kv[j])); s1 = fmaf(s1, dec, bfhi(kv[j])); }
    }
}

__device__ __forceinline__ void ssm_norm_phase(const Params& P, int lane, int wave) {
    unsigned char* ws = P.ws; const bf16* y2 = (const bf16*)(ws + WS_Y2); bf16* mix = (bf16*)(ws + WS_BUFA);
    const int gw = blockIdx.x * 8 + wave, NGW = gridDim.x * 8;
    for (int m = gw; m < MTOK; m += NGW) {
        const u32x4 a = *(const u32x4*)(y2 + (size_t)m * SW + lane * 8), c = *(const u32x4*)(y2 + (size_t)m * SW + 512 + lane * 8);
        const unsigned w[8] = {a.x, a.y, a.z, a.w, c.x, c.y, c.z, c.w};
        float v[16]; float s = 0.f;
#pragma unroll
        for (int j = 0; j < 8; ++j) { v[2 * j] = bflo(w[j]); v[2 * j + 1] = bfhi(w[j]); s += v[2 * j] * v[2 * j] + v[2 * j + 1] * v[2 * j + 1]; }
        const float r = rsqrtf(wave_sum(s) * (1.f / SW) + EPS);
        const f32x4* g0 = (const f32x4*)(P.in[14] + lane * 8); const f32x4* g1 = (const f32x4*)(P.in[14] + 512 + lane * 8);
        const f32x4 ga = g0[0], gb = g0[1], gc = g1[0], gd = g1[1];
        u32x4 o0, o1;
        o0.x = pk2(v[0] * r * ga.x, v[1] * r * ga.y); o0.y = pk2(v[2] * r * ga.z, v[3] * r * ga.w); o0.z = pk2(v[4] * r * gb.x, v[5] * r * gb.y); o0.w = pk2(v[6] * r * gb.z, v[7] * r * gb.w);
        o1.x = pk2(v[8] * r * gc.x, v[9] * r * gc.y); o1.y = pk2(v[10] * r * gc.z, v[11] * r * gc.w); o1.z = pk2(v[12] * r * gd.x, v[13] * r * gd.y); o1.w = pk2(v[14] * r * gd.z, v[15] * r * gd.w);
        *(u32x4*)(mix + (size_t)m * DM + RW + lane * 8) = o0; *(u32x4*)(mix + (size_t)m * DM + RW + 512 + lane * 8) = o1;
    }
}
__device__ __forceinline__ void final_norm_phase(const Params& P, int lane, int wave) {
    const bf16* x2 = (const bf16*)(P.ws + WS_BUFA);
    const int mb = panel_of((int)blockIdx.x) * 256 + ((int)blockIdx.x >> 6) * 64 + wave * 8;
    for (int m = mb; m < mb + 8; ++m) {
        const bf16* xr = x2 + (size_t)m * DM + lane * 8;
        u32x4 w[4]; float s = 0.f;
#pragma unroll
        for (int j = 0; j < 4; ++j) w[j] = *(const u32x4*)(xr + 512 * j);
        float v[4][8];
#pragma unroll
        for (int j = 0; j < 4; ++j) { const unsigned ww[4] = {w[j].x, w[j].y, w[j].z, w[j].w};
#pragma unroll
            for (int k = 0; k < 4; ++k) { v[j][2 * k] = bflo(ww[k]); v[j][2 * k + 1] = bfhi(ww[k]); s += v[j][2 * k] * v[j][2 * k] + v[j][2 * k + 1] * v[j][2 * k + 1]; } }
        const float r = rsqrtf(wave_sum(s) * (1.f / DM) + EPS);
        float* orow = P.out + (size_t)m * DM + lane * 8; const float* gr = P.in[20] + lane * 8;
#pragma unroll
        for (int j = 0; j < 4; ++j) { const f32x4 g0 = *(const f32x4*)(gr + 512 * j), g1 = *(const f32x4*)(gr + 512 * j + 4);
            *(f32x4*)(orow + 512 * j) = (f32x4){v[j][0] * r * g0.x, v[j][1] * r * g0.y, v[j][2] * r * g0.z, v[j][3] * r * g0.w};
            *(f32x4*)(orow + 512 * j + 4) = (f32x4){v[j][4] * r * g1.x, v[j][5] * r * g1.y, v[j][6] * r * g1.z, v[j][7] * r * g1.w}; }
    }
}

#define LAS __attribute__((address_space(3)))
#define XB_TMO      128
#define XB_XCNT(j)  (256  + 64 * (j))
#define XB_XSUB(j)  (1280 + 64 * (j))
#define XB_XGEN(j)  (2304 + 64 * (j))
#define XB_TOP      3328
#define XB_TOPGEN   3392
#define XCD_BAR_WORDS 3456
#define XB_SPIN_CAP (1u << 18)

__device__ __forceinline__ unsigned xb_ld(unsigned* p)              { return __hip_atomic_load(p, __ATOMIC_RELAXED, __HIP_MEMORY_SCOPE_AGENT); }
__device__ __forceinline__ unsigned xb_add(unsigned* p, unsigned v) { return __hip_atomic_fetch_add(p, v, __ATOMIC_RELAXED, __HIP_MEMORY_SCOPE_AGENT); }
__device__ __forceinline__ unsigned xb_xcc_id() { return (unsigned)__builtin_amdgcn_s_getreg((3 << 11) | 20) & 0xFu; }
#define XB_SPIN(cond, bar) do { unsigned _sp = 0; while (cond) { __builtin_amdgcn_s_sleep(1); \
    if ((++_sp & 255u) == 0u) { if (xb_ld(&(bar)[XB_TMO])) break; if (_sp > XB_SPIN_CAP) { atomicAdd(&(bar)[XB_TMO], 1u); break; } } } } while (0)

struct XcdBarrier {
    unsigned* bar; unsigned x;
    volatile LAS unsigned* st;
};

__device__ __forceinline__ XcdBarrier xcd_barrier_post(unsigned* bar, volatile LAS unsigned* st) {
    XcdBarrier b; b.bar = bar; b.x = xb_xcc_id(); b.st = st;
    if (threadIdx.x == 0) (void)xb_add(&bar[XB_XCNT(b.x)], 1u);
    return b;
}
__device__ __forceinline__ void xcd_barrier_complete(unsigned* bar, unsigned x, unsigned& nloc, unsigned& nx) {
    const unsigned G = gridDim.x * gridDim.y * gridDim.z;
    unsigned sum, cnt, mine, sp = 0u;
    for (;;) {
        sum = 0u; cnt = 0u; mine = 0u;
#pragma unroll
        for (unsigned j = 0; j < 16; ++j) { const unsigned c = xb_ld(&bar[XB_XCNT(j)]); sum += c; cnt += (c > 0u) ? 1u : 0u; mine = (j == x) ? c : mine; }
        if (sum == G) break;
        __builtin_amdgcn_s_sleep(1);
        if ((++sp & 255u) == 0u) { if (xb_ld(&bar[XB_TMO])) break; if (sp > XB_SPIN_CAP) { atomicAdd(&bar[XB_TMO], 1u); break; } }
    }
    nloc = mine > 0u ? mine : 1u; nx = cnt > 0u ? cnt : 1u;
}

__device__ __forceinline__ void xcd_barrier(const XcdBarrier& b) {
    asm volatile("s_waitcnt vmcnt(0)" ::: "memory");
    __syncthreads();
    if (threadIdx.x == 0) {
        unsigned* bar = b.bar;
        __builtin_amdgcn_s_waitcnt(0);
        unsigned nloc = b.st[0], nx = b.st[1];
        if (nloc == 0u) { xcd_barrier_complete(bar, b.x, nloc, nx); b.st[0] = nloc; b.st[1] = nx; }
        const unsigned old = xb_add(&bar[XB_XSUB(b.x)], 1u);
        const unsigned gen = old / nloc;
        if (old + 1u == (gen + 1u) * nloc) {
            __builtin_amdgcn_fence(__ATOMIC_RELEASE, "agent");
            asm volatile("s_waitcnt vmcnt(0)" ::: "memory");
            const unsigned og = xb_add(&bar[XB_TOP], 1u);
            const unsigned tg = og / nx;
            if (og + 1u == (tg + 1u) * nx) xb_add(&bar[XB_TOPGEN], 1u);
            else XB_SPIN(xb_ld(&bar[XB_TOPGEN]) == tg, bar);
            __builtin_amdgcn_fence(__ATOMIC_ACQUIRE, "agent");
            xb_add(&bar[XB_XGEN(b.x)], 1u);
            asm volatile("s_waitcnt vmcnt(0)" ::: "memory");
        } else {
            XB_SPIN(xb_ld(&bar[XB_XGEN(b.x)]) == gen, bar);
            __builtin_amdgcn_fence(__ATOMIC_ACQUIRE, "agent");
            asm volatile("s_waitcnt vmcnt(0)" ::: "memory");
        }
    }
    __syncthreads();
}

__device__ __forceinline__ void group_barrier(unsigned* ctl, int seam, int pm, bool samex) {
    asm volatile("s_waitcnt vmcnt(0)" ::: "memory");
    __syncthreads();
    if (threadIdx.x == 0) {
        unsigned* cnt = ctl + (CTL_GRP / 4) + (seam * 64 + pm) * 64;
        if (!samex) { __builtin_amdgcn_fence(__ATOMIC_RELEASE, "agent"); asm volatile("s_waitcnt vmcnt(0)" ::: "memory"); }
        xb_add(cnt, 1u);
        unsigned sp = 0u;
        while (xb_ld(cnt) < 4u) { __builtin_amdgcn_s_sleep(1); if (++sp > (1u << 22)) break; }
        __builtin_amdgcn_fence(__ATOMIC_ACQUIRE, "agent");
        asm volatile("s_waitcnt vmcnt(0)" ::: "memory");
    }
    __syncthreads();
}
template <int PH>
__device__ __forceinline__ void run_phase(const Params& P, unsigned char* lds, int tid, int lane, int wave) {
    unsigned char* ws = P.ws;
    PG8_LAS unsigned char* glds = (PG8_LAS unsigned char*)lds;
    if constexpr (PH == 0) p0_phase(P, lds, tid, lane, wave);
    if constexpr (PH == 1) {
        pg8::Gemm g{(const bf16*)(ws + WS_XB), (const bf16*)(ws + WS_WIN), MTOK, INW, DM}; pg8::StaticOrder S; S.init(MTOK, INW, gridDim.x, blockIdx.x);
        pg8::EpiStoreBf16 E{(bf16*)(ws + WS_PROJ), INW, (const float*)(ws + WS_RS0)};
        pg8::gemm_phase<pg8::EpiStoreBf16, pg8::StaticOrder, true, true>(glds, g, S, E);
    }
    if constexpr (PH == 2) {
        ret_pass_a(P, lds, tid, lane, wave);
        { const int id = blockIdx.x * 8 + wave; if (id < 2048) s5_wave<false>(P, lds + wave * S5_WLDS, id >> 10, id & 63, (id >> 6) & 15, lane, id); }
    }
    if constexpr (PH == 3) {
        scan_phase(P, tid);
        const int id = blockIdx.x * 8 + wave; if (id < 2048) s5_wave<true>(P, lds + wave * S5_WLDS, id >> 10, id & 63, (id >> 6) & 15, lane, id);
    }
    if constexpr (PH == 5) {
        pg8::Gemm g{(const bf16*)(ws + WS_Y1), (const bf16*)(ws + WS_WGLU), MTOK, SW, SW}; pg8::StaticOrder S; S.init(MTOK, SW, gridDim.x, blockIdx.x);
        pg8::EpiGlu E{(const bf16*)(ws + WS_Y1), P.in[13], P.in[14], (bf16*)(ws + WS_BUFA) + RW, (float*)(ws + WS_SQ2), SW, DM};
        pg8::gemm_phase<pg8::EpiGlu, pg8::StaticOrder, false, true>(glds, g, S, E);
    }
    if constexpr (PH == 6) ret_pass_c(P, lds, tid, lane, wave);
    if constexpr (PH == 7) {
        pg8::Gemm g{(const bf16*)(ws + WS_BUFA), (const bf16*)(ws + WS_WOUT), MTOK, DM, DM}; pg8::StaticOrder S; S.init(MTOK, DM, gridDim.x, blockIdx.x);
        pg8::EpiResB E{nullptr, (const bf16*)(ws + WS_XB), (bf16*)(ws + WS_X1B), DM, (const float*)(ws + WS_SQ2), 1.f / SW, (float*)(ws + WS_SQ1)};
        pg8::gemm_phase<pg8::EpiResB, pg8::StaticOrder, false, true>(glds, g, S, E);
    }
    if constexpr (PH == 9) {
        pg8::Gemm g{(const bf16*)(ws + WS_X1B), (const bf16*)(ws + WS_WGU), MTOK, 2 * DFF, DM}; pg8::StaticOrder S; S.init(MTOK, 2 * DFF, gridDim.x, blockIdx.x);
        pg8::Unit u0; int pm0 = -1; if (S.next(0, u0)) pm0 = u0.pm;
        float* rsl = (float*)(lds + LDS_KEEP + 64);
        if (pm0 >= 0 && tid < 256) { const f32x4* pp = (const f32x4*)((const float*)(ws + WS_SQ1) + (size_t)(pm0 * 256 + tid) * 32); float t = 0.f;
#pragma unroll
            for (int j = 0; j < 8; ++j) { const f32x4 p4 = pp[j]; t += (p4[0] + p4[1]) + (p4[2] + p4[3]); }
            rsl[tid] = rsqrtf(t * (1.f / DM) + EPS); }
        __syncthreads();
        pg8::EpiSwiGlu E{(bf16*)(ws + WS_ACT), DFF, (const float*)(ws + WS_SQ1), 1.f / DM, rsl, pm0};
        pg8::gemm_phase<pg8::EpiSwiGlu, pg8::StaticOrder, true, true>(glds, g, S, E);
    }
    if constexpr (PH == 10) {
        pg8::Gemm g{(const bf16*)(ws + WS_ACT), (const bf16*)(ws + WS_WD), MTOK, DM, DFF}; pg8::StaticOrder S; S.init(MTOK, DM, gridDim.x, blockIdx.x);
        pg8::EpiResB E{nullptr, (const bf16*)(ws + WS_X1B), (bf16*)(ws + WS_BUFA), DM, nullptr, 0.f, nullptr};
        pg8::gemm_phase<pg8::EpiResB, pg8::StaticOrder, false, true>(glds, g, S, E);
    }
    if constexpr (PH == 11) final_norm_phase(P, lane, wave);
}
#define R(k) { int t_ = threadIdx.x; asm volatile("" : "+v"(t_)); run_phase<k>(P, lds, t_, t_ & 63, __builtin_amdgcn_readfirstlane(t_ >> 6)); }
#define BST ((volatile LAS unsigned*)((LAS unsigned char*)lds + LDS_KEEP))
#define S { XcdBarrier b_; b_.bar = (unsigned*)(P.ws + WS_CTL); b_.x = xb_xcc_id(); b_.st = BST; xcd_barrier(b_); }
#define G(k) group_barrier((unsigned*)(P.ws + WS_CTL), k, panel_of((int)blockIdx.x), BST[2] != 0u);
#define PHASE_PROGRAM R(0) S R(1) S R(2) S R(3) S GROUP_CHECK R(5) G(0) R(6) S R(7) G(1) R(9) G(2) R(10) G(3) R(11)
__global__ void __launch_bounds__(512, 2) hybrid_fwd(Params P) {
    extern __shared__ __attribute__((aligned(16))) unsigned char lds[];
    cg::grid_group grid = cg::this_grid();
    const int tid = threadIdx.x, lane = tid & 63, wave = __builtin_amdgcn_readfirstlane(tid >> 6);
    if (P.ws == nullptr) grid.sync();
    if (tid < 3) BST[tid] = 0u;
    __syncthreads();
    { XcdBarrier bar = xcd_barrier_post((unsigned*)(P.ws + WS_CTL), BST); (void)bar; }
    if (tid == 0) __hip_atomic_store((unsigned*)(P.ws + WS_CTL + CTL_XID) + blockIdx.x, xb_xcc_id() + 1u, __ATOMIC_RELAXED, __HIP_MEMORY_SCOPE_AGENT);
#define GROUP_CHECK { unsigned ok_ = 1u; const unsigned* xid_ = (const unsigned*)(P.ws + WS_CTL + CTL_XID); _Pragma("unroll") for (int k_ = 0; k_ < 4; ++k_) ok_ &= (xb_ld((unsigned*)xid_ + ((blockIdx.x & 63) + 64 * k_)) == xb_xcc_id() + 1u) ? 1u : 0u; if (threadIdx.x == 0) BST[2] = ok_; __syncthreads(); }
    PHASE_PROGRAM
}
#undef R
#undef S

extern "C" void kernel_launch(void* const* d_in, const int* in_sizes, int n_in, void* d_out, int out_size, void* d_ws, size_t ws_size, hipStream_t stream) {
    static int grid = 0;
    if (grid == 0) {
        if (n_in != 21 || out_size != MTOK * DM || ws_size < WS_END) { fprintf(stderr, "kernel_launch: unexpected shapes (n_in %d out %d ws %zu)\n", n_in, out_size, ws_size); grid = -1; return; }
        int dev = 0, cus = 0, per_cu = 0;
        (void)hipGetDevice(&dev); (void)hipDeviceGetAttribute(&cus, hipDeviceAttributeMultiprocessorCount, dev);
        if (hipFuncSetAttribute((const void*)hybrid_fwd, hipFuncAttributeMaxDynamicSharedMemorySize, LDS_BYTES) != hipSuccess) { fprintf(stderr, "kernel_launch: hipFuncSetAttribute failed\n"); grid = -1; return; }
        if (hipOccupancyMaxActiveBlocksPerMultiprocessor(&per_cu, (const void*)hybrid_fwd, 512, LDS_BYTES) != hipSuccess || per_cu < 1) { fprintf(stderr, "kernel_launch: occupancy query says %d\n", per_cu); per_cu = 1; }
        (void)hipGetLastError();
        grid = cus * 1;
        if (grid != 256) { fprintf(stderr, "kernel_launch: built for a 256-CU device (got %d)\n", cus); grid = -1; return; }
    }
    if (grid < 0) return;
    Params p{};
    for (int i = 0; i < 21; ++i) p.in[i] = (const float*)d_in[i];
    p.out = (float*)d_out; p.ws = (unsigned char*)d_ws;
    if (hipMemsetAsync((unsigned char*)d_ws + WS_CTL, 0, CTL_ZERO, stream) != hipSuccess) { fprintf(stderr, "kernel_launch: memset of the barrier words failed\n"); return; }
    void* args[] = {&p};
    hipError_t e = hipLaunchCooperativeKernel((const void*)hybrid_fwd, dim3(grid), dim3(512), args, LDS_BYTES, stream);
    if (e != hipSuccess) fprintf(stderr, "cooperative launch failed: %s (grid %d)\n", hipGetErrorString(e), grid);
}
```

```cpp
#include <hip/hip_runtime.h>
#include <hip/hip_cooperative_groups.h>
#include <cstdio>
#include <cstdint>
namespace cg = cooperative_groups;
namespace pg8 {
#define PG8_LAS __attribute__((address_space(3)))
typedef unsigned short bf16_t;
typedef short bf16x8 __attribute__((ext_vector_type(8)));
typedef float f32x4 __attribute__((ext_vector_type(4)));
typedef unsigned u32x4 __attribute__((ext_vector_type(4)));
constexpr int BM = 256, BK = 64, HALF = 128, HTB = HALF * BK * 2  , STAGE_BYTES = 8 * HTB, NXCD = 8, WGM = 8;

__host__ __device__ __forceinline__ int lds_byte(int r, int c) { const int st = (r >> 4) * 2 + (c >> 5), rr = r & 15, cc = c & 31, ob = rr * 64 + cc * 2; return st * 1024 + (ob ^ (((ob >> 9) & 1) << 5)); }
__host__ __device__ __forceinline__ void stage_rc(int b, int& R, int& C) { const int st = b / 1024, sb = b % 1024, swz = sb ^ (((sb >> 9) & 1) << 5); R = (st >> 1) * 16 + swz / 64; C = (st & 1) * 32 + (swz % 64) / 2; }
__host__ __device__ __forceinline__ int perm32(int rho) { const int n = rho >> 4, i = rho & 15; return 8 * (i >> 2) + 4 * n + (i & 3); }

struct Unit { int pm, pn; };
struct Gemm { const bf16_t* A; const bf16_t* Bt; int M, N, K; };

struct StaticOrder {
    int nM, nN, nwg, G, c;
    __host__ __device__ void init(int M, int N, int G_, int c_) { nM = M / BM; nN = N / BM; nwg = nM * nN; G = G_; c = c_; }
    __host__ __device__ bool next(int i, Unit& u) const {
        const long L = (long)i * G + c; if (L >= nwg) return false;
        int wgid = (int)L; { const int q = nwg / NXCD, r = nwg % NXCD, xcd = wgid % NXCD, off = wgid / NXCD; wgid = (xcd < r ? xcd * (q + 1) : r * (q + 1) + (xcd - r) * q) + off; }
        const int nig = WGM * nN, gid = wgid / nig, fm = gid * WGM, gsz = (nM - fm) < WGM ? (nM - fm) : WGM;
        u.pm = fm + ((wgid % nig) % gsz); u.pn = (wgid % nig) / gsz; return true;
    }
    __device__ __forceinline__ void a_ready(const Unit&) const {}
    __device__ __forceinline__ void done(const Unit&) const {}
};

typedef __bf16 bf16x2_t __attribute__((ext_vector_type(2)));
__device__ __forceinline__ unsigned cvt_pk_bf16(float lo, float hi) { bf16x2_t v = {(__bf16)lo, (__bf16)hi}; return __builtin_bit_cast(unsigned, v); }
__device__ __forceinline__ float bf_lo(unsigned w) { return __uint_as_float(w << 16); }
__device__ __forceinline__ float bf_hi(unsigned w) { return __uint_as_float(w & 0xffff0000u); }
typedef unsigned u32x2v __attribute__((ext_vector_type(2)));
__device__ __forceinline__ float sigmoid_f(float z) { return __builtin_amdgcn_rcpf(1.0f + __expf(-z)); }

struct EpiStoreBf16 {
    static constexpr bool PERM = true, AFTER_DRAIN = false;
    bf16_t* O; int ldc; const float* rs;
    __device__ __forceinline__ void operator()(const f32x4 (&acc)[2][2][4][2], const Unit& u, int wr, int wc, int fr, int fq) const {
        const int row0 = u.pm * BM + wr * 64 + fr, col0 = u.pn * BM + wc * 32 + 8 * fq;
        float rv[2][4];
#pragma unroll
        for (int ai = 0; ai < 2; ++ai)
#pragma unroll
            for (int m = 0; m < 4; ++m) rv[ai][m] = rs[row0 + ai * HALF + m * 16];
#pragma unroll
        for (int ai = 0; ai < 2; ++ai)
#pragma unroll
            for (int m = 0; m < 4; ++m) { bf16_t* rowp = O + (size_t)(row0 + ai * HALF + m * 16) * ldc + col0;
#pragma unroll
                for (int bj = 0; bj < 2; ++bj) { const f32x4 v0 = acc[ai][bj][m][0] * rv[ai][m], v1 = acc[ai][bj][m][1] * rv[ai][m];
                    u32x4 w; w.x = cvt_pk_bf16(v0[0], v0[1]); w.y = cvt_pk_bf16(v0[2], v0[3]); w.z = cvt_pk_bf16(v1[0], v1[1]); w.w = cvt_pk_bf16(v1[2], v1[3]);
                    *(u32x4*)(rowp + bj * HALF) = w; } }
    }
};
struct EpiGlu {
    static constexpr bool PERM = true, AFTER_DRAIN = false;
    const bf16_t* Y1; const float* bias; const float* gain; bf16_t* Y2; float* rowsq; int ldc, ldo;
    __device__ __forceinline__ void operator()(const f32x4 (&acc)[2][2][4][2], const Unit& u, int wr, int wc, int fr, int fq) const {
        const int row0 = u.pm * BM + wr * 64 + fr, col0 = u.pn * BM + wc * 32 + 8 * fq;
        f32x4 bv[2][2], gv[2][2];
#pragma unroll
        for (int bj = 0; bj < 2; ++bj)
#pragma unroll
            for (int n = 0; n < 2; ++n) { bv[bj][n] = *(const f32x4*)(bias + col0 + bj * HALF + 4 * n); gv[bj][n] = *(const f32x4*)(gain + col0 + bj * HALF + 4 * n); }
#pragma unroll
        for (int ai = 0; ai < 2; ++ai) {
            u32x4 yv[4][2];
#pragma unroll
            for (int m = 0; m < 4; ++m)
#pragma unroll
                for (int bj = 0; bj < 2; ++bj) yv[m][bj] = *(const u32x4*)(Y1 + (size_t)(row0 + ai * HALF + m * 16) * ldc + col0 + bj * HALF);
#pragma unroll
            for (int m = 0; m < 4; ++m) { const int row = row0 + ai * HALF + m * 16; const size_t offo = (size_t)row * ldo + col0;
                float ss = 0.f;
#pragma unroll
                for (int bj = 0; bj < 2; ++bj) { const f32x4 z0 = acc[ai][bj][m][0] + bv[bj][0], z1 = acc[ai][bj][m][1] + bv[bj][1];
                    const u32x4 y = yv[m][bj];
                    f32x4 r0, r1;
                    r0[0] = bf_lo(y.x) * sigmoid_f(z0[0]); r0[1] = bf_hi(y.x) * sigmoid_f(z0[1]); r0[2] = bf_lo(y.y) * sigmoid_f(z0[2]); r0[3] = bf_hi(y.y) * sigmoid_f(z0[3]);
                    r1[0] = bf_lo(y.z) * sigmoid_f(z1[0]); r1[1] = bf_hi(y.z) * sigmoid_f(z1[1]); r1[2] = bf_lo(y.w) * sigmoid_f(z1[2]); r1[3] = bf_hi(y.w) * sigmoid_f(z1[3]);
                    ss += (r0[0] * r0[0] + r0[1] * r0[1]) + (r0[2] * r0[2] + r0[3] * r0[3]) + (r1[0] * r1[0] + r1[1] * r1[1]) + (r1[2] * r1[2] + r1[3] * r1[3]);
                    r0 = r0 * gv[bj][0]; r1 = r1 * gv[bj][1];
                    u32x4 w; w.x = cvt_pk_bf16(r0[0], r0[1]); w.y = cvt_pk_bf16(r0[2], r0[3]); w.z = cvt_pk_bf16(r1[0], r1[1]); w.w = cvt_pk_bf16(r1[2], r1[3]);
                    *(u32x4*)(Y2 + offo + bj * HALF) = w; }
                ss += __shfl_xor(ss, 16); ss += __shfl_xor(ss, 32);
                if (fq == 0) rowsq[(size_t)row * 16 + u.pn * 4 + wc] = ss; }
        }
    }
};
struct EpiResF32 {
    static constexpr bool PERM = false, AFTER_DRAIN = false;
    const float* X; float* O; int ldc; const float* insq; float inv_indim; bf16_t* OB; float* outsq;
    __device__ __forceinline__ void operator()(const f32x4 (&acc)[2][2][4][2], const Unit& u, int wr, int wc, int fr, int fq) const {
        const int row0 = u.pm * BM + wr * 64 + fr, col0 = u.pn * BM + wc * 32 + 4 * fq;
#pragma unroll
        for (int ai = 0; ai < 2; ++ai)
#pragma unroll
        for (int mh = 0; mh < 2; ++mh) {
            f32x4 xv[2][2][2]; f32x4 p4[2];
#pragma unroll
            for (int mm = 0; mm < 2; ++mm) { const int row = row0 + ai * HALF + (2 * mh + mm) * 16; const size_t off = (size_t)row * ldc + col0;
                p4[mm] = insq ? *(const f32x4*)(insq + (size_t)row * 16 + 4 * fq) : (f32x4){0.f, 0.f, 0.f, 0.f};
#pragma unroll
                for (int bj = 0; bj < 2; ++bj)
#pragma unroll
                    for (int n = 0; n < 2; ++n) xv[mm][bj][n] = *(const f32x4*)(X + off + bj * HALF + n * 16); }
#pragma unroll
            for (int mm = 0; mm < 2; ++mm) { const int m = 2 * mh + mm; const int row = row0 + ai * HALF + m * 16; const size_t off = (size_t)row * ldc + col0;
                float sc = 1.0f;
                if (insq) { float t = (p4[mm][0] + p4[mm][1]) + (p4[mm][2] + p4[mm][3]); t += __shfl_xor(t, 16); t += __shfl_xor(t, 32); sc = rsqrtf(t * inv_indim + 1e-6f); }
                float ss = 0.f;
#pragma unroll
                for (int bj = 0; bj < 2; ++bj)
#pragma unroll
                    for (int n = 0; n < 2; ++n) { const f32x4 o = xv[mm][bj][n] + acc[ai][bj][m][n] * sc;
                        *(f32x4*)(O + off + bj * HALF + n * 16) = o;
                        if (OB) { ss += (o[0] * o[0] + o[1] * o[1]) + (o[2] * o[2] + o[3] * o[3]); u32x2v w; w.x = cvt_pk_bf16(o[0], o[1]); w.y = cvt_pk_bf16(o[2], o[3]); *(u32x2v*)(OB + off + bj * HALF + n * 16) = w; } }
                if (OB) { ss += __shfl_xor(ss, 16); ss += __shfl_xor(ss, 32); if (fq == 0) outsq[(size_t)row * 32 + u.pn * 4 + wc] = ss; } }
        }
    }
};
struct EpiResB {
    static constexpr bool PERM = true, AFTER_DRAIN = false;
    const float* X; const bf16_t* XB; bf16_t* OB; int ldc; const float* insq; float inv_indim; float* outsq;
    __device__ __forceinline__ void operator()(const f32x4 (&acc)[2][2][4][2], const Unit& u, int wr, int wc, int fr, int fq) const {
        const int row0 = u.pm * BM + wr * 64 + fr, col0 = u.pn * BM + wc * 32 + 8 * fq;
#pragma unroll
        for (int ai = 0; ai < 2; ++ai)
#pragma unroll
        for (int mh = 0; mh < 2; ++mh) {
            f32x4 xv[2][2][2]; f32x4 p4[2];
#pragma unroll
            for (int mm = 0; mm < 2; ++mm) { const int row = row0 + ai * HALF + (2 * mh + mm) * 16; const size_t off = (size_t)row * ldc + col0;
                p4[mm] = insq ? *(const f32x4*)(insq + (size_t)row * 16 + 4 * fq) : (f32x4){0.f, 0.f, 0.f, 0.f};
#pragma unroll
                for (int bj = 0; bj < 2; ++bj) {
                    if (XB) { const u32x4 y = *(const u32x4*)(XB + off + bj * HALF); xv[mm][bj][0] = (f32x4){bf_lo(y.x), bf_hi(y.x), bf_lo(y.y), bf_hi(y.y)}; xv[mm][bj][1] = (f32x4){bf_lo(y.z), bf_hi(y.z), bf_lo(y.w), bf_hi(y.w)}; }
                    else { xv[mm][bj][0] = *(const f32x4*)(X + off + bj * HALF); xv[mm][bj][1] = *(const f32x4*)(X + off + bj * HALF + 4); } } }
#pragma unroll
            for (int mm = 0; mm < 2; ++mm) { const int m = 2 * mh + mm; const int row = row0 + ai * HALF + m * 16; const size_t off = (size_t)row * ldc + col0;
                float sc = 1.0f;
                if (insq) { float t = (p4[mm][0] + p4[mm][1]) + (p4[mm][2] + p4[mm][3]); t += __shfl_xor(t, 16); t += __shfl_xor(t, 32); sc = rsqrtf(t * inv_indim + 1e-6f); }
                float ss = 0.f;
#pragma unroll
                for (int bj = 0; bj < 2; ++bj) { const f32x4 o0 = xv[mm][bj][0] + acc[ai][bj][m][0] * sc, o1 = xv[mm][bj][1] + acc[ai][bj][m][1] * sc;
                    ss += ((o0[0] * o0[0] + o0[1] * o0[1]) + (o0[2] * o0[2] + o0[3] * o0[3])) + ((o1[0] * o1[0] + o1[1] * o1[1]) + (o1[2] * o1[2] + o1[3] * o1[3]));
                    u32x4 w; w.x = cvt_pk_bf16(o0[0], o0[1]); w.y = cvt_pk_bf16(o0[2], o0[3]); w.z = cvt_pk_bf16(o1[0], o1[1]); w.w = cvt_pk_bf16(o1[2], o1[3]);
                    *(u32x4*)(OB + off + bj * HALF) = w; }
                if (outsq) { ss += __shfl_xor(ss, 16); ss += __shfl_xor(ss, 32); if (fq == 0) outsq[(size_t)row * 32 + u.pn * 4 + wc] = ss; } }
        }
    }
};
struct EpiSwiGlu {
    static constexpr bool PERM = true, AFTER_DRAIN = false;
    bf16_t* O; int ldc; const float* insq; float inv_indim; const float* rs_lds; int pm_lds;
    __device__ __forceinline__ void operator()(const f32x4 (&acc)[2][2][4][2], const Unit& u, int wr, int wc, int fr, int fq) const {
        const int row0 = u.pm * BM + wr * 64 + fr, col0 = u.pn * HALF + wc * 32 + 8 * fq;
        float scv[2][4];
        if (u.pm == pm_lds) {
#pragma unroll
          for (int ai = 0; ai < 2; ++ai)
#pragma unroll
              for (int m = 0; m < 4; ++m) scv[ai][m] = rs_lds[wr * 64 + fr + ai * HALF + m * 16];
        } else { f32x4 pa[2][4], pb[2][4];
#pragma unroll
          for (int ai = 0; ai < 2; ++ai)
#pragma unroll
              for (int m = 0; m < 4; ++m) { const float* pp = insq + (size_t)(row0 + ai * HALF + m * 16) * 32 + 8 * fq; pa[ai][m] = *(const f32x4*)pp; pb[ai][m] = *(const f32x4*)(pp + 4); }
#pragma unroll
          for (int ai = 0; ai < 2; ++ai)
#pragma unroll
              for (int m = 0; m < 4; ++m) { float t = ((pa[ai][m][0] + pa[ai][m][1]) + (pa[ai][m][2] + pa[ai][m][3])) + ((pb[ai][m][0] + pb[ai][m][1]) + (pb[ai][m][2] + pb[ai][m][3]));
                  t += __shfl_xor(t, 16); t += __shfl_xor(t, 32); scv[ai][m] = rsqrtf(t * inv_indim + 1e-6f); } }
#pragma unroll
        for (int ai = 0; ai < 2; ++ai)
#pragma unroll
            for (int m = 0; m < 4; ++m) { const int row = row0 + ai * HALF + m * 16; bf16_t* rowp = O + (size_t)row * ldc + col0;
                const float sc = scv[ai][m];
                f32x4 r0, r1;
#pragma unroll
                for (int j = 0; j < 4; ++j) { const float g0 = acc[ai][0][m][0][j] * sc, g1 = acc[ai][0][m][1][j] * sc;
                    r0[j] = g0 * sigmoid_f(g0) * (acc[ai][1][m][0][j] * sc); r1[j] = g1 * sigmoid_f(g1) * (acc[ai][1][m][1][j] * sc); }
                u32x4 w; w.x = cvt_pk_bf16(r0[0], r0[1]); w.y = cvt_pk_bf16(r0[2], r0[3]); w.z = cvt_pk_bf16(r1[0], r1[1]); w.w = cvt_pk_bf16(r1[2], r1[3]);
                *(u32x4*)rowp = w; }
    }
};


template <class Epi, class Sched, bool ALIGN_EPI = false, bool SP2 = false>
__device__ __forceinline__ void gemm_phase(PG8_LAS unsigned char* lds, const Gemm g, const Sched& S, const Epi& E) {
    int tid_ = threadIdx.x; asm volatile("" : "+v"(tid_));
    const int tid = tid_, wid = __builtin_amdgcn_readfirstlane(tid >> 6), lane = tid & 63, wr = wid >> 2, wc = wid & 3, fr = lane & 15, fq = lane >> 4;
    const int K = g.K, nt = K / BK;
    unsigned voffA[2], voffB[2];
#pragma unroll
    for (int i = 0; i < 2; ++i) { int R, C; stage_rc(tid * 16 + i * 8192, R, C); const int Rb = Epi::PERM ? ((R & ~31) + perm32(R & 31)) : R;
        voffA[i] = (unsigned)(R * K + C) * 2u; voffB[i] = (unsigned)(Rb * K + C) * 2u; }
    const size_t kstep = (size_t)(BK * 2);
    const size_t hstep = (size_t)HALF * K * 2;
    const size_t tstep = 2 * hstep;
    const unsigned ldsw = (unsigned)wid * 1024u;
    const int aoff = lds_byte(wr * 64 + fr, fq * 8), boff = lds_byte(wc * 32 + fr, fq * 8);
#define PG8_SA(b, h) (((b) * 2 + (h)) * HTB)
#define PG8_SB(b, h) ((4 + (b) * 2 + (h)) * HTB)
#define PG8_STAGE(bufoff, gbase, voff) do { _Pragma("unroll") for (int _i = 0; _i < 2; ++_i) \
        __builtin_amdgcn_global_load_lds((const unsigned*)((const char*)(gbase) + (voff)[_i]), (PG8_LAS unsigned*)(lds + (bufoff) + ldsw + _i * 8192), 16, 0, 0); } while (0)
#define PG8_LDA(dst, b, h) do { _Pragma("unroll") for (int m = 0; m < 4; ++m) _Pragma("unroll") for (int k = 0; k < 2; ++k) dst[m][k] = *(const PG8_LAS bf16x8*)(lds + PG8_SA(b, h) + aoff + m * 2048 + k * 1024); } while (0)
#define PG8_LDB(dst, b, h) do { _Pragma("unroll") for (int n = 0; n < 2; ++n) _Pragma("unroll") for (int k = 0; k < 2; ++k) dst[n][k] = *(const PG8_LAS bf16x8*)(lds + PG8_SB(b, h) + boff + n * 2048 + k * 1024); } while (0)
#define PG8_MMA(ai, bj, At, Bt) do { __builtin_amdgcn_s_setprio(1); _Pragma("unroll") for (int m = 0; m < 4; ++m) _Pragma("unroll") for (int n = 0; n < 2; ++n) _Pragma("unroll") for (int k = 0; k < 2; ++k) \
        acc[ai][bj][m][n] = __builtin_amdgcn_mfma_f32_16x16x32_bf16(Bt[n][k], At[m][k], acc[ai][bj][m][n], 0, 0, 0); __builtin_amdgcn_s_setprio(0); } while (0)
#define PG8_WAIT_V(n) asm volatile("s_waitcnt vmcnt(" #n ")" ::: "memory")
#define PG8_WAIT_L(n) asm volatile("s_waitcnt lgkmcnt(" #n ")" ::: "memory")
#define PG8_BAR __builtin_amdgcn_s_barrier()
#define PG8_SCHED __builtin_amdgcn_sched_barrier(0)
    Unit cur, nxt; int ui = 0;
    if (!S.next(0, cur)) return;
    f32x4 acc[2][2][4][2];
#pragma unroll
    for (int a = 0; a < 2; ++a)
#pragma unroll
        for (int b = 0; b < 2; ++b)
#pragma unroll
            for (int m = 0; m < 4; ++m)
#pragma unroll
                for (int n = 0; n < 2; ++n) acc[a][b][m][n] = (f32x4){0.f, 0.f, 0.f, 0.f};
    bf16x8 At[4][2], B0[2][2], B1[2][2];
    const char* cA = (const char*)g.A + (size_t)cur.pm * tstep; const char* cB = (const char*)g.Bt + (size_t)cur.pn * tstep;
    S.a_ready(cur);
    if constexpr (SP2) {
        PG8_STAGE(PG8_SB(0, 0), cB, voffB); PG8_STAGE(PG8_SB(0, 1), cB + hstep, voffB); PG8_STAGE(PG8_SA(0, 0), cA, voffA); PG8_STAGE(PG8_SA(0, 1), cA + hstep, voffA);
        if (wr == 1) PG8_BAR;
        PG8_WAIT_V(2); PG8_BAR;
        PG8_STAGE(PG8_SB(1, 0), cB + kstep, voffB); PG8_STAGE(PG8_SA(1, 0), cA + kstep, voffA); PG8_STAGE(PG8_SB(1, 1), cB + hstep + kstep, voffB);
        PG8_WAIT_V(6); PG8_BAR;
    } else {
        PG8_STAGE(PG8_SB(0, 0), cB, voffB); PG8_STAGE(PG8_SA(0, 0), cA, voffA); PG8_STAGE(PG8_SB(0, 1), cB + hstep, voffB); PG8_STAGE(PG8_SA(0, 1), cA + hstep, voffA);
        if (wr == 1) PG8_BAR;
        PG8_WAIT_V(4); PG8_BAR;
        PG8_STAGE(PG8_SB(1, 0), cB + kstep, voffB); PG8_STAGE(PG8_SA(1, 0), cA + kstep, voffA); PG8_STAGE(PG8_SB(1, 1), cB + hstep + kstep, voffB);
        PG8_WAIT_V(6); PG8_BAR;
    }
    for (;;) {
        const bool has_next = S.next(ui + 1, nxt);
        const char* nA = has_next ? (const char*)g.A + (size_t)nxt.pm * tstep : cA; const char* nB = has_next ? (const char*)g.Bt + (size_t)nxt.pn * tstep : cB;
        for (int t = 0; t < nt; t += 2) {
            const bool last = (t == nt - 2);
            const char* a1 = cA + (size_t)(t + 1) * kstep;
            const char* a2 = last ? nA : cA + (size_t)(t + 2) * kstep; const char* b2 = last ? nB : cB + (size_t)(t + 2) * kstep;
            const char* a3 = a2 + kstep; const char* b3 = b2 + kstep;
            if (last && has_next) S.a_ready(nxt);
            if constexpr (SP2) {
            PG8_LDB(B0, 0, 0); PG8_LDB(B1, 0, 1); PG8_SCHED; PG8_LDA(At, 0, 0); PG8_STAGE(PG8_SA(1, 1), a1 + hstep, voffA);
            PG8_WAIT_V(8); PG8_WAIT_L(0); PG8_BAR; PG8_MMA(0, 0, At, B0); PG8_MMA(0, 1, At, B1); PG8_BAR; PG8_SCHED;
            PG8_LDA(At, 0, 1); PG8_STAGE(PG8_SB(0, 0), b2, voffB); PG8_STAGE(PG8_SB(0, 1), b2 + hstep, voffB); PG8_STAGE(PG8_SA(0, 0), a2, voffA);
            PG8_WAIT_V(8); PG8_WAIT_L(0); PG8_BAR; PG8_MMA(1, 0, At, B0); PG8_MMA(1, 1, At, B1); PG8_BAR; PG8_SCHED;
            PG8_LDB(B0, 1, 0); PG8_LDB(B1, 1, 1); PG8_SCHED; PG8_LDA(At, 1, 0); PG8_STAGE(PG8_SA(0, 1), a2 + hstep, voffA);
            PG8_WAIT_V(8); PG8_WAIT_L(0); PG8_BAR; PG8_MMA(0, 0, At, B0); PG8_MMA(0, 1, At, B1); PG8_BAR; PG8_SCHED;
            PG8_LDA(At, 1, 1); PG8_STAGE(PG8_SB(1, 0), b3, voffB); PG8_STAGE(PG8_SB(1, 1), b3 + hstep, voffB); PG8_STAGE(PG8_SA(1, 0), a3, voffA);
            PG8_WAIT_V(8); PG8_WAIT_L(0); PG8_BAR; PG8_MMA(1, 0, At, B0); PG8_MMA(1, 1, At, B1); PG8_BAR; PG8_SCHED;
            } else {
            PG8_LDB(B0, 0, 0); PG8_SCHED; PG8_LDA(At, 0, 0); PG8_STAGE(PG8_SA(1, 1), a1 + hstep, voffA);
            PG8_WAIT_L(8); PG8_BAR; PG8_WAIT_L(0); PG8_MMA(0, 0, At, B0); PG8_BAR; PG8_SCHED;
            PG8_LDB(B1, 0, 1); PG8_STAGE(PG8_SB(0, 0), b2, voffB);
            PG8_BAR; PG8_WAIT_L(0); PG8_MMA(0, 1, At, B1); PG8_BAR;
            PG8_LDA(At, 0, 1); PG8_STAGE(PG8_SA(0, 0), a2, voffA);
            PG8_BAR; PG8_WAIT_L(0); PG8_MMA(1, 0, At, B0); PG8_BAR; PG8_SCHED;
            PG8_STAGE(PG8_SB(0, 1), b2 + hstep, voffB);
            PG8_WAIT_V(6); PG8_BAR; PG8_MMA(1, 1, At, B1); PG8_BAR;
            PG8_LDB(B0, 1, 0); PG8_SCHED; PG8_LDA(At, 1, 0); PG8_STAGE(PG8_SA(0, 1), a2 + hstep, voffA);
            PG8_WAIT_L(8); PG8_BAR; PG8_WAIT_L(0); PG8_MMA(0, 0, At, B0); PG8_BAR; PG8_SCHED;
            PG8_LDB(B1, 1, 1); PG8_STAGE(PG8_SB(1, 0), b3, voffB);
            PG8_BAR; PG8_WAIT_L(0); PG8_MMA(0, 1, At, B1); PG8_BAR;
            PG8_LDA(At, 1, 1); PG8_STAGE(PG8_SA(1, 0), a3, voffA);
            PG8_BAR; PG8_WAIT_L(0); PG8_MMA(1, 0, At, B0); PG8_BAR; PG8_SCHED;
            PG8_STAGE(PG8_SB(1, 1), b3 + hstep, voffB);
            PG8_WAIT_V(6); PG8_BAR; PG8_MMA(1, 1, At, B1); PG8_BAR;
            }
        }
        if constexpr (ALIGN_EPI) { if (wr == 0) PG8_BAR; }
        if constexpr (!Epi::AFTER_DRAIN) { E(acc, cur, wr, wc, fr, fq); S.done(cur); }
        if (!has_next) break;
#pragma unroll
        for (int a = 0; a < 2; ++a)
#pragma unroll
            for (int b = 0; b < 2; ++b)
#pragma unroll
                for (int m = 0; m < 4; ++m)
#pragma unroll
                    for (int n = 0; n < 2; ++n) acc[a][b][m][n] = (f32x4){0.f, 0.f, 0.f, 0.f};
        cur = nxt; cA = nA; cB = nB; ++ui;
        if constexpr (ALIGN_EPI) { if (wr == 1) PG8_BAR; }
    }
    PG8_WAIT_V(0);
    if constexpr (!ALIGN_EPI) { if (wr == 0) PG8_BAR; }
    PG8_BAR;
    if constexpr (Epi::AFTER_DRAIN) { E.fused(acc, cur, wr, wc, fr, fq, lds, wid, lane); S.done(cur); }
#undef PG8_SA
#undef PG8_SB
#undef PG8_STAGE
#undef PG8_LDA
#undef PG8_LDB
#undef PG8_MMA
#undef PG8_WAIT_V
#undef PG8_WAIT_L
#undef PG8_BAR
#undef PG8_SCHED
}
}

typedef unsigned short bf16;
typedef short bf16x8 __attribute__((ext_vector_type(8)));
typedef float f32x4 __attribute__((ext_vector_type(4)));
typedef float f32x2 __attribute__((ext_vector_type(2)));
typedef float f32x16 __attribute__((ext_vector_type(16)));
typedef unsigned u32x4 __attribute__((ext_vector_type(4)));
typedef unsigned u32x2 __attribute__((ext_vector_type(2)));

constexpr int DM = 2048, SEQ = 8192, MTOK = 16384, INW = 5120, RW = 1024, NH = 8, HD = 128, SW = 1024, NG = 64, NP = 64, DFF = 5632;
constexpr float EPS = 1e-6f;
constexpr size_t MiB = 1u << 20;
constexpr size_t WS_WIN = 0, WS_WGLU = 20 * MiB, WS_WOUT = 22 * MiB, WS_WGU = 30 * MiB, WS_WD = 74 * MiB, WS_ROPE = 96 * MiB, WS_S5P = 100 * MiB, WS_S5ST = 101 * MiB,
                 WS_BUFA = 102 * MiB, WS_PROJ = 166 * MiB, WS_KV = 326 * MiB, WS_XB = 390 * MiB, WS_CTL = 454 * MiB, WS_SQ1 = 455 * MiB, WS_SQ2 = 457 * MiB, WS_TOT = 458 * MiB, WS_Y1 = 466 * MiB, WS_RS0 = 498 * MiB, WS_END = 499 * MiB, WS_ACT = WS_PROJ, WS_X1B = WS_XB, WS_Y2 = WS_Y1;
constexpr size_t CTL_XID = 16384, CTL_GRP = 32768, CTL_ZERO = 131072;
constexpr size_t S5P_BBT = 0, S5P_CMT = 256 * 1024, S5P_LAM = 512 * 1024, S5P_LAML = 544 * 1024;
constexpr int LDS_BYTES = 137216, LDS_KEEP = 135168, S5_WLDS = 16896;
constexpr int NPHASE = 12;

__device__ __forceinline__ int panel_of(int c) { return 8 * (c & 7) + ((c >> 3) & 7); }

struct Params { const float* in[21]; float* out; unsigned char* ws; };

#define MFMA32(a, b, c) __builtin_amdgcn_mfma_f32_32x32x16_bf16((a), (b), (c), 0, 0, 0)
#define MFMA16(a, b, c) __builtin_amdgcn_mfma_f32_16x16x32_bf16((a), (b), (c), 0, 0, 0)
#define LDS_FENCE() asm volatile("s_waitcnt lgkmcnt(0)" ::: "memory")

__device__ __forceinline__ float bflo(unsigned w) { return __uint_as_float(w << 16); }
__device__ __forceinline__ float bfhi(unsigned w) { return __uint_as_float(w & 0xffff0000u); }
__device__ __forceinline__ unsigned pk2(float lo, float hi) { return pg8::cvt_pk_bf16(lo, hi); }
__device__ __forceinline__ float wave_sum(float v) {
#pragma unroll
    for (int o = 1; o < 64; o <<= 1) v += __shfl_xor(v, o);
    return v;
}
__device__ __forceinline__ void sincos_d(double x, double& s, double& c) {
    const double k = rint(x * 0.63661977236758134308);
    double r = fma(-k, 1.57079632679489655800e+00, x); r = fma(-k, 6.12323399573676603587e-17, r);
    const int q = ((int)(long long)k) & 3;
    const double r2 = r * r;
    const double sn = r * (1.0 + r2 * (-1.0 / 6.0 + r2 * (1.0 / 120.0 + r2 * (-1.0 / 5040.0 + r2 * (1.0 / 362880.0 + r2 * (-1.0 / 39916800.0 + r2 * (1.0 / 6227020800.0 + r2 * (-1.0 / 1307674368000.0))))))));
    const double cs = 1.0 + r2 * (-0.5 + r2 * (1.0 / 24.0 + r2 * (-1.0 / 720.0 + r2 * (1.0 / 40320.0 + r2 * (-1.0 / 3628800.0 + r2 * (1.0 / 479001600.0 + r2 * (-1.0 / 87178291200.0 + r2 * (1.0 / 20922789888000.0))))))));
    s = (q == 0) ? sn : (q == 1) ? cs : (q == 2) ? -sn : -cs;
    c = (q == 0) ? cs : (q == 1) ? -sn : (q == 2) ? -cs : sn;
}

__device__ __forceinline__ void p0_transpose_item(const float* W, int K, int N, bf16* WT, int k0, int n0, int dst_row0, float* scr, int lane, const float* kscale = nullptr) {
#pragma unroll 8
    for (int i = 0; i < 32; ++i) { const int kk = 2 * i + (lane >> 5); scr[kk * 33 + (lane & 31)] = __builtin_nontemporal_load(W + (size_t)(k0 + kk) * N + n0 + (lane & 31)); }
    const int c = lane & 7;
    f32x4 ks0 = (f32x4){1.f, 1.f, 1.f, 1.f}, ks1 = ks0;
    if (kscale) { ks0 = *(const f32x4*)(kscale + k0 + 8 * c); ks1 = *(const f32x4*)(kscale + k0 + 8 * c + 4); }
    LDS_FENCE();
#pragma unroll
    for (int j = 0; j < 4; ++j) { const int n = (lane >> 3) + 8 * j; const float* s = scr + (8 * c) * 33 + n;
        u32x4 o; o.x = pk2(s[0 * 33] * ks0.x, s[1 * 33] * ks0.y); o.y = pk2(s[2 * 33] * ks0.z, s[3 * 33] * ks0.w); o.z = pk2(s[4 * 33] * ks1.x, s[5 * 33] * ks1.y); o.w = pk2(s[6 * 33] * ks1.z, s[7 * 33] * ks1.w);
        *(u32x4*)(WT + (size_t)(dst_row0 + n) * K + k0 + 8 * c) = o; }
    LDS_FENCE();
}
__device__ __forceinline__ void rms_row_to_bf16(const float* xrow, const float* g, bf16* orow, int lane) {
    const f32x4* xr = (const f32x4*)xrow + lane; const f32x4* gr = (const f32x4*)g + lane;
    f32x4 v[8]; float s = 0.f;
#pragma unroll
    for (int j = 0; j < 8; ++j) { v[j] = xr[64 * j]; s += (v[j].x * v[j].x + v[j].y * v[j].y) + (v[j].z * v[j].z + v[j].w * v[j].w); }
    const float r = rsqrtf(wave_sum(s) * (1.f / DM) + EPS);
    u32x2* o8 = (u32x2*)orow + lane;
#pragma unroll
    for (int j = 0; j < 8; ++j) { const f32x4 gg = gr[64 * j]; u32x2 w; w.x = pk2(v[j].x * r * gg.x, v[j].y * r * gg.y); w.y = pk2(v[j].z * r * gg.z, v[j].w * r * gg.w); o8[64 * j] = w; }
}
__device__ __forceinline__ void p0_phase(const Params& P, unsigned char* lds, int tid, int lane, int wave) {
    unsigned char* ws = P.ws;
    const int gw = blockIdx.x * 8 + wave, NGW = gridDim.x * 8;
    float* scr = (float*)(lds + wave * 16384);
    constexpr int I_IN = 32 * 160;
    for (int it = gw; it < I_IN; it += NGW) { const int kb = it / 160, nb = it % 160; p0_transpose_item(P.in[2], DM, INW, (bf16*)(ws + WS_WIN), kb * 64, nb * 32, nb * 32, scr, lane, P.in[1]); }
    for (int m = gw; m < MTOK; m += NGW) {
        const f32x4* xr = (const f32x4*)(P.in[0] + (size_t)m * DM) + lane; u32x2* o8 = (u32x2*)((bf16*)(ws + WS_XB) + (size_t)m * DM) + lane;
        f32x4 v[8]; float ss = 0.f;
#pragma unroll
        for (int j = 0; j < 8; ++j) { v[j] = __builtin_nontemporal_load(xr + 64 * j); ss += (v[j].x * v[j].x + v[j].y * v[j].y) + (v[j].z * v[j].z + v[j].w * v[j].w); }
#pragma unroll
        for (int j = 0; j < 8; ++j) { u32x2 w; w.x = pk2(v[j].x, v[j].y); w.y = pk2(v[j].z, v[j].w); o8[64 * j] = w; }
        ss = wave_sum(ss);
        if (lane == 0) ((float*)(ws + WS_RS0))[m] = rsqrtf(ss * (1.f / DM) + EPS);
    }
    const int gt = blockIdx.x * 512 + tid, NGT = gridDim.x * 512;
    for (int idx = gt; idx < SEQ * 64; idx += NGT) {
        const int pos = idx >> 6, i = idx & 63;
        const double freq = exp(-(double)i * (9.210340371976184 / 64.0));
        double s, c; sincos_d((double)pos * freq, s, c);
        ((f32x2*)(ws + WS_ROPE))[idx] = (f32x2){(float)c, (float)s};
    }
    if (gt < NG * NP) {
        const int g = gt >> 6, p = gt & 63;
        const double dt = exp((double)P.in[6][g]);
        const double ar = (double)P.in[4][gt], ai = (double)P.in[5][gt];
        double sn, cs; sincos_d(ai * dt, sn, cs);
        const double mag = exp(ar * dt), lbr = mag * cs, lbi = mag * sn;
        const double d2 = ar * ar + ai * ai, nr = lbr - 1.0, ni = lbi;
        const double cr = (nr * ar + ni * ai) / d2, ci = (ni * ar - nr * ai) / d2;
        bf16* BbT = (bf16*)(ws + WS_S5P + S5P_BBT); bf16* CmT = (bf16*)(ws + WS_S5P + S5P_CMT);
        const float* bre = P.in[7] + (size_t)gt * 16; const float* bim = P.in[8] + (size_t)gt * 16;
#pragma unroll
        for (int c2 = 0; c2 < 16; c2 += 2) {
            const double br0 = bre[c2], bi0 = bim[c2], br1 = bre[c2 + 1], bi1 = bim[c2 + 1];
            *(unsigned*)(BbT + ((size_t)g * 128 + p) * 16 + c2) = pk2((float)(cr * br0 - ci * bi0), (float)(cr * br1 - ci * bi1));
            *(unsigned*)(BbT + ((size_t)g * 128 + 64 + p) * 16 + c2) = pk2((float)(cr * bi0 + ci * br0), (float)(cr * bi1 + ci * br1));
        }
        ((f32x2*)(ws + WS_S5P + S5P_LAM))[gt] = (f32x2){(float)lbr, (float)lbi};
        double sL, cL; sincos_d(ai * dt * 512.0, sL, cL); const double mL = exp(ar * dt * 512.0);
        ((f32x2*)(ws + WS_S5P + S5P_LAML))[gt] = (f32x2){(float)(mL * cL), (float)(mL * sL)};
        const int n = p & 31, blk = p >> 5;
#pragma unroll
        for (int c = 0; c < 16; ++c) {
            const float cre = P.in[9][((size_t)g * 16 + c) * 64 + p], cim = P.in[10][((size_t)g * 16 + c) * 64 + p];
            *(unsigned*)(CmT + ((size_t)g * 16 + c) * 128 + 4 * n + 2 * blk) = pk2(cre, -cim);
        }
    }
}

constexpr int RA_KT = 0, RA_VT = 16384;
constexpr int RC_QS = 0, RC_KS = 17408, RC_VT = 34816, RC_PS = 53248, RC_OS = 62464;

__device__ __forceinline__ float head_lg2(int h) { const float t[8] = {-4.5803689613e-02f, -2.2720076500e-02f, -1.1315313228e-02f, -5.6465631411e-03f, -2.8205190624e-03f, -1.4095702547e-03f, -7.0461297659e-04f, -3.5226347163e-04f}; float r = t[0];
#pragma unroll
    for (int i = 1; i < 8; ++i) r = (h == i) ? t[i] : r;
    return r; }

__device__ __forceinline__ int tsw(int r, int tok) { return r * 64 + ((((tok >> 3) ^ ((r ^ (r >> 3)) & 7)) << 3) | (tok & 7)); }
__device__ __forceinline__ int sidx(int e, int d) { return ((((e >> 5) * 8 + (d >> 4)) * 32 + (e & 31)) << 4) + (d & 15); }
__device__ __forceinline__ void rope8(const u32x4 a, const u32x4 b, const f32x2* cs, float (&o1)[8], float (&o2)[8]) {
    const unsigned aw[4] = {a.x, a.y, a.z, a.w}, bw[4] = {b.x, b.y, b.z, b.w};
#pragma unroll
    for (int j = 0; j < 4; ++j) {
        const f32x2 c0 = cs[2 * j], c1 = cs[2 * j + 1];
        const float x1a = bflo(aw[j]), x1b = bfhi(aw[j]), x2a = bflo(bw[j]), x2b = bfhi(bw[j]);
        o1[2 * j] = x1a * c0.x - x2a * c0.y; o2[2 * j] = x2a * c0.x + x1a * c0.y;
        o1[2 * j + 1] = x1b * c1.x - x2b * c1.y; o2[2 * j + 1] = x2b * c1.x + x1b * c1.y;
    }
}

__device__ __forceinline__ void ret_pass_a(const Params& P, unsigned char* lds, int tid, int lane, int wave) {
    unsigned char* ws = P.ws;
    const bf16* proj = (const bf16*)(ws + WS_PROJ); const u32x4* rope = (const u32x4*)(ws + WS_ROPE); bf16* KV = (bf16*)(ws + WS_KV);
    bf16* KT = (bf16*)(lds + RA_KT); bf16* VT = (bf16*)(lds + RA_VT);
    const int tok = tid >> 3, dg = tid & 7;
    u32x4 k1, k2, v1, v2, c0, c1, c2, c3;
#define RA_LOAD(uu) do { const int bh_ = (uu) >> 7, n_ = (uu) & 127; const size_t row_ = (size_t)(bh_ >> 3) * SEQ + n_ * 64 + tok; \
        const bf16* kp_ = proj + row_ * INW + RW + (bh_ & 7) * HD + dg * 8; const u32x4* cp_ = rope + ((size_t)(n_ * 64 + tok) * 64 + dg * 8) / 2; \
        k1 = *(const u32x4*)kp_; k2 = *(const u32x4*)(kp_ + 64); v1 = *(const u32x4*)(kp_ + RW); v2 = *(const u32x4*)(kp_ + RW + 64); c0 = cp_[0]; c1 = cp_[1]; c2 = cp_[2]; c3 = cp_[3]; } while (0)
    f32x16 R0, R1;
#pragma unroll
    for (int i = 0; i < 16; ++i) { R0[i] = 0.f; R1[i] = 0.f; }
    int u = (int)blockIdx.x * 8;
    RA_LOAD(u);
    for (int ui = 0; ui < 8; ++ui, ++u) {
        const int bh = u >> 7, h = bh & 7;
        const float lg2 = head_lg2(h);
        const f32x2 cs[8] = {(f32x2){__uint_as_float(c0.x), __uint_as_float(c0.y)}, (f32x2){__uint_as_float(c0.z), __uint_as_float(c0.w)}, (f32x2){__uint_as_float(c1.x), __uint_as_float(c1.y)}, (f32x2){__uint_as_float(c1.z), __uint_as_float(c1.w)},
                             (f32x2){__uint_as_float(c2.x), __uint_as_float(c2.y)}, (f32x2){__uint_as_float(c2.z), __uint_as_float(c2.w)}, (f32x2){__uint_as_float(c3.x), __uint_as_float(c3.y)}, (f32x2){__uint_as_float(c3.z), __uint_as_float(c3.w)}};
        float o1[8], o2[8]; rope8(k1, k2, cs, o1, o2);
        const float ksc = 0.08838834764831845f * __builtin_amdgcn_exp2f(lg2 * (float)(63 - tok));
#pragma unroll
        for (int j = 0; j < 8; ++j) { KT[tsw(dg * 8 + j, tok)] = (bf16)(pk2(o1[j] * ksc, 0.f) & 0xffffu); KT[tsw(64 + dg * 8 + j, tok)] = (bf16)(pk2(o2[j] * ksc, 0.f) & 0xffffu); }
        const unsigned vw1[4] = {v1.x, v1.y, v1.z, v1.w}, vw2[4] = {v2.x, v2.y, v2.z, v2.w};
#pragma unroll
        for (int j = 0; j < 4; ++j) {
            VT[tsw(dg * 8 + 2 * j, tok)] = (bf16)(vw1[j] & 0xffffu); VT[tsw(dg * 8 + 2 * j + 1, tok)] = (bf16)(vw1[j] >> 16);
            VT[tsw(64 + dg * 8 + 2 * j, tok)] = (bf16)(vw2[j] & 0xffffu); VT[tsw(64 + dg * 8 + 2 * j + 1, tok)] = (bf16)(vw2[j] >> 16);
        }
        if (ui < 7) RA_LOAD(u + 1);
        __syncthreads();
        const int dt = wave & 3, et0 = (wave >> 2) * 2, l31 = lane & 31, hh = lane >> 5;
        f32x16 acc0, acc1;
#pragma unroll
        for (int i = 0; i < 16; ++i) { acc0[i] = 0.f; acc1[i] = 0.f; }
#pragma unroll
        for (int ks = 0; ks < 4; ++ks) {
            const bf16x8 a = *(const bf16x8*)(KT + tsw(dt * 32 + l31, ks * 16 + 8 * hh));
            const bf16x8 b0 = *(const bf16x8*)(VT + tsw(et0 * 32 + l31, ks * 16 + 8 * hh));
            const bf16x8 b1 = *(const bf16x8*)(VT + tsw((et0 + 1) * 32 + l31, ks * 16 + 8 * hh));
            acc0 = MFMA32(a, b0, acc0); acc1 = MFMA32(a, b1, acc1);
        }
        bf16* kvu = KV + (size_t)u * 16384;
        const float cdec = __builtin_amdgcn_exp2f(lg2 * 64.f);
        if (ui > 0)
#pragma unroll
        for (int q = 0; q < 4; ++q) {
            const int d0 = dt * 32 + 8 * q + 4 * hh;
            u32x2 w0; w0.x = pk2(R0[4 * q], R0[4 * q + 1]); w0.y = pk2(R0[4 * q + 2], R0[4 * q + 3]);
            u32x2 w1; w1.x = pk2(R1[4 * q], R1[4 * q + 1]); w1.y = pk2(R1[4 * q + 2], R1[4 * q + 3]);
            *(u32x2*)(kvu + sidx(et0 * 32 + l31, d0)) = w0; *(u32x2*)(kvu + sidx((et0 + 1) * 32 + l31, d0)) = w1;
        }
#pragma unroll
        for (int i = 0; i < 16; ++i) { R0[i] = fmaf(R0[i], cdec, acc0[i]); R1[i] = fmaf(R1[i], cdec, acc1[i]); }
        if (ui == 7) {
            bf16* tot = (bf16*)(ws + WS_TOT) + (size_t)blockIdx.x * 16384;
#pragma unroll
            for (int q = 0; q < 4; ++q) {
                const int d0 = dt * 32 + 8 * q + 4 * hh;
                u32x2 w0; w0.x = pk2(R0[4 * q], R0[4 * q + 1]); w0.y = pk2(R0[4 * q + 2], R0[4 * q + 3]);
                u32x2 w1; w1.x = pk2(R1[4 * q], R1[4 * q + 1]); w1.y = pk2(R1[4 * q + 2], R1[4 * q + 3]);
                *(u32x2*)(tot + sidx(et0 * 32 + l31, d0)) = w0; *(u32x2*)(tot + sidx((et0 + 1) * 32 + l31, d0)) = w1;
            }
        }
        __syncthreads();
    }
#undef RA_LOAD
}

__device__ __forceinline__ void ret_pass_c(const Params& P, unsigned char* lds, int tid, int lane, int wave) {
    unsigned char* ws = P.ws;
    const bf16* proj = (const bf16*)(ws + WS_PROJ); const u32x4* rope = (const u32x4*)(ws + WS_ROPE); const bf16* KV = (const bf16*)(ws + WS_KV);
    bf16* mix = (bf16*)(ws + WS_BUFA);
    bf16* Qs = (bf16*)(lds + RC_QS); bf16* Ks = (bf16*)(lds + RC_KS); bf16* VT = (bf16*)(lds + RC_VT); bf16* Ps = (bf16*)(lds + RC_PS); float* Os = (float*)(lds + RC_OS);
    const int tok = tid >> 3, dg = tid & 7, l31 = lane & 31, hh = lane >> 5, l15 = lane & 15, l4 = lane >> 4;
    const int rt = wave & 1, ct = wave >> 1;
    u32x4 q1, q2, k1, k2, v1, v2, c0, c1, c2, c3;
    bf16x8 st[8];
#define RC_LOAD(uu) do { const int bh_ = (uu) >> 7, n_ = (uu) & 127; const size_t row_ = (size_t)(bh_ >> 3) * SEQ + n_ * 64 + tok; \
        const bf16* qp_ = proj + row_ * INW + (bh_ & 7) * HD + dg * 8; const u32x4* cp_ = rope + ((size_t)(n_ * 64 + tok) * 64 + dg * 8) / 2; \
        q1 = *(const u32x4*)qp_; q2 = *(const u32x4*)(qp_ + 64); k1 = *(const u32x4*)(qp_ + RW); k2 = *(const u32x4*)(qp_ + RW + 64); \
        c0 = cp_[0]; c1 = cp_[1]; c2 = cp_[2]; c3 = cp_[3]; } while (0)
#define RC_LOAD_ST(uu) do { const bf16* sp_ = KV + (size_t)(uu) * 16384 + sidx(ct * 32 + l31, 8 * hh); _Pragma("unroll") for (int ks_ = 0; ks_ < 8; ++ks_) st[ks_] = *(const bf16x8*)(sp_ + ks_ * 512); } while (0)
    const int rowb = panel_of((int)blockIdx.x) * 256 + ((int)blockIdx.x >> 6) * 64, ub = ((rowb >> 13) * 8) * 128 + ((rowb & 8191) >> 6);
    int u = ub;
    RC_LOAD(u);
    for (int hi = 0; hi < 8; ++hi, u += 128) {
        const int bh = u >> 7, n = u & 127, b = bh >> 3, h = bh & 7;
        const int un = (hi < 7) ? u + 128 : u;
        const float lg2 = head_lg2(h);
        { const bf16* cp_ = (const bf16*)(ws + WS_TOT) + ((size_t)bh * 16 + (n >> 3)) * 16384 + sidx(ct * 32 + l31, 8 * hh);
#pragma unroll
          for (int ks = 0; ks < 8; ++ks) st[ks] = *(const bf16x8*)(cp_ + ks * 512); }
        const int t3 = tid >> 3, part = tid & 7;
        const size_t row3 = (size_t)b * SEQ + n * 64 + t3;
        const bf16* gp = proj + row3 * INW + 3 * RW + h * HD + part * 16;
        { const bf16* vp_ = proj + ((size_t)b * SEQ + n * 64 + tok) * INW + 2 * RW + h * HD + dg * 8; v1 = *(const u32x4*)vp_; v2 = *(const u32x4*)(vp_ + 64); }
        u32x4 g0, g1; f32x2 sq2p;
        {
            const f32x2 cs[8] = {(f32x2){__uint_as_float(c0.x), __uint_as_float(c0.y)}, (f32x2){__uint_as_float(c0.z), __uint_as_float(c0.w)}, (f32x2){__uint_as_float(c1.x), __uint_as_float(c1.y)}, (f32x2){__uint_as_float(c1.z), __uint_as_float(c1.w)},
                                 (f32x2){__uint_as_float(c2.x), __uint_as_float(c2.y)}, (f32x2){__uint_as_float(c2.z), __uint_as_float(c2.w)}, (f32x2){__uint_as_float(c3.x), __uint_as_float(c3.y)}, (f32x2){__uint_as_float(c3.z), __uint_as_float(c3.w)}};
            float o1[8], o2[8]; u32x4 w;
            rope8(q1, q2, cs, o1, o2);
            w.x = pk2(o1[0], o1[1]); w.y = pk2(o1[2], o1[3]); w.z = pk2(o1[4], o1[5]); w.w = pk2(o1[6], o1[7]); *(u32x4*)(Qs + tok * 136 + dg * 8) = w;
            w.x = pk2(o2[0], o2[1]); w.y = pk2(o2[2], o2[3]); w.z = pk2(o2[4], o2[5]); w.w = pk2(o2[6], o2[7]); *(u32x4*)(Qs + tok * 136 + 64 + dg * 8) = w;
            rope8(k1, k2, cs, o1, o2);
            w.x = pk2(o1[0], o1[1]); w.y = pk2(o1[2], o1[3]); w.z = pk2(o1[4], o1[5]); w.w = pk2(o1[6], o1[7]); *(u32x4*)(Ks + tok * 136 + dg * 8) = w;
            w.x = pk2(o2[0], o2[1]); w.y = pk2(o2[2], o2[3]); w.z = pk2(o2[4], o2[5]); w.w = pk2(o2[6], o2[7]); *(u32x4*)(Ks + tok * 136 + 64 + dg * 8) = w;
            const unsigned vw1[4] = {v1.x, v1.y, v1.z, v1.w}, vw2[4] = {v2.x, v2.y, v2.z, v2.w};
#pragma unroll
            for (int j = 0; j < 4; ++j) {
                VT[tsw(dg * 8 + 2 * j, tok)] = (bf16)(vw1[j] & 0xffffu); VT[tsw(dg * 8 + 2 * j + 1, tok)] = (bf16)(vw1[j] >> 16);
                VT[tsw(64 + dg * 8 + 2 * j, tok)] = (bf16)(vw2[j] & 0xffffu); VT[tsw(64 + dg * 8 + 2 * j + 1, tok)] = (bf16)(vw2[j] >> 16);
            }
        }
        RC_LOAD(un);
        __syncthreads();
#pragma unroll
        for (int tt = 0; tt < 2; ++tt) {
            const int T = wave * 2 + tt, kt = T & 3, qt = T >> 2;
            f32x4 acc = (f32x4){0.f, 0.f, 0.f, 0.f};
#pragma unroll
            for (int ks = 0; ks < 4; ++ks) {
                const bf16x8 a = *(const bf16x8*)(Ks + (kt * 16 + l15) * 136 + ks * 32 + 8 * l4);
                const bf16x8 bq = *(const bf16x8*)(Qs + (qt * 16 + l15) * 136 + ks * 32 + 8 * l4);
                acc = MFMA16(a, bq, acc);
            }
            const int q = qt * 16 + l15, key0 = kt * 16 + 4 * l4;
            float v[4];
#pragma unroll
            for (int r = 0; r < 4; ++r) { const int dist = q - (key0 + r); v[r] = acc[r] * 0.08838834764831845f * __builtin_amdgcn_exp2f(lg2 * (float)(dist < 0 ? -dist : dist)); }
            u32x2 w; w.x = pk2(v[0], v[1]); w.y = pk2(v[2], v[3]);
            *(u32x2*)(Ps + q * 72 + key0) = w;
        }
        asm volatile("" ::: "memory");
        f32x16 acc;
#pragma unroll
        for (int i = 0; i < 16; ++i) acc[i] = 0.f;
#pragma unroll
        for (int ks = 0; ks < 8; ++ks) { const bf16x8 a = *(const bf16x8*)(Qs + (rt * 32 + l31) * 136 + ks * 16 + 8 * hh); acc = MFMA32(a, st[ks], acc); }
        { const float dj = __builtin_amdgcn_exp2f(lg2 * (float)(64 * (n & 7)));
#pragma unroll
          for (int i = 0; i < 16; ++i) acc[i] *= dj; }
        if (n & 7) RC_LOAD_ST(u);
        __syncthreads();
        {
            if (n & 7) {
#pragma unroll
            for (int ks = 0; ks < 8; ++ks) { const bf16x8 a = *(const bf16x8*)(Qs + (rt * 32 + l31) * 136 + ks * 16 + 8 * hh); acc = MFMA32(a, st[ks], acc); }
            }
#pragma unroll
            for (int i = 0; i < 16; ++i) { const int c = rt * 32 + 8 * (i >> 2) + 4 * hh + (i & 3); acc[i] *= __builtin_amdgcn_exp2f(lg2 * (float)(c + 1)); }
#pragma unroll
            for (int ks = 0; ks < 4; ++ks) {
                const bf16x8 a = *(const bf16x8*)(Ps + (rt * 32 + l31) * 72 + ks * 16 + 8 * hh);
                const bf16x8 bv = *(const bf16x8*)(VT + tsw(ct * 32 + l31, ks * 16 + 8 * hh));
                acc = MFMA32(a, bv, acc);
            }
            g0 = *(const u32x4*)gp; g1 = *(const u32x4*)(gp + 8); sq2p = *(const f32x2*)((const float*)(ws + WS_SQ2) + row3 * 16 + part * 2);
#pragma unroll
            for (int i = 0; i < 16; ++i) { const int c = rt * 32 + 8 * (i >> 2) + 4 * hh + (i & 3); Os[c * 132 + ct * 32 + l31] = acc[i]; }
        }
        __syncthreads();
        {
            const f32x4* op = (const f32x4*)(Os + t3 * 132 + part * 16);
            f32x4 x[4]; float s = 0.f;
#pragma unroll
            for (int j = 0; j < 4; ++j) { x[j] = op[j]; s += (x[j].x + x[j].y) + (x[j].z + x[j].w); }
            s += __shfl_xor(s, 1); s += __shfl_xor(s, 2); s += __shfl_xor(s, 4);
            const float mu = s * (1.f / 128.f); float q2s = 0.f;
#pragma unroll
            for (int j = 0; j < 4; ++j) { x[j] = x[j] - mu; q2s += (x[j].x * x[j].x + x[j].y * x[j].y) + (x[j].z * x[j].z + x[j].w * x[j].w); }
            q2s += __shfl_xor(q2s, 1); q2s += __shfl_xor(q2s, 2); q2s += __shfl_xor(q2s, 4);
            float sq2 = sq2p.x + sq2p.y; sq2 += __shfl_xor(sq2, 1); sq2 += __shfl_xor(sq2, 2); sq2 += __shfl_xor(sq2, 4);
            const float rstd = rsqrtf(q2s * (1.f / 128.f) + EPS) * sqrtf(sq2 * (1.f / SW) + EPS);
            const unsigned gw[8] = {g0.x, g0.y, g0.z, g0.w, g1.x, g1.y, g1.z, g1.w};
            const f32x4* gn = (const f32x4*)(P.in[3] + h * HD + part * 16);
            unsigned ow[8];
#pragma unroll
            for (int j = 0; j < 4; ++j) {
                const f32x4 gg = gn[j];
                const float ga = bflo(gw[2 * j]), gb = bfhi(gw[2 * j]), gc = bflo(gw[2 * j + 1]), gd = bfhi(gw[2 * j + 1]);
                const float ya = ga * pg8::sigmoid_f(ga) * (x[j].x * rstd * gg.x), yb = gb * pg8::sigmoid_f(gb) * (x[j].y * rstd * gg.y);
                const float yc = gc * pg8::sigmoid_f(gc) * (x[j].z * rstd * gg.z), yd = gd * pg8::sigmoid_f(gd) * (x[j].w * rstd * gg.w);
                ow[2 * j] = pk2(ya, yb); ow[2 * j + 1] = pk2(yc, yd);
            }
            bf16* mp = mix + row3 * DM + h * HD + part * 16;
            *(u32x4*)mp = (u32x4){ow[0], ow[1], ow[2], ow[3]}; *(u32x4*)(mp + 8) = (u32x4){ow[4], ow[5], ow[6], ow[7]};
        }
    }
    __syncthreads();
#undef RC_LOAD
#undef RC_LOAD_ST
}

struct ConvItem { const float* W; bf16* WT; const float* ks; int K, N, k0, n0, dst0; };
constexpr int CONV_ITEMS = 16 * 32 + 32 * 64 + 2 * 32 * 176 + 88 * 64;
__device__ __forceinline__ bool conv_decode(const Params& P, int id, ConvItem& c) {
    unsigned char* ws = P.ws;
    constexpr int I_GLU = 16 * 32, I_OUT = 32 * 64, I_GATE = 32 * 176, I_DOWN = 88 * 64;
    int r = id, kb, nb; c.ks = nullptr;
    if (r < 0 || r >= CONV_ITEMS) return false;
    if (r < I_GLU) { c.W = P.in[12]; c.WT = (bf16*)(ws + WS_WGLU); c.K = SW; c.N = SW; kb = r / 32; nb = r % 32; c.dst0 = nb * 32; }
    else if ((r -= I_GLU) < I_OUT) { c.W = P.in[15]; c.WT = (bf16*)(ws + WS_WOUT); c.K = DM; c.N = DM; kb = r / 64; nb = r % 64; c.dst0 = nb * 32; }
    else if ((r -= I_OUT) < I_GATE) { c.W = P.in[17]; c.WT = (bf16*)(ws + WS_WGU); c.K = DM; c.N = DFF; kb = r / 176; nb = r % 176; c.dst0 = ((nb * 32) >> 7) * 256 + ((nb * 32) & 127); c.ks = P.in[16]; }
    else if ((r -= I_GATE) < I_GATE) { c.W = P.in[18]; c.WT = (bf16*)(ws + WS_WGU); c.K = DM; c.N = DFF; kb = r / 176; nb = r % 176; c.dst0 = ((nb * 32) >> 7) * 256 + 128 + ((nb * 32) & 127); c.ks = P.in[16]; }
    else { r -= I_GATE; c.W = P.in[19]; c.WT = (bf16*)(ws + WS_WD); c.K = DFF; c.N = DM; kb = r / 64; nb = r % 64; c.dst0 = nb * 32; }
    c.k0 = kb * 64; c.n0 = nb * 32; return true;
}
__device__ __forceinline__ void conv_issue(const ConvItem& c, unsigned char* scr, int lane) {
    const int kr = lane >> 3, p = lane & 7;
    const float* src = c.W + (size_t)(c.k0 + kr) * c.N + c.n0;
#pragma unroll
    for (int i = 0; i < 8; ++i) { const int sc = p ^ ((kr ^ i) & 7);
        __builtin_amdgcn_global_load_lds((const unsigned*)(src + (size_t)(8 * i) * c.N + 4 * sc), (PG8_LAS unsigned*)(scr + i * 1024), 16, 0, 2); }
}
__device__ __forceinline__ void conv_consume(const ConvItem& c, const unsigned char* scr, int lane) {
    asm volatile("s_waitcnt vmcnt(0)" ::: "memory");
    const int cc = lane & 7;
    f32x4 ks0 = (f32x4){1.f, 1.f, 1.f, 1.f}, ks1 = ks0;
    if (c.ks) { ks0 = *(const f32x4*)(c.ks + c.k0 + 8 * cc); ks1 = *(const f32x4*)(c.ks + c.k0 + 8 * cc + 4); }
#pragma unroll
    for (int j = 0; j < 4; ++j) { const int n = (lane >> 3) + 8 * j; float v[8];
#pragma unroll
        for (int t = 0; t < 8; ++t) v[t] = *(const float*)(scr + (8 * cc + t) * 128 + (((n >> 2) ^ ((t ^ cc) & 7)) * 16) + (n & 3) * 4);
        u32x4 o; o.x = pk2(v[0] * ks0.x, v[1] * ks0.y); o.y = pk2(v[2] * ks0.z, v[3] * ks0.w); o.z = pk2(v[4] * ks1.x, v[5] * ks1.y); o.w = pk2(v[6] * ks1.z, v[7] * ks1.w);
        *(u32x4*)(c.WT + (size_t)(c.dst0 + n) * c.K + c.k0 + 8 * cc) = o; }
    LDS_FENCE();
}

#define CMUL_ADD(or_, oi_, ar_, ai_, br_, bi_, cr_, ci_) do { const float _r = fmaf((ar_), (br_), fmaf(-(ai_), (bi_), (cr_))); const float _i = fmaf((ar_), (bi_), fmaf((ai_), (br_), (ci_))); (or_) = _r; (oi_) = _i; } while (0)
template <bool FULL>
__device__ __forceinline__ void s5_wave(const Params& P, unsigned char* wlds, int b, int g, int ch, int lane, int gw) {
    unsigned char* ws = P.ws;
    const bf16* proj = (const bf16*)(ws + WS_PROJ);
    const bf16* BbT = (const bf16*)(ws + WS_S5P + S5P_BBT); const bf16* CmT = (const bf16*)(ws + WS_S5P + S5P_CMT);
    const f32x2* lamp = (const f32x2*)(ws + WS_S5P + S5P_LAM);
    f32x2* ST = (f32x2*)(ws + WS_S5ST);
    const int n = lane & 31, hh = lane >> 5, l15 = lane & 15, l4 = lane >> 4;
    bf16x8 Bb[4];
#pragma unroll
    for (int v = 0; v < 4; ++v) Bb[v] = *(const bf16x8*)(BbT + ((size_t)g * 128 + (v & 1) * 64 + (v >> 1) * 32 + n) * 16 + 8 * hh);
    float lr[2][4], li[2][4];
#pragma unroll
    for (int k = 0; k < 2; ++k) {
        const f32x2 l1 = lamp[g * 64 + k * 32 + n]; lr[k][0] = l1.x; li[k][0] = l1.y;
#pragma unroll
        for (int e = 1; e < 4; ++e) { lr[k][e] = lr[k][e - 1] * l1.x - li[k][e - 1] * l1.y; li[k][e] = lr[k][e - 1] * l1.y + li[k][e - 1] * l1.x; }
    }
    float car[2], cai[2];
    const size_t stbase = (((size_t)b * 16 + ch) * 64 + g) * 64;
    car[0] = cai[0] = car[1] = cai[1] = 0.f;
    if (FULL) {
        const f32x2* lamL = (const f32x2*)(ws + WS_S5P + S5P_LAML);
        const f32x2 L0 = lamL[g * 64 + n], L1 = lamL[g * 64 + 32 + n];
        for (int c = 0; c < ch; ++c) { const size_t eb = (((size_t)b * 16 + c) * 64 + g) * 64; const f32x2 e0 = ST[eb + n], e1 = ST[eb + 32 + n];
            CMUL_ADD(car[0], cai[0], L0.x, L0.y, car[0], cai[0], e0.x, e0.y); CMUL_ADD(car[1], cai[1], L1.x, L1.y, car[1], cai[1], e1.x, e1.y); }
    }
    bf16x8 Cm[4];
    f32x4 dsk = (f32x4){0.f, 0.f, 0.f, 0.f};
    if (FULL) {
#pragma unroll
        for (int ks = 0; ks < 4; ++ks) Cm[ks] = *(const bf16x8*)(CmT + ((size_t)g * 16 + l15) * 128 + ks * 32 + 8 * l4);
        dsk = *(const f32x4*)(P.in[11] + g * 16 + 4 * l4);
    }
    bf16* y1 = (bf16*)(ws + WS_Y1);
    for (int sb = 0; sb < 16; ++sb) {
        const size_t row0 = (size_t)b * SEQ + ch * 512 + sb * 32;
        const bf16x8 U = *(const bf16x8*)(proj + (row0 + n) * INW + 4 * RW + g * 16 + 8 * hh);
        f32x16 bu[4];
#pragma unroll
        for (int v = 0; v < 4; ++v) {
#pragma unroll
            for (int i = 0; i < 16; ++i) bu[v][i] = 0.f;
            bu[v] = MFMA32(U, Bb[v], bu[v]);
        }
        ConvItem cvi; bool cvok = false;
        if (FULL && sb < 10) { cvok = conv_decode(P, sb * 2048 + gw, cvi); if (cvok) conv_issue(cvi, wlds + 8704, lane); }
        float er[2][4], ei[2][4];
#pragma unroll
        for (int k = 0; k < 2; ++k)
#pragma unroll
            for (int q = 0; q < 4; ++q) {
                float sr = bu[2 * k][4 * q], si = bu[2 * k + 1][4 * q];
#pragma unroll
                for (int j = 1; j < 4; ++j) { CMUL_ADD(sr, si, lr[k][0], li[k][0], sr, si, bu[2 * k][4 * q + j], bu[2 * k + 1][4 * q + j]); bu[2 * k][4 * q + j] = sr; bu[2 * k + 1][4 * q + j] = si; }
                er[k][q] = sr; ei[k][q] = si;
            }
        float mr[2][4], mi[2][4];
#pragma unroll
        for (int k = 0; k < 2; ++k) {
            float cr = car[k], ci = cai[k];
#pragma unroll
            for (int q = 0; q < 4; ++q) {
                const float pr = __shfl_xor(er[k][q], 32), pi = __shfl_xor(ei[k][q], 32);
                const float ear = hh ? pr : er[k][q], eai = hh ? pi : ei[k][q];
                const float ebr = hh ? er[k][q] : pr, ebi = hh ? ei[k][q] : pi;
                float c1r, c1i, c2r, c2i;
                CMUL_ADD(c1r, c1i, lr[k][3], li[k][3], cr, ci, ear, eai);
                CMUL_ADD(c2r, c2i, lr[k][3], li[k][3], c1r, c1i, ebr, ebi);
                mr[k][q] = hh ? c1r : cr; mi[k][q] = hh ? c1i : ci;
                cr = c2r; ci = c2i;
            }
            car[k] = cr; cai[k] = ci;
        }
        if (FULL) {
#pragma unroll
            for (int q = 0; q < 4; ++q)
#pragma unroll
                for (int j = 0; j < 4; ++j) {
                    float s0r, s0i, s1r, s1i;
                    CMUL_ADD(s0r, s0i, lr[0][j], li[0][j], mr[0][q], mi[0][q], bu[0][4 * q + j], bu[1][4 * q + j]);
                    CMUL_ADD(s1r, s1i, lr[1][j], li[1][j], mr[1][q], mi[1][q], bu[2][4 * q + j], bu[3][4 * q + j]);
                    u32x2 w; w.x = pk2(s0r, s0i); w.y = pk2(s1r, s1i);
                    *(u32x2*)(wlds + (8 * q + 4 * hh + j) * 272 + n * 8) = w;
                }
            LDS_FENCE();
            f32x4 yt[2];
#pragma unroll
            for (int tt = 0; tt < 2; ++tt) {
                yt[tt] = (f32x4){0.f, 0.f, 0.f, 0.f};
#pragma unroll
                for (int ks = 0; ks < 4; ++ks) { const bf16x8 sv = *(const bf16x8*)(wlds + (tt * 16 + l15) * 272 + (ks * 32 + 8 * l4) * 2); yt[tt] = MFMA16(Cm[ks], sv, yt[tt]); }
            }
            LDS_FENCE();
#pragma unroll
            for (int tt = 0; tt < 2; ++tt) {
                const size_t row = row0 + tt * 16 + l15;
                const u32x2 uw = *(const u32x2*)(proj + row * INW + 4 * RW + g * 16 + 4 * l4);
                const float uu[4] = {bflo(uw.x), bfhi(uw.x), bflo(uw.y), bfhi(uw.y)};
                float o[4];
#pragma unroll
                for (int r = 0; r < 4; ++r) { const float y = yt[tt][r] + dsk[r] * uu[r]; const float z = 1.5957691216057308f * (y + 0.044715f * y * y * y); o[r] = y * pg8::sigmoid_f(z); }
                u32x2 w; w.x = pk2(o[0], o[1]); w.y = pk2(o[2], o[3]);
                *(u32x2*)(y1 + row * SW + g * 16 + 4 * l4) = w;
            }
            if (cvok) conv_consume(cvi, wlds + 8704, lane);
        }
    }
    if (!FULL) { if (hh == 0) { ST[stbase + n] = (f32x2){car[0], cai[0]}; ST[stbase + 32 + n] = (f32x2){car[1], cai[1]}; } }
}

__device__ __forceinline__ void scan_phase(const Params& P, int tid) {
    unsigned char* ws = P.ws;
    const int gt = blockIdx.x * 512 + tid, NGT = gridDim.x * 512;
    for (int e = gt; e < 16 * 8192; e += NGT) {
        const int bh = e >> 13, off = (e & 8191) * 2, h = bh & 7;
        const float dec = __builtin_amdgcn_exp2f(head_lg2(h) * 512.f);
        unsigned* p = (unsigned*)((bf16*)(ws + WS_TOT) + (size_t)bh * 16 * 16384 + off);
        unsigned kv[16];
#pragma unroll
        for (int j = 0; j < 16; ++j) kv[j] = p[(size_t)j * 8192];
        float s0 = 0.f, s1 = 0.f;
#pragma unroll
        for (int j = 0; j < 16; ++j) { p[(size_t)j * 8192] = pk2(s0, s1); s0 = fmaf(s0, dec, bflo(kv[j])); s1 = fmaf(s1, dec, bfhi(kv[j])); }
    }
}

__device__ __forceinline__ void ssm_norm_phase(const Params& P, int lane, int wave) {
    unsigned char* ws = P.ws; const bf16* y2 = (const bf16*)(ws + WS_Y2); bf16* mix = (bf16*)(ws + WS_BUFA);
    const int gw = blockIdx.x * 8 + wave, NGW = gridDim.x * 8;
    for (int m = gw; m < MTOK; m += NGW) {
        const u32x4 a = *(const u32x4*)(y2 + (size_t)m * SW + lane * 8), c = *(const u32x4*)(y2 + (size_t)m * SW + 512 + lane * 8);
        const unsigned w[8] = {a.x, a.y, a.z, a.w, c.x, c.y, c.z, c.w};
        float v[16]; float s = 0.f;
#pragma unroll
        for (int j = 0; j < 8; ++j) { v[2 * j] = bflo(w[j]); v[2 * j + 1] = bfhi(w[j]); s += v[2 * j] * v[2 * j] + v[2 * j + 1] * v[2 * j + 1]; }
        const float r = rsqrtf(wave_sum(s) * (1.f / SW) + EPS);
        const f32x4* g0 = (const f32x4*)(P.in[14] + lane * 8); const f32x4* g1 = (const f32x4*)(P.in[14] + 512 + lane * 8);
        const f32x4 ga = g0[0], gb = g0[1], gc = g1[0], gd = g1[1];
        u32x4 o0, o1;
        o0.x = pk2(v[0] * r * ga.x, v[1] * r * ga.y); o0.y = pk2(v[2] * r * ga.z, v[3] * r * ga.w); o0.z = pk2(v[4] * r * gb.x, v[5] * r * gb.y); o0.w = pk2(v[6] * r * gb.z, v[7] * r * gb.w);
        o1.x = pk2(v[8] * r * gc.x, v[9] * r * gc.y); o1.y = pk2(v[10] * r * gc.z, v[11] * r * gc.w); o1.z = pk2(v[12] * r * gd.x, v[13] * r * gd.y); o1.w = pk2(v[14] * r * gd.z, v[15] * r * gd.w);
        *(u32x4*)(mix + (size_t)m * DM + RW + lane * 8) = o0; *(u32x4*)(mix + (size_t)m * DM + RW + 512 + lane * 8) = o1;
    }
}
__device__ __forceinline__ void final_norm_phase(const Params& P, int lane, int wave) {
    const bf16* x2 = (const bf16*)(P.ws + WS_BUFA);
    const int mb = panel_of((int)blockIdx.x) * 256 + ((int)blockIdx.x >> 6) * 64 + wave * 8;
    for (int m = mb; m < mb + 8; ++m) {
        const bf16* xr = x2 + (size_t)m * DM + lane * 8;
        u32x4 w[4]; float s = 0.f;
#pragma unroll
        for (int j = 0; j < 4; ++j) w[j] = *(const u32x4*)(xr + 512 * j);
        float v[4][8];
#pragma unroll
        for (int j = 0; j < 4; ++j) { const unsigned ww[4] = {w[j].x, w[j].y, w[j].z, w[j].w};
#pragma unroll
            for (int k = 0; k < 4; ++k) { v[j][2 * k] = bflo(ww[k]); v[j][2 * k + 1] = bfhi(ww[k]); s += v[j][2 * k] * v[j][2 * k] + v[j][2 * k + 1] * v[j][2 * k + 1]; } }
        const float r = rsqrtf(wave_sum(s) * (1.f / DM) + EPS);
        float* orow = P.out + (size_t)m * DM + lane * 8; const float* gr = P.in[20] + lane * 8;
#pragma unroll
        for (int j = 0; j < 4; ++j) { const f32x4 g0 = *(const f32x4*)(gr + 512 * j), g1 = *(const f32x4*)(gr + 512 * j + 4);
            __builtin_nontemporal_store((f32x4){v[j][0] * r * g0.x, v[j][1] * r * g0.y, v[j][2] * r * g0.z, v[j][3] * r * g0.w}, (f32x4*)(orow + 512 * j));
            __builtin_nontemporal_store((f32x4){v[j][4] * r * g1.x, v[j][5] * r * g1.y, v[j][6] * r * g1.z, v[j][7] * r * g1.w}, (f32x4*)(orow + 512 * j + 4)); }
    }
}

#define LAS __attribute__((address_space(3)))
#define XB_TMO      128
#define XB_XCNT(j)  (256  + 64 * (j))
#define XB_XSUB(j)  (1280 + 64 * (j))
#define XB_XGEN(j)  (2304 + 64 * (j))
#define XB_TOP      3328
#define XB_TOPGEN   3392
#define XCD_BAR_WORDS 3456
#define XB_SPIN_CAP (1u << 18)

__device__ __forceinline__ unsigned xb_ld(unsigned* p)              { return __hip_atomic_load(p, __ATOMIC_RELAXED, __HIP_MEMORY_SCOPE_AGENT); }
__device__ __forceinline__ unsigned xb_add(unsigned* p, unsigned v) { return __hip_atomic_fetch_add(p, v, __ATOMIC_RELAXED, __HIP_MEMORY_SCOPE_AGENT); }
__device__ __forceinline__ unsigned xb_xcc_id() { return (unsigned)__builtin_amdgcn_s_getreg((3 << 11) | 20) & 0xFu; }
#define XB_SPIN(cond, bar) do { unsigned _sp = 0; while (cond) { __builtin_amdgcn_s_sleep(1); \
    if ((++_sp & 255u) == 0u) { if (xb_ld(&(bar)[XB_TMO])) break; if (_sp > XB_SPIN_CAP) { atomicAdd(&(bar)[XB_TMO], 1u); break; } } } } while (0)

struct XcdBarrier {
    unsigned* bar; unsigned x;
    volatile LAS unsigned* st;
};

__device__ __forceinline__ XcdBarrier xcd_barrier_post(unsigned* bar, volatile LAS unsigned* st) {
    XcdBarrier b; b.bar = bar; b.x = xb_xcc_id(); b.st = st;
    if (threadIdx.x == 0) (void)xb_add(&bar[XB_XCNT(b.x)], 1u);
    return b;
}
__device__ __forceinline__ void xcd_barrier_complete(unsigned* bar, unsigned x, unsigned& nloc, unsigned& nx) {
    const unsigned G = gridDim.x * gridDim.y * gridDim.z;
    unsigned sum, cnt, mine, sp = 0u;
    for (;;) {
        sum = 0u; cnt = 0u; mine = 0u;
#pragma unroll
        for (unsigned j = 0; j < 16; ++j) { const unsigned c = xb_ld(&bar[XB_XCNT(j)]); sum += c; cnt += (c > 0u) ? 1u : 0u; mine = (j == x) ? c : mine; }
        if (sum == G) break;
        __builtin_amdgcn_s_sleep(1);
        if ((++sp & 255u) == 0u) { if (xb_ld(&bar[XB_TMO])) break; if (sp > XB_SPIN_CAP) { atomicAdd(&bar[XB_TMO], 1u); break; } }
    }
    nloc = mine > 0u ? mine : 1u; nx = cnt > 0u ? cnt : 1u;
}

__device__ __forceinline__ void xcd_barrier(const XcdBarrier& b) {
    asm volatile("s_waitcnt vmcnt(0)" ::: "memory");
    __syncthreads();
    if (threadIdx.x == 0) {
        unsigned* bar = b.bar;
        __builtin_amdgcn_s_waitcnt(0);
        unsigned nloc = b.st[0], nx = b.st[1];
        if (nloc == 0u) { xcd_barrier_complete(bar, b.x, nloc, nx); b.st[0] = nloc; b.st[1] = nx; }
        const unsigned old = xb_add(&bar[XB_XSUB(b.x)], 1u);
        const unsigned gen = old / nloc;
        if (old + 1u == (gen + 1u) * nloc) {
            __builtin_amdgcn_fence(__ATOMIC_RELEASE, "agent");
            asm volatile("s_waitcnt vmcnt(0)" ::: "memory");
            const unsigned og = xb_add(&bar[XB_TOP], 1u);
            const unsigned tg = og / nx;
            if (og + 1u == (tg + 1u) * nx) xb_add(&bar[XB_TOPGEN], 1u);
            else XB_SPIN(xb_ld(&bar[XB_TOPGEN]) == tg, bar);
            __builtin_amdgcn_fence(__ATOMIC_ACQUIRE, "agent");
            xb_add(&bar[XB_XGEN(b.x)], 1u);
            asm volatile("s_waitcnt vmcnt(0)" ::: "memory");
        } else {
            XB_SPIN(xb_ld(&bar[XB_XGEN(b.x)]) == gen, bar);
            __builtin_amdgcn_fence(__ATOMIC_ACQUIRE, "agent");
            asm volatile("s_waitcnt vmcnt(0)" ::: "memory");
        }
    }
    __syncthreads();
}

__device__ __forceinline__ void group_barrier(unsigned* ctl, int seam, int pm, bool samex) {
    asm volatile("s_waitcnt vmcnt(0)" ::: "memory");
    __syncthreads();
    if (threadIdx.x == 0) {
        unsigned* cnt = ctl + (CTL_GRP / 4) + (seam * 64 + pm) * 64;
        if (!samex) { __builtin_amdgcn_fence(__ATOMIC_RELEASE, "agent"); asm volatile("s_waitcnt vmcnt(0)" ::: "memory"); }
        xb_add(cnt, 1u);
        unsigned sp = 0u;
        while (xb_ld(cnt) < 4u) { __builtin_amdgcn_s_sleep(1); if (++sp > (1u << 22)) break; }
        __builtin_amdgcn_fence(__ATOMIC_ACQUIRE, "agent");
        asm volatile("s_waitcnt vmcnt(0)" ::: "memory");
    }
    __syncthreads();
}
template <int PH>
__device__ __forceinline__ void run_phase(const Params& P, unsigned char* lds, int tid, int lane, int wave) {
    unsigned char* ws = P.ws;
    PG8_LAS unsigned char* glds = (PG8_LAS unsigned char*)lds;
    if constexpr (PH == 0) p0_phase(P, lds, tid, lane, wave);
    if constexpr (PH == 1) {
        pg8::Gemm g{(const bf16*)(ws + WS_XB), (const bf16*)(ws + WS_WIN), MTOK, INW, DM}; pg8::StaticOrder S; S.init(MTOK, INW, gridDim.x, blockIdx.x);
        pg8::EpiStoreBf16 E{(bf16*)(ws + WS_PROJ), INW, (const float*)(ws + WS_RS0)};
        pg8::gemm_phase<pg8::EpiStoreBf16, pg8::StaticOrder, true, true>(glds, g, S, E);
    }
    if constexpr (PH == 2) {
        ret_pass_a(P, lds, tid, lane, wave);
        { const int id = blockIdx.x * 8 + wave; if (id < 2048) s5_wave<false>(P, lds + wave * S5_WLDS, id >> 10, id & 63, (id >> 6) & 15, lane, id); }
    }
    if constexpr (PH == 3) {
        scan_phase(P, tid);
        const int id = blockIdx.x * 8 + wave; if (id < 2048) s5_wave<true>(P, lds + wave * S5_WLDS, id >> 10, id & 63, (id >> 6) & 15, lane, id);
    }
    if constexpr (PH == 5) {
        pg8::Gemm g{(const bf16*)(ws + WS_Y1), (const bf16*)(ws + WS_WGLU), MTOK, SW, SW}; pg8::StaticOrder S; S.init(MTOK, SW, gridDim.x, blockIdx.x);
        pg8::EpiGlu E{(const bf16*)(ws + WS_Y1), P.in[13], P.in[14], (bf16*)(ws + WS_BUFA) + RW, (float*)(ws + WS_SQ2), SW, DM};
        pg8::gemm_phase<pg8::EpiGlu, pg8::StaticOrder, false, true>(glds, g, S, E);
    }
    if constexpr (PH == 6) ret_pass_c(P, lds, tid, lane, wave);
    if constexpr (PH == 7) {
        pg8::Gemm g{(const bf16*)(ws + WS_BUFA), (const bf16*)(ws + WS_WOUT), MTOK, DM, DM}; pg8::StaticOrder S; S.init(MTOK, DM, gridDim.x, blockIdx.x);
        pg8::EpiResB E{nullptr, (const bf16*)(ws + WS_XB), (bf16*)(ws + WS_X1B), DM, (const float*)(ws + WS_SQ2), 1.f / SW, (float*)(ws + WS_SQ1)};
        pg8::gemm_phase<pg8::EpiResB, pg8::StaticOrder, false, true>(glds, g, S, E);
    }
    if constexpr (PH == 9) {
        pg8::Gemm g{(const bf16*)(ws + WS_X1B), (const bf16*)(ws + WS_WGU), MTOK, 2 * DFF, DM}; pg8::StaticOrder S; S.init(MTOK, 2 * DFF, gridDim.x, blockIdx.x);
        pg8::Unit u0; int pm0 = -1; if (S.next(0, u0)) pm0 = u0.pm;
        float* rsl = (float*)(lds + LDS_KEEP + 64);
        if (pm0 >= 0 && tid < 256) { const f32x4* pp = (const f32x4*)((const float*)(ws + WS_SQ1) + (size_t)(pm0 * 256 + tid) * 32); float t = 0.f;
#pragma unroll
            for (int j = 0; j < 8; ++j) { const f32x4 p4 = pp[j]; t += (p4[0] + p4[1]) + (p4[2] + p4[3]); }
            rsl[tid] = rsqrtf(t * (1.f / DM) + EPS); }
        __syncthreads();
        pg8::EpiSwiGlu E{(bf16*)(ws + WS_ACT), DFF, (const float*)(ws + WS_SQ1), 1.f / DM, rsl, pm0};
        pg8::gemm_phase<pg8::EpiSwiGlu, pg8::StaticOrder, true, true>(glds, g, S, E);
    }
    if constexpr (PH == 10) {
        pg8::Gemm g{(const bf16*)(ws + WS_ACT), (const bf16*)(ws + WS_WD), MTOK, DM, DFF}; pg8::StaticOrder S; S.init(MTOK, DM, gridDim.x, blockIdx.x);
        pg8::EpiResB E{nullptr, (const bf16*)(ws + WS_X1B), (bf16*)(ws + WS_BUFA), DM, nullptr, 0.f, nullptr};
        pg8::gemm_phase<pg8::EpiResB, pg8::StaticOrder, false, true>(glds, g, S, E);
    }
    if constexpr (PH == 11) final_norm_phase(P, lane, wave);
}
#define R(k) { int t_ = threadIdx.x; asm volatile("" : "+v"(t_)); run_phase<k>(P, lds, t_, t_ & 63, __builtin_amdgcn_readfirstlane(t_ >> 6)); }
#define BST ((volatile LAS unsigned*)((LAS unsigned char*)lds + LDS_KEEP))
#define S { XcdBarrier b_; b_.bar = (unsigned*)(P.ws + WS_CTL); b_.x = xb_xcc_id(); b_.st = BST; xcd_barrier(b_); }
#define G(k) group_barrier((unsigned*)(P.ws + WS_CTL), k, panel_of((int)blockIdx.x), BST[2] != 0u);
#define PHASE_PROGRAM R(0) S R(1) S R(2) S R(3) S GROUP_CHECK R(5) G(0) R(6) S R(7) G(1) R(9) G(2) R(10) G(3) R(11)
__global__ void __launch_bounds__(512, 2) hybrid_fwd(Params P) {
    extern __shared__ __attribute__((aligned(16))) unsigned char lds[];
    cg::grid_group grid = cg::this_grid();
    const int tid = threadIdx.x, lane = tid & 63, wave = __builtin_amdgcn_readfirstlane(tid >> 6);
    if (P.ws == nullptr) grid.sync();
    if (tid < 3) BST[tid] = 0u;
    __syncthreads();
    { XcdBarrier bar = xcd_barrier_post((unsigned*)(P.ws + WS_CTL), BST); (void)bar; }
    if (tid == 0) __hip_atomic_store((unsigned*)(P.ws + WS_CTL + CTL_XID) + blockIdx.x, xb_xcc_id() + 1u, __ATOMIC_RELAXED, __HIP_MEMORY_SCOPE_AGENT);
#define GROUP_CHECK { unsigned ok_ = 1u; const unsigned* xid_ = (const unsigned*)(P.ws + WS_CTL + CTL_XID); _Pragma("unroll") for (int k_ = 0; k_ < 4; ++k_) ok_ &= (xb_ld((unsigned*)xid_ + ((blockIdx.x & 63) + 64 * k_)) == xb_xcc_id() + 1u) ? 1u : 0u; if (threadIdx.x == 0) BST[2] = ok_; __syncthreads(); }
    PHASE_PROGRAM
}
#undef R
#undef S

extern "C" void kernel_launch(void* const* d_in, const int* in_sizes, int n_in, void* d_out, int out_size, void* d_ws, size_t ws_size, hipStream_t stream) {
    static int grid = 0;
    if (grid == 0) {
        if (n_in != 21 || out_size != MTOK * DM || ws_size < WS_END) { fprintf(stderr, "kernel_launch: unexpected shapes (n_in %d out %d ws %zu)\n", n_in, out_size, ws_size); grid = -1; return; }
        int dev = 0, cus = 0, per_cu = 0;
        (void)hipGetDevice(&dev); (void)hipDeviceGetAttribute(&cus, hipDeviceAttributeMultiprocessorCount, dev);
        if (hipFuncSetAttribute((const void*)hybrid_fwd, hipFuncAttributeMaxDynamicSharedMemorySize, LDS_BYTES) != hipSuccess) { fprintf(stderr, "kernel_launch: hipFuncSetAttribute failed\n"); grid = -1; return; }
        if (hipOccupancyMaxActiveBlocksPerMultiprocessor(&per_cu, (const void*)hybrid_fwd, 512, LDS_BYTES) != hipSuccess || per_cu < 1) { fprintf(stderr, "kernel_launch: occupancy query says %d\n", per_cu); per_cu = 1; }
        (void)hipGetLastError();
        grid = cus * 1;
        if (grid != 256) { fprintf(stderr, "kernel_launch: built for a 256-CU device (got %d)\n", cus); grid = -1; return; }
    }
    if (grid < 0) return;
    Params p{};
    for (int i = 0; i < 21; ++i) p.in[i] = (const float*)d_in[i];
    p.out = (float*)d_out; p.ws = (unsigned char*)d_ws;
    if (hipMemsetAsync((unsigned char*)d_ws + WS_CTL, 0, CTL_ZERO, stream) != hipSuccess) { fprintf(stderr, "kernel_launch: memset of the barrier words failed\n"); return; }
    void* args[] = {&p};
    hipError_t e = hipLaunchCooperativeKernel((const void*)hybrid_fwd, dim3(grid), dim3(512), args, LDS_BYTES, stream);
    if (e != hipSuccess) fprintf(stderr, "cooperative launch failed: %s (grid %d)\n", hipGetErrorString(e), grid);
}
```

```cpp
#include <hip/hip_runtime.h>
#include <hip/hip_cooperative_groups.h>
#include <cstdio>
#include <cstdint>
namespace cg = cooperative_groups;
namespace pg8 {
#define PG8_LAS __attribute__((address_space(3)))
typedef unsigned short bf16_t;
typedef short bf16x8 __attribute__((ext_vector_type(8)));
typedef float f32x4 __attribute__((ext_vector_type(4)));
typedef unsigned u32x4 __attribute__((ext_vector_type(4)));
constexpr int BM = 256, BK = 64, HALF = 128, HTB = HALF * BK * 2  , STAGE_BYTES = 8 * HTB, NXCD = 8, WGM = 8;

__host__ __device__ __forceinline__ int lds_byte(int r, int c) { const int st = (r >> 4) * 2 + (c >> 5), rr = r & 15, cc = c & 31, ob = rr * 64 + cc * 2; return st * 1024 + (ob ^ (((ob >> 9) & 1) << 5)); }
__host__ __device__ __forceinline__ void stage_rc(int b, int& R, int& C) { const int st = b / 1024, sb = b % 1024, swz = sb ^ (((sb >> 9) & 1) << 5); R = (st >> 1) * 16 + swz / 64; C = (st & 1) * 32 + (swz % 64) / 2; }
__host__ __device__ __forceinline__ int perm32(int rho) { const int n = rho >> 4, i = rho & 15; return 8 * (i >> 2) + 4 * n + (i & 3); }

struct Unit { int pm, pn; };
struct Gemm { const bf16_t* A; const bf16_t* Bt; int M, N, K; };

struct StaticOrder {
    int nM, nN, nwg, G, c;
    __host__ __device__ void init(int M, int N, int G_, int c_) { nM = M / BM; nN = N / BM; nwg = nM * nN; G = G_; c = c_; }
    __host__ __device__ bool next(int i, Unit& u) const {
        const long L = (long)i * G + c; if (L >= nwg) return false;
        int wgid = (int)L; { const int q = nwg / NXCD, r = nwg % NXCD, xcd = wgid % NXCD, off = wgid / NXCD; wgid = (xcd < r ? xcd * (q + 1) : r * (q + 1) + (xcd - r) * q) + off; }
        const int nig = WGM * nN, gid = wgid / nig, fm = gid * WGM, gsz = (nM - fm) < WGM ? (nM - fm) : WGM;
        u.pm = fm + ((wgid % nig) % gsz); u.pn = (wgid % nig) / gsz; return true;
    }
    __device__ __forceinline__ void a_ready(const Unit&) const {}
    __device__ __forceinline__ void done(const Unit&) const {}
};

typedef __bf16 bf16x2_t __attribute__((ext_vector_type(2)));
__device__ __forceinline__ unsigned cvt_pk_bf16(float lo, float hi) { bf16x2_t v = {(__bf16)lo, (__bf16)hi}; return __builtin_bit_cast(unsigned, v); }
__device__ __forceinline__ float bf_lo(unsigned w) { return __uint_as_float(w << 16); }
__device__ __forceinline__ float bf_hi(unsigned w) { return __uint_as_float(w & 0xffff0000u); }
typedef unsigned u32x2v __attribute__((ext_vector_type(2)));
__device__ __forceinline__ float sigmoid_f(float z) { return __builtin_amdgcn_rcpf(1.0f + __expf(-z)); }

struct EpiStoreBf16 {
    static constexpr bool PERM = true, AFTER_DRAIN = false;
    bf16_t* O; int ldc; const float* rs;
    __device__ __forceinline__ void operator()(const f32x4 (&acc)[2][2][4][2], const Unit& u, int wr, int wc, int fr, int fq) const {
        const int row0 = u.pm * BM + wr * 64 + fr, col0 = u.pn * BM + wc * 32 + 8 * fq;
        float rv[2][4];
#pragma unroll
        for (int ai = 0; ai < 2; ++ai)
#pragma unroll
            for (int m = 0; m < 4; ++m) rv[ai][m] = rs[row0 + ai * HALF + m * 16];
#pragma unroll
        for (int ai = 0; ai < 2; ++ai)
#pragma unroll
            for (int m = 0; m < 4; ++m) { bf16_t* rowp = O + (size_t)(row0 + ai * HALF + m * 16) * ldc + col0;
#pragma unroll
                for (int bj = 0; bj < 2; ++bj) { const f32x4 v0 = acc[ai][bj][m][0] * rv[ai][m], v1 = acc[ai][bj][m][1] * rv[ai][m];
                    u32x4 w; w.x = cvt_pk_bf16(v0[0], v0[1]); w.y = cvt_pk_bf16(v0[2], v0[3]); w.z = cvt_pk_bf16(v1[0], v1[1]); w.w = cvt_pk_bf16(v1[2], v1[3]);
                    *(u32x4*)(rowp + bj * HALF) = w; } }
    }
};
struct EpiGlu {
    static constexpr bool PERM = true, AFTER_DRAIN = false;
    const bf16_t* Y1; const float* bias; const float* gain; bf16_t* Y2; float* rowsq; int ldc, ldo;
    __device__ __forceinline__ void operator()(const f32x4 (&acc)[2][2][4][2], const Unit& u, int wr, int wc, int fr, int fq) const {
        const int row0 = u.pm * BM + wr * 64 + fr, col0 = u.pn * BM + wc * 32 + 8 * fq;
        f32x4 bv[2][2], gv[2][2];
#pragma unroll
        for (int bj = 0; bj < 2; ++bj)
#pragma unroll
            for (int n = 0; n < 2; ++n) { bv[bj][n] = *(const f32x4*)(bias + col0 + bj * HALF + 4 * n); gv[bj][n] = *(const f32x4*)(gain + col0 + bj * HALF + 4 * n); }
#pragma unroll
        for (int ai = 0; ai < 2; ++ai) {
            u32x4 yv[4][2];
#pragma unroll
            for (int m = 0; m < 4; ++m)
#pragma unroll
                for (int bj = 0; bj < 2; ++bj) yv[m][bj] = *(const u32x4*)(Y1 + (size_t)(row0 + ai * HALF + m * 16) * ldc + col0 + bj * HALF);
#pragma unroll
            for (int m = 0; m < 4; ++m) { const int row = row0 + ai * HALF + m * 16; const size_t offo = (size_t)row * ldo + col0;
                float ss = 0.f;
#pragma unroll
                for (int bj = 0; bj < 2; ++bj) { const f32x4 z0 = acc[ai][bj][m][0] + bv[bj][0], z1 = acc[ai][bj][m][1] + bv[bj][1];
                    const u32x4 y = yv[m][bj];
                    f32x4 r0, r1;
                    r0[0] = bf_lo(y.x) * sigmoid_f(z0[0]); r0[1] = bf_hi(y.x) * sigmoid_f(z0[1]); r0[2] = bf_lo(y.y) * sigmoid_f(z0[2]); r0[3] = bf_hi(y.y) * sigmoid_f(z0[3]);
                    r1[0] = bf_lo(y.z) * sigmoid_f(z1[0]); r1[1] = bf_hi(y.z) * sigmoid_f(z1[1]); r1[2] = bf_lo(y.w) * sigmoid_f(z1[2]); r1[3] = bf_hi(y.w) * sigmoid_f(z1[3]);
                    ss += (r0[0] * r0[0] + r0[1] * r0[1]) + (r0[2] * r0[2] + r0[3] * r0[3]) + (r1[0] * r1[0] + r1[1] * r1[1]) + (r1[2] * r1[2] + r1[3] * r1[3]);
                    r0 = r0 * gv[bj][0]; r1 = r1 * gv[bj][1];
                    u32x4 w; w.x = cvt_pk_bf16(r0[0], r0[1]); w.y = cvt_pk_bf16(r0[2], r0[3]); w.z = cvt_pk_bf16(r1[0], r1[1]); w.w = cvt_pk_bf16(r1[2], r1[3]);
                    *(u32x4*)(Y2 + offo + bj * HALF) = w; }
                ss += __shfl_xor(ss, 16); ss += __shfl_xor(ss, 32);
                if (fq == 0) rowsq[(size_t)row * 16 + u.pn * 4 + wc] = ss; }
        }
    }
};
struct EpiResF32 {
    static constexpr bool PERM = false, AFTER_DRAIN = false;
    const float* X; float* O; int ldc; const float* insq; float inv_indim; bf16_t* OB; float* outsq;
    __device__ __forceinline__ void operator()(const f32x4 (&acc)[2][2][4][2], const Unit& u, int wr, int wc, int fr, int fq) const {
        const int row0 = u.pm * BM + wr * 64 + fr, col0 = u.pn * BM + wc * 32 + 4 * fq;
#pragma unroll
        for (int ai = 0; ai < 2; ++ai)
#pragma unroll
        for (int mh = 0; mh < 2; ++mh) {
            f32x4 xv[2][2][2]; f32x4 p4[2];
#pragma unroll
            for (int mm = 0; mm < 2; ++mm) { const int row = row0 + ai * HALF + (2 * mh + mm) * 16; const size_t off = (size_t)row * ldc + col0;
                p4[mm] = insq ? *(const f32x4*)(insq + (size_t)row * 16 + 4 * fq) : (f32x4){0.f, 0.f, 0.f, 0.f};
#pragma unroll
                for (int bj = 0; bj < 2; ++bj)
#pragma unroll
                    for (int n = 0; n < 2; ++n) xv[mm][bj][n] = *(const f32x4*)(X + off + bj * HALF + n * 16); }
#pragma unroll
            for (int mm = 0; mm < 2; ++mm) { const int m = 2 * mh + mm; const int row = row0 + ai * HALF + m * 16; const size_t off = (size_t)row * ldc + col0;
                float sc = 1.0f;
                if (insq) { float t = (p4[mm][0] + p4[mm][1]) + (p4[mm][2] + p4[mm][3]); t += __shfl_xor(t, 16); t += __shfl_xor(t, 32); sc = rsqrtf(t * inv_indim + 1e-6f); }
                float ss = 0.f;
#pragma unroll
                for (int bj = 0; bj < 2; ++bj)
#pragma unroll
                    for (int n = 0; n < 2; ++n) { const f32x4 o = xv[mm][bj][n] + acc[ai][bj][m][n] * sc;
                        *(f32x4*)(O + off + bj * HALF + n * 16) = o;
                        if (OB) { ss += (o[0] * o[0] + o[1] * o[1]) + (o[2] * o[2] + o[3] * o[3]); u32x2v w; w.x = cvt_pk_bf16(o[0], o[1]); w.y = cvt_pk_bf16(o[2], o[3]); *(u32x2v*)(OB + off + bj * HALF + n * 16) = w; } }
                if (OB) { ss += __shfl_xor(ss, 16); ss += __shfl_xor(ss, 32); if (fq == 0) outsq[(size_t)row * 32 + u.pn * 4 + wc] = ss; } }
        }
    }
};
struct EpiResB {
    static constexpr bool PERM = true, AFTER_DRAIN = false;
    const float* X; const bf16_t* XB; bf16_t* OB; int ldc; const float* insq; float inv_indim; float* outsq;
    __device__ __forceinline__ void operator()(const f32x4 (&acc)[2][2][4][2], const Unit& u, int wr, int wc, int fr, int fq) const {
        const int row0 = u.pm * BM + wr * 64 + fr, col0 = u.pn * BM + wc * 32 + 8 * fq;
#pragma unroll
        for (int ai = 0; ai < 2; ++ai)
#pragma unroll
        for (int mh = 0; mh < 2; ++mh) {
            f32x4 xv[2][2][2]; f32x4 p4[2];
#pragma unroll
            for (int mm = 0; mm < 2; ++mm) { const int row = row0 + ai * HALF + (2 * mh + mm) * 16; const size_t off = (size_t)row * ldc + col0;
                p4[mm] = insq ? *(const f32x4*)(insq + (size_t)row * 16 + 4 * fq) : (f32x4){0.f, 0.f, 0.f, 0.f};
#pragma unroll
                for (int bj = 0; bj < 2; ++bj) {
                    if (XB) { const u32x4 y = *(const u32x4*)(XB + off + bj * HALF); xv[mm][bj][0] = (f32x4){bf_lo(y.x), bf_hi(y.x), bf_lo(y.y), bf_hi(y.y)}; xv[mm][bj][1] = (f32x4){bf_lo(y.z), bf_hi(y.z), bf_lo(y.w), bf_hi(y.w)}; }
                    else { xv[mm][bj][0] = *(const f32x4*)(X + off + bj * HALF); xv[mm][bj][1] = *(const f32x4*)(X + off + bj * HALF + 4); } } }
#pragma unroll
            for (int mm = 0; mm < 2; ++mm) { const int m = 2 * mh + mm; const int row = row0 + ai * HALF + m * 16; const size_t off = (size_t)row * ldc + col0;
                float sc = 1.0f;
                if (insq) { float t = (p4[mm][0] + p4[mm][1]) + (p4[mm][2] + p4[mm][3]); t += __shfl_xor(t, 16); t += __shfl_xor(t, 32); sc = rsqrtf(t * inv_indim + 1e-6f); }
                float ss = 0.f;
#pragma unroll
                for (int bj = 0; bj < 2; ++bj) { const f32x4 o0 = xv[mm][bj][0] + acc[ai][bj][m][0] * sc, o1 = xv[mm][bj][1] + acc[ai][bj][m][1] * sc;
                    ss += ((o0[0] * o0[0] + o0[1] * o0[1]) + (o0[2] * o0[2] + o0[3] * o0[3])) + ((o1[0] * o1[0] + o1[1] * o1[1]) + (o1[2] * o1[2] + o1[3] * o1[3]));
                    u32x4 w; w.x = cvt_pk_bf16(o0[0], o0[1]); w.y = cvt_pk_bf16(o0[2], o0[3]); w.z = cvt_pk_bf16(o1[0], o1[1]); w.w = cvt_pk_bf16(o1[2], o1[3]);
                    *(u32x4*)(OB + off + bj * HALF) = w; }
                if (outsq) { ss += __shfl_xor(ss, 16); ss += __shfl_xor(ss, 32); if (fq == 0) outsq[(size_t)row * 32 + u.pn * 4 + wc] = ss; } }
        }
    }
};
struct EpiSwiGlu {
    static constexpr bool PERM = true, AFTER_DRAIN = false;
    bf16_t* O; int ldc; const float* insq; float inv_indim; const float* rs_lds; int pm_lds;
    __device__ __forceinline__ void operator()(const f32x4 (&acc)[2][2][4][2], const Unit& u, int wr, int wc, int fr, int fq) const {
        const int row0 = u.pm * BM + wr * 64 + fr, col0 = u.pn * HALF + wc * 32 + 8 * fq;
        float scv[2][4];
        if (u.pm == pm_lds) {
#pragma unroll
          for (int ai = 0; ai < 2; ++ai)
#pragma unroll
              for (int m = 0; m < 4; ++m) scv[ai][m] = rs_lds[wr * 64 + fr + ai * HALF + m * 16];
        } else { f32x4 pa[2][4], pb[2][4];
#pragma unroll
          for (int ai = 0; ai < 2; ++ai)
#pragma unroll
              for (int m = 0; m < 4; ++m) { const float* pp = insq + (size_t)(row0 + ai * HALF + m * 16) * 32 + 8 * fq; pa[ai][m] = *(const f32x4*)pp; pb[ai][m] = *(const f32x4*)(pp + 4); }
#pragma unroll
          for (int ai = 0; ai < 2; ++ai)
#pragma unroll
              for (int m = 0; m < 4; ++m) { float t = ((pa[ai][m][0] + pa[ai][m][1]) + (pa[ai][m][2] + pa[ai][m][3])) + ((pb[ai][m][0] + pb[ai][m][1]) + (pb[ai][m][2] + pb[ai][m][3]));
                  t += __shfl_xor(t, 16); t += __shfl_xor(t, 32); scv[ai][m] = rsqrtf(t * inv_indim + 1e-6f); } }
#pragma unroll
        for (int ai = 0; ai < 2; ++ai)
#pragma unroll
            for (int m = 0; m < 4; ++m) { const int row = row0 + ai * HALF + m * 16; bf16_t* rowp = O + (size_t)row * ldc + col0;
                const float sc = scv[ai][m];
                f32x4 r0, r1;
#pragma unroll
                for (int j = 0; j < 4; ++j) { const float g0 = acc[ai][0][m][0][j] * sc, g1 = acc[ai][0][m][1][j] * sc;
                    r0[j] = g0 * sigmoid_f(g0) * (acc[ai][1][m][0][j] * sc); r1[j] = g1 * sigmoid_f(g1) * (acc[ai][1][m][1][j] * sc); }
                u32x4 w; w.x = cvt_pk_bf16(r0[0], r0[1]); w.y = cvt_pk_bf16(r0[2], r0[3]); w.z = cvt_pk_bf16(r1[0], r1[1]); w.w = cvt_pk_bf16(r1[2], r1[3]);
                *(u32x4*)rowp = w; }
    }
};


template <class Epi, class Sched, bool ALIGN_EPI = false, bool SP2 = false>
__device__ __forceinline__ void gemm_phase(PG8_LAS unsigned char* lds, const Gemm g, const Sched& S, const Epi& E) {
    int tid_ = threadIdx.x; asm volatile("" : "+v"(tid_));
    const int tid = tid_, wid = __builtin_amdgcn_readfirstlane(tid >> 6), lane = tid & 63, wr = wid >> 2, wc = wid & 3, fr = lane & 15, fq = lane >> 4;
    const int K = g.K, nt = K / BK;
    unsigned voffA[2], voffB[2];
#pragma unroll
    for (int i = 0; i < 2; ++i) { int R, C; stage_rc(tid * 16 + i * 8192, R, C); const int Rb = Epi::PERM ? ((R & ~31) + perm32(R & 31)) : R;
        voffA[i] = (unsigned)(R * K + C) * 2u; voffB[i] = (unsigned)(Rb * K + C) * 2u; }
    const size_t kstep = (size_t)(BK * 2);
    const size_t hstep = (size_t)HALF * K * 2;
    const size_t tstep = 2 * hstep;
    const unsigned ldsw = (unsigned)wid * 1024u;
    const int aoff = lds_byte(wr * 64 + fr, fq * 8), boff = lds_byte(wc * 32 + fr, fq * 8);
#define PG8_SA(b, h) (((b) * 2 + (h)) * HTB)
#define PG8_SB(b, h) ((4 + (b) * 2 + (h)) * HTB)
#define PG8_STAGE(bufoff, gbase, voff) do { _Pragma("unroll") for (int _i = 0; _i < 2; ++_i) \
        __builtin_amdgcn_global_load_lds((const unsigned*)((const char*)(gbase) + (voff)[_i]), (PG8_LAS unsigned*)(lds + (bufoff) + ldsw + _i * 8192), 16, 0, 0); } while (0)
#define PG8_LDA(dst, b, h) do { _Pragma("unroll") for (int m = 0; m < 4; ++m) _Pragma("unroll") for (int k = 0; k < 2; ++k) dst[m][k] = *(const PG8_LAS bf16x8*)(lds + PG8_SA(b, h) + aoff + m * 2048 + k * 1024); } while (0)
#define PG8_LDB(dst, b, h) do { _Pragma("unroll") for (int n = 0; n < 2; ++n) _Pragma("unroll") for (int k = 0; k < 2; ++k) dst[n][k] = *(const PG8_LAS bf16x8*)(lds + PG8_SB(b, h) + boff + n * 2048 + k * 1024); } while (0)
#define PG8_MMA(ai, bj, At, Bt) do { __builtin_amdgcn_s_setprio(1); _Pragma("unroll") for (int m = 0; m < 4; ++m) _Pragma("unroll") for (int n = 0; n < 2; ++n) _Pragma("unroll") for (int k = 0; k < 2; ++k) \
        acc[ai][bj][m][n] = __builtin_amdgcn_mfma_f32_16x16x32_bf16(Bt[n][k], At[m][k], acc[ai][bj][m][n], 0, 0, 0); __builtin_amdgcn_s_setprio(0); } while (0)
#define PG8_WAIT_V(n) asm volatile("s_waitcnt vmcnt(" #n ")" ::: "memory")
#define PG8_WAIT_L(n) asm volatile("s_waitcnt lgkmcnt(" #n ")" ::: "memory")
#define PG8_BAR __builtin_amdgcn_s_barrier()
#define PG8_SCHED __builtin_amdgcn_sched_barrier(0)
    Unit cur, nxt; int ui = 0;
    if (!S.next(0, cur)) return;
    f32x4 acc[2][2][4][2];
#pragma unroll
    for (int a = 0; a < 2; ++a)
#pragma unroll
        for (int b = 0; b < 2; ++b)
#pragma unroll
            for (int m = 0; m < 4; ++m)
#pragma unroll
                for (int n = 0; n < 2; ++n) acc[a][b][m][n] = (f32x4){0.f, 0.f, 0.f, 0.f};
    bf16x8 At[4][2], B0[2][2], B1[2][2];
    const char* cA = (const char*)g.A + (size_t)cur.pm * tstep; const char* cB = (const char*)g.Bt + (size_t)cur.pn * tstep;
    S.a_ready(cur);
    if constexpr (SP2) {
        PG8_STAGE(PG8_SB(0, 0), cB, voffB); PG8_STAGE(PG8_SB(0, 1), cB + hstep, voffB); PG8_STAGE(PG8_SA(0, 0), cA, voffA); PG8_STAGE(PG8_SA(0, 1), cA + hstep, voffA);
        if (wr == 1) PG8_BAR;
        PG8_WAIT_V(2); PG8_BAR;
        PG8_STAGE(PG8_SB(1, 0), cB + kstep, voffB); PG8_STAGE(PG8_SA(1, 0), cA + kstep, voffA); PG8_STAGE(PG8_SB(1, 1), cB + hstep + kstep, voffB);
        PG8_WAIT_V(6); PG8_BAR;
    } else {
        PG8_STAGE(PG8_SB(0, 0), cB, voffB); PG8_STAGE(PG8_SA(0, 0), cA, voffA); PG8_STAGE(PG8_SB(0, 1), cB + hstep, voffB); PG8_STAGE(PG8_SA(0, 1), cA + hstep, voffA);
        if (wr == 1) PG8_BAR;
        PG8_WAIT_V(4); PG8_BAR;
        PG8_STAGE(PG8_SB(1, 0), cB + kstep, voffB); PG8_STAGE(PG8_SA(1, 0), cA + kstep, voffA); PG8_STAGE(PG8_SB(1, 1), cB + hstep + kstep, voffB);
        PG8_WAIT_V(6); PG8_BAR;
    }
    for (;;) {
        const bool has_next = S.next(ui + 1, nxt);
        const char* nA = has_next ? (const char*)g.A + (size_t)nxt.pm * tstep : cA; const char* nB = has_next ? (const char*)g.Bt + (size_t)nxt.pn * tstep : cB;
        for (int t = 0; t < nt; t += 2) {
            const bool last = (t == nt - 2);
            const char* a1 = cA + (size_t)(t + 1) * kstep;
            const char* a2 = last ? nA : cA + (size_t)(t + 2) * kstep; const char* b2 = last ? nB : cB + (size_t)(t + 2) * kstep;
            const char* a3 = a2 + kstep; const char* b3 = b2 + kstep;
            if (last && has_next) S.a_ready(nxt);
            if constexpr (SP2) {
            PG8_LDB(B0, 0, 0); PG8_LDB(B1, 0, 1); PG8_SCHED; PG8_LDA(At, 0, 0); PG8_STAGE(PG8_SA(1, 1), a1 + hstep, voffA);
            PG8_WAIT_V(8); PG8_WAIT_L(0); PG8_BAR; PG8_MMA(0, 0, At, B0); PG8_MMA(0, 1, At, B1); PG8_BAR; PG8_SCHED;
            PG8_LDA(At, 0, 1); PG8_STAGE(PG8_SB(0, 0), b2, voffB); PG8_STAGE(PG8_SB(0, 1), b2 + hstep, voffB); PG8_STAGE(PG8_SA(0, 0), a2, voffA);
            PG8_WAIT_V(8); PG8_WAIT_L(0); PG8_BAR; PG8_MMA(1, 0, At, B0); PG8_MMA(1, 1, At, B1); PG8_BAR; PG8_SCHED;
            PG8_LDB(B0, 1, 0); PG8_LDB(B1, 1, 1); PG8_SCHED; PG8_LDA(At, 1, 0); PG8_STAGE(PG8_SA(0, 1), a2 + hstep, voffA);
            PG8_WAIT_V(8); PG8_WAIT_L(0); PG8_BAR; PG8_MMA(0, 0, At, B0); PG8_MMA(0, 1, At, B1); PG8_BAR; PG8_SCHED;
            PG8_LDA(At, 1, 1); PG8_STAGE(PG8_SB(1, 0), b3, voffB); PG8_STAGE(PG8_SB(1, 1), b3 + hstep, voffB); PG8_STAGE(PG8_SA(1, 0), a3, voffA);
            PG8_WAIT_V(8); PG8_WAIT_L(0); PG8_BAR; PG8_MMA(1, 0, At, B0); PG8_MMA(1, 1, At, B1); PG8_BAR; PG8_SCHED;
            } else {
            PG8_LDB(B0, 0, 0); PG8_SCHED; PG8_LDA(At, 0, 0); PG8_STAGE(PG8_SA(1, 1), a1 + hstep, voffA);
            PG8_WAIT_L(8); PG8_BAR; PG8_WAIT_L(0); PG8_MMA(0, 0, At, B0); PG8_BAR; PG8_SCHED;
            PG8_LDB(B1, 0, 1); PG8_STAGE(PG8_SB(0, 0), b2, voffB);
            PG8_BAR; PG8_WAIT_L(0); PG8_MMA(0, 1, At, B1); PG8_BAR;
            PG8_LDA(At, 0, 1); PG8_STAGE(PG8_SA(0, 0), a2, voffA);
            PG8_BAR; PG8_WAIT_L(0); PG8_MMA(1, 0, At, B0); PG8_BAR; PG8_SCHED;
            PG8_STAGE(PG8_SB(0, 1), b2 + hstep, voffB);
            PG8_WAIT_V(6); PG8_BAR; PG8_MMA(1, 1, At, B1); PG8_BAR;
            PG8_LDB(B0, 1, 0); PG8_SCHED; PG8_LDA(At, 1, 0); PG8_STAGE(PG8_SA(0, 1), a2 + hstep, voffA);
            PG8_WAIT_L(8); PG8_BAR; PG8_WAIT_L(0); PG8_MMA(0, 0, At, B0); PG8_BAR; PG8_SCHED;
            PG8_LDB(B1, 1, 1); PG8_STAGE(PG8_SB(1, 0), b3, voffB);
            PG8_BAR; PG8_WAIT_L(0); PG8_MMA(0, 1, At, B1); PG8_BAR;
            PG8_LDA(At, 1, 1); PG8_STAGE(PG8_SA(1, 0), a3, voffA);
            PG8_BAR; PG8_WAIT_L(0); PG8_MMA(1, 0, At, B0); PG8_BAR; PG8_SCHED;
            PG8_STAGE(PG8_SB(1, 1), b3 + hstep, voffB);
            PG8_WAIT_V(6); PG8_BAR; PG8_MMA(1, 1, At, B1); PG8_BAR;
            }
        }
        if constexpr (ALIGN_EPI) { if (wr == 0) PG8_BAR; }
        if constexpr (!Epi::AFTER_DRAIN) { E(acc, cur, wr, wc, fr, fq); S.done(cur); }
        if (!has_next) break;
#pragma unroll
        for (int a = 0; a < 2; ++a)
#pragma unroll
            for (int b = 0; b < 2; ++b)
#pragma unroll
                for (int m = 0; m < 4; ++m)
#pragma unroll
                    for (int n = 0; n < 2; ++n) acc[a][b][m][n] = (f32x4){0.f, 0.f, 0.f, 0.f};
        cur = nxt; cA = nA; cB = nB; ++ui;
        if constexpr (ALIGN_EPI) { if (wr == 1) PG8_BAR; }
    }
    PG8_WAIT_V(0);
    if constexpr (!ALIGN_EPI) { if (wr == 0) PG8_BAR; }
    PG8_BAR;
    if constexpr (Epi::AFTER_DRAIN) { E.fused(acc, cur, wr, wc, fr, fq, lds, wid, lane); S.done(cur); }
#undef PG8_SA
#undef PG8_SB
#undef PG8_STAGE
#undef PG8_LDA
#undef PG8_LDB
#undef PG8_MMA
#undef PG8_WAIT_V
#undef PG8_WAIT_L
#undef PG8_BAR
#undef PG8_SCHED
}
}

typedef unsigned short bf16;
typedef short bf16x8 __attribute__((ext_vector_type(8)));
typedef float f32x4 __attribute__((ext_vector_type(4)));
typedef float f32x2 __attribute__((ext_vector_type(2)));
typedef float f32x16 __attribute__((ext_vector_type(16)));
typedef unsigned u32x4 __attribute__((ext_vector_type(4)));
typedef unsigned u32x2 __attribute__((ext_vector_type(2)));

constexpr int DM = 2048, SEQ = 8192, MTOK = 16384, INW = 5120, RW = 1024, NH = 8, HD = 128, SW = 1024, NG = 64, NP = 64, DFF = 5632;
constexpr float EPS = 1e-6f;
constexpr size_t MiB = 1u << 20;
constexpr size_t WS_WIN = 0, WS_WGLU = 20 * MiB, WS_WOUT = 22 * MiB, WS_WGU = 30 * MiB, WS_WD = 74 * MiB, WS_ROPE = 96 * MiB, WS_S5P = 100 * MiB, WS_S5ST = 101 * MiB,
                 WS_BUFA = 102 * MiB, WS_PROJ = 166 * MiB, WS_KV = 326 * MiB, WS_XB = 390 * MiB, WS_CTL = 454 * MiB, WS_SQ1 = 455 * MiB, WS_SQ2 = 457 * MiB, WS_TOT = 458 * MiB, WS_Y1 = 466 * MiB, WS_RS0 = 498 * MiB, WS_END = 499 * MiB, WS_ACT = WS_PROJ, WS_X1B = WS_XB, WS_Y2 = WS_Y1;
constexpr size_t CTL_XID = 16384, CTL_GRP = 32768, CTL_ZERO = 131072;
constexpr size_t S5P_BBT = 0, S5P_CMT = 256 * 1024, S5P_LAM = 512 * 1024, S5P_LAML = 544 * 1024;
constexpr int LDS_BYTES = 137216, LDS_KEEP = 135168, S5_WLDS = 16896;
constexpr int NPHASE = 12;

__device__ __forceinline__ int panel_of(int c) { return 8 * (c & 7) + ((c >> 3) & 7); }

struct Params { const float* in[21]; float* out; unsigned char* ws; };

#define MFMA32(a, b, c) __builtin_amdgcn_mfma_f32_32x32x16_bf16((a), (b), (c), 0, 0, 0)
#define MFMA16(a, b, c) __builtin_amdgcn_mfma_f32_16x16x32_bf16((a), (b), (c), 0, 0, 0)
#define LDS_FENCE() asm volatile("s_waitcnt lgkmcnt(0)" ::: "memory")

__device__ __forceinline__ float bflo(unsigned w) { return __uint_as_float(w << 16); }
__device__ __forceinline__ float bfhi(unsigned w) { return __uint_as_float(w & 0xffff0000u); }
__device__ __forceinline__ unsigned pk2(float lo, float hi) { return pg8::cvt_pk_bf16(lo, hi); }
__device__ __forceinline__ float wave_sum(float v) {
#pragma unroll
    for (int o = 1; o < 64; o <<= 1) v += __shfl_xor(v, o);
    return v;
}
__device__ __forceinline__ void sincos_d(double x, double& s, double& c) {
    const double k = rint(x * 0.63661977236758134308);
    double r = fma(-k, 1.57079632679489655800e+00, x); r = fma(-k, 6.12323399573676603587e-17, r);
    const int q = ((int)(long long)k) & 3;
    const double r2 = r * r;
    const double sn = r * (1.0 + r2 * (-1.0 / 6.0 + r2 * (1.0 / 120.0 + r2 * (-1.0 / 5040.0 + r2 * (1.0 / 362880.0 + r2 * (-1.0 / 39916800.0 + r2 * (1.0 / 6227020800.0 + r2 * (-1.0 / 1307674368000.0))))))));
    const double cs = 1.0 + r2 * (-0.5 + r2 * (1.0 / 24.0 + r2 * (-1.0 / 720.0 + r2 * (1.0 / 40320.0 + r2 * (-1.0 / 3628800.0 + r2 * (1.0 / 479001600.0 + r2 * (-1.0 / 87178291200.0 + r2 * (1.0 / 20922789888000.0))))))));
    s = (q == 0) ? sn : (q == 1) ? cs : (q == 2) ? -sn : -cs;
    c = (q == 0) ? cs : (q == 1) ? -sn : (q == 2) ? -cs : sn;
}

__device__ __forceinline__ void p0_transpose_item(const float* W, int K, int N, bf16* WT, int k0, int n0, int dst_row0, float* scr, int lane, const float* kscale = nullptr) {
#pragma unroll 8
    for (int i = 0; i < 32; ++i) { const int kk = 2 * i + (lane >> 5); scr[kk * 33 + (lane & 31)] = __builtin_nontemporal_load(W + (size_t)(k0 + kk) * N + n0 + (lane & 31)); }
    const int c = lane & 7;
    f32x4 ks0 = (f32x4){1.f, 1.f, 1.f, 1.f}, ks1 = ks0;
    if (kscale) { ks0 = *(const f32x4*)(kscale + k0 + 8 * c); ks1 = *(const f32x4*)(kscale + k0 + 8 * c + 4); }
    LDS_FENCE();
#pragma unroll
    for (int j = 0; j < 4; ++j) { const int n = (lane >> 3) + 8 * j; const float* s = scr + (8 * c) * 33 + n;
        u32x4 o; o.x = pk2(s[0 * 33] * ks0.x, s[1 * 33] * ks0.y); o.y = pk2(s[2 * 33] * ks0.z, s[3 * 33] * ks0.w); o.z = pk2(s[4 * 33] * ks1.x, s[5 * 33] * ks1.y); o.w = pk2(s[6 * 33] * ks1.z, s[7 * 33] * ks1.w);
        *(u32x4*)(WT + (size_t)(dst_row0 + n) * K + k0 + 8 * c) = o; }
    LDS_FENCE();
}
__device__ __forceinline__ void rms_row_to_bf16(const float* xrow, const float* g, bf16* orow, int lane) {
    const f32x4* xr = (const f32x4*)xrow + lane; const f32x4* gr = (const f32x4*)g + lane;
    f32x4 v[8]; float s = 0.f;
#pragma unroll
    for (int j = 0; j < 8; ++j) { v[j] = xr[64 * j]; s += (v[j].x * v[j].x + v[j].y * v[j].y) + (v[j].z * v[j].z + v[j].w * v[j].w); }
    const float r = rsqrtf(wave_sum(s) * (1.f / DM) + EPS);
    u32x2* o8 = (u32x2*)orow + lane;
#pragma unroll
    for (int j = 0; j < 8; ++j) { const f32x4 gg = gr[64 * j]; u32x2 w; w.x = pk2(v[j].x * r * gg.x, v[j].y * r * gg.y); w.y = pk2(v[j].z * r * gg.z, v[j].w * r * gg.w); o8[64 * j] = w; }
}
__device__ __forceinline__ void p0_phase(const Params& P, unsigned char* lds, int tid, int lane, int wave) {
    unsigned char* ws = P.ws;
    const int gw = blockIdx.x * 8 + wave, NGW = gridDim.x * 8;
    float* scr = (float*)(lds + wave * 16384);
    constexpr int I_IN = 32 * 160;
    for (int it = gw; it < I_IN; it += NGW) { const int kb = it / 160, nb = it % 160; p0_transpose_item(P.in[2], DM, INW, (bf16*)(ws + WS_WIN), kb * 64, nb * 32, nb * 32, scr, lane, P.in[1]); }
    for (int m = gw; m < MTOK; m += NGW) {
        const f32x4* xr = (const f32x4*)(P.in[0] + (size_t)m * DM) + lane; u32x2* o8 = (u32x2*)((bf16*)(ws + WS_XB) + (size_t)m * DM) + lane;
        f32x4 v[8]; float ss = 0.f;
#pragma unroll
        for (int j = 0; j < 8; ++j) { v[j] = __builtin_nontemporal_load(xr + 64 * j); ss += (v[j].x * v[j].x + v[j].y * v[j].y) + (v[j].z * v[j].z + v[j].w * v[j].w); }
#pragma unroll
        for (int j = 0; j < 8; ++j) { u32x2 w; w.x = pk2(v[j].x, v[j].y); w.y = pk2(v[j].z, v[j].w); o8[64 * j] = w; }
        ss = wave_sum(ss);
        if (lane == 0) ((float*)(ws + WS_RS0))[m] = rsqrtf(ss * (1.f / DM) + EPS);
    }
    const int gt = blockIdx.x * 512 + tid, NGT = gridDim.x * 512;
    for (int idx = gt; idx < SEQ * 64; idx += NGT) {
        const int pos = idx >> 6, i = idx & 63;
        const double freq = exp(-(double)i * (9.210340371976184 / 64.0));
        double s, c; sincos_d((double)pos * freq, s, c);
        ((f32x2*)(ws + WS_ROPE))[idx] = (f32x2){(float)c, (float)s};
    }
    if (gt < NG * NP) {
        const int g = gt >> 6, p = gt & 63;
        const double dt = exp((double)P.in[6][g]);
        const double ar = (double)P.in[4][gt], ai = (double)P.in[5][gt];
        double sn, cs; sincos_d(ai * dt, sn, cs);
        const double mag = exp(ar * dt), lbr = mag * cs, lbi = mag * sn;
        const double d2 = ar * ar + ai * ai, nr = lbr - 1.0, ni = lbi;
        const double cr = (nr * ar + ni * ai) / d2, ci = (ni * ar - nr * ai) / d2;
        bf16* BbT = (bf16*)(ws + WS_S5P + S5P_BBT); bf16* CmT = (bf16*)(ws + WS_S5P + S5P_CMT);
        const float* bre = P.in[7] + (size_t)gt * 16; const float* bim = P.in[8] + (size_t)gt * 16;
#pragma unroll
        for (int c2 = 0; c2 < 16; c2 += 2) {
            const double br0 = bre[c2], bi0 = bim[c2], br1 = bre[c2 + 1], bi1 = bim[c2 + 1];
            *(unsigned*)(BbT + ((size_t)g * 128 + p) * 16 + c2) = pk2((float)(cr * br0 - ci * bi0), (float)(cr * br1 - ci * bi1));
            *(unsigned*)(BbT + ((size_t)g * 128 + 64 + p) * 16 + c2) = pk2((float)(cr * bi0 + ci * br0), (float)(cr * bi1 + ci * br1));
        }
        ((f32x2*)(ws + WS_S5P + S5P_LAM))[gt] = (f32x2){(float)lbr, (float)lbi};
        double sL, cL; sincos_d(ai * dt * 512.0, sL, cL); const double mL = exp(ar * dt * 512.0);
        ((f32x2*)(ws + WS_S5P + S5P_LAML))[gt] = (f32x2){(float)(mL * cL), (float)(mL * sL)};
        const int n = p & 31, blk = p >> 5;
#pragma unroll
        for (int c = 0; c < 16; ++c) {
            const float cre = P.in[9][((size_t)g * 16 + c) * 64 + p], cim = P.in[10][((size_t)g * 16 + c) * 64 + p];
            *(unsigned*)(CmT + ((size_t)g * 16 + c) * 128 + 4 * n + 2 * blk) = pk2(cre, -cim);
        }
    }
}

constexpr int RA_KT = 0, RA_VT = 16384;
constexpr int RC_QS = 0, RC_KS = 17408, RC_VT = 34816, RC_PS = 53248, RC_OS = 62464;

__device__ __forceinline__ float head_lg2(int h) { const float t[8] = {-4.5803689613e-02f, -2.2720076500e-02f, -1.1315313228e-02f, -5.6465631411e-03f, -2.8205190624e-03f, -1.4095702547e-03f, -7.0461297659e-04f, -3.5226347163e-04f}; float r = t[0];
#pragma unroll
    for (int i = 1; i < 8; ++i) r = (h == i) ? t[i] : r;
    return r; }

__device__ __forceinline__ int tsw(int r, int tok) { return r * 64 + ((((tok >> 3) ^ ((r ^ (r >> 3)) & 7)) << 3) | (tok & 7)); }
__device__ __forceinline__ int sidx(int e, int d) { return ((((e >> 5) * 8 + (d >> 4)) * 32 + (e & 31)) << 4) + (d & 15); }
__device__ __forceinline__ void rope8(const u32x4 a, const u32x4 b, const f32x2* cs, float (&o1)[8], float (&o2)[8]) {
    const unsigned aw[4] = {a.x, a.y, a.z, a.w}, bw[4] = {b.x, b.y, b.z, b.w};
#pragma unroll
    for (int j = 0; j < 4; ++j) {
        const f32x2 c0 = cs[2 * j], c1 = cs[2 * j + 1];
        const float x1a = bflo(aw[j]), x1b = bfhi(aw[j]), x2a = bflo(bw[j]), x2b = bfhi(bw[j]);
        o1[2 * j] = x1a * c0.x - x2a * c0.y; o2[2 * j] = x2a * c0.x + x1a * c0.y;
        o1[2 * j + 1] = x1b * c1.x - x2b * c1.y; o2[2 * j + 1] = x2b * c1.x + x1b * c1.y;
    }
}

__device__ __forceinline__ void ret_pass_a(const Params& P, unsigned char* lds, int tid, int lane, int wave) {
    unsigned char* ws = P.ws;
    const bf16* proj = (const bf16*)(ws + WS_PROJ); const u32x4* rope = (const u32x4*)(ws + WS_ROPE); bf16* KV = (bf16*)(ws + WS_KV);
    bf16* KT = (bf16*)(lds + RA_KT); bf16* VT = (bf16*)(lds + RA_VT);
    const int tok = tid >> 3, dg = tid & 7;
    u32x4 k1, k2, v1, v2, c0, c1, c2, c3;
#define RA_LOAD(uu) do { const int bh_ = (uu) >> 7, n_ = (uu) & 127; const size_t row_ = (size_t)(bh_ >> 3) * SEQ + n_ * 64 + tok; \
        const bf16* kp_ = proj + row_ * INW + RW + (bh_ & 7) * HD + dg * 8; const u32x4* cp_ = rope + ((size_t)(n_ * 64 + tok) * 64 + dg * 8) / 2; \
        k1 = *(const u32x4*)kp_; k2 = *(const u32x4*)(kp_ + 64); v1 = *(const u32x4*)(kp_ + RW); v2 = *(const u32x4*)(kp_ + RW + 64); c0 = cp_[0]; c1 = cp_[1]; c2 = cp_[2]; c3 = cp_[3]; } while (0)
    f32x16 R0, R1;
#pragma unroll
    for (int i = 0; i < 16; ++i) { R0[i] = 0.f; R1[i] = 0.f; }
    int u = (int)blockIdx.x * 8;
    RA_LOAD(u);
    for (int ui = 0; ui < 8; ++ui, ++u) {
        const int bh = u >> 7, h = bh & 7;
        const float lg2 = head_lg2(h);
        const f32x2 cs[8] = {(f32x2){__uint_as_float(c0.x), __uint_as_float(c0.y)}, (f32x2){__uint_as_float(c0.z), __uint_as_float(c0.w)}, (f32x2){__uint_as_float(c1.x), __uint_as_float(c1.y)}, (f32x2){__uint_as_float(c1.z), __uint_as_float(c1.w)},
                             (f32x2){__uint_as_float(c2.x), __uint_as_float(c2.y)}, (f32x2){__uint_as_float(c2.z), __uint_as_float(c2.w)}, (f32x2){__uint_as_float(c3.x), __uint_as_float(c3.y)}, (f32x2){__uint_as_float(c3.z), __uint_as_float(c3.w)}};
        float o1[8], o2[8]; rope8(k1, k2, cs, o1, o2);
        const float ksc = 0.08838834764831845f * __builtin_amdgcn_exp2f(lg2 * (float)(63 - tok));
#pragma unroll
        for (int j = 0; j < 8; ++j) { KT[tsw(dg * 8 + j, tok)] = (bf16)(pk2(o1[j] * ksc, 0.f) & 0xffffu); KT[tsw(64 + dg * 8 + j, tok)] = (bf16)(pk2(o2[j] * ksc, 0.f) & 0xffffu); }
        const unsigned vw1[4] = {v1.x, v1.y, v1.z, v1.w}, vw2[4] = {v2.x, v2.y, v2.z, v2.w};
#pragma unroll
        for (int j = 0; j < 4; ++j) {
            VT[tsw(dg * 8 + 2 * j, tok)] = (bf16)(vw1[j] & 0xffffu); VT[tsw(dg * 8 + 2 * j + 1, tok)] = (bf16)(vw1[j] >> 16);
            VT[tsw(64 + dg * 8 + 2 * j, tok)] = (bf16)(vw2[j] & 0xffffu); VT[tsw(64 + dg * 8 + 2 * j + 1, tok)] = (bf16)(vw2[j] >> 16);
        }
        if (ui < 7) RA_LOAD(u + 1);
        __syncthreads();
        const int dt = wave & 3, et0 = (wave >> 2) * 2, l31 = lane & 31, hh = lane >> 5;
        f32x16 acc0, acc1;
#pragma unroll
        for (int i = 0; i < 16; ++i) { acc0[i] = 0.f; acc1[i] = 0.f; }
#pragma unroll
        for (int ks = 0; ks < 4; ++ks) {
            const bf16x8 a = *(const bf16x8*)(KT + tsw(dt * 32 + l31, ks * 16 + 8 * hh));
            const bf16x8 b0 = *(const bf16x8*)(VT + tsw(et0 * 32 + l31, ks * 16 + 8 * hh));
            const bf16x8 b1 = *(const bf16x8*)(VT + tsw((et0 + 1) * 32 + l31, ks * 16 + 8 * hh));
            acc0 = MFMA32(a, b0, acc0); acc1 = MFMA32(a, b1, acc1);
        }
        bf16* kvu = KV + (size_t)u * 16384;
        const float cdec = __builtin_amdgcn_exp2f(lg2 * 64.f);
        if (ui > 0)
#pragma unroll
        for (int q = 0; q < 4; ++q) {
            const int d0 = dt * 32 + 8 * q + 4 * hh;
            u32x2 w0; w0.x = pk2(R0[4 * q], R0[4 * q + 1]); w0.y = pk2(R0[4 * q + 2], R0[4 * q + 3]);
            u32x2 w1; w1.x = pk2(R1[4 * q], R1[4 * q + 1]); w1.y = pk2(R1[4 * q + 2], R1[4 * q + 3]);
            *(u32x2*)(kvu + sidx(et0 * 32 + l31, d0)) = w0; *(u32x2*)(kvu + sidx((et0 + 1) * 32 + l31, d0)) = w1;
        }
#pragma unroll
        for (int i = 0; i < 16; ++i) { R0[i] = fmaf(R0[i], cdec, acc0[i]); R1[i] = fmaf(R1[i], cdec, acc1[i]); }
        if (ui == 7) {
            bf16* tot = (bf16*)(ws + WS_TOT) + (size_t)blockIdx.x * 16384;
#pragma unroll
            for (int q = 0; q < 4; ++q) {
                const int d0 = dt * 32 + 8 * q + 4 * hh;
                u32x2 w0; w0.x = pk2(R0[4 * q], R0[4 * q + 1]); w0.y = pk2(R0[4 * q + 2], R0[4 * q + 3]);
                u32x2 w1; w1.x = pk2(R1[4 * q], R1[4 * q + 1]); w1.y = pk2(R1[4 * q + 2], R1[4 * q + 3]);
                *(u32x2*)(tot + sidx(et0 * 32 + l31, d0)) = w0; *(u32x2*)(tot + sidx((et0 + 1) * 32 + l31, d0)) = w1;
            }
        }
        __syncthreads();
    }
#undef RA_LOAD
}

__device__ __forceinline__ void ret_pass_c(const Params& P, unsigned char* lds, int tid, int lane, int wave) {
    unsigned char* ws = P.ws;
    const bf16* proj = (const bf16*)(ws + WS_PROJ); const u32x4* rope = (const u32x4*)(ws + WS_ROPE); const bf16* KV = (const bf16*)(ws + WS_KV);
    bf16* mix = (bf16*)(ws + WS_BUFA);
    bf16* Qs = (bf16*)(lds + RC_QS); bf16* Ks = (bf16*)(lds + RC_KS); bf16* VT = (bf16*)(lds + RC_VT); bf16* Ps = (bf16*)(lds + RC_PS); float* Os = (float*)(lds + RC_OS);
    const int tok = tid >> 3, dg = tid & 7, l31 = lane & 31, hh = lane >> 5, l15 = lane & 15, l4 = lane >> 4;
    const int rt = wave & 1, ct = wave >> 1;
    u32x4 q1, q2, k1, k2, v1, v2, c0, c1, c2, c3;
    bf16x8 st[8];
#define RC_LOAD(uu) do { const int bh_ = (uu) >> 7, n_ = (uu) & 127; const size_t row_ = (size_t)(bh_ >> 3) * SEQ + n_ * 64 + tok; \
        const bf16* qp_ = proj + row_ * INW + (bh_ & 7) * HD + dg * 8; const u32x4* cp_ = rope + ((size_t)(n_ * 64 + tok) * 64 + dg * 8) / 2; \
        q1 = __builtin_nontemporal_load((const u32x4*)qp_); q2 = __builtin_nontemporal_load((const u32x4*)(qp_ + 64)); k1 = __builtin_nontemporal_load((const u32x4*)(qp_ + RW)); k2 = __builtin_nontemporal_load((const u32x4*)(qp_ + RW + 64)); \
        c0 = cp_[0]; c1 = cp_[1]; c2 = cp_[2]; c3 = cp_[3]; } while (0)
#define RC_LOAD_ST(uu) do { const bf16* sp_ = KV + (size_t)(uu) * 16384 + sidx(ct * 32 + l31, 8 * hh); _Pragma("unroll") for (int ks_ = 0; ks_ < 8; ++ks_) st[ks_] = __builtin_nontemporal_load((const bf16x8*)(sp_ + ks_ * 512)); } while (0)
    const int rowb = panel_of((int)blockIdx.x) * 256 + ((int)blockIdx.x >> 6) * 64, ub = ((rowb >> 13) * 8) * 128 + ((rowb & 8191) >> 6);
    int u = ub;
    RC_LOAD(u);
    for (int hi = 0; hi < 8; ++hi, u += 128) {
        const int bh = u >> 7, n = u & 127, b = bh >> 3, h = bh & 7;
        const int un = (hi < 7) ? u + 128 : u;
        const float lg2 = head_lg2(h);
        { const bf16* cp_ = (const bf16*)(ws + WS_TOT) + ((size_t)bh * 16 + (n >> 3)) * 16384 + sidx(ct * 32 + l31, 8 * hh);
#pragma unroll
          for (int ks = 0; ks < 8; ++ks) st[ks] = *(const bf16x8*)(cp_ + ks * 512); }
        const int t3 = tid >> 3, part = tid & 7;
        const size_t row3 = (size_t)b * SEQ + n * 64 + t3;
        const bf16* gp = proj + row3 * INW + 3 * RW + h * HD + part * 16;
        { const bf16* vp_ = proj + ((size_t)b * SEQ + n * 64 + tok) * INW + 2 * RW + h * HD + dg * 8; v1 = __builtin_nontemporal_load((const u32x4*)vp_); v2 = __builtin_nontemporal_load((const u32x4*)(vp_ + 64)); }
        u32x4 g0, g1; f32x2 sq2p;
        {
            const f32x2 cs[8] = {(f32x2){__uint_as_float(c0.x), __uint_as_float(c0.y)}, (f32x2){__uint_as_float(c0.z), __uint_as_float(c0.w)}, (f32x2){__uint_as_float(c1.x), __uint_as_float(c1.y)}, (f32x2){__uint_as_float(c1.z), __uint_as_float(c1.w)},
                                 (f32x2){__uint_as_float(c2.x), __uint_as_float(c2.y)}, (f32x2){__uint_as_float(c2.z), __uint_as_float(c2.w)}, (f32x2){__uint_as_float(c3.x), __uint_as_float(c3.y)}, (f32x2){__uint_as_float(c3.z), __uint_as_float(c3.w)}};
            float o1[8], o2[8]; u32x4 w;
            rope8(q1, q2, cs, o1, o2);
            w.x = pk2(o1[0], o1[1]); w.y = pk2(o1[2], o1[3]); w.z = pk2(o1[4], o1[5]); w.w = pk2(o1[6], o1[7]); *(u32x4*)(Qs + tok * 136 + dg * 8) = w;
            w.x = pk2(o2[0], o2[1]); w.y = pk2(o2[2], o2[3]); w.z = pk2(o2[4], o2[5]); w.w = pk2(o2[6], o2[7]); *(u32x4*)(Qs + tok * 136 + 64 + dg * 8) = w;
            rope8(k1, k2, cs, o1, o2);
            w.x = pk2(o1[0], o1[1]); w.y = pk2(o1[2], o1[3]); w.z = pk2(o1[4], o1[5]); w.w = pk2(o1[6], o1[7]); *(u32x4*)(Ks + tok * 136 + dg * 8) = w;
            w.x = pk2(o2[0], o2[1]); w.y = pk2(o2[2], o2[3]); w.z = pk2(o2[4], o2[5]); w.w = pk2(o2[6], o2[7]); *(u32x4*)(Ks + tok * 136 + 64 + dg * 8) = w;
            const unsigned vw1[4] = {v1.x, v1.y, v1.z, v1.w}, vw2[4] = {v2.x, v2.y, v2.z, v2.w};
#pragma unroll
            for (int j = 0; j < 4; ++j) {
                VT[tsw(dg * 8 + 2 * j, tok)] = (bf16)(vw1[j] & 0xffffu); VT[tsw(dg * 8 + 2 * j + 1, tok)] = (bf16)(vw1[j] >> 16);
                VT[tsw(64 + dg * 8 + 2 * j, tok)] = (bf16)(vw2[j] & 0xffffu); VT[tsw(64 + dg * 8 + 2 * j + 1, tok)] = (bf16)(vw2[j] >> 16);
            }
        }
        RC_LOAD(un);
        __syncthreads();
#pragma unroll
        for (int tt = 0; tt < 2; ++tt) {
            const int T = wave * 2 + tt, kt = T & 3, qt = T >> 2;
            f32x4 acc = (f32x4){0.f, 0.f, 0.f, 0.f};
#pragma unroll
            for (int ks = 0; ks < 4; ++ks) {
                const bf16x8 a = *(const bf16x8*)(Ks + (kt * 16 + l15) * 136 + ks * 32 + 8 * l4);
                const bf16x8 bq = *(const bf16x8*)(Qs + (qt * 16 + l15) * 136 + ks * 32 + 8 * l4);
                acc = MFMA16(a, bq, acc);
            }
            const int q = qt * 16 + l15, key0 = kt * 16 + 4 * l4;
            float v[4];
#pragma unroll
            for (int r = 0; r < 4; ++r) { const int dist = q - (key0 + r); v[r] = acc[r] * 0.08838834764831845f * __builtin_amdgcn_exp2f(lg2 * (float)(dist < 0 ? -dist : dist)); }
            u32x2 w; w.x = pk2(v[0], v[1]); w.y = pk2(v[2], v[3]);
            *(u32x2*)(Ps + q * 72 + key0) = w;
        }
        asm volatile("" ::: "memory");
        f32x16 acc;
#pragma unroll
        for (int i = 0; i < 16; ++i) acc[i] = 0.f;
#pragma unroll
        for (int ks = 0; ks < 8; ++ks) { const bf16x8 a = *(const bf16x8*)(Qs + (rt * 32 + l31) * 136 + ks * 16 + 8 * hh); acc = MFMA32(a, st[ks], acc); }
        { const float dj = __builtin_amdgcn_exp2f(lg2 * (float)(64 * (n & 7)));
#pragma unroll
          for (int i = 0; i < 16; ++i) acc[i] *= dj; }
        if (n & 7) RC_LOAD_ST(u);
        __syncthreads();
        {
            if (n & 7) {
#pragma unroll
            for (int ks = 0; ks < 8; ++ks) { const bf16x8 a = *(const bf16x8*)(Qs + (rt * 32 + l31) * 136 + ks * 16 + 8 * hh); acc = MFMA32(a, st[ks], acc); }
            }
#pragma unroll
            for (int i = 0; i < 16; ++i) { const int c = rt * 32 + 8 * (i >> 2) + 4 * hh + (i & 3); acc[i] *= __builtin_amdgcn_exp2f(lg2 * (float)(c + 1)); }
#pragma unroll
            for (int ks = 0; ks < 4; ++ks) {
                const bf16x8 a = *(const bf16x8*)(Ps + (rt * 32 + l31) * 72 + ks * 16 + 8 * hh);
                const bf16x8 bv = *(const bf16x8*)(VT + tsw(ct * 32 + l31, ks * 16 + 8 * hh));
                acc = MFMA32(a, bv, acc);
            }
            g0 = __builtin_nontemporal_load((const u32x4*)gp); g1 = __builtin_nontemporal_load((const u32x4*)(gp + 8)); sq2p = *(const f32x2*)((const float*)(ws + WS_SQ2) + row3 * 16 + part * 2);
#pragma unroll
            for (int i = 0; i < 16; ++i) { const int c = rt * 32 + 8 * (i >> 2) + 4 * hh + (i & 3); Os[c * 132 + ct * 32 + l31] = acc[i]; }
        }
        __syncthreads();
        {
            const f32x4* op = (const f32x4*)(Os + t3 * 132 + part * 16);
            f32x4 x[4]; float s = 0.f;
#pragma unroll
            for (int j = 0; j < 4; ++j) { x[j] = op[j]; s += (x[j].x + x[j].y) + (x[j].z + x[j].w); }
            s += __shfl_xor(s, 1); s += __shfl_xor(s, 2); s += __shfl_xor(s, 4);
            const float mu = s * (1.f / 128.f); float q2s = 0.f;
#pragma unroll
            for (int j = 0; j < 4; ++j) { x[j] = x[j] - mu; q2s += (x[j].x * x[j].x + x[j].y * x[j].y) + (x[j].z * x[j].z + x[j].w * x[j].w); }
            q2s += __shfl_xor(q2s, 1); q2s += __shfl_xor(q2s, 2); q2s += __shfl_xor(q2s, 4);
            float sq2 = sq2p.x + sq2p.y; sq2 += __shfl_xor(sq2, 1); sq2 += __shfl_xor(sq2, 2); sq2 += __shfl_xor(sq2, 4);
            const float rstd = rsqrtf(q2s * (1.f / 128.f) + EPS) * sqrtf(sq2 * (1.f / SW) + EPS);
            const unsigned gw[8] = {g0.x, g0.y, g0.z, g0.w, g1.x, g1.y, g1.z, g1.w};
            const f32x4* gn = (const f32x4*)(P.in[3] + h * HD + part * 16);
            unsigned ow[8];
#pragma unroll
            for (int j = 0; j < 4; ++j) {
                const f32x4 gg = gn[j];
                const float ga = bflo(gw[2 * j]), gb = bfhi(gw[2 * j]), gc = bflo(gw[2 * j + 1]), gd = bfhi(gw[2 * j + 1]);
                const float ya = ga * pg8::sigmoid_f(ga) * (x[j].x * rstd * gg.x), yb = gb * pg8::sigmoid_f(gb) * (x[j].y * rstd * gg.y);
                const float yc = gc * pg8::sigmoid_f(gc) * (x[j].z * rstd * gg.z), yd = gd * pg8::sigmoid_f(gd) * (x[j].w * rstd * gg.w);
                ow[2 * j] = pk2(ya, yb); ow[2 * j + 1] = pk2(yc, yd);
            }
            bf16* mp = mix + row3 * DM + h * HD + part * 16;
            *(u32x4*)mp = (u32x4){ow[0], ow[1], ow[2], ow[3]}; *(u32x4*)(mp + 8) = (u32x4){ow[4], ow[5], ow[6], ow[7]};
        }
    }
    __syncthreads();
#undef RC_LOAD
#undef RC_LOAD_ST
}

struct ConvItem { const float* W; bf16* WT; const float* ks; int K, N, k0, n0, dst0; };
constexpr int CONV_ITEMS = 16 * 32 + 32 * 64 + 2 * 32 * 176 + 88 * 64;
__device__ __forceinline__ bool conv_decode(const Params& P, int id, ConvItem& c) {
    unsigned char* ws = P.ws;
    constexpr int I_GLU = 16 * 32, I_OUT = 32 * 64, I_GATE = 32 * 176, I_DOWN = 88 * 64;
    int r = id, kb, nb; c.ks = nullptr;
    if (r < 0 || r >= CONV_ITEMS) return false;
    if (r < I_GLU) { c.W = P.in[12]; c.WT = (bf16*)(ws + WS_WGLU); c.K = SW; c.N = SW; kb = r / 32; nb = r % 32; c.dst0 = nb * 32; }
    else if ((r -= I_GLU) < I_OUT) { c.W = P.in[15]; c.WT = (bf16*)(ws + WS_WOUT); c.K = DM; c.N = DM; kb = r / 64; nb = r % 64; c.dst0 = nb * 32; }
    else if ((r -= I_OUT) < I_GATE) { c.W = P.in[17]; c.WT = (bf16*)(ws + WS_WGU); c.K = DM; c.N = DFF; kb = r / 176; nb = r % 176; c.dst0 = ((nb * 32) >> 7) * 256 + ((nb * 32) & 127); c.ks = P.in[16]; }
    else if ((r -= I_GATE) < I_GATE) { c.W = P.in[18]; c.WT = (bf16*)(ws + WS_WGU); c.K = DM; c.N = DFF; kb = r / 176; nb = r % 176; c.dst0 = ((nb * 32) >> 7) * 256 + 128 + ((nb * 32) & 127); c.ks = P.in[16]; }
    else { r -= I_GATE; c.W = P.in[19]; c.WT = (bf16*)(ws + WS_WD); c.K = DFF; c.N = DM; kb = r / 64; nb = r % 64; c.dst0 = nb * 32; }
    c.k0 = kb * 64; c.n0 = nb * 32; return true;
}
__device__ __forceinline__ void conv_issue(const ConvItem& c, unsigned char* scr, int lane) {
    const int kr = lane >> 3, p = lane & 7;
    const float* src = c.W + (size_t)(c.k0 + kr) * c.N + c.n0;
#pragma unroll
    for (int i = 0; i < 8; ++i) { const int sc = p ^ ((kr ^ i) & 7);
        __builtin_amdgcn_global_load_lds((const unsigned*)(src + (size_t)(8 * i) * c.N + 4 * sc), (PG8_LAS unsigned*)(scr + i * 1024), 16, 0, 2); }
}
__device__ __forceinline__ void conv_consume(const ConvItem& c, const unsigned char* scr, int lane) {
    asm volatile("s_waitcnt vmcnt(0)" ::: "memory");
    const int cc = lane & 7;
    f32x4 ks0 = (f32x4){1.f, 1.f, 1.f, 1.f}, ks1 = ks0;
    if (c.ks) { ks0 = *(const f32x4*)(c.ks + c.k0 + 8 * cc); ks1 = *(const f32x4*)(c.ks + c.k0 + 8 * cc + 4); }
#pragma unroll
    for (int j = 0; j < 4; ++j) { const int n = (lane >> 3) + 8 * j; float v[8];
#pragma unroll
        for (int t = 0; t < 8; ++t) v[t] = *(const float*)(scr + (8 * cc + t) * 128 + (((n >> 2) ^ ((t ^ cc) & 7)) * 16) + (n & 3) * 4);
        u32x4 o; o.x = pk2(v[0] * ks0.x, v[1] * ks0.y); o.y = pk2(v[2] * ks0.z, v[3] * ks0.w); o.z = pk2(v[4] * ks1.x, v[5] * ks1.y); o.w = pk2(v[6] * ks1.z, v[7] * ks1.w);
        *(u32x4*)(c.WT + (size_t)(c.dst0 + n) * c.K + c.k0 + 8 * cc) = o; }
    LDS_FENCE();
}

#define CMUL_ADD(or_, oi_, ar_, ai_, br_, bi_, cr_, ci_) do { const float _r = fmaf((ar_), (br_), fmaf(-(ai_), (bi_), (cr_))); const float _i = fmaf((ar_), (bi_), fmaf((ai_), (br_), (ci_))); (or_) = _r; (oi_) = _i; } while (0)
template <bool FULL>
__device__ __forceinline__ void s5_wave(const Params& P, unsigned char* wlds, int b, int g, int ch, int lane, int gw) {
    unsigned char* ws = P.ws;
    const bf16* proj = (const bf16*)(ws + WS_PROJ);
    const bf16* BbT = (const bf16*)(ws + WS_S5P + S5P_BBT); const bf16* CmT = (const bf16*)(ws + WS_S5P + S5P_CMT);
    const f32x2* lamp = (const f32x2*)(ws + WS_S5P + S5P_LAM);
    f32x2* ST = (f32x2*)(ws + WS_S5ST);
    const int n = lane & 31, hh = lane >> 5, l15 = lane & 15, l4 = lane >> 4;
    bf16x8 Bb[4];
#pragma unroll
    for (int v = 0; v < 4; ++v) Bb[v] = *(const bf16x8*)(BbT + ((size_t)g * 128 + (v & 1) * 64 + (v >> 1) * 32 + n) * 16 + 8 * hh);
    float lr[2][4], li[2][4];
#pragma unroll
    for (int k = 0; k < 2; ++k) {
        const f32x2 l1 = lamp[g * 64 + k * 32 + n]; lr[k][0] = l1.x; li[k][0] = l1.y;
#pragma unroll
        for (int e = 1; e < 4; ++e) { lr[k][e] = lr[k][e - 1] * l1.x - li[k][e - 1] * l1.y; li[k][e] = lr[k][e - 1] * l1.y + li[k][e - 1] * l1.x; }
    }
    float car[2], cai[2];
    const size_t stbase = (((size_t)b * 16 + ch) * 64 + g) * 64;
    car[0] = cai[0] = car[1] = cai[1] = 0.f;
    if (FULL) {
        const f32x2* lamL = (const f32x2*)(ws + WS_S5P + S5P_LAML);
        const f32x2 L0 = lamL[g * 64 + n], L1 = lamL[g * 64 + 32 + n];
        for (int c = 0; c < ch; ++c) { const size_t eb = (((size_t)b * 16 + c) * 64 + g) * 64; const f32x2 e0 = ST[eb + n], e1 = ST[eb + 32 + n];
            CMUL_ADD(car[0], cai[0], L0.x, L0.y, car[0], cai[0], e0.x, e0.y); CMUL_ADD(car[1], cai[1], L1.x, L1.y, car[1], cai[1], e1.x, e1.y); }
    }
    bf16x8 Cm[4];
    f32x4 dsk = (f32x4){0.f, 0.f, 0.f, 0.f};
    if (FULL) {
#pragma unroll
        for (int ks = 0; ks < 4; ++ks) Cm[ks] = *(const bf16x8*)(CmT + ((size_t)g * 16 + l15) * 128 + ks * 32 + 8 * l4);
        dsk = *(const f32x4*)(P.in[11] + g * 16 + 4 * l4);
    }
    bf16* y1 = (bf16*)(ws + WS_Y1);
    for (int sb = 0; sb < 16; ++sb) {
        const size_t row0 = (size_t)b * SEQ + ch * 512 + sb * 32;
        const bf16x8 U = *(const bf16x8*)(proj + (row0 + n) * INW + 4 * RW + g * 16 + 8 * hh);
        f32x16 bu[4];
#pragma unroll
        for (int v = 0; v < 4; ++v) {
#pragma unroll
            for (int i = 0; i < 16; ++i) bu[v][i] = 0.f;
            bu[v] = MFMA32(U, Bb[v], bu[v]);
        }
        ConvItem cvi; bool cvok = false;
        if (FULL && sb < 10) { cvok = conv_decode(P, sb * 2048 + gw, cvi); if (cvok) conv_issue(cvi, wlds + 8704, lane); }
        float er[2][4], ei[2][4];
#pragma unroll
        for (int k = 0; k < 2; ++k)
#pragma unroll
            for (int q = 0; q < 4; ++q) {
                float sr = bu[2 * k][4 * q], si = bu[2 * k + 1][4 * q];
#pragma unroll
                for (int j = 1; j < 4; ++j) { CMUL_ADD(sr, si, lr[k][0], li[k][0], sr, si, bu[2 * k][4 * q + j], bu[2 * k + 1][4 * q + j]); bu[2 * k][4 * q + j] = sr; bu[2 * k + 1][4 * q + j] = si; }
                er[k][q] = sr; ei[k][q] = si;
            }
        float mr[2][4], mi[2][4];
#pragma unroll
        for (int k = 0; k < 2; ++k) {
            float cr = car[k], ci = cai[k];
#pragma unroll
            for (int q = 0; q < 4; ++q) {
                const float pr = __shfl_xor(er[k][q], 32), pi = __shfl_xor(ei[k][q], 32);
                const float ear = hh ? pr : er[k][q], eai = hh ? pi : ei[k][q];
                const float ebr = hh ? er[k][q] : pr, ebi = hh ? ei[k][q] : pi;
                float c1r, c1i, c2r, c2i;
                CMUL_ADD(c1r, c1i, lr[k][3], li[k][3], cr, ci, ear, eai);
                CMUL_ADD(c2r, c2i, lr[k][3], li[k][3], c1r, c1i, ebr, ebi);
                mr[k][q] = hh ? c1r : cr; mi[k][q] = hh ? c1i : ci;
                cr = c2r; ci = c2i;
            }
            car[k] = cr; cai[k] = ci;
        }
        if (FULL) {
#pragma unroll
            for (int q = 0; q < 4; ++q)
#pragma unroll
                for (int j = 0; j < 4; ++j) {
                    float s0r, s0i, s1r, s1i;
                    CMUL_ADD(s0r, s0i, lr[0][j], li[0][j], mr[0][q], mi[0][q], bu[0][4 * q + j], bu[1][4 * q + j]);
                    CMUL_ADD(s1r, s1i, lr[1][j], li[1][j], mr[1][q], mi[1][q], bu[2][4 * q + j], bu[3][4 * q + j]);
                    u32x2 w; w.x = pk2(s0r, s0i); w.y = pk2(s1r, s1i);
                    *(u32x2*)(wlds + (8 * q + 4 * hh + j) * 272 + n * 8) = w;
                }
            LDS_FENCE();
            f32x4 yt[2];
#pragma unroll
            for (int tt = 0; tt < 2; ++tt) {
                yt[tt] = (f32x4){0.f, 0.f, 0.f, 0.f};
#pragma unroll
                for (int ks = 0; ks < 4; ++ks) { const bf16x8 sv = *(const bf16x8*)(wlds + (tt * 16 + l15) * 272 + (ks * 32 + 8 * l4) * 2); yt[tt] = MFMA16(Cm[ks], sv, yt[tt]); }
            }
            LDS_FENCE();
#pragma unroll
            for (int tt = 0; tt < 2; ++tt) {
                const size_t row = row0 + tt * 16 + l15;
                const u32x2 uw = *(const u32x2*)(proj + row * INW + 4 * RW + g * 16 + 4 * l4);
                const float uu[4] = {bflo(uw.x), bfhi(uw.x), bflo(uw.y), bfhi(uw.y)};
                float o[4];
#pragma unroll
                for (int r = 0; r < 4; ++r) { const float y = yt[tt][r] + dsk[r] * uu[r]; const float z = 1.5957691216057308f * (y + 0.044715f * y * y * y); o[r] = y * pg8::sigmoid_f(z); }
                u32x2 w; w.x = pk2(o[0], o[1]); w.y = pk2(o[2], o[3]);
                *(u32x2*)(y1 + row * SW + g * 16 + 4 * l4) = w;
            }
            if (cvok) conv_consume(cvi, wlds + 8704, lane);
        }
    }
    if (!FULL) { if (hh == 0) { ST[stbase + n] = (f32x2){car[0], cai[0]}; ST[stbase + 32 + n] = (f32x2){car[1], cai[1]}; } }
}

__device__ __forceinline__ void scan_phase(const Params& P, int tid) {
    unsigned char* ws = P.ws;
    const int gt = blockIdx.x * 512 + tid, NGT = gridDim.x * 512;
    for (int e = gt; e < 16 * 8192; e += NGT) {
        const int bh = e >> 13, off = (e & 8191) * 2, h = bh & 7;
        const float dec = __builtin_amdgcn_exp2f(head_lg2(h) * 512.f);
        unsigned* p = (unsigned*)((bf16*)(ws + WS_TOT) + (size_t)bh * 16 * 16384 + off);
        unsigned kv[16];
#pragma unroll
        for (int j = 0; j < 16; ++j) kv[j] = p[(size_t)j * 8192];
        float s0 = 0.f, s1 = 0.f;
#pragma unroll
        for (int j = 0; j < 16; ++j) { p[(size_t)j * 8192] = pk2(s0, s1); s0 = fmaf(s0, dec, bflo(kv[j])); s1 = fmaf(s1, dec, bfhi(kv[j])); }
    }
}

__device__ __forceinline__ void ssm_norm_phase(const Params& P, int lane, int wave) {
    unsigned char* ws = P.ws; const bf16* y2 = (const bf16*)(ws + WS_Y2); bf16* mix = (bf16*)(ws + WS_BUFA);
    const int gw = blockIdx.x * 8 + wave, NGW = gridDim.x * 8;
    for (int m = gw; m < MTOK; m += NGW) {
        const u32x4 a = *(const u32x4*)(y2 + (size_t)m * SW + lane * 8), c = *(const u32x4*)(y2 + (size_t)m * SW + 512 + lane * 8);
        const unsigned w[8] = {a.x, a.y, a.z, a.w, c.x, c.y, c.z, c.w};
        float v[16]; float s = 0.f;
#pragma unroll
        for (int j = 0; j < 8; ++j) { v[2 * j] = bflo(w[j]); v[2 * j + 1] = bfhi(w[j]); s += v[2 * j] * v[2 * j] + v[2 * j + 1] * v[2 * j + 1]; }
        const float r = rsqrtf(wave_sum(s) * (1.f / SW) + EPS);
        const f32x4* g0 = (const f32x4*)(P.in[14] + lane * 8); const f32x4* g1 = (const f32x4*)(P.in[14] + 512 + lane * 8);
        const f32x4 ga = g0[0], gb = g0[1], gc = g1[0], gd = g1[1];
        u32x4 o0, o1;
        o0.x = pk2(v[0] * r * ga.x, v[1] * r * ga.y); o0.y = pk2(v[2] * r * ga.z, v[3] * r * ga.w); o0.z = pk2(v[4] * r * gb.x, v[5] * r * gb.y); o0.w = pk2(v[6] * r * gb.z, v[7] * r * gb.w);
        o1.x = pk2(v[8] * r * gc.x, v[9] * r * gc.y); o1.y = pk2(v[10] * r * gc.z, v[11] * r * gc.w); o1.z = pk2(v[12] * r * gd.x, v[13] * r * gd.y); o1.w = pk2(v[14] * r * gd.z, v[15] * r * gd.w);
        *(u32x4*)(mix + (size_t)m * DM + RW + lane * 8) = o0; *(u32x4*)(mix + (size_t)m * DM + RW + 512 + lane * 8) = o1;
    }
}
__device__ __forceinline__ void final_norm_phase(const Params& P, int lane, int wave) {
    const bf16* x2 = (const bf16*)(P.ws + WS_BUFA);
    const int mb = panel_of((int)blockIdx.x) * 256 + ((int)blockIdx.x >> 6) * 64 + wave * 8;
    for (int m = mb; m < mb + 8; ++m) {
        const bf16* xr = x2 + (size_t)m * DM + lane * 8;
        u32x4 w[4]; float s = 0.f;
#pragma unroll
        for (int j = 0; j < 4; ++j) w[j] = *(const u32x4*)(xr + 512 * j);
        float v[4][8];
#pragma unroll
        for (int j = 0; j < 4; ++j) { const unsigned ww[4] = {w[j].x, w[j].y, w[j].z, w[j].w};
#pragma unroll
            for (int k = 0; k < 4; ++k) { v[j][2 * k] = bflo(ww[k]); v[j][2 * k + 1] = bfhi(ww[k]); s += v[j][2 * k] * v[j][2 * k] + v[j][2 * k + 1] * v[j][2 * k + 1]; } }
        const float r = rsqrtf(wave_sum(s) * (1.f / DM) + EPS);
        float* orow = P.out + (size_t)m * DM + lane * 8; const float* gr = P.in[20] + lane * 8;
#pragma unroll
        for (int j = 0; j < 4; ++j) { const f32x4 g0 = *(const f32x4*)(gr + 512 * j), g1 = *(const f32x4*)(gr + 512 * j + 4);
            __builtin_nontemporal_store((f32x4){v[j][0] * r * g0.x, v[j][1] * r * g0.y, v[j][2] * r * g0.z, v[j][3] * r * g0.w}, (f32x4*)(orow + 512 * j));
            __builtin_nontemporal_store((f32x4){v[j][4] * r * g1.x, v[j][5] * r * g1.y, v[j][6] * r * g1.z, v[j][7] * r * g1.w}, (f32x4*)(orow + 512 * j + 4)); }
    }
}

#define LAS __attribute__((address_space(3)))
#define XB_TMO      128
#define XB_XCNT(j)  (256  + 64 * (j))
#define XB_XSUB(j)  (1280 + 64 * (j))
#define XB_XGEN(j)  (2304 + 64 * (j))
#define XB_TOP      3328
#define XB_TOPGEN   3392
#define XCD_BAR_WORDS 3456
#define XB_SPIN_CAP (1u << 18)

__device__ __forceinline__ unsigned xb_ld(unsigned* p)              { return __hip_atomic_load(p, __ATOMIC_RELAXED, __HIP_MEMORY_SCOPE_AGENT); }
__device__ __forceinline__ unsigned xb_add(unsigned* p, unsigned v) { return __hip_atomic_fetch_add(p, v, __ATOMIC_RELAXED, __HIP_MEMORY_SCOPE_AGENT); }
__device__ __forceinline__ unsigned xb_xcc_id() { return (unsigned)__builtin_amdgcn_s_getreg((3 << 11) | 20) & 0xFu; }
#define XB_SPIN(cond, bar) do { unsigned _sp = 0; while (cond) { __builtin_amdgcn_s_sleep(1); \
    if ((++_sp & 255u) == 0u) { if (xb_ld(&(bar)[XB_TMO])) break; if (_sp > XB_SPIN_CAP) { atomicAdd(&(bar)[XB_TMO], 1u); break; } } } } while (0)

struct XcdBarrier {
    unsigned* bar; unsigned x;
    volatile LAS unsigned* st;
};

__device__ __forceinline__ XcdBarrier xcd_barrier_post(unsigned* bar, volatile LAS unsigned* st) {
    XcdBarrier b; b.bar = bar; b.x = xb_xcc_id(); b.st = st;
    if (threadIdx.x == 0) (void)xb_add(&bar[XB_XCNT(b.x)], 1u);
    return b;
}
__device__ __forceinline__ void xcd_barrier_complete(unsigned* bar, unsigned x, unsigned& nloc, unsigned& nx) {
    const unsigned G = gridDim.x * gridDim.y * gridDim.z;
    unsigned sum, cnt, mine, sp = 0u;
    for (;;) {
        sum = 0u; cnt = 0u; mine = 0u;
#pragma unroll
        for (unsigned j = 0; j < 16; ++j) { const unsigned c = xb_ld(&bar[XB_XCNT(j)]); sum += c; cnt += (c > 0u) ? 1u : 0u; mine = (j == x) ? c : mine; }
        if (sum == G) break;
        __builtin_amdgcn_s_sleep(1);
        if ((++sp & 255u) == 0u) { if (xb_ld(&bar[XB_TMO])) break; if (sp > XB_SPIN_CAP) { atomicAdd(&bar[XB_TMO], 1u); break; } }
    }
    nloc = mine > 0u ? mine : 1u; nx = cnt > 0u ? cnt : 1u;
}

__device__ __forceinline__ void xcd_barrier(const XcdBarrier& b) {
    asm volatile("s_waitcnt vmcnt(0)" ::: "memory");
    __syncthreads();
    if (threadIdx.x == 0) {
        unsigned* bar = b.bar;
        __builtin_amdgcn_s_waitcnt(0);
        unsigned nloc = b.st[0], nx = b.st[1];
        if (nloc == 0u) { xcd_barrier_complete(bar, b.x, nloc, nx); b.st[0] = nloc; b.st[1] = nx; }
        const unsigned old = xb_add(&bar[XB_XSUB(b.x)], 1u);
        const unsigned gen = old / nloc;
        if (old + 1u == (gen + 1u) * nloc) {
            __builtin_amdgcn_fence(__ATOMIC_RELEASE, "agent");
            asm volatile("s_waitcnt vmcnt(0)" ::: "memory");
            const unsigned og = xb_add(&bar[XB_TOP], 1u);
            const unsigned tg = og / nx;
            if (og + 1u == (tg + 1u) * nx) xb_add(&bar[XB_TOPGEN], 1u);
            else XB_SPIN(xb_ld(&bar[XB_TOPGEN]) == tg, bar);
            __builtin_amdgcn_fence(__ATOMIC_ACQUIRE, "agent");
            xb_add(&bar[XB_XGEN(b.x)], 1u);
            asm volatile("s_waitcnt vmcnt(0)" ::: "memory");
        } else {
            XB_SPIN(xb_ld(&bar[XB_XGEN(b.x)]) == gen, bar);
            __builtin_amdgcn_fence(__ATOMIC_ACQUIRE, "agent");
            asm volatile("s_waitcnt vmcnt(0)" ::: "memory");
        }
    }
    __syncthreads();
}

__device__ __forceinline__ void group_barrier(unsigned* ctl, int seam, int pm, bool samex) {
    asm volatile("s_waitcnt vmcnt(0)" ::: "memory");
    __syncthreads();
    if (threadIdx.x == 0) {
        unsigned* cnt = ctl + (CTL_GRP / 4) + (seam * 64 + pm) * 64;
        if (!samex) { __builtin_amdgcn_fence(__ATOMIC_RELEASE, "agent"); asm volatile("s_waitcnt vmcnt(0)" ::: "memory"); }
        xb_add(cnt, 1u);
        unsigned sp = 0u;
        while (xb_ld(cnt) < 4u) { __builtin_amdgcn_s_sleep(1); if (++sp > (1u << 22)) break; }
        __builtin_amdgcn_fence(__ATOMIC_ACQUIRE, "agent");
        asm volatile("s_waitcnt vmcnt(0)" ::: "memory");
    }
    __syncthreads();
}
template <int PH>
__device__ __forceinline__ void run_phase(const Params& P, unsigned char* lds, int tid, int lane, int wave) {
    unsigned char* ws = P.ws;
    PG8_LAS unsigned char* glds = (PG8_LAS unsigned char*)lds;
    if constexpr (PH == 0) p0_phase(P, lds, tid, lane, wave);
    if constexpr (PH == 1) {
        pg8::Gemm g{(const bf16*)(ws + WS_XB), (const bf16*)(ws + WS_WIN), MTOK, INW, DM}; pg8::StaticOrder S; S.init(MTOK, INW, gridDim.x, blockIdx.x);
        pg8::EpiStoreBf16 E{(bf16*)(ws + WS_PROJ), INW, (const float*)(ws + WS_RS0)};
        pg8::gemm_phase<pg8::EpiStoreBf16, pg8::StaticOrder, true, true>(glds, g, S, E);
    }
    if constexpr (PH == 2) {
        ret_pass_a(P, lds, tid, lane, wave);
        { const int id = blockIdx.x * 8 + wave; if (id < 2048) s5_wave<false>(P, lds + wave * S5_WLDS, id >> 10, id & 63, (id >> 6) & 15, lane, id); }
    }
    if constexpr (PH == 3) {
        scan_phase(P, tid);
        const int id = blockIdx.x * 8 + wave; if (id < 2048) s5_wave<true>(P, lds + wave * S5_WLDS, id >> 10, id & 63, (id >> 6) & 15, lane, id);
    }
    if constexpr (PH == 5) {
        pg8::Gemm g{(const bf16*)(ws + WS_Y1), (const bf16*)(ws + WS_WGLU), MTOK, SW, SW}; pg8::StaticOrder S; S.init(MTOK, SW, gridDim.x, blockIdx.x);
        pg8::EpiGlu E{(const bf16*)(ws + WS_Y1), P.in[13], P.in[14], (bf16*)(ws + WS_BUFA) + RW, (float*)(ws + WS_SQ2), SW, DM};
        pg8::gemm_phase<pg8::EpiGlu, pg8::StaticOrder, false, true>(glds, g, S, E);
    }
    if constexpr (PH == 6) ret_pass_c(P, lds, tid, lane, wave);
    if constexpr (PH == 7) {
        pg8::Gemm g{(const bf16*)(ws + WS_BUFA), (const bf16*)(ws + WS_WOUT), MTOK, DM, DM}; pg8::StaticOrder S; S.init(MTOK, DM, gridDim.x, blockIdx.x);
        pg8::EpiResB E{nullptr, (const bf16*)(ws + WS_XB), (bf16*)(ws + WS_X1B), DM, (const float*)(ws + WS_SQ2), 1.f / SW, (float*)(ws + WS_SQ1)};
        pg8::gemm_phase<pg8::EpiResB, pg8::StaticOrder, false, true>(glds, g, S, E);
    }
    if constexpr (PH == 9) {
        pg8::Gemm g{(const bf16*)(ws + WS_X1B), (const bf16*)(ws + WS_WGU), MTOK, 2 * DFF, DM}; pg8::StaticOrder S; S.init(MTOK, 2 * DFF, gridDim.x, blockIdx.x);
        pg8::Unit u0; int pm0 = -1; if (S.next(0, u0)) pm0 = u0.pm;
        float* rsl = (float*)(lds + LDS_KEEP + 64);
        if (pm0 >= 0 && tid < 256) { const f32x4* pp = (const f32x4*)((const float*)(ws + WS_SQ1) + (size_t)(pm0 * 256 + tid) * 32); float t = 0.f;
#pragma unroll
            for (int j = 0; j < 8; ++j) { const f32x4 p4 = pp[j]; t += (p4[0] + p4[1]) + (p4[2] + p4[3]); }
            rsl[tid] = rsqrtf(t * (1.f / DM) + EPS); }
        __syncthreads();
        pg8::EpiSwiGlu E{(bf16*)(ws + WS_ACT), DFF, (const float*)(ws + WS_SQ1), 1.f / DM, rsl, pm0};
        pg8::gemm_phase<pg8::EpiSwiGlu, pg8::StaticOrder, true, true>(glds, g, S, E);
    }
    if constexpr (PH == 10) {
        pg8::Gemm g{(const bf16*)(ws + WS_ACT), (const bf16*)(ws + WS_WD), MTOK, DM, DFF}; pg8::StaticOrder S; S.init(MTOK, DM, gridDim.x, blockIdx.x);
        pg8::EpiResB E{nullptr, (const bf16*)(ws + WS_X1B), (bf16*)(ws + WS_BUFA), DM, nullptr, 0.f, nullptr};
        pg8::gemm_phase<pg8::EpiResB, pg8::StaticOrder, false, true>(glds, g, S, E);
    }
    if constexpr (PH == 11) final_norm_phase(P, lane, wave);
}
#define R(k) { int t_ = threadIdx.x; asm volatile("" : "+v"(t_)); run_phase<k>(P, lds, t_, t_ & 63, __builtin_amdgcn_readfirstlane(t_ >> 6)); }
#define BST ((volatile LAS unsigned*)((LAS unsigned char*)lds + LDS_KEEP))
#define S { XcdBarrier b_; b_.bar = (unsigned*)(P.ws + WS_CTL); b_.x = xb_xcc_id(); b_.st = BST; xcd_barrier(b_); }
#define G(k) group_barrier((unsigned*)(P.ws + WS_CTL), k, panel_of((int)blockIdx.x), BST[2] != 0u);
#define PHASE_PROGRAM R(0) S R(1) S R(2) S R(3) S GROUP_CHECK R(5) G(0) R(6) S R(7) G(1) R(9) G(2) R(10) G(3) R(11)
__global__ void __launch_bounds__(512, 2) hybrid_fwd(Params P) {
    extern __shared__ __attribute__((aligned(16))) unsigned char lds[];
    cg::grid_group grid = cg::this_grid();
    const int tid = threadIdx.x, lane = tid & 63, wave = __builtin_amdgcn_readfirstlane(tid >> 6);
    if (P.ws == nullptr) grid.sync();
    if (tid < 3) BST[tid] = 0u;
    __syncthreads();
    { XcdBarrier bar = xcd_barrier_post((unsigned*)(P.ws + WS_CTL), BST); (void)bar; }
    if (tid == 0) __hip_atomic_store((unsigned*)(P.ws + WS_CTL + CTL_XID) + blockIdx.x, xb_xcc_id() + 1u, __ATOMIC_RELAXED, __HIP_MEMORY_SCOPE_AGENT);
#define GROUP_CHECK { unsigned ok_ = 1u; const unsigned* xid_ = (const unsigned*)(P.ws + WS_CTL + CTL_XID); _Pragma("unroll") for (int k_ = 0; k_ < 4; ++k_) ok_ &= (xb_ld((unsigned*)xid_ + ((blockIdx.x & 63) + 64 * k_)) == xb_xcc_id() + 1u) ? 1u : 0u; if (threadIdx.x == 0) BST[2] = ok_; __syncthreads(); }
    PHASE_PROGRAM
}
#undef R
#undef S

extern "C" void kernel_launch(void* const* d_in, const int* in_sizes, int n_in, void* d_out, int out_size, void* d_ws, size_t ws_size, hipStream_t stream) {
    static int grid = 0;
    if (grid == 0) {
        if (n_in != 21 || out_size != MTOK * DM || ws_size < WS_END) { fprintf(stderr, "kernel_launch: unexpected shapes (n_in %d out %d ws %zu)\n", n_in, out_size, ws_size); grid = -1; return; }
        int dev = 0, cus = 0, per_cu = 0;
        (void)hipGetDevice(&dev); (void)hipDeviceGetAttribute(&cus, hipDeviceAttributeMultiprocessorCount, dev);
        if (hipFuncSetAttribute((const void*)hybrid_fwd, hipFuncAttributeMaxDynamicSharedMemorySize, LDS_BYTES) != hipSuccess) { fprintf(stderr, "kernel_launch: hipFuncSetAttribute failed\n"); grid = -1; return; }
        if (hipOccupancyMaxActiveBlocksPerMultiprocessor(&per_cu, (const void*)hybrid_fwd, 512, LDS_BYTES) != hipSuccess || per_cu < 1) { fprintf(stderr, "kernel_launch: occupancy query says %d\n", per_cu); per_cu = 1; }
        (void)hipGetLastError();
        grid = cus * 1;
        if (grid != 256) { fprintf(stderr, "kernel_launch: built for a 256-CU device (got %d)\n", cus); grid = -1; return; }
    }
    if (grid < 0) return;
    Params p{};
    for (int i = 0; i < 21; ++i) p.in[i] = (const float*)d_in[i];
    p.out = (float*)d_out; p.ws = (unsigned char*)d_ws;
    if (hipMemsetAsync((unsigned char*)d_ws + WS_CTL, 0, CTL_ZERO, stream) != hipSuccess) { fprintf(stderr, "kernel_launch: memset of the barrier words failed\n"); return; }
    void* args[] = {&p};
    hipError_t e = hipLaunchCooperativeKernel((const void*)hybrid_fwd, dim3(grid), dim3(512), args, LDS_BYTES, stream);
    if (e != hipSuccess) fprintf(stderr, "cooperative launch failed: %s (grid %d)\n", hipGetErrorString(e), grid);
}
```

```cpp
#include <hip/hip_runtime.h>
#include <hip/hip_cooperative_groups.h>
#include <cstdio>
#include <cstdint>
namespace cg = cooperative_groups;
namespace pg8 {
#define PG8_LAS __attribute__((address_space(3)))
typedef unsigned short bf16_t;
typedef short bf16x8 __attribute__((ext_vector_type(8)));
typedef float f32x4 __attribute__((ext_vector_type(4)));
typedef unsigned u32x4 __attribute__((ext_vector_type(4)));
constexpr int BM = 256, BK = 64, HALF = 128, HTB = HALF * BK * 2  , STAGE_BYTES = 8 * HTB, NXCD = 8, WGM = 8;

__host__ __device__ __forceinline__ int lds_byte(int r, int c) { const int st = (r >> 4) * 2 + (c >> 5), rr = r & 15, cc = c & 31, ob = rr * 64 + cc * 2; return st * 1024 + (ob ^ (((ob >> 9) & 1) << 5)); }
__host__ __device__ __forceinline__ void stage_rc(int b, int& R, int& C) { const int st = b / 1024, sb = b % 1024, swz = sb ^ (((sb >> 9) & 1) << 5); R = (st >> 1) * 16 + swz / 64; C = (st & 1) * 32 + (swz % 64) / 2; }
__host__ __device__ __forceinline__ int perm32(int rho) { const int n = rho >> 4, i = rho & 15; return 8 * (i >> 2) + 4 * n + (i & 3); }

struct Unit { int pm, pn; };
struct Gemm { const bf16_t* A; const bf16_t* Bt; int M, N, K; };

struct StaticOrder {
    int nM, nN, nwg, G, c;
    __host__ __device__ void init(int M, int N, int G_, int c_) { nM = M / BM; nN = N / BM; nwg = nM * nN; G = G_; c = c_; }
    __host__ __device__ bool next(int i, Unit& u) const {
        const long L = (long)i * G + c; if (L >= nwg) return false;
        int wgid = (int)L; { const int q = nwg / NXCD, r = nwg % NXCD, xcd = wgid % NXCD, off = wgid / NXCD; wgid = (xcd < r ? xcd * (q + 1) : r * (q + 1) + (xcd - r) * q) + off; }
        const int nig = WGM * nN, gid = wgid / nig, fm = gid * WGM, gsz = (nM - fm) < WGM ? (nM - fm) : WGM;
        u.pm = fm + ((wgid % nig) % gsz); u.pn = (wgid % nig) / gsz; return true;
    }
    __device__ __forceinline__ void a_ready(const Unit&) const {}
    __device__ __forceinline__ void done(const Unit&) const {}
};

typedef __bf16 bf16x2_t __attribute__((ext_vector_type(2)));
__device__ __forceinline__ unsigned cvt_pk_bf16(float lo, float hi) { bf16x2_t v = {(__bf16)lo, (__bf16)hi}; return __builtin_bit_cast(unsigned, v); }
__device__ __forceinline__ float bf_lo(unsigned w) { return __uint_as_float(w << 16); }
__device__ __forceinline__ float bf_hi(unsigned w) { return __uint_as_float(w & 0xffff0000u); }
typedef unsigned u32x2v __attribute__((ext_vector_type(2)));
__device__ __forceinline__ float sigmoid_f(float z) { return __builtin_amdgcn_rcpf(1.0f + __expf(-z)); }

struct EpiStoreBf16 {
    static constexpr bool PERM = true, AFTER_DRAIN = false;
    bf16_t* O; int ldc; const float* rs;
    __device__ __forceinline__ void operator()(const f32x4 (&acc)[2][2][4][2], const Unit& u, int wr, int wc, int fr, int fq) const {
        const int row0 = u.pm * BM + wr * 64 + fr, col0 = u.pn * BM + wc * 32 + 8 * fq;
        float rv[2][4];
#pragma unroll
        for (int ai = 0; ai < 2; ++ai)
#pragma unroll
            for (int m = 0; m < 4; ++m) rv[ai][m] = rs[row0 + ai * HALF + m * 16];
#pragma unroll
        for (int ai = 0; ai < 2; ++ai)
#pragma unroll
            for (int m = 0; m < 4; ++m) { bf16_t* rowp = O + (size_t)(row0 + ai * HALF + m * 16) * ldc + col0;
#pragma unroll
                for (int bj = 0; bj < 2; ++bj) { const f32x4 v0 = acc[ai][bj][m][0] * rv[ai][m], v1 = acc[ai][bj][m][1] * rv[ai][m];
                    u32x4 w; w.x = cvt_pk_bf16(v0[0], v0[1]); w.y = cvt_pk_bf16(v0[2], v0[3]); w.z = cvt_pk_bf16(v1[0], v1[1]); w.w = cvt_pk_bf16(v1[2], v1[3]);
                    *(u32x4*)(rowp + bj * HALF) = w; } }
    }
};
struct EpiGlu {
    static constexpr bool PERM = true, AFTER_DRAIN = false;
    const bf16_t* Y1; const float* bias; const float* gain; bf16_t* Y2; float* rowsq; int ldc, ldo;
    __device__ __forceinline__ void operator()(const f32x4 (&acc)[2][2][4][2], const Unit& u, int wr, int wc, int fr, int fq) const {
        const int row0 = u.pm * BM + wr * 64 + fr, col0 = u.pn * BM + wc * 32 + 8 * fq;
        f32x4 bv[2][2], gv[2][2];
#pragma unroll
        for (int bj = 0; bj < 2; ++bj)
#pragma unroll
            for (int n = 0; n < 2; ++n) { bv[bj][n] = *(const f32x4*)(bias + col0 + bj * HALF + 4 * n); gv[bj][n] = *(const f32x4*)(gain + col0 + bj * HALF + 4 * n); }
#pragma unroll
        for (int ai = 0; ai < 2; ++ai) {
            u32x4 yv[4][2];
#pragma unroll
            for (int m = 0; m < 4; ++m)
#pragma unroll
                for (int bj = 0; bj < 2; ++bj) yv[m][bj] = *(const u32x4*)(Y1 + (size_t)(row0 + ai * HALF + m * 16) * ldc + col0 + bj * HALF);
#pragma unroll
            for (int m = 0; m < 4; ++m) { const int row = row0 + ai * HALF + m * 16; const size_t offo = (size_t)row * ldo + col0;
                float ss = 0.f;
#pragma unroll
                for (int bj = 0; bj < 2; ++bj) { const f32x4 z0 = acc[ai][bj][m][0] + bv[bj][0], z1 = acc[ai][bj][m][1] + bv[bj][1];
                    const u32x4 y = yv[m][bj];
                    f32x4 r0, r1;
                    r0[0] = bf_lo(y.x) * sigmoid_f(z0[0]); r0[1] = bf_hi(y.x) * sigmoid_f(z0[1]); r0[2] = bf_lo(y.y) * sigmoid_f(z0[2]); r0[3] = bf_hi(y.y) * sigmoid_f(z0[3]);
                    r1[0] = bf_lo(y.z) * sigmoid_f(z1[0]); r1[1] = bf_hi(y.z) * sigmoid_f(z1[1]); r1[2] = bf_lo(y.w) * sigmoid_f(z1[2]); r1[3] = bf_hi(y.w) * sigmoid_f(z1[3]);
                    ss += (r0[0] * r0[0] + r0[1] * r0[1]) + (r0[2] * r0[2] + r0[3] * r0[3]) + (r1[0] * r1[0] + r1[1] * r1[1]) + (r1[2] * r1[2] + r1[3] * r1[3]);
                    r0 = r0 * gv[bj][0]; r1 = r1 * gv[bj][1];
                    u32x4 w; w.x = cvt_pk_bf16(r0[0], r0[1]); w.y = cvt_pk_bf16(r0[2], r0[3]); w.z = cvt_pk_bf16(r1[0], r1[1]); w.w = cvt_pk_bf16(r1[2], r1[3]);
                    *(u32x4*)(Y2 + offo + bj * HALF) = w; }
                ss += __shfl_xor(ss, 16); ss += __shfl_xor(ss, 32);
                if (fq == 0) rowsq[(size_t)row * 16 + u.pn * 4 + wc] = ss; }
        }
    }
};
struct EpiResF32 {
    static constexpr bool PERM = false, AFTER_DRAIN = false;
    const float* X; float* O; int ldc; const float* insq; float inv_indim; bf16_t* OB; float* outsq;
    __device__ __forceinline__ void operator()(const f32x4 (&acc)[2][2][4][2], const Unit& u, int wr, int wc, int fr, int fq) const {
        const int row0 = u.pm * BM + wr * 64 + fr, col0 = u.pn * BM + wc * 32 + 4 * fq;
#pragma unroll
        for (int ai = 0; ai < 2; ++ai)
#pragma unroll
        for (int mh = 0; mh < 2; ++mh) {
            f32x4 xv[2][2][2]; f32x4 p4[2];
#pragma unroll
            for (int mm = 0; mm < 2; ++mm) { const int row = row0 + ai * HALF + (2 * mh + mm) * 16; const size_t off = (size_t)row * ldc + col0;
                p4[mm] = insq ? *(const f32x4*)(insq + (size_t)row * 16 + 4 * fq) : (f32x4){0.f, 0.f, 0.f, 0.f};
#pragma unroll
                for (int bj = 0; bj < 2; ++bj)
#pragma unroll
                    for (int n = 0; n < 2; ++n) xv[mm][bj][n] = *(const f32x4*)(X + off + bj * HALF + n * 16); }
#pragma unroll
            for (int mm = 0; mm < 2; ++mm) { const int m = 2 * mh + mm; const int row = row0 + ai * HALF + m * 16; const size_t off = (size_t)row * ldc + col0;
                float sc = 1.0f;
                if (insq) { float t = (p4[mm][0] + p4[mm][1]) + (p4[mm][2] + p4[mm][3]); t += __shfl_xor(t, 16); t += __shfl_xor(t, 32); sc = rsqrtf(t * inv_indim + 1e-6f); }
                float ss = 0.f;
#pragma unroll
                for (int bj = 0; bj < 2; ++bj)
#pragma unroll
                    for (int n = 0; n < 2; ++n) { const f32x4 o = xv[mm][bj][n] + acc[ai][bj][m][n] * sc;
                        *(f32x4*)(O + off + bj * HALF + n * 16) = o;
                        if (OB) { ss += (o[0] * o[0] + o[1] * o[1]) + (o[2] * o[2] + o[3] * o[3]); u32x2v w; w.x = cvt_pk_bf16(o[0], o[1]); w.y = cvt_pk_bf16(o[2], o[3]); *(u32x2v*)(OB + off + bj * HALF + n * 16) = w; } }
                if (OB) { ss += __shfl_xor(ss, 16); ss += __shfl_xor(ss, 32); if (fq == 0) outsq[(size_t)row * 32 + u.pn * 4 + wc] = ss; } }
        }
    }
};
struct EpiResB {
    static constexpr bool PERM = true, AFTER_DRAIN = false;
    const float* X; const bf16_t* XB; bf16_t* OB; int ldc; const float* insq; float inv_indim; float* outsq;
    __device__ __forceinline__ void operator()(const f32x4 (&acc)[2][2][4][2], const Unit& u, int wr, int wc, int fr, int fq) const {
        const int row0 = u.pm * BM + wr * 64 + fr, col0 = u.pn * BM + wc * 32 + 8 * fq;
#pragma unroll
        for (int ai = 0; ai < 2; ++ai)
#pragma unroll
        for (int mh = 0; mh < 2; ++mh) {
            f32x4 xv[2][2][2]; f32x4 p4[2];
#pragma unroll
            for (int mm = 0; mm < 2; ++mm) { const int row = row0 + ai * HALF + (2 * mh + mm) * 16; const size_t off = (size_t)row * ldc + col0;
                p4[mm] = insq ? *(const f32x4*)(insq + (size_t)row * 16 + 4 * fq) : (f32x4){0.f, 0.f, 0.f, 0.f};
#pragma unroll
                for (int bj = 0; bj < 2; ++bj) {
                    if (XB) { const u32x4 y = *(const u32x4*)(XB + off + bj * HALF); xv[mm][bj][0] = (f32x4){bf_lo(y.x), bf_hi(y.x), bf_lo(y.y), bf_hi(y.y)}; xv[mm][bj][1] = (f32x4){bf_lo(y.z), bf_hi(y.z), bf_lo(y.w), bf_hi(y.w)}; }
                    else { xv[mm][bj][0] = *(const f32x4*)(X + off + bj * HALF); xv[mm][bj][1] = *(const f32x4*)(X + off + bj * HALF + 4); } } }
#pragma unroll
            for (int mm = 0; mm < 2; ++mm) { const int m = 2 * mh + mm; const int row = row0 + ai * HALF + m * 16; const size_t off = (size_t)row * ldc + col0;
                float sc = 1.0f;
                if (insq) { float t = (p4[mm][0] + p4[mm][1]) + (p4[mm][2] + p4[mm][3]); t += __shfl_xor(t, 16); t += __shfl_xor(t, 32); sc = rsqrtf(t * inv_indim + 1e-6f); }
                float ss = 0.f;
#pragma unroll
                for (int bj = 0; bj < 2; ++bj) { const f32x4 o0 = xv[mm][bj][0] + acc[ai][bj][m][0] * sc, o1 = xv[mm][bj][1] + acc[ai][bj][m][1] * sc;
                    ss += ((o0[0] * o0[0] + o0[1] * o0[1]) + (o0[2] * o0[2] + o0[3] * o0[3])) + ((o1[0] * o1[0] + o1[1] * o1[1]) + (o1[2] * o1[2] + o1[3] * o1[3]));
                    u32x4 w; w.x = cvt_pk_bf16(o0[0], o0[1]); w.y = cvt_pk_bf16(o0[2], o0[3]); w.z = cvt_pk_bf16(o1[0], o1[1]); w.w = cvt_pk_bf16(o1[2], o1[3]);
                    *(u32x4*)(OB + off + bj * HALF) = w; }
                if (outsq) { ss += __shfl_xor(ss, 16); ss += __shfl_xor(ss, 32); if (fq == 0) outsq[(size_t)row * 32 + u.pn * 4 + wc] = ss; } }
        }
    }
};
struct EpiSwiGlu {
    static constexpr bool PERM = true, AFTER_DRAIN = false;
    bf16_t* O; int ldc; const float* insq; float inv_indim; const float* rs_lds; int pm_lds;
    __device__ __forceinline__ void operator()(const f32x4 (&acc)[2][2][4][2], const Unit& u, int wr, int wc, int fr, int fq) const {
        const int row0 = u.pm * BM + wr * 64 + fr, col0 = u.pn * HALF + wc * 32 + 8 * fq;
        float scv[2][4];
        if (u.pm == pm_lds) {
#pragma unroll
          for (int ai = 0; ai < 2; ++ai)
#pragma unroll
              for (int m = 0; m < 4; ++m) scv[ai][m] = rs_lds[wr * 64 + fr + ai * HALF + m * 16];
        } else { f32x4 pa[2][4], pb[2][4];
#pragma unroll
          for (int ai = 0; ai < 2; ++ai)
#pragma unroll
              for (int m = 0; m < 4; ++m) { const float* pp = insq + (size_t)(row0 + ai * HALF + m * 16) * 32 + 8 * fq; pa[ai][m] = *(const f32x4*)pp; pb[ai][m] = *(const f32x4*)(pp + 4); }
#pragma unroll
          for (int ai = 0; ai < 2; ++ai)
#pragma unroll
              for (int m = 0; m < 4; ++m) { float t = ((pa[ai][m][0] + pa[ai][m][1]) + (pa[ai][m][2] + pa[ai][m][3])) + ((pb[ai][m][0] + pb[ai][m][1]) + (pb[ai][m][2] + pb[ai][m][3]));
                  t += __shfl_xor(t, 16); t += __shfl_xor(t, 32); scv[ai][m] = rsqrtf(t * inv_indim + 1e-6f); } }
#pragma unroll
        for (int ai = 0; ai < 2; ++ai)
#pragma unroll
            for (int m = 0; m < 4; ++m) { const int row = row0 + ai * HALF + m * 16; bf16_t* rowp = O + (size_t)row * ldc + col0;
                const float sc = scv[ai][m];
                f32x4 r0, r1;
#pragma unroll
                for (int j = 0; j < 4; ++j) { const float g0 = acc[ai][0][m][0][j] * sc, g1 = acc[ai][0][m][1][j] * sc;
                    r0[j] = g0 * sigmoid_f(g0) * (acc[ai][1][m][0][j] * sc); r1[j] = g1 * sigmoid_f(g1) * (acc[ai][1][m][1][j] * sc); }
                u32x4 w; w.x = cvt_pk_bf16(r0[0], r0[1]); w.y = cvt_pk_bf16(r0[2], r0[3]); w.z = cvt_pk_bf16(r1[0], r1[1]); w.w = cvt_pk_bf16(r1[2], r1[3]);
                *(u32x4*)rowp = w; }
    }
};


template <class Epi, class Sched, bool ALIGN_EPI = false, bool SP2 = false>
__device__ __forceinline__ void gemm_phase(PG8_LAS unsigned char* lds, const Gemm g, const Sched& S, const Epi& E) {
    int tid_ = threadIdx.x; asm volatile("" : "+v"(tid_));
    const int tid = tid_, wid = __builtin_amdgcn_readfirstlane(tid >> 6), lane = tid & 63, wr = wid >> 2, wc = wid & 3, fr = lane & 15, fq = lane >> 4;
    const int K = g.K, nt = K / BK;
    unsigned voffA[2], voffB[2];
#pragma unroll
    for (int i = 0; i < 2; ++i) { int R, C; stage_rc(tid * 16 + i * 8192, R, C); const int Rb = Epi::PERM ? ((R & ~31) + perm32(R & 31)) : R;
        voffA[i] = (unsigned)(R * K + C) * 2u; voffB[i] = (unsigned)(Rb * K + C) * 2u; }
    const size_t kstep = (size_t)(BK * 2);
    const size_t hstep = (size_t)HALF * K * 2;
    const size_t tstep = 2 * hstep;
    const unsigned ldsw = (unsigned)wid * 1024u;
    const int aoff = lds_byte(wr * 64 + fr, fq * 8), boff = lds_byte(wc * 32 + fr, fq * 8);
#define PG8_SA(b, h) (((b) * 2 + (h)) * HTB)
#define PG8_SB(b, h) ((4 + (b) * 2 + (h)) * HTB)
#define PG8_STAGE(bufoff, gbase, voff) do { _Pragma("unroll") for (int _i = 0; _i < 2; ++_i) \
        __builtin_amdgcn_global_load_lds((const unsigned*)((const char*)(gbase) + (voff)[_i]), (PG8_LAS unsigned*)(lds + (bufoff) + ldsw + _i * 8192), 16, 0, 0); } while (0)
#define PG8_LDA(dst, b, h) do { _Pragma("unroll") for (int m = 0; m < 4; ++m) _Pragma("unroll") for (int k = 0; k < 2; ++k) dst[m][k] = *(const PG8_LAS bf16x8*)(lds + PG8_SA(b, h) + aoff + m * 2048 + k * 1024); } while (0)
#define PG8_LDB(dst, b, h) do { _Pragma("unroll") for (int n = 0; n < 2; ++n) _Pragma("unroll") for (int k = 0; k < 2; ++k) dst[n][k] = *(const PG8_LAS bf16x8*)(lds + PG8_SB(b, h) + boff + n * 2048 + k * 1024); } while (0)
#define PG8_MMA(ai, bj, At, Bt) do { __builtin_amdgcn_s_setprio(1); _Pragma("unroll") for (int m = 0; m < 4; ++m) _Pragma("unroll") for (int n = 0; n < 2; ++n) _Pragma("unroll") for (int k = 0; k < 2; ++k) \
        acc[ai][bj][m][n] = __builtin_amdgcn_mfma_f32_16x16x32_bf16(Bt[n][k], At[m][k], acc[ai][bj][m][n], 0, 0, 0); __builtin_amdgcn_s_setprio(0); } while (0)
#define PG8_WAIT_V(n) asm volatile("s_waitcnt vmcnt(" #n ")" ::: "memory")
#define PG8_WAIT_L(n) asm volatile("s_waitcnt lgkmcnt(" #n ")" ::: "memory")
#define PG8_BAR __builtin_amdgcn_s_barrier()
#define PG8_SCHED __builtin_amdgcn_sched_barrier(0)
    Unit cur, nxt; int ui = 0;
    if (!S.next(0, cur)) return;
    f32x4 acc[2][2][4][2];
#pragma unroll
    for (int a = 0; a < 2; ++a)
#pragma unroll
        for (int b = 0; b < 2; ++b)
#pragma unroll
            for (int m = 0; m < 4; ++m)
#pragma unroll
                for (int n = 0; n < 2; ++n) acc[a][b][m][n] = (f32x4){0.f, 0.f, 0.f, 0.f};
    bf16x8 At[4][2], B0[2][2], B1[2][2];
    const char* cA = (const char*)g.A + (size_t)cur.pm * tstep; const char* cB = (const char*)g.Bt + (size_t)cur.pn * tstep;
    S.a_ready(cur);
    if constexpr (SP2) {
        PG8_STAGE(PG8_SB(0, 0), cB, voffB); PG8_STAGE(PG8_SB(0, 1), cB + hstep, voffB); PG8_STAGE(PG8_SA(0, 0), cA, voffA); PG8_STAGE(PG8_SA(0, 1), cA + hstep, voffA);
        if (wr == 1) PG8_BAR;
        PG8_WAIT_V(2); PG8_BAR;
        PG8_STAGE(PG8_SB(1, 0), cB + kstep, voffB); PG8_STAGE(PG8_SA(1, 0), cA + kstep, voffA); PG8_STAGE(PG8_SB(1, 1), cB + hstep + kstep, voffB);
        PG8_WAIT_V(6); PG8_BAR;
    } else {
        PG8_STAGE(PG8_SB(0, 0), cB, voffB); PG8_STAGE(PG8_SA(0, 0), cA, voffA); PG8_STAGE(PG8_SB(0, 1), cB + hstep, voffB); PG8_STAGE(PG8_SA(0, 1), cA + hstep, voffA);
        if (wr == 1) PG8_BAR;
        PG8_WAIT_V(4); PG8_BAR;
        PG8_STAGE(PG8_SB(1, 0), cB + kstep, voffB); PG8_STAGE(PG8_SA(1, 0), cA + kstep, voffA); PG8_STAGE(PG8_SB(1, 1), cB + hstep + kstep, voffB);
        PG8_WAIT_V(6); PG8_BAR;
    }
    for (;;) {
        const bool has_next = S.next(ui + 1, nxt);
        const char* nA = has_next ? (const char*)g.A + (size_t)nxt.pm * tstep : cA; const char* nB = has_next ? (const char*)g.Bt + (size_t)nxt.pn * tstep : cB;
        for (int t = 0; t < nt; t += 2) {
            const bool last = (t == nt - 2);
            const char* a1 = cA + (size_t)(t + 1) * kstep;
            const char* a2 = last ? nA : cA + (size_t)(t + 2) * kstep; const char* b2 = last ? nB : cB + (size_t)(t + 2) * kstep;
            const char* a3 = a2 + kstep; const char* b3 = b2 + kstep;
            if (last && has_next) S.a_ready(nxt);
            if constexpr (SP2) {
            PG8_LDB(B0, 0, 0); PG8_LDB(B1, 0, 1); PG8_SCHED; PG8_LDA(At, 0, 0); PG8_STAGE(PG8_SA(1, 1), a1 + hstep, voffA);
            PG8_WAIT_V(8); PG8_WAIT_L(0); PG8_BAR; PG8_MMA(0, 0, At, B0); PG8_MMA(0, 1, At, B1); PG8_BAR; PG8_SCHED;
            PG8_LDA(At, 0, 1); PG8_STAGE(PG8_SB(0, 0), b2, voffB); PG8_STAGE(PG8_SB(0, 1), b2 + hstep, voffB); PG8_STAGE(PG8_SA(0, 0), a2, voffA);
            PG8_WAIT_V(8); PG8_WAIT_L(0); PG8_BAR; PG8_MMA(1, 0, At, B0); PG8_MMA(1, 1, At, B1); PG8_BAR; PG8_SCHED;
            PG8_LDB(B0, 1, 0); PG8_LDB(B1, 1, 1); PG8_SCHED; PG8_LDA(At, 1, 0); PG8_STAGE(PG8_SA(0, 1), a2 + hstep, voffA);
            PG8_WAIT_V(8); PG8_WAIT_L(0); PG8_BAR; PG8_MMA(0, 0, At, B0); PG8_MMA(0, 1, At, B1); PG8_BAR; PG8_SCHED;
            PG8_LDA(At, 1, 1); PG8_STAGE(PG8_SB(1, 0), b3, voffB); PG8_STAGE(PG8_SB(1, 1), b3 + hstep, voffB); PG8_STAGE(PG8_SA(1, 0), a3, voffA);
            PG8_WAIT_V(8); PG8_WAIT_L(0); PG8_BAR; PG8_MMA(1, 0, At, B0); PG8_MMA(1, 1, At, B1); PG8_BAR; PG8_SCHED;
            } else {
            PG8_LDB(B0, 0, 0); PG8_SCHED; PG8_LDA(At, 0, 0); PG8_STAGE(PG8_SA(1, 1), a1 + hstep, voffA);
            PG8_WAIT_L(8); PG8_BAR; PG8_WAIT_L(0); PG8_MMA(0, 0, At, B0); PG8_BAR; PG8_SCHED;
            PG8_LDB(B1, 0, 1); PG8_STAGE(PG8_SB(0, 0), b2, voffB);
            PG8_BAR; PG8_WAIT_L(0); PG8_MMA(0, 1, At, B1); PG8_BAR;
            PG8_LDA(At, 0, 1); PG8_STAGE(PG8_SA(0, 0), a2, voffA);
            PG8_BAR; PG8_WAIT_L(0); PG8_MMA(1, 0, At, B0); PG8_BAR; PG8_SCHED;
            PG8_STAGE(PG8_SB(0, 1), b2 + hstep, voffB);
            PG8_WAIT_V(6); PG8_BAR; PG8_MMA(1, 1, At, B1); PG8_BAR;
            PG8_LDB(B0, 1, 0); PG8_SCHED; PG8_LDA(At, 1, 0); PG8_STAGE(PG8_SA(0, 1), a2 + hstep, voffA);
            PG8_WAIT_L(8); PG8_BAR; PG8_WAIT_L(0); PG8_MMA(0, 0, At, B0); PG8_BAR; PG8_SCHED;
            PG8_LDB(B1, 1, 1); PG8_STAGE(PG8_SB(1, 0), b3, voffB);
            PG8_BAR; PG8_WAIT_L(0); PG8_MMA(0, 1, At, B1); PG8_BAR;
            PG8_LDA(At, 1, 1); PG8_STAGE(PG8_SA(1, 0), a3, voffA);
            PG8_BAR; PG8_WAIT_L(0); PG8_MMA(1, 0, At, B0); PG8_BAR; PG8_SCHED;
            PG8_STAGE(PG8_SB(1, 1), b3 + hstep, voffB);
            PG8_WAIT_V(6); PG8_BAR; PG8_MMA(1, 1, At, B1); PG8_BAR;
            }
        }
        if constexpr (ALIGN_EPI) { if (wr == 0) PG8_BAR; }
        if constexpr (!Epi::AFTER_DRAIN) { E(acc, cur, wr, wc, fr, fq); S.done(cur); }
        if (!has_next) break;
#pragma unroll
        for (int a = 0; a < 2; ++a)
#pragma unroll
            for (int b = 0; b < 2; ++b)
#pragma unroll
                for (int m = 0; m < 4; ++m)
#pragma unroll
                    for (int n = 0; n < 2; ++n) acc[a][b][m][n] = (f32x4){0.f, 0.f, 0.f, 0.f};
        cur = nxt; cA = nA; cB = nB; ++ui;
        if constexpr (ALIGN_EPI) { if (wr == 1) PG8_BAR; }
    }
    PG8_WAIT_V(0);
    if constexpr (!ALIGN_EPI) { if (wr == 0) PG8_BAR; }
    PG8_BAR;
    if constexpr (Epi::AFTER_DRAIN) { E.fused(acc, cur, wr, wc, fr, fq, lds, wid, lane); S.done(cur); }
#undef PG8_SA
#undef PG8_SB
#undef PG8_STAGE
#undef PG8_LDA
#undef PG8_LDB
#undef PG8_MMA
#undef PG8_WAIT_V
#undef PG8_WAIT_L
#undef PG8_BAR
#undef PG8_SCHED
}
}

typedef unsigned short bf16;
typedef short bf16x8 __attribute__((ext_vector_type(8)));
typedef float f32x4 __attribute__((ext_vector_type(4)));
typedef float f32x2 __attribute__((ext_vector_type(2)));
typedef float f32x16 __attribute__((ext_vector_type(16)));
typedef unsigned u32x4 __attribute__((ext_vector_type(4)));
typedef unsigned u32x2 __attribute__((ext_vector_type(2)));

constexpr int DM = 2048, SEQ = 8192, MTOK = 16384, INW = 5120, RW = 1024, NH = 8, HD = 128, SW = 1024, NG = 64, NP = 64, DFF = 5632;
constexpr float EPS = 1e-6f;
constexpr size_t MiB = 1u << 20;
constexpr size_t WS_WIN = 0, WS_WGLU = 20 * MiB, WS_WOUT = 22 * MiB, WS_WGU = 30 * MiB, WS_WD = 74 * MiB, WS_ROPE = 96 * MiB, WS_S5P = 100 * MiB, WS_S5ST = 101 * MiB,
                 WS_BUFA = 102 * MiB, WS_PROJ = 166 * MiB, WS_KV = 326 * MiB, WS_XB = 390 * MiB, WS_CTL = 454 * MiB, WS_SQ1 = 455 * MiB, WS_SQ2 = 457 * MiB, WS_TOT = 458 * MiB, WS_Y1 = 466 * MiB, WS_RS0 = 498 * MiB, WS_END = 499 * MiB, WS_ACT = WS_PROJ, WS_X1B = WS_XB, WS_Y2 = WS_Y1;
constexpr size_t CTL_XID = 16384, CTL_GRP = 32768, CTL_ZERO = 131072;
constexpr size_t S5P_BBT = 0, S5P_CMT = 256 * 1024, S5P_LAM = 512 * 1024, S5P_LAML = 544 * 1024;
constexpr int LDS_BYTES = 137216, LDS_KEEP = 135168, S5_WLDS = 16896;
constexpr int NPHASE = 12;

__device__ __forceinline__ int panel_of(int c) { return 8 * (c & 7) + ((c >> 3) & 7); }

struct Params { const float* in[21]; float* out; unsigned char* ws; };

#define MFMA32(a, b, c) __builtin_amdgcn_mfma_f32_32x32x16_bf16((a), (b), (c), 0, 0, 0)
#define MFMA16(a, b, c) __builtin_amdgcn_mfma_f32_16x16x32_bf16((a), (b), (c), 0, 0, 0)
#define LDS_FENCE() asm volatile("s_waitcnt lgkmcnt(0)" ::: "memory")

__device__ __forceinline__ float bflo(unsigned w) { return __uint_as_float(w << 16); }
__device__ __forceinline__ float bfhi(unsigned w) { return __uint_as_float(w & 0xffff0000u); }
__device__ __forceinline__ unsigned pk2(float lo, float hi) { return pg8::cvt_pk_bf16(lo, hi); }
__device__ __forceinline__ float wave_sum(float v) {
#pragma unroll
    for (int o = 1; o < 64; o <<= 1) v += __shfl_xor(v, o);
    return v;
}
__device__ __forceinline__ void sincos_d(double x, double& s, double& c) {
    const double k = rint(x * 0.63661977236758134308);
    double r = fma(-k, 1.57079632679489655800e+00, x); r = fma(-k, 6.12323399573676603587e-17, r);
    const int q = ((int)(long long)k) & 3;
    const double r2 = r * r;
    const double sn = r * (1.0 + r2 * (-1.0 / 6.0 + r2 * (1.0 / 120.0 + r2 * (-1.0 / 5040.0 + r2 * (1.0 / 362880.0 + r2 * (-1.0 / 39916800.0 + r2 * (1.0 / 6227020800.0 + r2 * (-1.0 / 1307674368000.0))))))));
    const double cs = 1.0 + r2 * (-0.5 + r2 * (1.0 / 24.0 + r2 * (-1.0 / 720.0 + r2 * (1.0 / 40320.0 + r2 * (-1.0 / 3628800.0 + r2 * (1.0 / 479001600.0 + r2 * (-1.0 / 87178291200.0 + r2 * (1.0 / 20922789888000.0))))))));
    s = (q == 0) ? sn : (q == 1) ? cs : (q == 2) ? -sn : -cs;
    c = (q == 0) ? cs : (q == 1) ? -sn : (q == 2) ? -cs : sn;
}

__device__ __forceinline__ void p0_transpose_item(const float* W, int K, int N, bf16* WT, int k0, int n0, int dst_row0, float* scr, int lane, const float* kscale = nullptr) {
#pragma unroll 8
    for (int i = 0; i < 32; ++i) { const int kk = 2 * i + (lane >> 5); scr[kk * 33 + (lane & 31)] = __builtin_nontemporal_load(W + (size_t)(k0 + kk) * N + n0 + (lane & 31)); }
    const int c = lane & 7;
    f32x4 ks0 = (f32x4){1.f, 1.f, 1.f, 1.f}, ks1 = ks0;
    if (kscale) { ks0 = *(const f32x4*)(kscale + k0 + 8 * c); ks1 = *(const f32x4*)(kscale + k0 + 8 * c + 4); }
    LDS_FENCE();
#pragma unroll
    for (int j = 0; j < 4; ++j) { const int n = (lane >> 3) + 8 * j; const float* s = scr + (8 * c) * 33 + n;
        u32x4 o; o.x = pk2(s[0 * 33] * ks0.x, s[1 * 33] * ks0.y); o.y = pk2(s[2 * 33] * ks0.z, s[3 * 33] * ks0.w); o.z = pk2(s[4 * 33] * ks1.x, s[5 * 33] * ks1.y); o.w = pk2(s[6 * 33] * ks1.z, s[7 * 33] * ks1.w);
        *(u32x4*)(WT + (size_t)(dst_row0 + n) * K + k0 + 8 * c) = o; }
    LDS_FENCE();
}
__device__ __forceinline__ void rms_row_to_bf16(const float* xrow, const float* g, bf16* orow, int lane) {
    const f32x4* xr = (const f32x4*)xrow + lane; const f32x4* gr = (const f32x4*)g + lane;
    f32x4 v[8]; float s = 0.f;
#pragma unroll
    for (int j = 0; j < 8; ++j) { v[j] = xr[64 * j]; s += (v[j].x * v[j].x + v[j].y * v[j].y) + (v[j].z * v[j].z + v[j].w * v[j].w); }
    const float r = rsqrtf(wave_sum(s) * (1.f / DM) + EPS);
    u32x2* o8 = (u32x2*)orow + lane;
#pragma unroll
    for (int j = 0; j < 8; ++j) { const f32x4 gg = gr[64 * j]; u32x2 w; w.x = pk2(v[j].x * r * gg.x, v[j].y * r * gg.y); w.y = pk2(v[j].z * r * gg.z, v[j].w * r * gg.w); o8[64 * j] = w; }
}
__device__ __forceinline__ void p0_phase(const Params& P, unsigned char* lds, int tid, int lane, int wave) {
    unsigned char* ws = P.ws;
    const int gw = blockIdx.x * 8 + wave, NGW = gridDim.x * 8;
    float* scr = (float*)(lds + wave * 16384);
    constexpr int I_IN = 32 * 160;
    for (int it = gw; it < I_IN; it += NGW) { const int kb = it / 160, nb = it % 160; p0_transpose_item(P.in[2], DM, INW, (bf16*)(ws + WS_WIN), kb * 64, nb * 32, nb * 32, scr, lane, P.in[1]); }
    for (int m = gw; m < MTOK; m += NGW) {
        const f32x4* xr = (const f32x4*)(P.in[0] + (size_t)m * DM) + lane; u32x2* o8 = (u32x2*)((bf16*)(ws + WS_XB) + (size_t)m * DM) + lane;
        f32x4 v[8]; float ss = 0.f;
#pragma unroll
        for (int j = 0; j < 8; ++j) { v[j] = __builtin_nontemporal_load(xr + 64 * j); ss += (v[j].x * v[j].x + v[j].y * v[j].y) + (v[j].z * v[j].z + v[j].w * v[j].w); }
#pragma unroll
        for (int j = 0; j < 8; ++j) { u32x2 w; w.x = pk2(v[j].x, v[j].y); w.y = pk2(v[j].z, v[j].w); o8[64 * j] = w; }
        ss = wave_sum(ss);
        if (lane == 0) ((float*)(ws + WS_RS0))[m] = rsqrtf(ss * (1.f / DM) + EPS);
    }
    const int gt = blockIdx.x * 512 + tid, NGT = gridDim.x * 512;
    for (int idx = gt; idx < SEQ * 64; idx += NGT) {
        const int pos = idx >> 6, i = idx & 63;
        const double freq = exp(-(double)i * (9.210340371976184 / 64.0));
        double s, c; sincos_d((double)pos * freq, s, c);
        ((f32x2*)(ws + WS_ROPE))[idx] = (f32x2){(float)c, (float)s};
    }
    if (gt < NG * NP) {
        const int g = gt >> 6, p = gt & 63;
        const double dt = exp((double)P.in[6][g]);
        const double ar = (double)P.in[4][gt], ai = (double)P.in[5][gt];
        double sn, cs; sincos_d(ai * dt, sn, cs);
        const double mag = exp(ar * dt), lbr = mag * cs, lbi = mag * sn;
        const double d2 = ar * ar + ai * ai, nr = lbr - 1.0, ni = lbi;
        const double cr = (nr * ar + ni * ai) / d2, ci = (ni * ar - nr * ai) / d2;
        bf16* BbT = (bf16*)(ws + WS_S5P + S5P_BBT); bf16* CmT = (bf16*)(ws + WS_S5P + S5P_CMT);
        const float* bre = P.in[7] + (size_t)gt * 16; const float* bim = P.in[8] + (size_t)gt * 16;
#pragma unroll
        for (int c2 = 0; c2 < 16; c2 += 2) {
            const double br0 = bre[c2], bi0 = bim[c2], br1 = bre[c2 + 1], bi1 = bim[c2 + 1];
            *(unsigned*)(BbT + ((size_t)g * 128 + p) * 16 + c2) = pk2((float)(cr * br0 - ci * bi0), (float)(cr * br1 - ci * bi1));
            *(unsigned*)(BbT + ((size_t)g * 128 + 64 + p) * 16 + c2) = pk2((float)(cr * bi0 + ci * br0), (float)(cr * bi1 + ci * br1));
        }
        ((f32x2*)(ws + WS_S5P + S5P_LAM))[gt] = (f32x2){(float)lbr, (float)lbi};
        double sL, cL; sincos_d(ai * dt * 512.0, sL, cL); const double mL = exp(ar * dt * 512.0);
        ((f32x2*)(ws + WS_S5P + S5P_LAML))[gt] = (f32x2){(float)(mL * cL), (float)(mL * sL)};
        const int n = p & 31, blk = p >> 5;
#pragma unroll
        for (int c = 0; c < 16; ++c) {
            const float cre = P.in[9][((size_t)g * 16 + c) * 64 + p], cim = P.in[10][((size_t)g * 16 + c) * 64 + p];
            *(unsigned*)(CmT + ((size_t)g * 16 + c) * 128 + 4 * n + 2 * blk) = pk2(cre, -cim);
        }
    }
}

constexpr int RA_KT = 0, RA_VT = 16384;
constexpr int RC_QS = 0, RC_KS = 17408, RC_VT = 34816, RC_PS = 53248, RC_OS = 62464;

__device__ __forceinline__ float head_lg2(int h) { const float t[8] = {-4.5803689613e-02f, -2.2720076500e-02f, -1.1315313228e-02f, -5.6465631411e-03f, -2.8205190624e-03f, -1.4095702547e-03f, -7.0461297659e-04f, -3.5226347163e-04f}; float r = t[0];
#pragma unroll
    for (int i = 1; i < 8; ++i) r = (h == i) ? t[i] : r;
    return r; }

__device__ __forceinline__ int tsw(int r, int tok) { return r * 64 + ((((tok >> 3) ^ ((r ^ (r >> 3)) & 7)) << 3) | (tok & 7)); }
__device__ __forceinline__ int sidx(int e, int d) { return ((((e >> 5) * 8 + (d >> 4)) * 32 + (e & 31)) << 4) + (d & 15); }
__device__ __forceinline__ void rope8(const u32x4 a, const u32x4 b, const f32x2* cs, float (&o1)[8], float (&o2)[8]) {
    const unsigned aw[4] = {a.x, a.y, a.z, a.w}, bw[4] = {b.x, b.y, b.z, b.w};
#pragma unroll
    for (int j = 0; j < 4; ++j) {
        const f32x2 c0 = cs[2 * j], c1 = cs[2 * j + 1];
        const float x1a = bflo(aw[j]), x1b = bfhi(aw[j]), x2a = bflo(bw[j]), x2b = bfhi(bw[j]);
        o1[2 * j] = x1a * c0.x - x2a * c0.y; o2[2 * j] = x2a * c0.x + x1a * c0.y;
        o1[2 * j + 1] = x1b * c1.x - x2b * c1.y; o2[2 * j + 1] = x2b * c1.x + x1b * c1.y;
    }
}

__device__ __forceinline__ void ret_pass_a(const Params& P, unsigned char* lds, int tid, int lane, int wave) {
    unsigned char* ws = P.ws;
    const bf16* proj = (const bf16*)(ws + WS_PROJ); const u32x4* rope = (const u32x4*)(ws + WS_ROPE); bf16* KV = (bf16*)(ws + WS_KV);
    bf16* KT = (bf16*)(lds + RA_KT); bf16* VT = (bf16*)(lds + RA_VT);
    const int tok = tid >> 3, dg = tid & 7;
    u32x4 k1, k2, v1, v2, c0, c1, c2, c3;
#define RA_LOAD(uu) do { const int bh_ = (uu) >> 7, n_ = (uu) & 127; const size_t row_ = (size_t)(bh_ >> 3) * SEQ + n_ * 64 + tok; \
        const bf16* kp_ = proj + row_ * INW + RW + (bh_ & 7) * HD + dg * 8; const u32x4* cp_ = rope + ((size_t)(n_ * 64 + tok) * 64 + dg * 8) / 2; \
        k1 = *(const u32x4*)kp_; k2 = *(const u32x4*)(kp_ + 64); v1 = *(const u32x4*)(kp_ + RW); v2 = *(const u32x4*)(kp_ + RW + 64); c0 = cp_[0]; c1 = cp_[1]; c2 = cp_[2]; c3 = cp_[3]; } while (0)
    f32x16 R0, R1;
#pragma unroll
    for (int i = 0; i < 16; ++i) { R0[i] = 0.f; R1[i] = 0.f; }
    int u = (int)blockIdx.x * 8;
    RA_LOAD(u);
    for (int ui = 0; ui < 8; ++ui, ++u) {
        const int bh = u >> 7, h = bh & 7;
        const float lg2 = head_lg2(h);
        const f32x2 cs[8] = {(f32x2){__uint_as_float(c0.x), __uint_as_float(c0.y)}, (f32x2){__uint_as_float(c0.z), __uint_as_float(c0.w)}, (f32x2){__uint_as_float(c1.x), __uint_as_float(c1.y)}, (f32x2){__uint_as_float(c1.z), __uint_as_float(c1.w)},
                             (f32x2){__uint_as_float(c2.x), __uint_as_float(c2.y)}, (f32x2){__uint_as_float(c2.z), __uint_as_float(c2.w)}, (f32x2){__uint_as_float(c3.x), __uint_as_float(c3.y)}, (f32x2){__uint_as_float(c3.z), __uint_as_float(c3.w)}};
        float o1[8], o2[8]; rope8(k1, k2, cs, o1, o2);
        const float ksc = 0.08838834764831845f * __builtin_amdgcn_exp2f(lg2 * (float)(63 - tok));
#pragma unroll
        for (int j = 0; j < 8; ++j) { KT[tsw(dg * 8 + j, tok)] = (bf16)(pk2(o1[j] * ksc, 0.f) & 0xffffu); KT[tsw(64 + dg * 8 + j, tok)] = (bf16)(pk2(o2[j] * ksc, 0.f) & 0xffffu); }
        const unsigned vw1[4] = {v1.x, v1.y, v1.z, v1.w}, vw2[4] = {v2.x, v2.y, v2.z, v2.w};
#pragma unroll
        for (int j = 0; j < 4; ++j) {
            VT[tsw(dg * 8 + 2 * j, tok)] = (bf16)(vw1[j] & 0xffffu); VT[tsw(dg * 8 + 2 * j + 1, tok)] = (bf16)(vw1[j] >> 16);
            VT[tsw(64 + dg * 8 + 2 * j, tok)] = (bf16)(vw2[j] & 0xffffu); VT[tsw(64 + dg * 8 + 2 * j + 1, tok)] = (bf16)(vw2[j] >> 16);
        }
        if (ui < 7) RA_LOAD(u + 1);
        __syncthreads();
        const int dt = wave & 3, et0 = (wave >> 2) * 2, l31 = lane & 31, hh = lane >> 5;
        f32x16 acc0, acc1;
#pragma unroll
        for (int i = 0; i < 16; ++i) { acc0[i] = 0.f; acc1[i] = 0.f; }
#pragma unroll
        for (int ks = 0; ks < 4; ++ks) {
            const bf16x8 a = *(const bf16x8*)(KT + tsw(dt * 32 + l31, ks * 16 + 8 * hh));
            const bf16x8 b0 = *(const bf16x8*)(VT + tsw(et0 * 32 + l31, ks * 16 + 8 * hh));
            const bf16x8 b1 = *(const bf16x8*)(VT + tsw((et0 + 1) * 32 + l31, ks * 16 + 8 * hh));
            acc0 = MFMA32(a, b0, acc0); acc1 = MFMA32(a, b1, acc1);
        }
        bf16* kvu = KV + (size_t)u * 16384;
        const float cdec = __builtin_amdgcn_exp2f(lg2 * 64.f);
        if (ui > 0)
#pragma unroll
        for (int q = 0; q < 4; ++q) {
            const int d0 = dt * 32 + 8 * q + 4 * hh;
            u32x2 w0; w0.x = pk2(R0[4 * q], R0[4 * q + 1]); w0.y = pk2(R0[4 * q + 2], R0[4 * q + 3]);
            u32x2 w1; w1.x = pk2(R1[4 * q], R1[4 * q + 1]); w1.y = pk2(R1[4 * q + 2], R1[4 * q + 3]);
            *(u32x2*)(kvu + sidx(et0 * 32 + l31, d0)) = w0; *(u32x2*)(kvu + sidx((et0 + 1) * 32 + l31, d0)) = w1;
        }
#pragma unroll
        for (int i = 0; i < 16; ++i) { R0[i] = fmaf(R0[i], cdec, acc0[i]); R1[i] = fmaf(R1[i], cdec, acc1[i]); }
        if (ui == 7) {
            bf16* tot = (bf16*)(ws + WS_TOT) + (size_t)blockIdx.x * 16384;
#pragma unroll
            for (int q = 0; q < 4; ++q) {
                const int d0 = dt * 32 + 8 * q + 4 * hh;
                u32x2 w0; w0.x = pk2(R0[4 * q], R0[4 * q + 1]); w0.y = pk2(R0[4 * q + 2], R0[4 * q + 3]);
                u32x2 w1; w1.x = pk2(R1[4 * q], R1[4 * q + 1]); w1.y = pk2(R1[4 * q + 2], R1[4 * q + 3]);
                *(u32x2*)(tot + sidx(et0 * 32 + l31, d0)) = w0; *(u32x2*)(tot + sidx((et0 + 1) * 32 + l31, d0)) = w1;
            }
        }
        __syncthreads();
    }
#undef RA_LOAD
}

__device__ __forceinline__ void ret_pass_c(const Params& P, unsigned char* lds, int tid, int lane, int wave) {
    unsigned char* ws = P.ws;
    const bf16* proj = (const bf16*)(ws + WS_PROJ); const u32x4* rope = (const u32x4*)(ws + WS_ROPE); const bf16* KV = (const bf16*)(ws + WS_KV);
    bf16* mix = (bf16*)(ws + WS_BUFA);
    bf16* Qs = (bf16*)(lds + RC_QS); bf16* Ks = (bf16*)(lds + RC_KS); bf16* VT = (bf16*)(lds + RC_VT); bf16* Ps = (bf16*)(lds + RC_PS); float* Os = (float*)(lds + RC_OS);
    const int tok = tid >> 3, dg = tid & 7, l31 = lane & 31, hh = lane >> 5, l15 = lane & 15, l4 = lane >> 4;
    const int rt = wave & 1, ct = wave >> 1;
    u32x4 q1, q2, k1, k2, v1, v2, c0, c1, c2, c3;
    bf16x8 st[8];
#define RC_LOAD(uu) do { const int bh_ = (uu) >> 7, n_ = (uu) & 127; const size_t row_ = (size_t)(bh_ >> 3) * SEQ + n_ * 64 + tok; \
        const bf16* qp_ = proj + row_ * INW + (bh_ & 7) * HD + dg * 8; const u32x4* cp_ = rope + ((size_t)(n_ * 64 + tok) * 64 + dg * 8) / 2; \
        q1 = __builtin_nontemporal_load((const u32x4*)qp_); q2 = __builtin_nontemporal_load((const u32x4*)(qp_ + 64)); k1 = __builtin_nontemporal_load((const u32x4*)(qp_ + RW)); k2 = __builtin_nontemporal_load((const u32x4*)(qp_ + RW + 64)); \
        c0 = cp_[0]; c1 = cp_[1]; c2 = cp_[2]; c3 = cp_[3]; } while (0)
#define RC_LOAD_ST(uu) do { const bf16* sp_ = KV + (size_t)(uu) * 16384 + sidx(ct * 32 + l31, 8 * hh); _Pragma("unroll") for (int ks_ = 0; ks_ < 8; ++ks_) st[ks_] = __builtin_nontemporal_load((const bf16x8*)(sp_ + ks_ * 512)); } while (0)
    const int rowb = panel_of((int)blockIdx.x) * 256 + ((int)blockIdx.x >> 6) * 64, ub = ((rowb >> 13) * 8) * 128 + ((rowb & 8191) >> 6);
    int u = ub;
    RC_LOAD(u);
    for (int hi = 0; hi < 8; ++hi, u += 128) {
        const int bh = u >> 7, n = u & 127, b = bh >> 3, h = bh & 7;
        const int un = (hi < 7) ? u + 128 : u;
        const float lg2 = head_lg2(h);
        { const bf16* cp_ = (const bf16*)(ws + WS_TOT) + ((size_t)bh * 16 + (n >> 3)) * 16384 + sidx(ct * 32 + l31, 8 * hh);
#pragma unroll
          for (int ks = 0; ks < 8; ++ks) st[ks] = *(const bf16x8*)(cp_ + ks * 512); }
        const int t3 = tid >> 3, part = tid & 7;
        const size_t row3 = (size_t)b * SEQ + n * 64 + t3;
        const bf16* gp = proj + row3 * INW + 3 * RW + h * HD + part * 16;
        { const bf16* vp_ = proj + ((size_t)b * SEQ + n * 64 + tok) * INW + 2 * RW + h * HD + dg * 8; v1 = __builtin_nontemporal_load((const u32x4*)vp_); v2 = __builtin_nontemporal_load((const u32x4*)(vp_ + 64)); }
        u32x4 g0, g1; f32x2 sq2p;
        {
            const f32x2 cs[8] = {(f32x2){__uint_as_float(c0.x), __uint_as_float(c0.y)}, (f32x2){__uint_as_float(c0.z), __uint_as_float(c0.w)}, (f32x2){__uint_as_float(c1.x), __uint_as_float(c1.y)}, (f32x2){__uint_as_float(c1.z), __uint_as_float(c1.w)},
                                 (f32x2){__uint_as_float(c2.x), __uint_as_float(c2.y)}, (f32x2){__uint_as_float(c2.z), __uint_as_float(c2.w)}, (f32x2){__uint_as_float(c3.x), __uint_as_float(c3.y)}, (f32x2){__uint_as_float(c3.z), __uint_as_float(c3.w)}};
            float o1[8], o2[8]; u32x4 w;
            rope8(q1, q2, cs, o1, o2);
            w.x = pk2(o1[0], o1[1]); w.y = pk2(o1[2], o1[3]); w.z = pk2(o1[4], o1[5]); w.w = pk2(o1[6], o1[7]); *(u32x4*)(Qs + tok * 136 + dg * 8) = w;
            w.x = pk2(o2[0], o2[1]); w.y = pk2(o2[2], o2[3]); w.z = pk2(o2[4], o2[5]); w.w = pk2(o2[6], o2[7]); *(u32x4*)(Qs + tok * 136 + 64 + dg * 8) = w;
            rope8(k1, k2, cs, o1, o2);
            w.x = pk2(o1[0], o1[1]); w.y = pk2(o1[2], o1[3]); w.z = pk2(o1[4], o1[5]); w.w = pk2(o1[6], o1[7]); *(u32x4*)(Ks + tok * 136 + dg * 8) = w;
            w.x = pk2(o2[0], o2[1]); w.y = pk2(o2[2], o2[3]); w.z = pk2(o2[4], o2[5]); w.w = pk2(o2[6], o2[7]); *(u32x4*)(Ks + tok * 136 + 64 + dg * 8) = w;
            const unsigned vw1[4] = {v1.x, v1.y, v1.z, v1.w}, vw2[4] = {v2.x, v2.y, v2.z, v2.w};
#pragma unroll
            for (int j = 0; j < 4; ++j) {
                VT[tsw(dg * 8 + 2 * j, tok)] = (bf16)(vw1[j] & 0xffffu); VT[tsw(dg * 8 + 2 * j + 1, tok)] = (bf16)(vw1[j] >> 16);
                VT[tsw(64 + dg * 8 + 2 * j, tok)] = (bf16)(vw2[j] & 0xffffu); VT[tsw(64 + dg * 8 + 2 * j + 1, tok)] = (bf16)(vw2[j] >> 16);
            }
        }
        RC_LOAD(un);
        __syncthreads();
#pragma unroll
        for (int tt = 0; tt < 2; ++tt) {
            const int T = wave * 2 + tt, kt = T & 3, qt = T >> 2;
            f32x4 acc = (f32x4){0.f, 0.f, 0.f, 0.f};
#pragma unroll
            for (int ks = 0; ks < 4; ++ks) {
                const bf16x8 a = *(const bf16x8*)(Ks + (kt * 16 + l15) * 136 + ks * 32 + 8 * l4);
                const bf16x8 bq = *(const bf16x8*)(Qs + (qt * 16 + l15) * 136 + ks * 32 + 8 * l4);
                acc = MFMA16(a, bq, acc);
            }
            const int q = qt * 16 + l15, key0 = kt * 16 + 4 * l4;
            float v[4];
#pragma unroll
            for (int r = 0; r < 4; ++r) { const int dist = q - (key0 + r); v[r] = acc[r] * 0.08838834764831845f * __builtin_amdgcn_exp2f(lg2 * (float)(dist < 0 ? -dist : dist)); }
            u32x2 w; w.x = pk2(v[0], v[1]); w.y = pk2(v[2], v[3]);
            *(u32x2*)(Ps + q * 72 + key0) = w;
        }
        asm volatile("" ::: "memory");
        f32x16 acc;
#pragma unroll
        for (int i = 0; i < 16; ++i) acc[i] = 0.f;
#pragma unroll
        for (int ks = 0; ks < 8; ++ks) { const bf16x8 a = *(const bf16x8*)(Qs + (rt * 32 + l31) * 136 + ks * 16 + 8 * hh); acc = MFMA32(a, st[ks], acc); }
        { const float dj = __builtin_amdgcn_exp2f(lg2 * (float)(64 * (n & 7)));
#pragma unroll
          for (int i = 0; i < 16; ++i) acc[i] *= dj; }
        if (n & 7) RC_LOAD_ST(u);
        __syncthreads();
        {
            if (n & 7) {
#pragma unroll
            for (int ks = 0; ks < 8; ++ks) { const bf16x8 a = *(const bf16x8*)(Qs + (rt * 32 + l31) * 136 + ks * 16 + 8 * hh); acc = MFMA32(a, st[ks], acc); }
            }
#pragma unroll
            for (int i = 0; i < 16; ++i) { const int c = rt * 32 + 8 * (i >> 2) + 4 * hh + (i & 3); acc[i] *= __builtin_amdgcn_exp2f(lg2 * (float)(c + 1)); }
#pragma unroll
            for (int ks = 0; ks < 4; ++ks) {
                const bf16x8 a = *(const bf16x8*)(Ps + (rt * 32 + l31) * 72 + ks * 16 + 8 * hh);
                const bf16x8 bv = *(const bf16x8*)(VT + tsw(ct * 32 + l31, ks * 16 + 8 * hh));
                acc = MFMA32(a, bv, acc);
            }
            g0 = __builtin_nontemporal_load((const u32x4*)gp); g1 = __builtin_nontemporal_load((const u32x4*)(gp + 8)); sq2p = *(const f32x2*)((const float*)(ws + WS_SQ2) + row3 * 16 + part * 2);
#pragma unroll
            for (int i = 0; i < 16; ++i) { const int c = rt * 32 + 8 * (i >> 2) + 4 * hh + (i & 3); Os[c * 132 + ct * 32 + l31] = acc[i]; }
        }
        __syncthreads();
        {
            const f32x4* op = (const f32x4*)(Os + t3 * 132 + part * 16);
            f32x4 x[4]; float s = 0.f;
#pragma unroll
            for (int j = 0; j < 4; ++j) { x[j] = op[j]; s += (x[j].x + x[j].y) + (x[j].z + x[j].w); }
            s += __shfl_xor(s, 1); s += __shfl_xor(s, 2); s += __shfl_xor(s, 4);
            const float mu = s * (1.f / 128.f); float q2s = 0.f;
#pragma unroll
            for (int j = 0; j < 4; ++j) { x[j] = x[j] - mu; q2s += (x[j].x * x[j].x + x[j].y * x[j].y) + (x[j].z * x[j].z + x[j].w * x[j].w); }
            q2s += __shfl_xor(q2s, 1); q2s += __shfl_xor(q2s, 2); q2s += __shfl_xor(q2s, 4);
            float sq2 = sq2p.x + sq2p.y; sq2 += __shfl_xor(sq2, 1); sq2 += __shfl_xor(sq2, 2); sq2 += __shfl_xor(sq2, 4);
            const float rstd = rsqrtf(q2s * (1.f / 128.f) + EPS) * sqrtf(sq2 * (1.f / SW) + EPS);
            const unsigned gw[8] = {g0.x, g0.y, g0.z, g0.w, g1.x, g1.y, g1.z, g1.w};
            const f32x4* gn = (const f32x4*)(P.in[3] + h * HD + part * 16);
            unsigned ow[8];
#pragma unroll
            for (int j = 0; j < 4; ++j) {
                const f32x4 gg = gn[j];
                const float ga = bflo(gw[2 * j]), gb = bfhi(gw[2 * j]), gc = bflo(gw[2 * j + 1]), gd = bfhi(gw[2 * j + 1]);
                const float ya = ga * pg8::sigmoid_f(ga) * (x[j].x * rstd * gg.x), yb = gb * pg8::sigmoid_f(gb) * (x[j].y * rstd * gg.y);
                const float yc = gc * pg8::sigmoid_f(gc) * (x[j].z * rstd * gg.z), yd = gd * pg8::sigmoid_f(gd) * (x[j].w * rstd * gg.w);
                ow[2 * j] = pk2(ya, yb); ow[2 * j + 1] = pk2(yc, yd);
            }
            bf16* mp = mix + row3 * DM + h * HD + part * 16;
            *(u32x4*)mp = (u32x4){ow[0], ow[1], ow[2], ow[3]}; *(u32x4*)(mp + 8) = (u32x4){ow[4], ow[5], ow[6], ow[7]};
        }
    }
    __syncthreads();
#undef RC_LOAD
#undef RC_LOAD_ST
}

struct ConvItem { const float* W; bf16* WT; const float* ks; int K, N, k0, n0, dst0; };
constexpr int CONV_ITEMS = 16 * 32 + 32 * 64 + 2 * 32 * 176 + 88 * 64;
__device__ __forceinline__ bool conv_decode(const Params& P, int id, ConvItem& c) {
    unsigned char* ws = P.ws;
    constexpr int I_GLU = 16 * 32, I_OUT = 32 * 64, I_GATE = 32 * 176, I_DOWN = 88 * 64;
    int r = id, kb, nb; c.ks = nullptr;
    if (r < 0 || r >= CONV_ITEMS) return false;
    if (r < I_GLU) { c.W = P.in[12]; c.WT = (bf16*)(ws + WS_WGLU); c.K = SW; c.N = SW; kb = r / 32; nb = r % 32; c.dst0 = nb * 32; }
    else if ((r -= I_GLU) < I_OUT) { c.W = P.in[15]; c.WT = (bf16*)(ws + WS_WOUT); c.K = DM; c.N = DM; kb = r / 64; nb = r % 64; c.dst0 = nb * 32; }
    else if ((r -= I_OUT) < I_GATE) { c.W = P.in[17]; c.WT = (bf16*)(ws + WS_WGU); c.K = DM; c.N = DFF; kb = r / 176; nb = r % 176; c.dst0 = ((nb * 32) >> 7) * 256 + ((nb * 32) & 127); c.ks = P.in[16]; }
    else if ((r -= I_GATE) < I_GATE) { c.W = P.in[18]; c.WT = (bf16*)(ws + WS_WGU); c.K = DM; c.N = DFF; kb = r / 176; nb = r % 176; c.dst0 = ((nb * 32) >> 7) * 256 + 128 + ((nb * 32) & 127); c.ks = P.in[16]; }
    else { r -= I_GATE; c.W = P.in[19]; c.WT = (bf16*)(ws + WS_WD); c.K = DFF; c.N = DM; kb = r / 64; nb = r % 64; c.dst0 = nb * 32; }
    c.k0 = kb * 64; c.n0 = nb * 32; return true;
}
__device__ __forceinline__ void conv_issue(const ConvItem& c, unsigned char* scr, int lane) {
    const int kr = lane >> 3, p = lane & 7;
    const float* src = c.W + (size_t)(c.k0 + kr) * c.N + c.n0;
#pragma unroll
    for (int i = 0; i < 8; ++i) { const int sc = p ^ ((kr ^ i) & 7);
        __builtin_amdgcn_global_load_lds((const unsigned*)(src + (size_t)(8 * i) * c.N + 4 * sc), (PG8_LAS unsigned*)(scr + i * 1024), 16, 0, 2); }
}
__device__ __forceinline__ void conv_consume(const ConvItem& c, const unsigned char* scr, int lane) {
    asm volatile("s_waitcnt vmcnt(0)" ::: "memory");
    const int cc = lane & 7;
    f32x4 ks0 = (f32x4){1.f, 1.f, 1.f, 1.f}, ks1 = ks0;
    if (c.ks) { ks0 = *(const f32x4*)(c.ks + c.k0 + 8 * cc); ks1 = *(const f32x4*)(c.ks + c.k0 + 8 * cc + 4); }
#pragma unroll
    for (int j = 0; j < 4; ++j) { const int n = (lane >> 3) + 8 * j; float v[8];
#pragma unroll
        for (int t = 0; t < 8; ++t) v[t] = *(const float*)(scr + (8 * cc + t) * 128 + (((n >> 2) ^ ((t ^ cc) & 7)) * 16) + (n & 3) * 4);
        u32x4 o; o.x = pk2(v[0] * ks0.x, v[1] * ks0.y); o.y = pk2(v[2] * ks0.z, v[3] * ks0.w); o.z = pk2(v[4] * ks1.x, v[5] * ks1.y); o.w = pk2(v[6] * ks1.z, v[7] * ks1.w);
        *(u32x4*)(c.WT + (size_t)(c.dst0 + n) * c.K + c.k0 + 8 * cc) = o; }
    LDS_FENCE();
}

#define CMUL_ADD(or_, oi_, ar_, ai_, br_, bi_, cr_, ci_) do { const float _r = fmaf((ar_), (br_), fmaf(-(ai_), (bi_), (cr_))); const float _i = fmaf((ar_), (bi_), fmaf((ai_), (br_), (ci_))); (or_) = _r; (oi_) = _i; } while (0)
template <bool FULL>
__device__ __forceinline__ void s5_wave(const Params& P, unsigned char* wlds, int b, int g, int ch, int lane, int gw) {
    unsigned char* ws = P.ws;
    const bf16* proj = (const bf16*)(ws + WS_PROJ);
    const bf16* BbT = (const bf16*)(ws + WS_S5P + S5P_BBT); const bf16* CmT = (const bf16*)(ws + WS_S5P + S5P_CMT);
    const f32x2* lamp = (const f32x2*)(ws + WS_S5P + S5P_LAM);
    f32x2* ST = (f32x2*)(ws + WS_S5ST);
    const int n = lane & 31, hh = lane >> 5, l15 = lane & 15, l4 = lane >> 4;
    bf16x8 Bb[4];
#pragma unroll
    for (int v = 0; v < 4; ++v) Bb[v] = *(const bf16x8*)(BbT + ((size_t)g * 128 + (v & 1) * 64 + (v >> 1) * 32 + n) * 16 + 8 * hh);
    float lr[2][4], li[2][4];
#pragma unroll
    for (int k = 0; k < 2; ++k) {
        const f32x2 l1 = lamp[g * 64 + k * 32 + n]; lr[k][0] = l1.x; li[k][0] = l1.y;
#pragma unroll
        for (int e = 1; e < 4; ++e) { lr[k][e] = lr[k][e - 1] * l1.x - li[k][e - 1] * l1.y; li[k][e] = lr[k][e - 1] * l1.y + li[k][e - 1] * l1.x; }
    }
    float car[2], cai[2];
    const size_t stbase = (((size_t)b * 16 + ch) * 64 + g) * 64;
    car[0] = cai[0] = car[1] = cai[1] = 0.f;
    if (FULL) {
        const f32x2* lamL = (const f32x2*)(ws + WS_S5P + S5P_LAML);
        const f32x2 L0 = lamL[g * 64 + n], L1 = lamL[g * 64 + 32 + n];
        for (int c = 0; c < ch; ++c) { const size_t eb = (((size_t)b * 16 + c) * 64 + g) * 64; const f32x2 e0 = ST[eb + n], e1 = ST[eb + 32 + n];
            CMUL_ADD(car[0], cai[0], L0.x, L0.y, car[0], cai[0], e0.x, e0.y); CMUL_ADD(car[1], cai[1], L1.x, L1.y, car[1], cai[1], e1.x, e1.y); }
    }
    bf16x8 Cm[4];
    f32x4 dsk = (f32x4){0.f, 0.f, 0.f, 0.f};
    if (FULL) {
#pragma unroll
        for (int ks = 0; ks < 4; ++ks) Cm[ks] = *(const bf16x8*)(CmT + ((size_t)g * 16 + l15) * 128 + ks * 32 + 8 * l4);
        dsk = *(const f32x4*)(P.in[11] + g * 16 + 4 * l4);
    }
    bf16* y1 = (bf16*)(ws + WS_Y1);
    for (int sb = 0; sb < 16; ++sb) {
        const size_t row0 = (size_t)b * SEQ + ch * 512 + sb * 32;
        const bf16x8 U = *(const bf16x8*)(proj + (row0 + n) * INW + 4 * RW + g * 16 + 8 * hh);
        f32x16 bu[4];
#pragma unroll
        for (int v = 0; v < 4; ++v) {
#pragma unroll
            for (int i = 0; i < 16; ++i) bu[v][i] = 0.f;
            bu[v] = MFMA32(U, Bb[v], bu[v]);
        }
        ConvItem cvi; bool cvok = false;
        if (FULL && sb < 10) { cvok = conv_decode(P, sb * 2048 + gw, cvi); if (cvok) conv_issue(cvi, wlds + 8704, lane); }
        float er[2][4], ei[2][4];
#pragma unroll
        for (int k = 0; k < 2; ++k)
#pragma unroll
            for (int q = 0; q < 4; ++q) {
                float sr = bu[2 * k][4 * q], si = bu[2 * k + 1][4 * q];
#pragma unroll
                for (int j = 1; j < 4; ++j) { CMUL_ADD(sr, si, lr[k][0], li[k][0], sr, si, bu[2 * k][4 * q + j], bu[2 * k + 1][4 * q + j]); bu[2 * k][4 * q + j] = sr; bu[2 * k + 1][4 * q + j] = si; }
                er[k][q] = sr; ei[k][q] = si;
            }
        float mr[2][4], mi[2][4];
#pragma unroll
        for (int k = 0; k < 2; ++k) {
            float cr = car[k], ci = cai[k];
#pragma unroll
            for (int q = 0; q < 4; ++q) {
                const float pr = __shfl_xor(er[k][q], 32), pi = __shfl_xor(ei[k][q], 32);
                const float ear = hh ? pr : er[k][q], eai = hh ? pi : ei[k][q];
                const float ebr = hh ? er[k][q] : pr, ebi = hh ? ei[k][q] : pi;
                float c1r, c1i, c2r, c2i;
                CMUL_ADD(c1r, c1i, lr[k][3], li[k][3], cr, ci, ear, eai);
                CMUL_ADD(c2r, c2i, lr[k][3], li[k][3], c1r, c1i, ebr, ebi);
                mr[k][q] = hh ? c1r : cr; mi[k][q] = hh ? c1i : ci;
                cr = c2r; ci = c2i;
            }
            car[k] = cr; cai[k] = ci;
        }
        if (FULL) {
#pragma unroll
            for (int q = 0; q < 4; ++q)
#pragma unroll
                for (int j = 0; j < 4; ++j) {
                    float s0r, s0i, s1r, s1i;
                    CMUL_ADD(s0r, s0i, lr[0][j], li[0][j], mr[0][q], mi[0][q], bu[0][4 * q + j], bu[1][4 * q + j]);
                    CMUL_ADD(s1r, s1i, lr[1][j], li[1][j], mr[1][q], mi[1][q], bu[2][4 * q + j], bu[3][4 * q + j]);
                    u32x2 w; w.x = pk2(s0r, s0i); w.y = pk2(s1r, s1i);
                    *(u32x2*)(wlds + (8 * q + 4 * hh + j) * 272 + n * 8) = w;
                }
            LDS_FENCE();
            f32x4 yt[2];
#pragma unroll
            for (int tt = 0; tt < 2; ++tt) {
                yt[tt] = (f32x4){0.f, 0.f, 0.f, 0.f};
#pragma unroll
                for (int ks = 0; ks < 4; ++ks) { const bf16x8 sv = *(const bf16x8*)(wlds + (tt * 16 + l15) * 272 + (ks * 32 + 8 * l4) * 2); yt[tt] = MFMA16(Cm[ks], sv, yt[tt]); }
            }
            LDS_FENCE();
#pragma unroll
            for (int tt = 0; tt < 2; ++tt) {
                const size_t row = row0 + tt * 16 + l15;
                const u32x2 uw = *(const u32x2*)(proj + row * INW + 4 * RW + g * 16 + 4 * l4);
                const float uu[4] = {bflo(uw.x), bfhi(uw.x), bflo(uw.y), bfhi(uw.y)};
                float o[4];
#pragma unroll
                for (int r = 0; r < 4; ++r) { const float y = yt[tt][r] + dsk[r] * uu[r]; const float z = 1.5957691216057308f * (y + 0.044715f * y * y * y); o[r] = y * pg8::sigmoid_f(z); }
                u32x2 w; w.x = pk2(o[0], o[1]); w.y = pk2(o[2], o[3]);
                *(u32x2*)(y1 + row * SW + g * 16 + 4 * l4) = w;
            }
            if (cvok) conv_consume(cvi, wlds + 8704, lane);
        }
    }
    if (!FULL) { if (hh == 0) { ST[stbase + n] = (f32x2){car[0], cai[0]}; ST[stbase + 32 + n] = (f32x2){car[1], cai[1]}; } }
}

__device__ __forceinline__ void scan_phase(const Params& P, int tid) {
    unsigned char* ws = P.ws;
    const int gt = blockIdx.x * 512 + tid, NGT = gridDim.x * 512;
    for (int e = gt; e < 16 * 8192; e += NGT) {
        const int bh = e >> 13, off = (e & 8191) * 2, h = bh & 7;
        const float dec = __builtin_amdgcn_exp2f(head_lg2(h) * 512.f);
        unsigned* p = (unsigned*)((bf16*)(ws + WS_TOT) + (size_t)bh * 16 * 16384 + off);
        unsigned kv[16];
#pragma unroll
        for (int j = 0; j < 16; ++j) kv[j] = p[(size_t)j * 8192];
        float s0 = 0.f, s1 = 0.f;
#pragma unroll
        for (int j = 0; j < 16; ++j) { p[(size_t)j * 8192] = pk2(s0, s1); s0 = fmaf(s0, dec, bflo(kv[j])); s1 = fmaf(s1, dec, bfhi(kv[j])); }
    }
}

__device__ __forceinline__ void ssm_norm_phase(const Params& P, int lane, int wave) {
    unsigned char* ws = P.ws; const bf16* y2 = (const bf16*)(ws + WS_Y2); bf16* mix = (bf16*)(ws + WS_BUFA);
    const int gw = blockIdx.x * 8 + wave, NGW = gridDim.x * 8;
    for (int m = gw; m < MTOK; m += NGW) {
        const u32x4 a = *(const u32x4*)(y2 + (size_t)m * SW + lane * 8), c = *(const u32x4*)(y2 + (size_t)m * SW + 512 + lane * 8);
        const unsigned w[8] = {a.x, a.y, a.z, a.w, c.x, c.y, c.z, c.w};
        float v[16]; float s = 0.f;
#pragma unroll
        for (int j = 0; j < 8; ++j) { v[2 * j] = bflo(w[j]); v[2 * j + 1] = bfhi(w[j]); s += v[2 * j] * v[2 * j] + v[2 * j + 1] * v[2 * j + 1]; }
        const float r = rsqrtf(wave_sum(s) * (1.f / SW) + EPS);
        const f32x4* g0 = (const f32x4*)(P.in[14] + lane * 8); const f32x4* g1 = (const f32x4*)(P.in[14] + 512 + lane * 8);
        const f32x4 ga = g0[0], gb = g0[1], gc = g1[0], gd = g1[1];
        u32x4 o0, o1;
        o0.x = pk2(v[0] * r * ga.x, v[1] * r * ga.y); o0.y = pk2(v[2] * r * ga.z, v[3] * r * ga.w); o0.z = pk2(v[4] * r * gb.x, v[5] * r * gb.y); o0.w = pk2(v[6] * r * gb.z, v[7] * r * gb.w);
        o1.x = pk2(v[8] * r * gc.x, v[9] * r * gc.y); o1.y = pk2(v[10] * r * gc.z, v[11] * r * gc.w); o1.z = pk2(v[12] * r * gd.x, v[13] * r * gd.y); o1.w = pk2(v[14] * r * gd.z, v[15] * r * gd.w);
        *(u32x4*)(mix + (size_t)m * DM + RW + lane * 8) = o0; *(u32x4*)(mix + (size_t)m * DM + RW + 512 + lane * 8) = o1;
    }
}
__device__ __forceinline__ void final_norm_phase(const Params& P, int lane, int wave) {
    const bf16* x2 = (const bf16*)(P.ws + WS_BUFA);
    const int mb = panel_of((int)blockIdx.x) * 256 + ((int)blockIdx.x >> 6) * 64 + wave * 8;
    for (int m = mb; m < mb + 8; ++m) {
        const bf16* xr = x2 + (size_t)m * DM + lane * 8;
        u32x4 w[4]; float s = 0.f;
#pragma unroll
        for (int j = 0; j < 4; ++j) w[j] = __builtin_nontemporal_load((const u32x4*)(xr + 512 * j));
        float v[4][8];
#pragma unroll
        for (int j = 0; j < 4; ++j) { const unsigned ww[4] = {w[j].x, w[j].y, w[j].z, w[j].w};
#pragma unroll
            for (int k = 0; k < 4; ++k) { v[j][2 * k] = bflo(ww[k]); v[j][2 * k + 1] = bfhi(ww[k]); s += v[j][2 * k] * v[j][2 * k] + v[j][2 * k + 1] * v[j][2 * k + 1]; } }
        const float r = rsqrtf(wave_sum(s) * (1.f / DM) + EPS);
        float* orow = P.out + (size_t)m * DM + lane * 8; const float* gr = P.in[20] + lane * 8;
#pragma unroll
        for (int j = 0; j < 4; ++j) { const f32x4 g0 = *(const f32x4*)(gr + 512 * j), g1 = *(const f32x4*)(gr + 512 * j + 4);
            __builtin_nontemporal_store((f32x4){v[j][0] * r * g0.x, v[j][1] * r * g0.y, v[j][2] * r * g0.z, v[j][3] * r * g0.w}, (f32x4*)(orow + 512 * j));
            __builtin_nontemporal_store((f32x4){v[j][4] * r * g1.x, v[j][5] * r * g1.y, v[j][6] * r * g1.z, v[j][7] * r * g1.w}, (f32x4*)(orow + 512 * j + 4)); }
    }
}

#define LAS __attribute__((address_space(3)))
#define XB_TMO      128
#define XB_XCNT(j)  (256  + 64 * (j))
#define XB_XSUB(j)  (1280 + 64 * (j))
#define XB_XGEN(j)  (2304 + 64 * (j))
#define XB_TOP      3328
#define XB_TOPGEN   3392
#define XCD_BAR_WORDS 3456
#define XB_SPIN_CAP (1u << 18)

__device__ __forceinline__ unsigned xb_ld(unsigned* p)              { return __hip_atomic_load(p, __ATOMIC_RELAXED, __HIP_MEMORY_SCOPE_AGENT); }
__device__ __forceinline__ unsigned xb_add(unsigned* p, unsigned v) { return __hip_atomic_fetch_add(p, v, __ATOMIC_RELAXED, __HIP_MEMORY_SCOPE_AGENT); }
__device__ __forceinline__ unsigned xb_xcc_id() { return (unsigned)__builtin_amdgcn_s_getreg((3 << 11) | 20) & 0xFu; }
#define XB_SPIN(cond, bar) do { unsigned _sp = 0; while (cond) { __builtin_amdgcn_s_sleep(1); \
    if ((++_sp & 255u) == 0u) { if (xb_ld(&(bar)[XB_TMO])) break; if (_sp > XB_SPIN_CAP) { atomicAdd(&(bar)[XB_TMO], 1u); break; } } } } while (0)

struct XcdBarrier {
    unsigned* bar; unsigned x;
    volatile LAS unsigned* st;
};

__device__ __forceinline__ XcdBarrier xcd_barrier_post(unsigned* bar, volatile LAS unsigned* st) {
    XcdBarrier b; b.bar = bar; b.x = xb_xcc_id(); b.st = st;
    if (threadIdx.x == 0) (void)xb_add(&bar[XB_XCNT(b.x)], 1u);
    return b;
}
__device__ __forceinline__ void xcd_barrier_complete(unsigned* bar, unsigned x, unsigned& nloc, unsigned& nx) {
    const unsigned G = gridDim.x * gridDim.y * gridDim.z;
    unsigned sum, cnt, mine, sp = 0u;
    for (;;) {
        sum = 0u; cnt = 0u; mine = 0u;
#pragma unroll
        for (unsigned j = 0; j < 16; ++j) { const unsigned c = xb_ld(&bar[XB_XCNT(j)]); sum += c; cnt += (c > 0u) ? 1u : 0u; mine = (j == x) ? c : mine; }
        if (sum == G) break;
        __builtin_amdgcn_s_sleep(1);
        if ((++sp & 255u) == 0u) { if (xb_ld(&bar[XB_TMO])) break; if (sp > XB_SPIN_CAP) { atomicAdd(&bar[XB_TMO], 1u); break; } }
    }
    nloc = mine > 0u ? mine : 1u; nx = cnt > 0u ? cnt : 1u;
}

__device__ __forceinline__ void xcd_barrier(const XcdBarrier& b) {
    asm volatile("s_waitcnt vmcnt(0)" ::: "memory");
    __syncthreads();
    if (threadIdx.x == 0) {
        unsigned* bar = b.bar;
        __builtin_amdgcn_s_waitcnt(0);
        unsigned nloc = b.st[0], nx = b.st[1];
        if (nloc == 0u) { xcd_barrier_complete(bar, b.x, nloc, nx); b.st[0] = nloc; b.st[1] = nx; }
        const unsigned old = xb_add(&bar[XB_XSUB(b.x)], 1u);
        const unsigned gen = old / nloc;
        if (old + 1u == (gen + 1u) * nloc) {
            __builtin_amdgcn_fence(__ATOMIC_RELEASE, "agent");
            asm volatile("s_waitcnt vmcnt(0)" ::: "memory");
            const unsigned og = xb_add(&bar[XB_TOP], 1u);
            const unsigned tg = og / nx;
            if (og + 1u == (tg + 1u) * nx) xb_add(&bar[XB_TOPGEN], 1u);
            else XB_SPIN(xb_ld(&bar[XB_TOPGEN]) == tg, bar);
            __builtin_amdgcn_fence(__ATOMIC_ACQUIRE, "agent");
            xb_add(&bar[XB_XGEN(b.x)], 1u);
            asm volatile("s_waitcnt vmcnt(0)" ::: "memory");
        } else {
            XB_SPIN(xb_ld(&bar[XB_XGEN(b.x)]) == gen, bar);
            __builtin_amdgcn_fence(__ATOMIC_ACQUIRE, "agent");
            asm volatile("s_waitcnt vmcnt(0)" ::: "memory");
        }
    }
    __syncthreads();
}

__device__ __forceinline__ void group_barrier(unsigned* ctl, int seam, int pm, bool samex) {
    asm volatile("s_waitcnt vmcnt(0)" ::: "memory");
    __syncthreads();
    if (threadIdx.x == 0) {
        unsigned* cnt = ctl + (CTL_GRP / 4) + (seam * 64 + pm) * 64;
        if (!samex) { __builtin_amdgcn_fence(__ATOMIC_RELEASE, "agent"); asm volatile("s_waitcnt vmcnt(0)" ::: "memory"); }
        xb_add(cnt, 1u);
        unsigned sp = 0u;
        while (xb_ld(cnt) < 4u) { __builtin_amdgcn_s_sleep(1); if (++sp > (1u << 22)) break; }
        __builtin_amdgcn_fence(__ATOMIC_ACQUIRE, "agent");
        asm volatile("s_waitcnt vmcnt(0)" ::: "memory");
    }
    __syncthreads();
}
template <int PH>
__device__ __forceinline__ void run_phase(const Params& P, unsigned char* lds, int tid, int lane, int wave) {
    unsigned char* ws = P.ws;
    PG8_LAS unsigned char* glds = (PG8_LAS unsigned char*)lds;
    if constexpr (PH == 0) p0_phase(P, lds, tid, lane, wave);
    if constexpr (PH == 1) {
        pg8::Gemm g{(const bf16*)(ws + WS_XB), (const bf16*)(ws + WS_WIN), MTOK, INW, DM}; pg8::StaticOrder S; S.init(MTOK, INW, gridDim.x, blockIdx.x);
        pg8::EpiStoreBf16 E{(bf16*)(ws + WS_PROJ), INW, (const float*)(ws + WS_RS0)};
        pg8::gemm_phase<pg8::EpiStoreBf16, pg8::StaticOrder, true, true>(glds, g, S, E);
    }
    if constexpr (PH == 2) {
        ret_pass_a(P, lds, tid, lane, wave);
        { const int id = blockIdx.x * 8 + wave; if (id < 2048) s5_wave<false>(P, lds + wave * S5_WLDS, id >> 10, id & 63, (id >> 6) & 15, lane, id); }
    }
    if constexpr (PH == 3) {
        scan_phase(P, tid);
        const int id = blockIdx.x * 8 + wave; if (id < 2048) s5_wave<true>(P, lds + wave * S5_WLDS, id >> 10, id & 63, (id >> 6) & 15, lane, id);
    }
    if constexpr (PH == 5) {
        pg8::Gemm g{(const bf16*)(ws + WS_Y1), (const bf16*)(ws + WS_WGLU), MTOK, SW, SW}; pg8::StaticOrder S; S.init(MTOK, SW, gridDim.x, blockIdx.x);
        pg8::EpiGlu E{(const bf16*)(ws + WS_Y1), P.in[13], P.in[14], (bf16*)(ws + WS_BUFA) + RW, (float*)(ws + WS_SQ2), SW, DM};
        pg8::gemm_phase<pg8::EpiGlu, pg8::StaticOrder, false, true>(glds, g, S, E);
    }
    if constexpr (PH == 6) ret_pass_c(P, lds, tid, lane, wave);
    if constexpr (PH == 7) {
        pg8::Gemm g{(const bf16*)(ws + WS_BUFA), (const bf16*)(ws + WS_WOUT), MTOK, DM, DM}; pg8::StaticOrder S; S.init(MTOK, DM, gridDim.x, blockIdx.x);
        pg8::EpiResB E{nullptr, (const bf16*)(ws + WS_XB), (bf16*)(ws + WS_X1B), DM, (const float*)(ws + WS_SQ2), 1.f / SW, (float*)(ws + WS_SQ1)};
        pg8::gemm_phase<pg8::EpiResB, pg8::StaticOrder, false, true>(glds, g, S, E);
    }
    if constexpr (PH == 9) {
        pg8::Gemm g{(const bf16*)(ws + WS_X1B), (const bf16*)(ws + WS_WGU), MTOK, 2 * DFF, DM}; pg8::StaticOrder S; S.init(MTOK, 2 * DFF, gridDim.x, blockIdx.x);
        pg8::Unit u0; int pm0 = -1; if (S.next(0, u0)) pm0 = u0.pm;
        float* rsl = (float*)(lds + LDS_KEEP + 64);
        if (pm0 >= 0 && tid < 256) { const f32x4* pp = (const f32x4*)((const float*)(ws + WS_SQ1) + (size_t)(pm0 * 256 + tid) * 32); float t = 0.f;
#pragma unroll
            for (int j = 0; j < 8; ++j) { const f32x4 p4 = pp[j]; t += (p4[0] + p4[1]) + (p4[2] + p4[3]); }
            rsl[tid] = rsqrtf(t * (1.f / DM) + EPS); }
        __syncthreads();
        pg8::EpiSwiGlu E{(bf16*)(ws + WS_ACT), DFF, (const float*)(ws + WS_SQ1), 1.f / DM, rsl, pm0};
        pg8::gemm_phase<pg8::EpiSwiGlu, pg8::StaticOrder, true, true>(glds, g, S, E);
    }
    if constexpr (PH == 10) {
        pg8::Gemm g{(const bf16*)(ws + WS_ACT), (const bf16*)(ws + WS_WD), MTOK, DM, DFF}; pg8::StaticOrder S; S.init(MTOK, DM, gridDim.x, blockIdx.x);
        pg8::EpiResB E{nullptr, (const bf16*)(ws + WS_X1B), (bf16*)(ws + WS_BUFA), DM, nullptr, 0.f, nullptr};
        pg8::gemm_phase<pg8::EpiResB, pg8::StaticOrder, false, true>(glds, g, S, E);
    }
    if constexpr (PH == 11) final_norm_phase(P, lane, wave);
}
#define R(k) { int t_ = threadIdx.x; asm volatile("" : "+v"(t_)); run_phase<k>(P, lds, t_, t_ & 63, __builtin_amdgcn_readfirstlane(t_ >> 6)); }
#define BST ((volatile LAS unsigned*)((LAS unsigned char*)lds + LDS_KEEP))
#define S { XcdBarrier b_; b_.bar = (unsigned*)(P.ws + WS_CTL); b_.x = xb_xcc_id(); b_.st = BST; xcd_barrier(b_); }
#define G(k) group_barrier((unsigned*)(P.ws + WS_CTL), k, panel_of((int)blockIdx.x), BST[2] != 0u);
#define PHASE_PROGRAM R(0) S R(1) S R(2) S R(3) S GROUP_CHECK R(5) G(0) R(6) S R(7) G(1) R(9) G(2) R(10) G(3) R(11)
__global__ void __launch_bounds__(512, 2) hybrid_fwd(Params P) {
    extern __shared__ __attribute__((aligned(16))) unsigned char lds[];
    cg::grid_group grid = cg::this_grid();
    const int tid = threadIdx.x, lane = tid & 63, wave = __builtin_amdgcn_readfirstlane(tid >> 6);
    if (P.ws == nullptr) grid.sync();
    if (tid < 3) BST[tid] = 0u;
    __syncthreads();
    { XcdBarrier bar = xcd_barrier_post((unsigned*)(P.ws + WS_CTL), BST); (void)bar; }
    if (tid == 0) __hip_atomic_store((unsigned*)(P.ws + WS_CTL + CTL_XID) + blockIdx.x, xb_xcc_id() + 1u, __ATOMIC_RELAXED, __HIP_MEMORY_SCOPE_AGENT);
#define GROUP_CHECK { unsigned ok_ = 1u; const unsigned* xid_ = (const unsigned*)(P.ws + WS_CTL + CTL_XID); _Pragma("unroll") for (int k_ = 0; k_ < 4; ++k_) ok_ &= (xb_ld((unsigned*)xid_ + ((blockIdx.x & 63) + 64 * k_)) == xb_xcc_id() + 1u) ? 1u : 0u; if (threadIdx.x == 0) BST[2] = ok_; __syncthreads(); }
    PHASE_PROGRAM
}
#undef R
#undef S

extern "C" void kernel_launch(void* const* d_in, const int* in_sizes, int n_in, void* d_out, int out_size, void* d_ws, size_t ws_size, hipStream_t stream) {
    static int grid = 0;
    if (grid == 0) {
        if (n_in != 21 || out_size != MTOK * DM || ws_size < WS_END) { fprintf(stderr, "kernel_launch: unexpected shapes (n_in %d out %d ws %zu)\n", n_in, out_size, ws_size); grid = -1; return; }
        int dev = 0, cus = 0, per_cu = 0;
        (void)hipGetDevice(&dev); (void)hipDeviceGetAttribute(&cus, hipDeviceAttributeMultiprocessorCount, dev);
        if (hipFuncSetAttribute((const void*)hybrid_fwd, hipFuncAttributeMaxDynamicSharedMemorySize, LDS_BYTES) != hipSuccess) { fprintf(stderr, "kernel_launch: hipFuncSetAttribute failed\n"); grid = -1; return; }
        if (hipOccupancyMaxActiveBlocksPerMultiprocessor(&per_cu, (const void*)hybrid_fwd, 512, LDS_BYTES) != hipSuccess || per_cu < 1) { fprintf(stderr, "kernel_launch: occupancy query says %d\n", per_cu); per_cu = 1; }
        (void)hipGetLastError();
        grid = cus * 1;
        if (grid != 256) { fprintf(stderr, "kernel_launch: built for a 256-CU device (got %d)\n", cus); grid = -1; return; }
    }
    if (grid < 0) return;
    Params p{};
    for (int i = 0; i < 21; ++i) p.in[i] = (const float*)d_in[i];
    p.out = (float*)d_out; p.ws = (unsigned char*)d_ws;
    if (hipMemsetAsync((unsigned char*)d_ws + WS_CTL, 0, CTL_ZERO, stream) != hipSuccess) { fprintf(stderr, "kernel_launch: memset of the barrier words failed\n"); return; }
    void* args[] = {&p};
    hipError_t e = hipLaunchCooperativeKernel((const void*)hybrid_fwd, dim3(grid), dim3(512), args, LDS_BYTES, stream);
    if (e != hipSuccess) fprintf(stderr, "cooperative launch failed: %s (grid %d)\n", hipGetErrorString(e), grid);
}
```

```cpp
#include <hip/hip_runtime.h>
#include <hip/hip_cooperative_groups.h>
#include <cstdio>
#include <cstdint>
namespace cg = cooperative_groups;
namespace pg8 {
#define PG8_LAS __attribute__((address_space(3)))
typedef unsigned short bf16_t;
typedef short bf16x8 __attribute__((ext_vector_type(8)));
typedef float f32x4 __attribute__((ext_vector_type(4)));
typedef unsigned u32x4 __attribute__((ext_vector_type(4)));
constexpr int BM = 256, BK = 64, HALF = 128, HTB = HALF * BK * 2  , STAGE_BYTES = 8 * HTB, NXCD = 8, WGM = 8;

__host__ __device__ __forceinline__ int lds_byte(int r, int c) { const int st = (r >> 4) * 2 + (c >> 5), rr = r & 15, cc = c & 31, ob = rr * 64 + cc * 2; return st * 1024 + (ob ^ (((ob >> 9) & 1) << 5)); }
__host__ __device__ __forceinline__ void stage_rc(int b, int& R, int& C) { const int st = b / 1024, sb = b % 1024, swz = sb ^ (((sb >> 9) & 1) << 5); R = (st >> 1) * 16 + swz / 64; C = (st & 1) * 32 + (swz % 64) / 2; }
__host__ __device__ __forceinline__ int perm32(int rho) { const int n = rho >> 4, i = rho & 15; return 8 * (i >> 2) + 4 * n + (i & 3); }

struct Unit { int pm, pn; };
struct Gemm { const bf16_t* A; const bf16_t* Bt; int M, N, K; };

struct StaticOrder {
    int nM, nN, nwg, G, c;
    __host__ __device__ void init(int M, int N, int G_, int c_) { nM = M / BM; nN = N / BM; nwg = nM * nN; G = G_; c = c_; }
    __host__ __device__ bool next(int i, Unit& u) const {
        const long L = (long)i * G + c; if (L >= nwg) return false;
        int wgid = (int)L; { const int q = nwg / NXCD, r = nwg % NXCD, xcd = wgid % NXCD, off = wgid / NXCD; wgid = (xcd < r ? xcd * (q + 1) : r * (q + 1) + (xcd - r) * q) + off; }
        const int nig = WGM * nN, gid = wgid / nig, fm = gid * WGM, gsz = (nM - fm) < WGM ? (nM - fm) : WGM;
        u.pm = fm + ((wgid % nig) % gsz); u.pn = (wgid % nig) / gsz; return true;
    }
    __device__ __forceinline__ void a_ready(const Unit&) const {}
    __device__ __forceinline__ void done(const Unit&) const {}
};

typedef __bf16 bf16x2_t __attribute__((ext_vector_type(2)));
__device__ __forceinline__ unsigned cvt_pk_bf16(float lo, float hi) { bf16x2_t v = {(__bf16)lo, (__bf16)hi}; return __builtin_bit_cast(unsigned, v); }
__device__ __forceinline__ float bf_lo(unsigned w) { return __uint_as_float(w << 16); }
__device__ __forceinline__ float bf_hi(unsigned w) { return __uint_as_float(w & 0xffff0000u); }
typedef unsigned u32x2v __attribute__((ext_vector_type(2)));
__device__ __forceinline__ float sigmoid_f(float z) { return __builtin_amdgcn_rcpf(1.0f + __expf(-z)); }

struct EpiStoreBf16 {
    static constexpr bool PERM = true, AFTER_DRAIN = false;
    bf16_t* O; int ldc; const float* rs;
    __device__ __forceinline__ void operator()(const f32x4 (&acc)[2][2][4][2], const Unit& u, int wr, int wc, int fr, int fq) const {
        const int row0 = u.pm * BM + wr * 64 + fr, col0 = u.pn * BM + wc * 32 + 8 * fq;
        float rv[2][4];
#pragma unroll
        for (int ai = 0; ai < 2; ++ai)
#pragma unroll
            for (int m = 0; m < 4; ++m) rv[ai][m] = rs[row0 + ai * HALF + m * 16];
#pragma unroll
        for (int ai = 0; ai < 2; ++ai)
#pragma unroll
            for (int m = 0; m < 4; ++m) { bf16_t* rowp = O + (size_t)(row0 + ai * HALF + m * 16) * ldc + col0;
#pragma unroll
                for (int bj = 0; bj < 2; ++bj) { const f32x4 v0 = acc[ai][bj][m][0] * rv[ai][m], v1 = acc[ai][bj][m][1] * rv[ai][m];
                    u32x4 w; w.x = cvt_pk_bf16(v0[0], v0[1]); w.y = cvt_pk_bf16(v0[2], v0[3]); w.z = cvt_pk_bf16(v1[0], v1[1]); w.w = cvt_pk_bf16(v1[2], v1[3]);
                    *(u32x4*)(rowp + bj * HALF) = w; } }
    }
};
struct EpiGlu {
    static constexpr bool PERM = true, AFTER_DRAIN = false;
    const bf16_t* Y1; const float* bias; const float* gain; bf16_t* Y2; float* rowsq; int ldc, ldo;
    __device__ __forceinline__ void operator()(const f32x4 (&acc)[2][2][4][2], const Unit& u, int wr, int wc, int fr, int fq) const {
        const int row0 = u.pm * BM + wr * 64 + fr, col0 = u.pn * BM + wc * 32 + 8 * fq;
        f32x4 bv[2][2], gv[2][2];
#pragma unroll
        for (int bj = 0; bj < 2; ++bj)
#pragma unroll
            for (int n = 0; n < 2; ++n) { bv[bj][n] = *(const f32x4*)(bias + col0 + bj * HALF + 4 * n); gv[bj][n] = *(const f32x4*)(gain + col0 + bj * HALF + 4 * n); }
#pragma unroll
        for (int ai = 0; ai < 2; ++ai) {
            u32x4 yv[4][2];
#pragma unroll
            for (int m = 0; m < 4; ++m)
#pragma unroll
                for (int bj = 0; bj < 2; ++bj) yv[m][bj] = *(const u32x4*)(Y1 + (size_t)(row0 + ai * HALF + m * 16) * ldc + col0 + bj * HALF);
#pragma unroll
            for (int m = 0; m < 4; ++m) { const int row = row0 + ai * HALF + m * 16; const size_t offo = (size_t)row * ldo + col0;
                float ss = 0.f;
#pragma unroll
                for (int bj = 0; bj < 2; ++bj) { const f32x4 z0 = acc[ai][bj][m][0] + bv[bj][0], z1 = acc[ai][bj][m][1] + bv[bj][1];
                    const u32x4 y = yv[m][bj];
                    f32x4 r0, r1;
                    r0[0] = bf_lo(y.x) * sigmoid_f(z0[0]); r0[1] = bf_hi(y.x) * sigmoid_f(z0[1]); r0[2] = bf_lo(y.y) * sigmoid_f(z0[2]); r0[3] = bf_hi(y.y) * sigmoid_f(z0[3]);
                    r1[0] = bf_lo(y.z) * sigmoid_f(z1[0]); r1[1] = bf_hi(y.z) * sigmoid_f(z1[1]); r1[2] = bf_lo(y.w) * sigmoid_f(z1[2]); r1[3] = bf_hi(y.w) * sigmoid_f(z1[3]);
                    ss += (r0[0] * r0[0] + r0[1] * r0[1]) + (r0[2] * r0[2] + r0[3] * r0[3]) + (r1[0] * r1[0] + r1[1] * r1[1]) + (r1[2] * r1[2] + r1[3] * r1[3]);
                    r0 = r0 * gv[bj][0]; r1 = r1 * gv[bj][1];
                    u32x4 w; w.x = cvt_pk_bf16(r0[0], r0[1]); w.y = cvt_pk_bf16(r0[2], r0[3]); w.z = cvt_pk_bf16(r1[0], r1[1]); w.w = cvt_pk_bf16(r1[2], r1[3]);
                    *(u32x4*)(Y2 + offo + bj * HALF) = w; }
                ss += __shfl_xor(ss, 16); ss += __shfl_xor(ss, 32);
                if (fq == 0) rowsq[(size_t)row * 16 + u.pn * 4 + wc] = ss; }
        }
    }
};
struct EpiResF32 {
    static constexpr bool PERM = false, AFTER_DRAIN = false;
    const float* X; float* O; int ldc; const float* insq; float inv_indim; bf16_t* OB; float* outsq;
    __device__ __forceinline__ void operator()(const f32x4 (&acc)[2][2][4][2], const Unit& u, int wr, int wc, int fr, int fq) const {
        const int row0 = u.pm * BM + wr * 64 + fr, col0 = u.pn * BM + wc * 32 + 4 * fq;
#pragma unroll
        for (int ai = 0; ai < 2; ++ai)
#pragma unroll
        for (int mh = 0; mh < 2; ++mh) {
            f32x4 xv[2][2][2]; f32x4 p4[2];
#pragma unroll
            for (int mm = 0; mm < 2; ++mm) { const int row = row0 + ai * HALF + (2 * mh + mm) * 16; const size_t off = (size_t)row * ldc + col0;
                p4[mm] = insq ? *(const f32x4*)(insq + (size_t)row * 16 + 4 * fq) : (f32x4){0.f, 0.f, 0.f, 0.f};
#pragma unroll
                for (int bj = 0; bj < 2; ++bj)
#pragma unroll
                    for (int n = 0; n < 2; ++n) xv[mm][bj][n] = *(const f32x4*)(X + off + bj * HALF + n * 16); }
#pragma unroll
            for (int mm = 0; mm < 2; ++mm) { const int m = 2 * mh + mm; const int row = row0 + ai * HALF + m * 16; const size_t off = (size_t)row * ldc + col0;
                float sc = 1.0f;
                if (insq) { float t = (p4[mm][0] + p4[mm][1]) + (p4[mm][2] + p4[mm][3]); t += __shfl_xor(t, 16); t += __shfl_xor(t, 32); sc = rsqrtf(t * inv_indim + 1e-6f); }
                float ss = 0.f;
#pragma unroll
                for (int bj = 0; bj < 2; ++bj)
#pragma unroll
                    for (int n = 0; n < 2; ++n) { const f32x4 o = xv[mm][bj][n] + acc[ai][bj][m][n] * sc;
                        *(f32x4*)(O + off + bj * HALF + n * 16) = o;
                        if (OB) { ss += (o[0] * o[0] + o[1] * o[1]) + (o[2] * o[2] + o[3] * o[3]); u32x2v w; w.x = cvt_pk_bf16(o[0], o[1]); w.y = cvt_pk_bf16(o[2], o[3]); *(u32x2v*)(OB + off + bj * HALF + n * 16) = w; } }
                if (OB) { ss += __shfl_xor(ss, 16); ss += __shfl_xor(ss, 32); if (fq == 0) outsq[(size_t)row * 32 + u.pn * 4 + wc] = ss; } }
        }
    }
};
struct EpiResB {
    static constexpr bool PERM = true, AFTER_DRAIN = false;
    const float* X; const bf16_t* XB; bf16_t* OB; int ldc; const float* insq; float inv_indim; float* outsq; bool ntx;
    __device__ __forceinline__ void operator()(const f32x4 (&acc)[2][2][4][2], const Unit& u, int wr, int wc, int fr, int fq) const {
        const int row0 = u.pm * BM + wr * 64 + fr, col0 = u.pn * BM + wc * 32 + 8 * fq;
#pragma unroll
        for (int ai = 0; ai < 2; ++ai)
#pragma unroll
        for (int mh = 0; mh < 2; ++mh) {
            f32x4 xv[2][2][2]; f32x4 p4[2];
#pragma unroll
            for (int mm = 0; mm < 2; ++mm) { const int row = row0 + ai * HALF + (2 * mh + mm) * 16; const size_t off = (size_t)row * ldc + col0;
                p4[mm] = insq ? *(const f32x4*)(insq + (size_t)row * 16 + 4 * fq) : (f32x4){0.f, 0.f, 0.f, 0.f};
#pragma unroll
                for (int bj = 0; bj < 2; ++bj) {
                    if (XB) { const u32x4 y = ntx ? __builtin_nontemporal_load((const u32x4*)(XB + off + bj * HALF)) : *(const u32x4*)(XB + off + bj * HALF); xv[mm][bj][0] = (f32x4){bf_lo(y.x), bf_hi(y.x), bf_lo(y.y), bf_hi(y.y)}; xv[mm][bj][1] = (f32x4){bf_lo(y.z), bf_hi(y.z), bf_lo(y.w), bf_hi(y.w)}; }
                    else { xv[mm][bj][0] = *(const f32x4*)(X + off + bj * HALF); xv[mm][bj][1] = *(const f32x4*)(X + off + bj * HALF + 4); } } }
#pragma unroll
            for (int mm = 0; mm < 2; ++mm) { const int m = 2 * mh + mm; const int row = row0 + ai * HALF + m * 16; const size_t off = (size_t)row * ldc + col0;
                float sc = 1.0f;
                if (insq) { float t = (p4[mm][0] + p4[mm][1]) + (p4[mm][2] + p4[mm][3]); t += __shfl_xor(t, 16); t += __shfl_xor(t, 32); sc = rsqrtf(t * inv_indim + 1e-6f); }
                float ss = 0.f;
#pragma unroll
                for (int bj = 0; bj < 2; ++bj) { const f32x4 o0 = xv[mm][bj][0] + acc[ai][bj][m][0] * sc, o1 = xv[mm][bj][1] + acc[ai][bj][m][1] * sc;
                    ss += ((o0[0] * o0[0] + o0[1] * o0[1]) + (o0[2] * o0[2] + o0[3] * o0[3])) + ((o1[0] * o1[0] + o1[1] * o1[1]) + (o1[2] * o1[2] + o1[3] * o1[3]));
                    u32x4 w; w.x = cvt_pk_bf16(o0[0], o0[1]); w.y = cvt_pk_bf16(o0[2], o0[3]); w.z = cvt_pk_bf16(o1[0], o1[1]); w.w = cvt_pk_bf16(o1[2], o1[3]);
                    *(u32x4*)(OB + off + bj * HALF) = w; }
                if (outsq) { ss += __shfl_xor(ss, 16); ss += __shfl_xor(ss, 32); if (fq == 0) outsq[(size_t)row * 32 + u.pn * 4 + wc] = ss; } }
        }
    }
};
struct EpiSwiGlu {
    static constexpr bool PERM = true, AFTER_DRAIN = false;
    bf16_t* O; int ldc; const float* insq; float inv_indim; const float* rs_lds; int pm_lds;
    __device__ __forceinline__ void operator()(const f32x4 (&acc)[2][2][4][2], const Unit& u, int wr, int wc, int fr, int fq) const {
        const int row0 = u.pm * BM + wr * 64 + fr, col0 = u.pn * HALF + wc * 32 + 8 * fq;
        float scv[2][4];
        if (u.pm == pm_lds) {
#pragma unroll
          for (int ai = 0; ai < 2; ++ai)
#pragma unroll
              for (int m = 0; m < 4; ++m) scv[ai][m] = rs_lds[wr * 64 + fr + ai * HALF + m * 16];
        } else { f32x4 pa[2][4], pb[2][4];
#pragma unroll
          for (int ai = 0; ai < 2; ++ai)
#pragma unroll
              for (int m = 0; m < 4; ++m) { const float* pp = insq + (size_t)(row0 + ai * HALF + m * 16) * 32 + 8 * fq; pa[ai][m] = *(const f32x4*)pp; pb[ai][m] = *(const f32x4*)(pp + 4); }
#pragma unroll
          for (int ai = 0; ai < 2; ++ai)
#pragma unroll
              for (int m = 0; m < 4; ++m) { float t = ((pa[ai][m][0] + pa[ai][m][1]) + (pa[ai][m][2] + pa[ai][m][3])) + ((pb[ai][m][0] + pb[ai][m][1]) + (pb[ai][m][2] + pb[ai][m][3]));
                  t += __shfl_xor(t, 16); t += __shfl_xor(t, 32); scv[ai][m] = rsqrtf(t * inv_indim + 1e-6f); } }
#pragma unroll
        for (int ai = 0; ai < 2; ++ai)
#pragma unroll
            for (int m = 0; m < 4; ++m) { const int row = row0 + ai * HALF + m * 16; bf16_t* rowp = O + (size_t)row * ldc + col0;
                const float sc = scv[ai][m];
                f32x4 r0, r1;
#pragma unroll
                for (int j = 0; j < 4; ++j) { const float g0 = acc[ai][0][m][0][j] * sc, g1 = acc[ai][0][m][1][j] * sc;
                    r0[j] = g0 * sigmoid_f(g0) * (acc[ai][1][m][0][j] * sc); r1[j] = g1 * sigmoid_f(g1) * (acc[ai][1][m][1][j] * sc); }
                u32x4 w; w.x = cvt_pk_bf16(r0[0], r0[1]); w.y = cvt_pk_bf16(r0[2], r0[3]); w.z = cvt_pk_bf16(r1[0], r1[1]); w.w = cvt_pk_bf16(r1[2], r1[3]);
                *(u32x4*)rowp = w; }
    }
};


template <class Epi, class Sched, bool ALIGN_EPI = false, bool SP2 = false>
__device__ __forceinline__ void gemm_phase(PG8_LAS unsigned char* lds, const Gemm g, const Sched& S, const Epi& E) {
    int tid_ = threadIdx.x; asm volatile("" : "+v"(tid_));
    const int tid = tid_, wid = __builtin_amdgcn_readfirstlane(tid >> 6), lane = tid & 63, wr = wid >> 2, wc = wid & 3, fr = lane & 15, fq = lane >> 4;
    const int K = g.K, nt = K / BK;
    unsigned voffA[2], voffB[2];
#pragma unroll
    for (int i = 0; i < 2; ++i) { int R, C; stage_rc(tid * 16 + i * 8192, R, C); const int Rb = Epi::PERM ? ((R & ~31) + perm32(R & 31)) : R;
        voffA[i] = (unsigned)(R * K + C) * 2u; voffB[i] = (unsigned)(Rb * K + C) * 2u; }
    const size_t kstep = (size_t)(BK * 2);
    const size_t hstep = (size_t)HALF * K * 2;
    const size_t tstep = 2 * hstep;
    const unsigned ldsw = (unsigned)wid * 1024u;
    const int aoff = lds_byte(wr * 64 + fr, fq * 8), boff = lds_byte(wc * 32 + fr, fq * 8);
#define PG8_SA(b, h) (((b) * 2 + (h)) * HTB)
#define PG8_SB(b, h) ((4 + (b) * 2 + (h)) * HTB)
#define PG8_STAGE(bufoff, gbase, voff) do { _Pragma("unroll") for (int _i = 0; _i < 2; ++_i) \
        __builtin_amdgcn_global_load_lds((const unsigned*)((const char*)(gbase) + (voff)[_i]), (PG8_LAS unsigned*)(lds + (bufoff) + ldsw + _i * 8192), 16, 0, 0); } while (0)
#define PG8_LDA(dst, b, h) do { _Pragma("unroll") for (int m = 0; m < 4; ++m) _Pragma("unroll") for (int k = 0; k < 2; ++k) dst[m][k] = *(const PG8_LAS bf16x8*)(lds + PG8_SA(b, h) + aoff + m * 2048 + k * 1024); } while (0)
#define PG8_LDB(dst, b, h) do { _Pragma("unroll") for (int n = 0; n < 2; ++n) _Pragma("unroll") for (int k = 0; k < 2; ++k) dst[n][k] = *(const PG8_LAS bf16x8*)(lds + PG8_SB(b, h) + boff + n * 2048 + k * 1024); } while (0)
#define PG8_MMA(ai, bj, At, Bt) do { __builtin_amdgcn_s_setprio(1); _Pragma("unroll") for (int m = 0; m < 4; ++m) _Pragma("unroll") for (int n = 0; n < 2; ++n) _Pragma("unroll") for (int k = 0; k < 2; ++k) \
        acc[ai][bj][m][n] = __builtin_amdgcn_mfma_f32_16x16x32_bf16(Bt[n][k], At[m][k], acc[ai][bj][m][n], 0, 0, 0); __builtin_amdgcn_s_setprio(0); } while (0)
#define PG8_WAIT_V(n) asm volatile("s_waitcnt vmcnt(" #n ")" ::: "memory")
#define PG8_WAIT_L(n) asm volatile("s_waitcnt lgkmcnt(" #n ")" ::: "memory")
#define PG8_BAR __builtin_amdgcn_s_barrier()
#define PG8_SCHED __builtin_amdgcn_sched_barrier(0)
    Unit cur, nxt; int ui = 0;
    if (!S.next(0, cur)) return;
    f32x4 acc[2][2][4][2];
#pragma unroll
    for (int a = 0; a < 2; ++a)
#pragma unroll
        for (int b = 0; b < 2; ++b)
#pragma unroll
            for (int m = 0; m < 4; ++m)
#pragma unroll
                for (int n = 0; n < 2; ++n) acc[a][b][m][n] = (f32x4){0.f, 0.f, 0.f, 0.f};
    bf16x8 At[4][2], B0[2][2], B1[2][2];
    const char* cA = (const char*)g.A + (size_t)cur.pm * tstep; const char* cB = (const char*)g.Bt + (size_t)cur.pn * tstep;
    S.a_ready(cur);
    if constexpr (SP2) {
        PG8_STAGE(PG8_SB(0, 0), cB, voffB); PG8_STAGE(PG8_SB(0, 1), cB + hstep, voffB); PG8_STAGE(PG8_SA(0, 0), cA, voffA); PG8_STAGE(PG8_SA(0, 1), cA + hstep, voffA);
        if (wr == 1) PG8_BAR;
        PG8_WAIT_V(2); PG8_BAR;
        PG8_STAGE(PG8_SB(1, 0), cB + kstep, voffB); PG8_STAGE(PG8_SA(1, 0), cA + kstep, voffA); PG8_STAGE(PG8_SB(1, 1), cB + hstep + kstep, voffB);
        PG8_WAIT_V(6); PG8_BAR;
    } else {
        PG8_STAGE(PG8_SB(0, 0), cB, voffB); PG8_STAGE(PG8_SA(0, 0), cA, voffA); PG8_STAGE(PG8_SB(0, 1), cB + hstep, voffB); PG8_STAGE(PG8_SA(0, 1), cA + hstep, voffA);
        if (wr == 1) PG8_BAR;
        PG8_WAIT_V(4); PG8_BAR;
        PG8_STAGE(PG8_SB(1, 0), cB + kstep, voffB); PG8_STAGE(PG8_SA(1, 0), cA + kstep, voffA); PG8_STAGE(PG8_SB(1, 1), cB + hstep + kstep, voffB);
        PG8_WAIT_V(6); PG8_BAR;
    }
    for (;;) {
        const bool has_next = S.next(ui + 1, nxt);
        const char* nA = has_next ? (const char*)g.A + (size_t)nxt.pm * tstep : cA; const char* nB = has_next ? (const char*)g.Bt + (size_t)nxt.pn * tstep : cB;
        for (int t = 0; t < nt; t += 2) {
            const bool last = (t == nt - 2);
            const char* a1 = cA + (size_t)(t + 1) * kstep;
            const char* a2 = last ? nA : cA + (size_t)(t + 2) * kstep; const char* b2 = last ? nB : cB + (size_t)(t + 2) * kstep;
            const char* a3 = a2 + kstep; const char* b3 = b2 + kstep;
            if (last && has_next) S.a_ready(nxt);
            if constexpr (SP2) {
            PG8_LDB(B0, 0, 0); PG8_LDB(B1, 0, 1); PG8_SCHED; PG8_LDA(At, 0, 0); PG8_STAGE(PG8_SA(1, 1), a1 + hstep, voffA);
            PG8_WAIT_V(8); PG8_WAIT_L(0); PG8_BAR; PG8_MMA(0, 0, At, B0); PG8_MMA(0, 1, At, B1); PG8_BAR; PG8_SCHED;
            PG8_LDA(At, 0, 1); PG8_STAGE(PG8_SB(0, 0), b2, voffB); PG8_STAGE(PG8_SB(0, 1), b2 + hstep, voffB); PG8_STAGE(PG8_SA(0, 0), a2, voffA);
            PG8_WAIT_V(8); PG8_WAIT_L(0); PG8_BAR; PG8_MMA(1, 0, At, B0); PG8_MMA(1, 1, At, B1); PG8_BAR; PG8_SCHED;
            PG8_LDB(B0, 1, 0); PG8_LDB(B1, 1, 1); PG8_SCHED; PG8_LDA(At, 1, 0); PG8_STAGE(PG8_SA(0, 1), a2 + hstep, voffA);
            PG8_WAIT_V(8); PG8_WAIT_L(0); PG8_BAR; PG8_MMA(0, 0, At, B0); PG8_MMA(0, 1, At, B1); PG8_BAR; PG8_SCHED;
            PG8_LDA(At, 1, 1); PG8_STAGE(PG8_SB(1, 0), b3, voffB); PG8_STAGE(PG8_SB(1, 1), b3 + hstep, voffB); PG8_STAGE(PG8_SA(1, 0), a3, voffA);
            PG8_WAIT_V(8); PG8_WAIT_L(0); PG8_BAR; PG8_MMA(1, 0, At, B0); PG8_MMA(1, 1, At, B1); PG8_BAR; PG8_SCHED;
            } else {
            PG8_LDB(B0, 0, 0); PG8_SCHED; PG8_LDA(At, 0, 0); PG8_STAGE(PG8_SA(1, 1), a1 + hstep, voffA);
            PG8_WAIT_L(8); PG8_BAR; PG8_WAIT_L(0); PG8_MMA(0, 0, At, B0); PG8_BAR; PG8_SCHED;
            PG8_LDB(B1, 0, 1); PG8_STAGE(PG8_SB(0, 0), b2, voffB);
            PG8_BAR; PG8_WAIT_L(0); PG8_MMA(0, 1, At, B1); PG8_BAR;
            PG8_LDA(At, 0, 1); PG8_STAGE(PG8_SA(0, 0), a2, voffA);
            PG8_BAR; PG8_WAIT_L(0); PG8_MMA(1, 0, At, B0); PG8_BAR; PG8_SCHED;
            PG8_STAGE(PG8_SB(0, 1), b2 + hstep, voffB);
            PG8_WAIT_V(6); PG8_BAR; PG8_MMA(1, 1, At, B1); PG8_BAR;
            PG8_LDB(B0, 1, 0); PG8_SCHED; PG8_LDA(At, 1, 0); PG8_STAGE(PG8_SA(0, 1), a2 + hstep, voffA);
            PG8_WAIT_L(8); PG8_BAR; PG8_WAIT_L(0); PG8_MMA(0, 0, At, B0); PG8_BAR; PG8_SCHED;
            PG8_LDB(B1, 1, 1); PG8_STAGE(PG8_SB(1, 0), b3, voffB);
            PG8_BAR; PG8_WAIT_L(0); PG8_MMA(0, 1, At, B1); PG8_BAR;
            PG8_LDA(At, 1, 1); PG8_STAGE(PG8_SA(1, 0), a3, voffA);
            PG8_BAR; PG8_WAIT_L(0); PG8_MMA(1, 0, At, B0); PG8_BAR; PG8_SCHED;
            PG8_STAGE(PG8_SB(1, 1), b3 + hstep, voffB);
            PG8_WAIT_V(6); PG8_BAR; PG8_MMA(1, 1, At, B1); PG8_BAR;
            }
        }
        if constexpr (ALIGN_EPI) { if (wr == 0) PG8_BAR; }
        if constexpr (!Epi::AFTER_DRAIN) { E(acc, cur, wr, wc, fr, fq); S.done(cur); }
        if (!has_next) break;
#pragma unroll
        for (int a = 0; a < 2; ++a)
#pragma unroll
            for (int b = 0; b < 2; ++b)
#pragma unroll
                for (int m = 0; m < 4; ++m)
#pragma unroll
                    for (int n = 0; n < 2; ++n) acc[a][b][m][n] = (f32x4){0.f, 0.f, 0.f, 0.f};
        cur = nxt; cA = nA; cB = nB; ++ui;
        if constexpr (ALIGN_EPI) { if (wr == 1) PG8_BAR; }
    }
    PG8_WAIT_V(0);
    if constexpr (!ALIGN_EPI) { if (wr == 0) PG8_BAR; }
    PG8_BAR;
    if constexpr (Epi::AFTER_DRAIN) { E.fused(acc, cur, wr, wc, fr, fq, lds, wid, lane); S.done(cur); }
#undef PG8_SA
#undef PG8_SB
#undef PG8_STAGE
#undef PG8_LDA
#undef PG8_LDB
#undef PG8_MMA
#undef PG8_WAIT_V
#undef PG8_WAIT_L
#undef PG8_BAR
#undef PG8_SCHED
}
}

typedef unsigned short bf16;
typedef short bf16x8 __attribute__((ext_vector_type(8)));
typedef float f32x4 __attribute__((ext_vector_type(4)));
typedef float f32x2 __attribute__((ext_vector_type(2)));
typedef float f32x16 __attribute__((ext_vector_type(16)));
typedef unsigned u32x4 __attribute__((ext_vector_type(4)));
typedef unsigned u32x2 __attribute__((ext_vector_type(2)));

constexpr int DM = 2048, SEQ = 8192, MTOK = 16384, INW = 5120, RW = 1024, NH = 8, HD = 128, SW = 1024, NG = 64, NP = 64, DFF = 5632;
constexpr float EPS = 1e-6f;
constexpr size_t MiB = 1u << 20;
constexpr size_t WS_WIN = 0, WS_WGLU = 20 * MiB, WS_WOUT = 22 * MiB, WS_WGU = 30 * MiB, WS_WD = 74 * MiB, WS_ROPE = 96 * MiB, WS_S5P = 100 * MiB, WS_S5ST = 101 * MiB,
                 WS_BUFA = 102 * MiB, WS_PROJ = 166 * MiB, WS_KV = 326 * MiB, WS_XB = 390 * MiB, WS_CTL = 454 * MiB, WS_SQ1 = 455 * MiB, WS_SQ2 = 457 * MiB, WS_TOT = 458 * MiB, WS_Y1 = 466 * MiB, WS_RS0 = 498 * MiB, WS_END = 499 * MiB, WS_ACT = WS_PROJ, WS_X1B = WS_XB, WS_Y2 = WS_Y1;
constexpr size_t CTL_XID = 16384, CTL_GRP = 32768, CTL_ZERO = 131072;
constexpr size_t S5P_BBT = 0, S5P_CMT = 256 * 1024, S5P_LAM = 512 * 1024, S5P_LAML = 544 * 1024;
constexpr int LDS_BYTES = 137216, LDS_KEEP = 135168, S5_WLDS = 16896;
constexpr int NPHASE = 12;

__device__ __forceinline__ int panel_of(int c) { return 8 * (c & 7) + ((c >> 3) & 7); }

struct Params { const float* in[21]; float* out; unsigned char* ws; };

#define MFMA32(a, b, c) __builtin_amdgcn_mfma_f32_32x32x16_bf16((a), (b), (c), 0, 0, 0)
#define MFMA16(a, b, c) __builtin_amdgcn_mfma_f32_16x16x32_bf16((a), (b), (c), 0, 0, 0)
#define LDS_FENCE() asm volatile("s_waitcnt lgkmcnt(0)" ::: "memory")

__device__ __forceinline__ float bflo(unsigned w) { return __uint_as_float(w << 16); }
__device__ __forceinline__ float bfhi(unsigned w) { return __uint_as_float(w & 0xffff0000u); }
__device__ __forceinline__ unsigned pk2(float lo, float hi) { return pg8::cvt_pk_bf16(lo, hi); }
__device__ __forceinline__ float wave_sum(float v) {
#pragma unroll
    for (int o = 1; o < 64; o <<= 1) v += __shfl_xor(v, o);
    return v;
}
__device__ __forceinline__ void sincos_d(double x, double& s, double& c) {
    const double k = rint(x * 0.63661977236758134308);
    double r = fma(-k, 1.57079632679489655800e+00, x); r = fma(-k, 6.12323399573676603587e-17, r);
    const int q = ((int)(long long)k) & 3;
    const double r2 = r * r;
    const double sn = r * (1.0 + r2 * (-1.0 / 6.0 + r2 * (1.0 / 120.0 + r2 * (-1.0 / 5040.0 + r2 * (1.0 / 362880.0 + r2 * (-1.0 / 39916800.0 + r2 * (1.0 / 6227020800.0 + r2 * (-1.0 / 1307674368000.0))))))));
    const double cs = 1.0 + r2 * (-0.5 + r2 * (1.0 / 24.0 + r2 * (-1.0 / 720.0 + r2 * (1.0 / 40320.0 + r2 * (-1.0 / 3628800.0 + r2 * (1.0 / 479001600.0 + r2 * (-1.0 / 87178291200.0 + r2 * (1.0 / 20922789888000.0))))))));
    s = (q == 0) ? sn : (q == 1) ? cs : (q == 2) ? -sn : -cs;
    c = (q == 0) ? cs : (q == 1) ? -sn : (q == 2) ? -cs : sn;
}

__device__ __forceinline__ void p0_transpose_item(const float* W, int K, int N, bf16* WT, int k0, int n0, int dst_row0, float* scr, int lane, const float* kscale = nullptr) {
#pragma unroll 8
    for (int i = 0; i < 32; ++i) { const int kk = 2 * i + (lane >> 5); scr[kk * 33 + (lane & 31)] = __builtin_nontemporal_load(W + (size_t)(k0 + kk) * N + n0 + (lane & 31)); }
    const int c = lane & 7;
    f32x4 ks0 = (f32x4){1.f, 1.f, 1.f, 1.f}, ks1 = ks0;
    if (kscale) { ks0 = *(const f32x4*)(kscale + k0 + 8 * c); ks1 = *(const f32x4*)(kscale + k0 + 8 * c + 4); }
    LDS_FENCE();
#pragma unroll
    for (int j = 0; j < 4; ++j) { const int n = (lane >> 3) + 8 * j; const float* s = scr + (8 * c) * 33 + n;
        u32x4 o; o.x = pk2(s[0 * 33] * ks0.x, s[1 * 33] * ks0.y); o.y = pk2(s[2 * 33] * ks0.z, s[3 * 33] * ks0.w); o.z = pk2(s[4 * 33] * ks1.x, s[5 * 33] * ks1.y); o.w = pk2(s[6 * 33] * ks1.z, s[7 * 33] * ks1.w);
        *(u32x4*)(WT + (size_t)(dst_row0 + n) * K + k0 + 8 * c) = o; }
    LDS_FENCE();
}
__device__ __forceinline__ void rms_row_to_bf16(const float* xrow, const float* g, bf16* orow, int lane) {
    const f32x4* xr = (const f32x4*)xrow + lane; const f32x4* gr = (const f32x4*)g + lane;
    f32x4 v[8]; float s = 0.f;
#pragma unroll
    for (int j = 0; j < 8; ++j) { v[j] = xr[64 * j]; s += (v[j].x * v[j].x + v[j].y * v[j].y) + (v[j].z * v[j].z + v[j].w * v[j].w); }
    const float r = rsqrtf(wave_sum(s) * (1.f / DM) + EPS);
    u32x2* o8 = (u32x2*)orow + lane;
#pragma unroll
    for (int j = 0; j < 8; ++j) { const f32x4 gg = gr[64 * j]; u32x2 w; w.x = pk2(v[j].x * r * gg.x, v[j].y * r * gg.y); w.y = pk2(v[j].z * r * gg.z, v[j].w * r * gg.w); o8[64 * j] = w; }
}
__device__ __forceinline__ void p0_phase(const Params& P, unsigned char* lds, int tid, int lane, int wave) {
    unsigned char* ws = P.ws;
    const int gw = blockIdx.x * 8 + wave, NGW = gridDim.x * 8;
    float* scr = (float*)(lds + wave * 16384);
    constexpr int I_IN = 32 * 160;
    for (int it = gw; it < I_IN; it += NGW) { const int kb = it / 160, nb = it % 160; p0_transpose_item(P.in[2], DM, INW, (bf16*)(ws + WS_WIN), kb * 64, nb * 32, nb * 32, scr, lane, P.in[1]); }
    for (int m = gw; m < MTOK; m += NGW) {
        const f32x4* xr = (const f32x4*)(P.in[0] + (size_t)m * DM) + lane; u32x2* o8 = (u32x2*)((bf16*)(ws + WS_XB) + (size_t)m * DM) + lane;
        f32x4 v[8]; float ss = 0.f;
#pragma unroll
        for (int j = 0; j < 8; ++j) { v[j] = __builtin_nontemporal_load(xr + 64 * j); ss += (v[j].x * v[j].x + v[j].y * v[j].y) + (v[j].z * v[j].z + v[j].w * v[j].w); }
#pragma unroll
        for (int j = 0; j < 8; ++j) { u32x2 w; w.x = pk2(v[j].x, v[j].y); w.y = pk2(v[j].z, v[j].w); o8[64 * j] = w; }
        ss = wave_sum(ss);
        if (lane == 0) ((float*)(ws + WS_RS0))[m] = rsqrtf(ss * (1.f / DM) + EPS);
    }
    const int gt = blockIdx.x * 512 + tid, NGT = gridDim.x * 512;
    for (int idx = gt; idx < SEQ * 64; idx += NGT) {
        const int pos = idx >> 6, i = idx & 63;
        const double freq = exp(-(double)i * (9.210340371976184 / 64.0));
        double s, c; sincos_d((double)pos * freq, s, c);
        ((f32x2*)(ws + WS_ROPE))[idx] = (f32x2){(float)c, (float)s};
    }
    if (gt < NG * NP) {
        const int g = gt >> 6, p = gt & 63;
        const double dt = exp((double)P.in[6][g]);
        const double ar = (double)P.in[4][gt], ai = (double)P.in[5][gt];
        double sn, cs; sincos_d(ai * dt, sn, cs);
        const double mag = exp(ar * dt), lbr = mag * cs, lbi = mag * sn;
        const double d2 = ar * ar + ai * ai, nr = lbr - 1.0, ni = lbi;
        const double cr = (nr * ar + ni * ai) / d2, ci = (ni * ar - nr * ai) / d2;
        bf16* BbT = (bf16*)(ws + WS_S5P + S5P_BBT); bf16* CmT = (bf16*)(ws + WS_S5P + S5P_CMT);
        const float* bre = P.in[7] + (size_t)gt * 16; const float* bim = P.in[8] + (size_t)gt * 16;
#pragma unroll
        for (int c2 = 0; c2 < 16; c2 += 2) {
            const double br0 = bre[c2], bi0 = bim[c2], br1 = bre[c2 + 1], bi1 = bim[c2 + 1];
            *(unsigned*)(BbT + ((size_t)g * 128 + p) * 16 + c2) = pk2((float)(cr * br0 - ci * bi0), (float)(cr * br1 - ci * bi1));
            *(unsigned*)(BbT + ((size_t)g * 128 + 64 + p) * 16 + c2) = pk2((float)(cr * bi0 + ci * br0), (float)(cr * bi1 + ci * br1));
        }
        ((f32x2*)(ws + WS_S5P + S5P_LAM))[gt] = (f32x2){(float)lbr, (float)lbi};
        double sL, cL; sincos_d(ai * dt * 512.0, sL, cL); const double mL = exp(ar * dt * 512.0);
        ((f32x2*)(ws + WS_S5P + S5P_LAML))[gt] = (f32x2){(float)(mL * cL), (float)(mL * sL)};
        const int n = p & 31, blk = p >> 5;
#pragma unroll
        for (int c = 0; c < 16; ++c) {
            const float cre = P.in[9][((size_t)g * 16 + c) * 64 + p], cim = P.in[10][((size_t)g * 16 + c) * 64 + p];
            *(unsigned*)(CmT + ((size_t)g * 16 + c) * 128 + 4 * n + 2 * blk) = pk2(cre, -cim);
        }
    }
}

constexpr int RA_KT = 0, RA_VT = 16384;
constexpr int RC_QS = 0, RC_KS = 17408, RC_VT = 34816, RC_PS = 53248, RC_OS = 62464;

__device__ __forceinline__ float head_lg2(int h) { const float t[8] = {-4.5803689613e-02f, -2.2720076500e-02f, -1.1315313228e-02f, -5.6465631411e-03f, -2.8205190624e-03f, -1.4095702547e-03f, -7.0461297659e-04f, -3.5226347163e-04f}; float r = t[0];
#pragma unroll
    for (int i = 1; i < 8; ++i) r = (h == i) ? t[i] : r;
    return r; }

__device__ __forceinline__ int tsw(int r, int tok) { return r * 64 + ((((tok >> 3) ^ ((r ^ (r >> 3)) & 7)) << 3) | (tok & 7)); }
__device__ __forceinline__ int sidx(int e, int d) { return ((((e >> 5) * 8 + (d >> 4)) * 32 + (e & 31)) << 4) + (d & 15); }
__device__ __forceinline__ void rope8(const u32x4 a, const u32x4 b, const f32x2* cs, float (&o1)[8], float (&o2)[8]) {
    const unsigned aw[4] = {a.x, a.y, a.z, a.w}, bw[4] = {b.x, b.y, b.z, b.w};
#pragma unroll
    for (int j = 0; j < 4; ++j) {
        const f32x2 c0 = cs[2 * j], c1 = cs[2 * j + 1];
        const float x1a = bflo(aw[j]), x1b = bfhi(aw[j]), x2a = bflo(bw[j]), x2b = bfhi(bw[j]);
        o1[2 * j] = x1a * c0.x - x2a * c0.y; o2[2 * j] = x2a * c0.x + x1a * c0.y;
        o1[2 * j + 1] = x1b * c1.x - x2b * c1.y; o2[2 * j + 1] = x2b * c1.x + x1b * c1.y;
    }
}

__device__ __forceinline__ void ret_pass_a(const Params& P, unsigned char* lds, int tid, int lane, int wave) {
    unsigned char* ws = P.ws;
    const bf16* proj = (const bf16*)(ws + WS_PROJ); const u32x4* rope = (const u32x4*)(ws + WS_ROPE); bf16* KV = (bf16*)(ws + WS_KV);
    bf16* KT = (bf16*)(lds + RA_KT); bf16* VT = (bf16*)(lds + RA_VT);
    const int tok = tid >> 3, dg = tid & 7;
    u32x4 k1, k2, v1, v2, c0, c1, c2, c3;
#define RA_LOAD(uu) do { const int bh_ = (uu) >> 7, n_ = (uu) & 127; const size_t row_ = (size_t)(bh_ >> 3) * SEQ + n_ * 64 + tok; \
        const bf16* kp_ = proj + row_ * INW + RW + (bh_ & 7) * HD + dg * 8; const u32x4* cp_ = rope + ((size_t)(n_ * 64 + tok) * 64 + dg * 8) / 2; \
        k1 = *(const u32x4*)kp_; k2 = *(const u32x4*)(kp_ + 64); v1 = *(const u32x4*)(kp_ + RW); v2 = *(const u32x4*)(kp_ + RW + 64); c0 = cp_[0]; c1 = cp_[1]; c2 = cp_[2]; c3 = cp_[3]; } while (0)
    f32x16 R0, R1;
#pragma unroll
    for (int i = 0; i < 16; ++i) { R0[i] = 0.f; R1[i] = 0.f; }
    int u = (int)blockIdx.x * 8;
    RA_LOAD(u);
    for (int ui = 0; ui < 8; ++ui, ++u) {
        const int bh = u >> 7, h = bh & 7;
        const float lg2 = head_lg2(h);
        const f32x2 cs[8] = {(f32x2){__uint_as_float(c0.x), __uint_as_float(c0.y)}, (f32x2){__uint_as_float(c0.z), __uint_as_float(c0.w)}, (f32x2){__uint_as_float(c1.x), __uint_as_float(c1.y)}, (f32x2){__uint_as_float(c1.z), __uint_as_float(c1.w)},
                             (f32x2){__uint_as_float(c2.x), __uint_as_float(c2.y)}, (f32x2){__uint_as_float(c2.z), __uint_as_float(c2.w)}, (f32x2){__uint_as_float(c3.x), __uint_as_float(c3.y)}, (f32x2){__uint_as_float(c3.z), __uint_as_float(c3.w)}};
        float o1[8], o2[8]; rope8(k1, k2, cs, o1, o2);
        const float ksc = 0.08838834764831845f * __builtin_amdgcn_exp2f(lg2 * (float)(63 - tok));
#pragma unroll
        for (int j = 0; j < 8; ++j) { KT[tsw(dg * 8 + j, tok)] = (bf16)(pk2(o1[j] * ksc, 0.f) & 0xffffu); KT[tsw(64 + dg * 8 + j, tok)] = (bf16)(pk2(o2[j] * ksc, 0.f) & 0xffffu); }
        const unsigned vw1[4] = {v1.x, v1.y, v1.z, v1.w}, vw2[4] = {v2.x, v2.y, v2.z, v2.w};
#pragma unroll
        for (int j = 0; j < 4; ++j) {
            VT[tsw(dg * 8 + 2 * j, tok)] = (bf16)(vw1[j] & 0xffffu); VT[tsw(dg * 8 + 2 * j + 1, tok)] = (bf16)(vw1[j] >> 16);
            VT[tsw(64 + dg * 8 + 2 * j, tok)] = (bf16)(vw2[j] & 0xffffu); VT[tsw(64 + dg * 8 + 2 * j + 1, tok)] = (bf16)(vw2[j] >> 16);
        }
        if (ui < 7) RA_LOAD(u + 1);
        __syncthreads();
        const int dt = wave & 3, et0 = (wave >> 2) * 2, l31 = lane & 31, hh = lane >> 5;
        f32x16 acc0, acc1;
#pragma unroll
        for (int i = 0; i < 16; ++i) { acc0[i] = 0.f; acc1[i] = 0.f; }
#pragma unroll
        for (int ks = 0; ks < 4; ++ks) {
            const bf16x8 a = *(const bf16x8*)(KT + tsw(dt * 32 + l31, ks * 16 + 8 * hh));
            const bf16x8 b0 = *(const bf16x8*)(VT + tsw(et0 * 32 + l31, ks * 16 + 8 * hh));
            const bf16x8 b1 = *(const bf16x8*)(VT + tsw((et0 + 1) * 32 + l31, ks * 16 + 8 * hh));
            acc0 = MFMA32(a, b0, acc0); acc1 = MFMA32(a, b1, acc1);
        }
        bf16* kvu = KV + (size_t)u * 16384;
        const float cdec = __builtin_amdgcn_exp2f(lg2 * 64.f);
        if (ui > 0)
#pragma unroll
        for (int q = 0; q < 4; ++q) {
            const int d0 = dt * 32 + 8 * q + 4 * hh;
            u32x2 w0; w0.x = pk2(R0[4 * q], R0[4 * q + 1]); w0.y = pk2(R0[4 * q + 2], R0[4 * q + 3]);
            u32x2 w1; w1.x = pk2(R1[4 * q], R1[4 * q + 1]); w1.y = pk2(R1[4 * q + 2], R1[4 * q + 3]);
            *(u32x2*)(kvu + sidx(et0 * 32 + l31, d0)) = w0; *(u32x2*)(kvu + sidx((et0 + 1) * 32 + l31, d0)) = w1;
        }
#pragma unroll
        for (int i = 0; i < 16; ++i) { R0[i] = fmaf(R0[i], cdec, acc0[i]); R1[i] = fmaf(R1[i], cdec, acc1[i]); }
        if (ui == 7) {
            bf16* tot = (bf16*)(ws + WS_TOT) + (size_t)blockIdx.x * 16384;
#pragma unroll
            for (int q = 0; q < 4; ++q) {
                const int d0 = dt * 32 + 8 * q + 4 * hh;
                u32x2 w0; w0.x = pk2(R0[4 * q], R0[4 * q + 1]); w0.y = pk2(R0[4 * q + 2], R0[4 * q + 3]);
                u32x2 w1; w1.x = pk2(R1[4 * q], R1[4 * q + 1]); w1.y = pk2(R1[4 * q + 2], R1[4 * q + 3]);
                *(u32x2*)(tot + sidx(et0 * 32 + l31, d0)) = w0; *(u32x2*)(tot + sidx((et0 + 1) * 32 + l31, d0)) = w1;
            }
        }
        __syncthreads();
    }
#undef RA_LOAD
}

__device__ __forceinline__ void ret_pass_c(const Params& P, unsigned char* lds, int tid, int lane, int wave) {
    unsigned char* ws = P.ws;
    const bf16* proj = (const bf16*)(ws + WS_PROJ); const u32x4* rope = (const u32x4*)(ws + WS_ROPE); const bf16* KV = (const bf16*)(ws + WS_KV);
    bf16* mix = (bf16*)(ws + WS_BUFA);
    bf16* Qs = (bf16*)(lds + RC_QS); bf16* Ks = (bf16*)(lds + RC_KS); bf16* VT = (bf16*)(lds + RC_VT); bf16* Ps = (bf16*)(lds + RC_PS); float* Os = (float*)(lds + RC_OS);
    const int tok = tid >> 3, dg = tid & 7, l31 = lane & 31, hh = lane >> 5, l15 = lane & 15, l4 = lane >> 4;
    const int rt = wave & 1, ct = wave >> 1;
    u32x4 q1, q2, k1, k2, v1, v2, c0, c1, c2, c3;
    bf16x8 st[8];
#define RC_LOAD(uu) do { const int bh_ = (uu) >> 7, n_ = (uu) & 127; const size_t row_ = (size_t)(bh_ >> 3) * SEQ + n_ * 64 + tok; \
        const bf16* qp_ = proj + row_ * INW + (bh_ & 7) * HD + dg * 8; const u32x4* cp_ = rope + ((size_t)(n_ * 64 + tok) * 64 + dg * 8) / 2; \
        q1 = __builtin_nontemporal_load((const u32x4*)qp_); q2 = __builtin_nontemporal_load((const u32x4*)(qp_ + 64)); k1 = __builtin_nontemporal_load((const u32x4*)(qp_ + RW)); k2 = __builtin_nontemporal_load((const u32x4*)(qp_ + RW + 64)); \
        c0 = cp_[0]; c1 = cp_[1]; c2 = cp_[2]; c3 = cp_[3]; } while (0)
#define RC_LOAD_ST(uu) do { const bf16* sp_ = KV + (size_t)(uu) * 16384 + sidx(ct * 32 + l31, 8 * hh); _Pragma("unroll") for (int ks_ = 0; ks_ < 8; ++ks_) st[ks_] = __builtin_nontemporal_load((const bf16x8*)(sp_ + ks_ * 512)); } while (0)
    const int rowb = panel_of((int)blockIdx.x) * 256 + ((int)blockIdx.x >> 6) * 64, ub = ((rowb >> 13) * 8) * 128 + ((rowb & 8191) >> 6);
    int u = ub;
    RC_LOAD(u);
    for (int hi = 0; hi < 8; ++hi, u += 128) {
        const int bh = u >> 7, n = u & 127, b = bh >> 3, h = bh & 7;
        const int un = (hi < 7) ? u + 128 : u;
        const float lg2 = head_lg2(h);
        { const bf16* cp_ = (const bf16*)(ws + WS_TOT) + ((size_t)bh * 16 + (n >> 3)) * 16384 + sidx(ct * 32 + l31, 8 * hh);
#pragma unroll
          for (int ks = 0; ks < 8; ++ks) st[ks] = *(const bf16x8*)(cp_ + ks * 512); }
        const int t3 = tid >> 3, part = tid & 7;
        const size_t row3 = (size_t)b * SEQ + n * 64 + t3;
        const bf16* gp = proj + row3 * INW + 3 * RW + h * HD + part * 16;
        { const bf16* vp_ = proj + ((size_t)b * SEQ + n * 64 + tok) * INW + 2 * RW + h * HD + dg * 8; v1 = __builtin_nontemporal_load((const u32x4*)vp_); v2 = __builtin_nontemporal_load((const u32x4*)(vp_ + 64)); }
        u32x4 g0, g1; f32x2 sq2p;
        {
            const f32x2 cs[8] = {(f32x2){__uint_as_float(c0.x), __uint_as_float(c0.y)}, (f32x2){__uint_as_float(c0.z), __uint_as_float(c0.w)}, (f32x2){__uint_as_float(c1.x), __uint_as_float(c1.y)}, (f32x2){__uint_as_float(c1.z), __uint_as_float(c1.w)},
                                 (f32x2){__uint_as_float(c2.x), __uint_as_float(c2.y)}, (f32x2){__uint_as_float(c2.z), __uint_as_float(c2.w)}, (f32x2){__uint_as_float(c3.x), __uint_as_float(c3.y)}, (f32x2){__uint_as_float(c3.z), __uint_as_float(c3.w)}};
            float o1[8], o2[8]; u32x4 w;
            rope8(q1, q2, cs, o1, o2);
            w.x = pk2(o1[0], o1[1]); w.y = pk2(o1[2], o1[3]); w.z = pk2(o1[4], o1[5]); w.w = pk2(o1[6], o1[7]); *(u32x4*)(Qs + tok * 136 + dg * 8) = w;
            w.x = pk2(o2[0], o2[1]); w.y = pk2(o2[2], o2[3]); w.z = pk2(o2[4], o2[5]); w.w = pk2(o2[6], o2[7]); *(u32x4*)(Qs + tok * 136 + 64 + dg * 8) = w;
            rope8(k1, k2, cs, o1, o2);
            w.x = pk2(o1[0], o1[1]); w.y = pk2(o1[2], o1[3]); w.z = pk2(o1[4], o1[5]); w.w = pk2(o1[6], o1[7]); *(u32x4*)(Ks + tok * 136 + dg * 8) = w;
            w.x = pk2(o2[0], o2[1]); w.y = pk2(o2[2], o2[3]); w.z = pk2(o2[4], o2[5]); w.w = pk2(o2[6], o2[7]); *(u32x4*)(Ks + tok * 136 + 64 + dg * 8) = w;
            const unsigned vw1[4] = {v1.x, v1.y, v1.z, v1.w}, vw2[4] = {v2.x, v2.y, v2.z, v2.w};
#pragma unroll
            for (int j = 0; j < 4; ++j) {
                VT[tsw(dg * 8 + 2 * j, tok)] = (bf16)(vw1[j] & 0xffffu); VT[tsw(dg * 8 + 2 * j + 1, tok)] = (bf16)(vw1[j] >> 16);
                VT[tsw(64 + dg * 8 + 2 * j, tok)] = (bf16)(vw2[j] & 0xffffu); VT[tsw(64 + dg * 8 + 2 * j + 1, tok)] = (bf16)(vw2[j] >> 16);
            }
        }
        RC_LOAD(un);
        __syncthreads();
#pragma unroll
        for (int tt = 0; tt < 2; ++tt) {
            const int T = wave * 2 + tt, kt = T & 3, qt = T >> 2;
            f32x4 acc = (f32x4){0.f, 0.f, 0.f, 0.f};
#pragma unroll
            for (int ks = 0; ks < 4; ++ks) {
                const bf16x8 a = *(const bf16x8*)(Ks + (kt * 16 + l15) * 136 + ks * 32 + 8 * l4);
                const bf16x8 bq = *(const bf16x8*)(Qs + (qt * 16 + l15) * 136 + ks * 32 + 8 * l4);
                acc = MFMA16(a, bq, acc);
            }
            const int q = qt * 16 + l15, key0 = kt * 16 + 4 * l4;
            float v[4];
#pragma unroll
            for (int r = 0; r < 4; ++r) { const int dist = q - (key0 + r); v[r] = acc[r] * 0.08838834764831845f * __builtin_amdgcn_exp2f(lg2 * (float)(dist < 0 ? -dist : dist)); }
            u32x2 w; w.x = pk2(v[0], v[1]); w.y = pk2(v[2], v[3]);
            *(u32x2*)(Ps + q * 72 + key0) = w;
        }
        asm volatile("" ::: "memory");
        f32x16 acc;
#pragma unroll
        for (int i = 0; i < 16; ++i) acc[i] = 0.f;
#pragma unroll
        for (int ks = 0; ks < 8; ++ks) { const bf16x8 a = *(const bf16x8*)(Qs + (rt * 32 + l31) * 136 + ks * 16 + 8 * hh); acc = MFMA32(a, st[ks], acc); }
        { const float dj = __builtin_amdgcn_exp2f(lg2 * (float)(64 * (n & 7)));
#pragma unroll
          for (int i = 0; i < 16; ++i) acc[i] *= dj; }
        if (n & 7) RC_LOAD_ST(u);
        __syncthreads();
        {
            if (n & 7) {
#pragma unroll
            for (int ks = 0; ks < 8; ++ks) { const bf16x8 a = *(const bf16x8*)(Qs + (rt * 32 + l31) * 136 + ks * 16 + 8 * hh); acc = MFMA32(a, st[ks], acc); }
            }
#pragma unroll
            for (int i = 0; i < 16; ++i) { const int c = rt * 32 + 8 * (i >> 2) + 4 * hh + (i & 3); acc[i] *= __builtin_amdgcn_exp2f(lg2 * (float)(c + 1)); }
#pragma unroll
            for (int ks = 0; ks < 4; ++ks) {
                const bf16x8 a = *(const bf16x8*)(Ps + (rt * 32 + l31) * 72 + ks * 16 + 8 * hh);
                const bf16x8 bv = *(const bf16x8*)(VT + tsw(ct * 32 + l31, ks * 16 + 8 * hh));
                acc = MFMA32(a, bv, acc);
            }
            g0 = __builtin_nontemporal_load((const u32x4*)gp); g1 = __builtin_nontemporal_load((const u32x4*)(gp + 8)); sq2p = *(const f32x2*)((const float*)(ws + WS_SQ2) + row3 * 16 + part * 2);
#pragma unroll
            for (int i = 0; i < 16; ++i) { const int c = rt * 32 + 8 * (i >> 2) + 4 * hh + (i & 3); Os[c * 132 + ct * 32 + l31] = acc[i]; }
        }
        __syncthreads();
        {
            const f32x4* op = (const f32x4*)(Os + t3 * 132 + part * 16);
            f32x4 x[4]; float s = 0.f;
#pragma unroll
            for (int j = 0; j < 4; ++j) { x[j] = op[j]; s += (x[j].x + x[j].y) + (x[j].z + x[j].w); }
            s += __shfl_xor(s, 1); s += __shfl_xor(s, 2); s += __shfl_xor(s, 4);
            const float mu = s * (1.f / 128.f); float q2s = 0.f;
#pragma unroll
            for (int j = 0; j < 4; ++j) { x[j] = x[j] - mu; q2s += (x[j].x * x[j].x + x[j].y * x[j].y) + (x[j].z * x[j].z + x[j].w * x[j].w); }
            q2s += __shfl_xor(q2s, 1); q2s += __shfl_xor(q2s, 2); q2s += __shfl_xor(q2s, 4);
            float sq2 = sq2p.x + sq2p.y; sq2 += __shfl_xor(sq2, 1); sq2 += __shfl_xor(sq2, 2); sq2 += __shfl_xor(sq2, 4);
            const float rstd = rsqrtf(q2s * (1.f / 128.f) + EPS) * sqrtf(sq2 * (1.f / SW) + EPS);
            const unsigned gw[8] = {g0.x, g0.y, g0.z, g0.w, g1.x, g1.y, g1.z, g1.w};
            const f32x4* gn = (const f32x4*)(P.in[3] + h * HD + part * 16);
            unsigned ow[8];
#pragma unroll
            for (int j = 0; j < 4; ++j) {
                const f32x4 gg = gn[j];
                const float ga = bflo(gw[2 * j]), gb = bfhi(gw[2 * j]), gc = bflo(gw[2 * j + 1]), gd = bfhi(gw[2 * j + 1]);
                const float ya = ga * pg8::sigmoid_f(ga) * (x[j].x * rstd * gg.x), yb = gb * pg8::sigmoid_f(gb) * (x[j].y * rstd * gg.y);
                const float yc = gc * pg8::sigmoid_f(gc) * (x[j].z * rstd * gg.z), yd = gd * pg8::sigmoid_f(gd) * (x[j].w * rstd * gg.w);
                ow[2 * j] = pk2(ya, yb); ow[2 * j + 1] = pk2(yc, yd);
            }
            bf16* mp = mix + row3 * DM + h * HD + part * 16;
            *(u32x4*)mp = (u32x4){ow[0], ow[1], ow[2], ow[3]}; *(u32x4*)(mp + 8) = (u32x4){ow[4], ow[5], ow[6], ow[7]};
        }
    }
    __syncthreads();
#undef RC_LOAD
#undef RC_LOAD_ST
}

struct ConvItem { const float* W; bf16* WT; const float* ks; int K, N, k0, n0, dst0; };
constexpr int CONV_ITEMS = 16 * 32 + 32 * 64 + 2 * 32 * 176 + 88 * 64;
__device__ __forceinline__ bool conv_decode(const Params& P, int id, ConvItem& c) {
    unsigned char* ws = P.ws;
    constexpr int I_GLU = 16 * 32, I_OUT = 32 * 64, I_GATE = 32 * 176, I_DOWN = 88 * 64;
    int r = id, kb, nb; c.ks = nullptr;
    if (r < 0 || r >= CONV_ITEMS) return false;
    if (r < I_GLU) { c.W = P.in[12]; c.WT = (bf16*)(ws + WS_WGLU); c.K = SW; c.N = SW; kb = r / 32; nb = r % 32; c.dst0 = nb * 32; }
    else if ((r -= I_GLU) < I_OUT) { c.W = P.in[15]; c.WT = (bf16*)(ws + WS_WOUT); c.K = DM; c.N = DM; kb = r / 64; nb = r % 64; c.dst0 = nb * 32; }
    else if ((r -= I_OUT) < I_GATE) { c.W = P.in[17]; c.WT = (bf16*)(ws + WS_WGU); c.K = DM; c.N = DFF; kb = r / 176; nb = r % 176; c.dst0 = ((nb * 32) >> 7) * 256 + ((nb * 32) & 127); c.ks = P.in[16]; }
    else if ((r -= I_GATE) < I_GATE) { c.W = P.in[18]; c.WT = (bf16*)(ws + WS_WGU); c.K = DM; c.N = DFF; kb = r / 176; nb = r % 176; c.dst0 = ((nb * 32) >> 7) * 256 + 128 + ((nb * 32) & 127); c.ks = P.in[16]; }
    else { r -= I_GATE; c.W = P.in[19]; c.WT = (bf16*)(ws + WS_WD); c.K = DFF; c.N = DM; kb = r / 64; nb = r % 64; c.dst0 = nb * 32; }
    c.k0 = kb * 64; c.n0 = nb * 32; return true;
}
__device__ __forceinline__ void conv_issue(const ConvItem& c, unsigned char* scr, int lane) {
    const int kr = lane >> 3, p = lane & 7;
    const float* src = c.W + (size_t)(c.k0 + kr) * c.N + c.n0;
#pragma unroll
    for (int i = 0; i < 8; ++i) { const int sc = p ^ ((kr ^ i) & 7);
        __builtin_amdgcn_global_load_lds((const unsigned*)(src + (size_t)(8 * i) * c.N + 4 * sc), (PG8_LAS unsigned*)(scr + i * 1024), 16, 0, 2); }
}
__device__ __forceinline__ void conv_consume(const ConvItem& c, const unsigned char* scr, int lane) {
    asm volatile("s_waitcnt vmcnt(0)" ::: "memory");
    const int cc = lane & 7;
    f32x4 ks0 = (f32x4){1.f, 1.f, 1.f, 1.f}, ks1 = ks0;
    if (c.ks) { ks0 = *(const f32x4*)(c.ks + c.k0 + 8 * cc); ks1 = *(const f32x4*)(c.ks + c.k0 + 8 * cc + 4); }
#pragma unroll
    for (int j = 0; j < 4; ++j) { const int n = (lane >> 3) + 8 * j; float v[8];
#pragma unroll
        for (int t = 0; t < 8; ++t) v[t] = *(const float*)(scr + (8 * cc + t) * 128 + (((n >> 2) ^ ((t ^ cc) & 7)) * 16) + (n & 3) * 4);
        u32x4 o; o.x = pk2(v[0] * ks0.x, v[1] * ks0.y); o.y = pk2(v[2] * ks0.z, v[3] * ks0.w); o.z = pk2(v[4] * ks1.x, v[5] * ks1.y); o.w = pk2(v[6] * ks1.z, v[7] * ks1.w);
        *(u32x4*)(c.WT + (size_t)(c.dst0 + n) * c.K + c.k0 + 8 * cc) = o; }
    LDS_FENCE();
}

#define CMUL_ADD(or_, oi_, ar_, ai_, br_, bi_, cr_, ci_) do { const float _r = fmaf((ar_), (br_), fmaf(-(ai_), (bi_), (cr_))); const float _i = fmaf((ar_), (bi_), fmaf((ai_), (br_), (ci_))); (or_) = _r; (oi_) = _i; } while (0)
template <bool FULL>
__device__ __forceinline__ void s5_wave(const Params& P, unsigned char* wlds, int b, int g, int ch, int lane, int gw) {
    unsigned char* ws = P.ws;
    const bf16* proj = (const bf16*)(ws + WS_PROJ);
    const bf16* BbT = (const bf16*)(ws + WS_S5P + S5P_BBT); const bf16* CmT = (const bf16*)(ws + WS_S5P + S5P_CMT);
    const f32x2* lamp = (const f32x2*)(ws + WS_S5P + S5P_LAM);
    f32x2* ST = (f32x2*)(ws + WS_S5ST);
    const int n = lane & 31, hh = lane >> 5, l15 = lane & 15, l4 = lane >> 4;
    bf16x8 Bb[4];
#pragma unroll
    for (int v = 0; v < 4; ++v) Bb[v] = *(const bf16x8*)(BbT + ((size_t)g * 128 + (v & 1) * 64 + (v >> 1) * 32 + n) * 16 + 8 * hh);
    float lr[2][4], li[2][4];
#pragma unroll
    for (int k = 0; k < 2; ++k) {
        const f32x2 l1 = lamp[g * 64 + k * 32 + n]; lr[k][0] = l1.x; li[k][0] = l1.y;
#pragma unroll
        for (int e = 1; e < 4; ++e) { lr[k][e] = lr[k][e - 1] * l1.x - li[k][e - 1] * l1.y; li[k][e] = lr[k][e - 1] * l1.y + li[k][e - 1] * l1.x; }
    }
    float car[2], cai[2];
    const size_t stbase = (((size_t)b * 16 + ch) * 64 + g) * 64;
    car[0] = cai[0] = car[1] = cai[1] = 0.f;
    if (FULL) {
        const f32x2* lamL = (const f32x2*)(ws + WS_S5P + S5P_LAML);
        const f32x2 L0 = lamL[g * 64 + n], L1 = lamL[g * 64 + 32 + n];
        for (int c = 0; c < ch; ++c) { const size_t eb = (((size_t)b * 16 + c) * 64 + g) * 64; const f32x2 e0 = ST[eb + n], e1 = ST[eb + 32 + n];
            CMUL_ADD(car[0], cai[0], L0.x, L0.y, car[0], cai[0], e0.x, e0.y); CMUL_ADD(car[1], cai[1], L1.x, L1.y, car[1], cai[1], e1.x, e1.y); }
    }
    bf16x8 Cm[4];
    f32x4 dsk = (f32x4){0.f, 0.f, 0.f, 0.f};
    if (FULL) {
#pragma unroll
        for (int ks = 0; ks < 4; ++ks) Cm[ks] = *(const bf16x8*)(CmT + ((size_t)g * 16 + l15) * 128 + ks * 32 + 8 * l4);
        dsk = *(const f32x4*)(P.in[11] + g * 16 + 4 * l4);
    }
    bf16* y1 = (bf16*)(ws + WS_Y1);
    for (int sb = 0; sb < 16; ++sb) {
        const size_t row0 = (size_t)b * SEQ + ch * 512 + sb * 32;
        const bf16x8 U = *(const bf16x8*)(proj + (row0 + n) * INW + 4 * RW + g * 16 + 8 * hh);
        f32x16 bu[4];
#pragma unroll
        for (int v = 0; v < 4; ++v) {
#pragma unroll
            for (int i = 0; i < 16; ++i) bu[v][i] = 0.f;
            bu[v] = MFMA32(U, Bb[v], bu[v]);
        }
        ConvItem cvi; bool cvok = false;
        if (FULL && sb < 10) { cvok = conv_decode(P, sb * 2048 + gw, cvi); if (cvok) conv_issue(cvi, wlds + 8704, lane); }
        float er[2][4], ei[2][4];
#pragma unroll
        for (int k = 0; k < 2; ++k)
#pragma unroll
            for (int q = 0; q < 4; ++q) {
                float sr = bu[2 * k][4 * q], si = bu[2 * k + 1][4 * q];
#pragma unroll
                for (int j = 1; j < 4; ++j) { CMUL_ADD(sr, si, lr[k][0], li[k][0], sr, si, bu[2 * k][4 * q + j], bu[2 * k + 1][4 * q + j]); bu[2 * k][4 * q + j] = sr; bu[2 * k + 1][4 * q + j] = si; }
                er[k][q] = sr; ei[k][q] = si;
            }
        float mr[2][4], mi[2][4];
#pragma unroll
        for (int k = 0; k < 2; ++k) {
            float cr = car[k], ci = cai[k];
#pragma unroll
            for (int q = 0; q < 4; ++q) {
                const float pr = __shfl_xor(er[k][q], 32), pi = __shfl_xor(ei[k][q], 32);
                const float ear = hh ? pr : er[k][q], eai = hh ? pi : ei[k][q];
                const float ebr = hh ? er[k][q] : pr, ebi = hh ? ei[k][q] : pi;
                float c1r, c1i, c2r, c2i;
                CMUL_ADD(c1r, c1i, lr[k][3], li[k][3], cr, ci, ear, eai);
                CMUL_ADD(c2r, c2i, lr[k][3], li[k][3], c1r, c1i, ebr, ebi);
                mr[k][q] = hh ? c1r : cr; mi[k][q] = hh ? c1i : ci;
                cr = c2r; ci = c2i;
            }
            car[k] = cr; cai[k] = ci;
        }
        if (FULL) {
#pragma unroll
            for (int q = 0; q < 4; ++q)
#pragma unroll
                for (int j = 0; j < 4; ++j) {
                    float s0r, s0i, s1r, s1i;
                    CMUL_ADD(s0r, s0i, lr[0][j], li[0][j], mr[0][q], mi[0][q], bu[0][4 * q + j], bu[1][4 * q + j]);
                    CMUL_ADD(s1r, s1i, lr[1][j], li[1][j], mr[1][q], mi[1][q], bu[2][4 * q + j], bu[3][4 * q + j]);
                    u32x2 w; w.x = pk2(s0r, s0i); w.y = pk2(s1r, s1i);
                    *(u32x2*)(wlds + (8 * q + 4 * hh + j) * 272 + n * 8) = w;
                }
            LDS_FENCE();
            f32x4 yt[2];
#pragma unroll
            for (int tt = 0; tt < 2; ++tt) {
                yt[tt] = (f32x4){0.f, 0.f, 0.f, 0.f};
#pragma unroll
                for (int ks = 0; ks < 4; ++ks) { const bf16x8 sv = *(const bf16x8*)(wlds + (tt * 16 + l15) * 272 + (ks * 32 + 8 * l4) * 2); yt[tt] = MFMA16(Cm[ks], sv, yt[tt]); }
            }
            LDS_FENCE();
#pragma unroll
            for (int tt = 0; tt < 2; ++tt) {
                const size_t row = row0 + tt * 16 + l15;
                const u32x2 uw = *(const u32x2*)(proj + row * INW + 4 * RW + g * 16 + 4 * l4);
                const float uu[4] = {bflo(uw.x), bfhi(uw.x), bflo(uw.y), bfhi(uw.y)};
                float o[4];
#pragma unroll
                for (int r = 0; r < 4; ++r) { const float y = yt[tt][r] + dsk[r] * uu[r]; const float z = 1.5957691216057308f * (y + 0.044715f * y * y * y); o[r] = y * pg8::sigmoid_f(z); }
                u32x2 w; w.x = pk2(o[0], o[1]); w.y = pk2(o[2], o[3]);
                *(u32x2*)(y1 + row * SW + g * 16 + 4 * l4) = w;
            }
            if (cvok) conv_consume(cvi, wlds + 8704, lane);
        }
    }
    if (!FULL) { if (hh == 0) { ST[stbase + n] = (f32x2){car[0], cai[0]}; ST[stbase + 32 + n] = (f32x2){car[1], cai[1]}; } }
}

__device__ __forceinline__ void scan_phase(const Params& P, int tid) {
    unsigned char* ws = P.ws;
    const int gt = blockIdx.x * 512 + tid, NGT = gridDim.x * 512;
    for (int e = gt; e < 16 * 8192; e += NGT) {
        const int bh = e >> 13, off = (e & 8191) * 2, h = bh & 7;
        const float dec = __builtin_amdgcn_exp2f(head_lg2(h) * 512.f);
        unsigned* p = (unsigned*)((bf16*)(ws + WS_TOT) + (size_t)bh * 16 * 16384 + off);
        unsigned kv[16];
#pragma unroll
        for (int j = 0; j < 16; ++j) kv[j] = p[(size_t)j * 8192];
        float s0 = 0.f, s1 = 0.f;
#pragma unroll
        for (int j = 0; j < 16; ++j) { p[(size_t)j * 8192] = pk2(s0, s1); s0 = fmaf(s0, dec, bflo(kv[j])); s1 = fmaf(s1, dec, bfhi(kv[j])); }
    }
}

__device__ __forceinline__ void ssm_norm_phase(const Params& P, int lane, int wave) {
    unsigned char* ws = P.ws; const bf16* y2 = (const bf16*)(ws + WS_Y2); bf16* mix = (bf16*)(ws + WS_BUFA);
    const int gw = blockIdx.x * 8 + wave, NGW = gridDim.x * 8;
    for (int m = gw; m < MTOK; m += NGW) {
        const u32x4 a = *(const u32x4*)(y2 + (size_t)m * SW + lane * 8), c = *(const u32x4*)(y2 + (size_t)m * SW + 512 + lane * 8);
        const unsigned w[8] = {a.x, a.y, a.z, a.w, c.x, c.y, c.z, c.w};
        float v[16]; float s = 0.f;
#pragma unroll
        for (int j = 0; j < 8; ++j) { v[2 * j] = bflo(w[j]); v[2 * j + 1] = bfhi(w[j]); s += v[2 * j] * v[2 * j] + v[2 * j + 1] * v[2 * j + 1]; }
        const float r = rsqrtf(wave_sum(s) * (1.f / SW) + EPS);
        const f32x4* g0 = (const f32x4*)(P.in[14] + lane * 8); const f32x4* g1 = (const f32x4*)(P.in[14] + 512 + lane * 8);
        const f32x4 ga = g0[0], gb = g0[1], gc = g1[0], gd = g1[1];
        u32x4 o0, o1;
        o0.x = pk2(v[0] * r * ga.x, v[1] * r * ga.y); o0.y = pk2(v[2] * r * ga.z, v[3] * r * ga.w); o0.z = pk2(v[4] * r * gb.x, v[5] * r * gb.y); o0.w = pk2(v[6] * r * gb.z, v[7] * r * gb.w);
        o1.x = pk2(v[8] * r * gc.x, v[9] * r * gc.y); o1.y = pk2(v[10] * r * gc.z, v[11] * r * gc.w); o1.z = pk2(v[12] * r * gd.x, v[13] * r * gd.y); o1.w = pk2(v[14] * r * gd.z, v[15] * r * gd.w);
        *(u32x4*)(mix + (size_t)m * DM + RW + lane * 8) = o0; *(u32x4*)(mix + (size_t)m * DM + RW + 512 + lane * 8) = o1;
    }
}
__device__ __forceinline__ void final_norm_phase(const Params& P, int lane, int wave) {
    const bf16* x2 = (const bf16*)(P.ws + WS_BUFA);
    const int mb = panel_of((int)blockIdx.x) * 256 + ((int)blockIdx.x >> 6) * 64 + wave * 8;
    for (int m = mb; m < mb + 8; ++m) {
        const bf16* xr = x2 + (size_t)m * DM + lane * 8;
        u32x4 w[4]; float s = 0.f;
#pragma unroll
        for (int j = 0; j < 4; ++j) w[j] = __builtin_nontemporal_load((const u32x4*)(xr + 512 * j));
        float v[4][8];
#pragma unroll
        for (int j = 0; j < 4; ++j) { const unsigned ww[4] = {w[j].x, w[j].y, w[j].z, w[j].w};
#pragma unroll
            for (int k = 0; k < 4; ++k) { v[j][2 * k] = bflo(ww[k]); v[j][2 * k + 1] = bfhi(ww[k]); s += v[j][2 * k] * v[j][2 * k] + v[j][2 * k + 1] * v[j][2 * k + 1]; } }
        const float r = rsqrtf(wave_sum(s) * (1.f / DM) + EPS);
        float* orow = P.out + (size_t)m * DM + lane * 8; const float* gr = P.in[20] + lane * 8;
#pragma unroll
        for (int j = 0; j < 4; ++j) { const f32x4 g0 = *(const f32x4*)(gr + 512 * j), g1 = *(const f32x4*)(gr + 512 * j + 4);
            __builtin_nontemporal_store((f32x4){v[j][0] * r * g0.x, v[j][1] * r * g0.y, v[j][2] * r * g0.z, v[j][3] * r * g0.w}, (f32x4*)(orow + 512 * j));
            __builtin_nontemporal_store((f32x4){v[j][4] * r * g1.x, v[j][5] * r * g1.y, v[j][6] * r * g1.z, v[j][7] * r * g1.w}, (f32x4*)(orow + 512 * j + 4)); }
    }
}

#define LAS __attribute__((address_space(3)))
#define XB_TMO      128
#define XB_XCNT(j)  (256  + 64 * (j))
#define XB_XSUB(j)  (1280 + 64 * (j))
#define XB_XGEN(j)  (2304 + 64 * (j))
#define XB_TOP      3328
#define XB_TOPGEN   3392
#define XCD_BAR_WORDS 3456
#define XB_SPIN_CAP (1u << 18)

__device__ __forceinline__ unsigned xb_ld(unsigned* p)              { return __hip_atomic_load(p, __ATOMIC_RELAXED, __HIP_MEMORY_SCOPE_AGENT); }
__device__ __forceinline__ unsigned xb_add(unsigned* p, unsigned v) { return __hip_atomic_fetch_add(p, v, __ATOMIC_RELAXED, __HIP_MEMORY_SCOPE_AGENT); }
__device__ __forceinline__ unsigned xb_xcc_id() { return (unsigned)__builtin_amdgcn_s_getreg((3 << 11) | 20) & 0xFu; }
#define XB_SPIN(cond, bar) do { unsigned _sp = 0; while (cond) { __builtin_amdgcn_s_sleep(1); \
    if ((++_sp & 255u) == 0u) { if (xb_ld(&(bar)[XB_TMO])) break; if (_sp > XB_SPIN_CAP) { atomicAdd(&(bar)[XB_TMO], 1u); break; } } } } while (0)

struct XcdBarrier {
    unsigned* bar; unsigned x;
    volatile LAS unsigned* st;
};

__device__ __forceinline__ XcdBarrier xcd_barrier_post(unsigned* bar, volatile LAS unsigned* st) {
    XcdBarrier b; b.bar = bar; b.x = xb_xcc_id(); b.st = st;
    if (threadIdx.x == 0) (void)xb_add(&bar[XB_XCNT(b.x)], 1u);
    return b;
}
__device__ __forceinline__ void xcd_barrier_complete(unsigned* bar, unsigned x, unsigned& nloc, unsigned& nx) {
    const unsigned G = gridDim.x * gridDim.y * gridDim.z;
    unsigned sum, cnt, mine, sp = 0u;
    for (;;) {
        sum = 0u; cnt = 0u; mine = 0u;
#pragma unroll
        for (unsigned j = 0; j < 16; ++j) { const unsigned c = xb_ld(&bar[XB_XCNT(j)]); sum += c; cnt += (c > 0u) ? 1u : 0u; mine = (j == x) ? c : mine; }
        if (sum == G) break;
        __builtin_amdgcn_s_sleep(1);
        if ((++sp & 255u) == 0u) { if (xb_ld(&bar[XB_TMO])) break; if (sp > XB_SPIN_CAP) { atomicAdd(&bar[XB_TMO], 1u); break; } }
    }
    nloc = mine > 0u ? mine : 1u; nx = cnt > 0u ? cnt : 1u;
}

__device__ __forceinline__ void xcd_barrier(const XcdBarrier& b) {
    asm volatile("s_waitcnt vmcnt(0)" ::: "memory");
    __syncthreads();
    if (threadIdx.x == 0) {
        unsigned* bar = b.bar;
        __builtin_amdgcn_s_waitcnt(0);
        unsigned nloc = b.st[0], nx = b.st[1];
        if (nloc == 0u) { xcd_barrier_complete(bar, b.x, nloc, nx); b.st[0] = nloc; b.st[1] = nx; }
        const unsigned old = xb_add(&bar[XB_XSUB(b.x)], 1u);
        const unsigned gen = old / nloc;
        if (old + 1u == (gen + 1u) * nloc) {
            __builtin_amdgcn_fence(__ATOMIC_RELEASE, "agent");
            asm volatile("s_waitcnt vmcnt(0)" ::: "memory");
            const unsigned og = xb_add(&bar[XB_TOP], 1u);
            const unsigned tg = og / nx;
            if (og + 1u == (tg + 1u) * nx) xb_add(&bar[XB_TOPGEN], 1u);
            else XB_SPIN(xb_ld(&bar[XB_TOPGEN]) == tg, bar);
            __builtin_amdgcn_fence(__ATOMIC_ACQUIRE, "agent");
            xb_add(&bar[XB_XGEN(b.x)], 1u);
            asm volatile("s_waitcnt vmcnt(0)" ::: "memory");
        } else {
            XB_SPIN(xb_ld(&bar[XB_XGEN(b.x)]) == gen, bar);
            __builtin_amdgcn_fence(__ATOMIC_ACQUIRE, "agent");
            asm volatile("s_waitcnt vmcnt(0)" ::: "memory");
        }
    }
    __syncthreads();
}

__device__ __forceinline__ void group_barrier(unsigned* ctl, int seam, int pm, bool samex) {
    asm volatile("s_waitcnt vmcnt(0)" ::: "memory");
    __syncthreads();
    if (threadIdx.x == 0) {
        unsigned* cnt = ctl + (CTL_GRP / 4) + (seam * 64 + pm) * 64;
        if (!samex) { __builtin_amdgcn_fence(__ATOMIC_RELEASE, "agent"); asm volatile("s_waitcnt vmcnt(0)" ::: "memory"); }
        xb_add(cnt, 1u);
        unsigned sp = 0u;
        while (xb_ld(cnt) < 4u) { __builtin_amdgcn_s_sleep(1); if (++sp > (1u << 22)) break; }
        __builtin_amdgcn_fence(__ATOMIC_ACQUIRE, "agent");
        asm volatile("s_waitcnt vmcnt(0)" ::: "memory");
    }
    __syncthreads();
}
template <int PH>
__device__ __forceinline__ void run_phase(const Params& P, unsigned char* lds, int tid, int lane, int wave) {
    unsigned char* ws = P.ws;
    PG8_LAS unsigned char* glds = (PG8_LAS unsigned char*)lds;
    if constexpr (PH == 0) p0_phase(P, lds, tid, lane, wave);
    if constexpr (PH == 1) {
        pg8::Gemm g{(const bf16*)(ws + WS_XB), (const bf16*)(ws + WS_WIN), MTOK, INW, DM}; pg8::StaticOrder S; S.init(MTOK, INW, gridDim.x, blockIdx.x);
        pg8::EpiStoreBf16 E{(bf16*)(ws + WS_PROJ), INW, (const float*)(ws + WS_RS0)};
        pg8::gemm_phase<pg8::EpiStoreBf16, pg8::StaticOrder, true, true>(glds, g, S, E);
    }
    if constexpr (PH == 2) {
        ret_pass_a(P, lds, tid, lane, wave);
        { const int id = blockIdx.x * 8 + wave; if (id < 2048) s5_wave<false>(P, lds + wave * S5_WLDS, id >> 10, id & 63, (id >> 6) & 15, lane, id); }
    }
    if constexpr (PH == 3) {
        scan_phase(P, tid);
        const int id = blockIdx.x * 8 + wave; if (id < 2048) s5_wave<true>(P, lds + wave * S5_WLDS, id >> 10, id & 63, (id >> 6) & 15, lane, id);
    }
    if constexpr (PH == 5) {
        pg8::Gemm g{(const bf16*)(ws + WS_Y1), (const bf16*)(ws + WS_WGLU), MTOK, SW, SW}; pg8::StaticOrder S; S.init(MTOK, SW, gridDim.x, blockIdx.x);
        pg8::EpiGlu E{(const bf16*)(ws + WS_Y1), P.in[13], P.in[14], (bf16*)(ws + WS_BUFA) + RW, (float*)(ws + WS_SQ2), SW, DM};
        pg8::gemm_phase<pg8::EpiGlu, pg8::StaticOrder, false, true>(glds, g, S, E);
    }
    if constexpr (PH == 6) ret_pass_c(P, lds, tid, lane, wave);
    if constexpr (PH == 7) {
        pg8::Gemm g{(const bf16*)(ws + WS_BUFA), (const bf16*)(ws + WS_WOUT), MTOK, DM, DM}; pg8::StaticOrder S; S.init(MTOK, DM, gridDim.x, blockIdx.x);
        pg8::EpiResB E{nullptr, (const bf16*)(ws + WS_XB), (bf16*)(ws + WS_X1B), DM, (const float*)(ws + WS_SQ2), 1.f / SW, (float*)(ws + WS_SQ1), true};
        pg8::gemm_phase<pg8::EpiResB, pg8::StaticOrder, false, true>(glds, g, S, E);
    }
    if constexpr (PH == 9) {
        pg8::Gemm g{(const bf16*)(ws + WS_X1B), (const bf16*)(ws + WS_WGU), MTOK, 2 * DFF, DM}; pg8::StaticOrder S; S.init(MTOK, 2 * DFF, gridDim.x, blockIdx.x);
        pg8::Unit u0; int pm0 = -1; if (S.next(0, u0)) pm0 = u0.pm;
        float* rsl = (float*)(lds + LDS_KEEP + 64);
        if (pm0 >= 0 && tid < 256) { const f32x4* pp = (const f32x4*)((const float*)(ws + WS_SQ1) + (size_t)(pm0 * 256 + tid) * 32); float t = 0.f;
#pragma unroll
            for (int j = 0; j < 8; ++j) { const f32x4 p4 = pp[j]; t += (p4[0] + p4[1]) + (p4[2] + p4[3]); }
            rsl[tid] = rsqrtf(t * (1.f / DM) + EPS); }
        __syncthreads();
        pg8::EpiSwiGlu E{(bf16*)(ws + WS_ACT), DFF, (const float*)(ws + WS_SQ1), 1.f / DM, rsl, pm0};
        pg8::gemm_phase<pg8::EpiSwiGlu, pg8::StaticOrder, true, true>(glds, g, S, E);
    }
    if constexpr (PH == 10) {
        pg8::Gemm g{(const bf16*)(ws + WS_ACT), (const bf16*)(ws + WS_WD), MTOK, DM, DFF}; pg8::StaticOrder S; S.init(MTOK, DM, gridDim.x, blockIdx.x);
        pg8::EpiResB E{nullptr, (const bf16*)(ws + WS_X1B), (bf16*)(ws + WS_BUFA), DM, nullptr, 0.f, nullptr, false};
        pg8::gemm_phase<pg8::EpiResB, pg8::StaticOrder, false, true>(glds, g, S, E);
    }
    if constexpr (PH == 11) final_norm_phase(P, lane, wave);
}
#define R(k) { int t_ = threadIdx.x; asm volatile("" : "+v"(t_)); run_phase<k>(P, lds, t_, t_ & 63, __builtin_amdgcn_readfirstlane(t_ >> 6)); }
#define BST ((volatile LAS unsigned*)((LAS unsigned char*)lds + LDS_KEEP))
#define S { XcdBarrier b_; b_.bar = (unsigned*)(P.ws + WS_CTL); b_.x = xb_xcc_id(); b_.st = BST; xcd_barrier(b_); }
#define G(k) group_barrier((unsigned*)(P.ws + WS_CTL), k, panel_of((int)blockIdx.x), BST[2] != 0u);
#define PHASE_PROGRAM R(0) S R(1) S R(2) S R(3) S GROUP_CHECK R(5) G(0) R(6) S R(7) G(1) R(9) G(2) R(10) G(3) R(11)
__global__ void __launch_bounds__(512, 2) hybrid_fwd(Params P) {
    extern __shared__ __attribute__((aligned(16))) unsigned char lds[];
    cg::grid_group grid = cg::this_grid();
    const int tid = threadIdx.x, lane = tid & 63, wave = __builtin_amdgcn_readfirstlane(tid >> 6);
    if (P.ws == nullptr) grid.sync();
    if (tid < 3) BST[tid] = 0u;
    __syncthreads();
    { XcdBarrier bar = xcd_barrier_post((unsigned*)(P.ws + WS_CTL), BST); (void)bar; }
    if (tid == 0) __hip_atomic_store((unsigned*)(P.ws + WS_CTL + CTL_XID) + blockIdx.x, xb_xcc_id() + 1u, __ATOMIC_RELAXED, __HIP_MEMORY_SCOPE_AGENT);
#define GROUP_CHECK { unsigned ok_ = 1u; const unsigned* xid_ = (const unsigned*)(P.ws + WS_CTL + CTL_XID); _Pragma("unroll") for (int k_ = 0; k_ < 4; ++k_) ok_ &= (xb_ld((unsigned*)xid_ + ((blockIdx.x & 63) + 64 * k_)) == xb_xcc_id() + 1u) ? 1u : 0u; if (threadIdx.x == 0) BST[2] = ok_; __syncthreads(); }
    PHASE_PROGRAM
}
#undef R
#undef S

extern "C" void kernel_launch(void* const* d_in, const int* in_sizes, int n_in, void* d_out, int out_size, void* d_ws, size_t ws_size, hipStream_t stream) {
    static int grid = 0;
    if (grid == 0) {
        if (n_in != 21 || out_size != MTOK * DM || ws_size < WS_END) { fprintf(stderr, "kernel_launch: unexpected shapes (n_in %d out %d ws %zu)\n", n_in, out_size, ws_size); grid = -1; return; }
        int dev = 0, cus = 0, per_cu = 0;
        (void)hipGetDevice(&dev); (void)hipDeviceGetAttribute(&cus, hipDeviceAttributeMultiprocessorCount, dev);
        if (hipFuncSetAttribute((const void*)hybrid_fwd, hipFuncAttributeMaxDynamicSharedMemorySize, LDS_BYTES) != hipSuccess) { fprintf(stderr, "kernel_launch: hipFuncSetAttribute failed\n"); grid = -1; return; }
        if (hipOccupancyMaxActiveBlocksPerMultiprocessor(&per_cu, (const void*)hybrid_fwd, 512, LDS_BYTES) != hipSuccess || per_cu < 1) { fprintf(stderr, "kernel_launch: occupancy query says %d\n", per_cu); per_cu = 1; }
        (void)hipGetLastError();
        grid = cus * 1;
        if (grid != 256) { fprintf(stderr, "kernel_launch: built for a 256-CU device (got %d)\n", cus); grid = -1; return; }
    }
    if (grid < 0) return;
    Params p{};
    for (int i = 0; i < 21; ++i) p.in[i] = (const float*)d_in[i];
    p.out = (float*)d_out; p.ws = (unsigned char*)d_ws;
    if (hipMemsetAsync((unsigned char*)d_ws + WS_CTL, 0, CTL_ZERO, stream) != hipSuccess) { fprintf(stderr, "kernel_launch: memset of the barrier words failed\n"); return; }
    void* args[] = {&p};
    hipError_t e = hipLaunchCooperativeKernel((const void*)hybrid_fwd, dim3(grid), dim3(512), args, LDS_BYTES, stream);
    if (e != hipSuccess) fprintf(stderr, "cooperative launch failed: %s (grid %d)\n", hipGetErrorString(e), grid);
}
```

```cpp
#include <hip/hip_runtime.h>
#include <hip/hip_cooperative_groups.h>
#include <cstdio>
#include <cstdint>
namespace cg = cooperative_groups;
namespace pg8 {
#define PG8_LAS __attribute__((address_space(3)))
typedef unsigned short bf16_t;
typedef short bf16x8 __attribute__((ext_vector_type(8)));
typedef float f32x4 __attribute__((ext_vector_type(4)));
typedef unsigned u32x4 __attribute__((ext_vector_type(4)));
constexpr int BM = 256, BK = 64, HALF = 128, HTB = HALF * BK * 2  , STAGE_BYTES = 8 * HTB, NXCD = 8, WGM = 8;

__host__ __device__ __forceinline__ int lds_byte(int r, int c) { const int st = (r >> 4) * 2 + (c >> 5), rr = r & 15, cc = c & 31, ob = rr * 64 + cc * 2; return st * 1024 + (ob ^ (((ob >> 9) & 1) << 5)); }
__host__ __device__ __forceinline__ void stage_rc(int b, int& R, int& C) { const int st = b / 1024, sb = b % 1024, swz = sb ^ (((sb >> 9) & 1) << 5); R = (st >> 1) * 16 + swz / 64; C = (st & 1) * 32 + (swz % 64) / 2; }
__host__ __device__ __forceinline__ int perm32(int rho) { const int n = rho >> 4, i = rho & 15; return 8 * (i >> 2) + 4 * n + (i & 3); }

struct Unit { int pm, pn; };
struct Gemm { const bf16_t* A; const bf16_t* Bt; int M, N, K; };

struct StaticOrder {
    int nM, nN, nwg, G, c;
    __host__ __device__ void init(int M, int N, int G_, int c_) { nM = M / BM; nN = N / BM; nwg = nM * nN; G = G_; c = c_; }
    __host__ __device__ bool next(int i, Unit& u) const {
        const long L = (long)i * G + c; if (L >= nwg) return false;
        int wgid = (int)L; { const int q = nwg / NXCD, r = nwg % NXCD, xcd = wgid % NXCD, off = wgid / NXCD; wgid = (xcd < r ? xcd * (q + 1) : r * (q + 1) + (xcd - r) * q) + off; }
        const int nig = WGM * nN, gid = wgid / nig, fm = gid * WGM, gsz = (nM - fm) < WGM ? (nM - fm) : WGM;
        u.pm = fm + ((wgid % nig) % gsz); u.pn = (wgid % nig) / gsz; return true;
    }
    __device__ __forceinline__ void a_ready(const Unit&) const {}
    __device__ __forceinline__ void done(const Unit&) const {}
};

typedef __bf16 bf16x2_t __attribute__((ext_vector_type(2)));
__device__ __forceinline__ unsigned cvt_pk_bf16(float lo, float hi) { bf16x2_t v = {(__bf16)lo, (__bf16)hi}; return __builtin_bit_cast(unsigned, v); }
__device__ __forceinline__ float bf_lo(unsigned w) { return __uint_as_float(w << 16); }
__device__ __forceinline__ float bf_hi(unsigned w) { return __uint_as_float(w & 0xffff0000u); }
typedef unsigned u32x2v __attribute__((ext_vector_type(2)));
__device__ __forceinline__ float sigmoid_f(float z) { return __builtin_amdgcn_rcpf(1.0f + __expf(-z)); }

struct EpiStoreBf16 {
    static constexpr bool PERM = true, AFTER_DRAIN = false;
    bf16_t* O; int ldc; const float* rs;
    __device__ __forceinline__ void operator()(const f32x4 (&acc)[2][2][4][2], const Unit& u, int wr, int wc, int fr, int fq) const {
        const int row0 = u.pm * BM + wr * 64 + fr, col0 = u.pn * BM + wc * 32 + 8 * fq;
        float rv[2][4];
#pragma unroll
        for (int ai = 0; ai < 2; ++ai)
#pragma unroll
            for (int m = 0; m < 4; ++m) rv[ai][m] = rs[row0 + ai * HALF + m * 16];
#pragma unroll
        for (int ai = 0; ai < 2; ++ai)
#pragma unroll
            for (int m = 0; m < 4; ++m) { bf16_t* rowp = O + (size_t)(row0 + ai * HALF + m * 16) * ldc + col0;
#pragma unroll
                for (int bj = 0; bj < 2; ++bj) { const f32x4 v0 = acc[ai][bj][m][0] * rv[ai][m], v1 = acc[ai][bj][m][1] * rv[ai][m];
                    u32x4 w; w.x = cvt_pk_bf16(v0[0], v0[1]); w.y = cvt_pk_bf16(v0[2], v0[3]); w.z = cvt_pk_bf16(v1[0], v1[1]); w.w = cvt_pk_bf16(v1[2], v1[3]);
                    *(u32x4*)(rowp + bj * HALF) = w; } }
    }
};
struct EpiGlu {
    static constexpr bool PERM = true, AFTER_DRAIN = false;
    const bf16_t* Y1; const float* bias; const float* gain; bf16_t* Y2; float* rowsq; int ldc, ldo;
    __device__ __forceinline__ void operator()(const f32x4 (&acc)[2][2][4][2], const Unit& u, int wr, int wc, int fr, int fq) const {
        const int row0 = u.pm * BM + wr * 64 + fr, col0 = u.pn * BM + wc * 32 + 8 * fq;
        f32x4 bv[2][2], gv[2][2];
#pragma unroll
        for (int bj = 0; bj < 2; ++bj)
#pragma unroll
            for (int n = 0; n < 2; ++n) { bv[bj][n] = *(const f32x4*)(bias + col0 + bj * HALF + 4 * n); gv[bj][n] = *(const f32x4*)(gain + col0 + bj * HALF + 4 * n); }
#pragma unroll
        for (int ai = 0; ai < 2; ++ai) {
            u32x4 yv[4][2];
#pragma unroll
            for (int m = 0; m < 4; ++m)
#pragma unroll
                for (int bj = 0; bj < 2; ++bj) yv[m][bj] = *(const u32x4*)(Y1 + (size_t)(row0 + ai * HALF + m * 16) * ldc + col0 + bj * HALF);
#pragma unroll
            for (int m = 0; m < 4; ++m) { const int row = row0 + ai * HALF + m * 16; const size_t offo = (size_t)row * ldo + col0;
                float ss = 0.f;
#pragma unroll
                for (int bj = 0; bj < 2; ++bj) { const f32x4 z0 = acc[ai][bj][m][0] + bv[bj][0], z1 = acc[ai][bj][m][1] + bv[bj][1];
                    const u32x4 y = yv[m][bj];
                    f32x4 r0, r1;
                    r0[0] = bf_lo(y.x) * sigmoid_f(z0[0]); r0[1] = bf_hi(y.x) * sigmoid_f(z0[1]); r0[2] = bf_lo(y.y) * sigmoid_f(z0[2]); r0[3] = bf_hi(y.y) * sigmoid_f(z0[3]);
                    r1[0] = bf_lo(y.z) * sigmoid_f(z1[0]); r1[1] = bf_hi(y.z) * sigmoid_f(z1[1]); r1[2] = bf_lo(y.w) * sigmoid_f(z1[2]); r1[3] = bf_hi(y.w) * sigmoid_f(z1[3]);
                    ss += (r0[0] * r0[0] + r0[1] * r0[1]) + (r0[2] * r0[2] + r0[3] * r0[3]) + (r1[0] * r1[0] + r1[1] * r1[1]) + (r1[2] * r1[2] + r1[3] * r1[3]);
                    r0 = r0 * gv[bj][0]; r1 = r1 * gv[bj][1];
                    u32x4 w; w.x = cvt_pk_bf16(r0[0], r0[1]); w.y = cvt_pk_bf16(r0[2], r0[3]); w.z = cvt_pk_bf16(r1[0], r1[1]); w.w = cvt_pk_bf16(r1[2], r1[3]);
                    *(u32x4*)(Y2 + offo + bj * HALF) = w; }
                ss += __shfl_xor(ss, 16); ss += __shfl_xor(ss, 32);
                if (fq == 0) rowsq[(size_t)row * 16 + u.pn * 4 + wc] = ss; }
        }
    }
};
struct EpiResF32 {
    static constexpr bool PERM = false, AFTER_DRAIN = false;
    const float* X; float* O; int ldc; const float* insq; float inv_indim; bf16_t* OB; float* outsq;
    __device__ __forceinline__ void operator()(const f32x4 (&acc)[2][2][4][2], const Unit& u, int wr, int wc, int fr, int fq) const {
        const int row0 = u.pm * BM + wr * 64 + fr, col0 = u.pn * BM + wc * 32 + 4 * fq;
#pragma unroll
        for (int ai = 0; ai < 2; ++ai)
#pragma unroll
        for (int mh = 0; mh < 2; ++mh) {
            f32x4 xv[2][2][2]; f32x4 p4[2];
#pragma unroll
            for (int mm = 0; mm < 2; ++mm) { const int row = row0 + ai * HALF + (2 * mh + mm) * 16; const size_t off = (size_t)row * ldc + col0;
                p4[mm] = insq ? *(const f32x4*)(insq + (size_t)row * 16 + 4 * fq) : (f32x4){0.f, 0.f, 0.f, 0.f};
#pragma unroll
                for (int bj = 0; bj < 2; ++bj)
#pragma unroll
                    for (int n = 0; n < 2; ++n) xv[mm][bj][n] = *(const f32x4*)(X + off + bj * HALF + n * 16); }
#pragma unroll
            for (int mm = 0; mm < 2; ++mm) { const int m = 2 * mh + mm; const int row = row0 + ai * HALF + m * 16; const size_t off = (size_t)row * ldc + col0;
                float sc = 1.0f;
                if (insq) { float t = (p4[mm][0] + p4[mm][1]) + (p4[mm][2] + p4[mm][3]); t += __shfl_xor(t, 16); t += __shfl_xor(t, 32); sc = rsqrtf(t * inv_indim + 1e-6f); }
                float ss = 0.f;
#pragma unroll
                for (int bj = 0; bj < 2; ++bj)
#pragma unroll
                    for (int n = 0; n < 2; ++n) { const f32x4 o = xv[mm][bj][n] + acc[ai][bj][m][n] * sc;
                        *(f32x4*)(O + off + bj * HALF + n * 16) = o;
                        if (OB) { ss += (o[0] * o[0] + o[1] * o[1]) + (o[2] * o[2] + o[3] * o[3]); u32x2v w; w.x = cvt_pk_bf16(o[0], o[1]); w.y = cvt_pk_bf16(o[2], o[3]); *(u32x2v*)(OB + off + bj * HALF + n * 16) = w; } }
                if (OB) { ss += __shfl_xor(ss, 16); ss += __shfl_xor(ss, 32); if (fq == 0) outsq[(size_t)row * 32 + u.pn * 4 + wc] = ss; } }
        }
    }
};
struct EpiResB {
    static constexpr bool PERM = true, AFTER_DRAIN = false;
    const float* X; const bf16_t* XB; bf16_t* OB; int ldc; const float* insq; float inv_indim; float* outsq; bool ntx;
    __device__ __forceinline__ void operator()(const f32x4 (&acc)[2][2][4][2], const Unit& u, int wr, int wc, int fr, int fq) const {
        const int row0 = u.pm * BM + wr * 64 + fr, col0 = u.pn * BM + wc * 32 + 8 * fq;
#pragma unroll
        for (int ai = 0; ai < 2; ++ai)
#pragma unroll
        for (int mh = 0; mh < 2; ++mh) {
            f32x4 xv[2][2][2]; f32x4 p4[2];
#pragma unroll
            for (int mm = 0; mm < 2; ++mm) { const int row = row0 + ai * HALF + (2 * mh + mm) * 16; const size_t off = (size_t)row * ldc + col0;
                p4[mm] = insq ? *(const f32x4*)(insq + (size_t)row * 16 + 4 * fq) : (f32x4){0.f, 0.f, 0.f, 0.f};
#pragma unroll
                for (int bj = 0; bj < 2; ++bj) {
                    if (XB) { const u32x4 y = ntx ? __builtin_nontemporal_load((const u32x4*)(XB + off + bj * HALF)) : *(const u32x4*)(XB + off + bj * HALF); xv[mm][bj][0] = (f32x4){bf_lo(y.x), bf_hi(y.x), bf_lo(y.y), bf_hi(y.y)}; xv[mm][bj][1] = (f32x4){bf_lo(y.z), bf_hi(y.z), bf_lo(y.w), bf_hi(y.w)}; }
                    else { xv[mm][bj][0] = *(const f32x4*)(X + off + bj * HALF); xv[mm][bj][1] = *(const f32x4*)(X + off + bj * HALF + 4); } } }
#pragma unroll
            for (int mm = 0; mm < 2; ++mm) { const int m = 2 * mh + mm; const int row = row0 + ai * HALF + m * 16; const size_t off = (size_t)row * ldc + col0;
                float sc = 1.0f;
                if (insq) { float t = (p4[mm][0] + p4[mm][1]) + (p4[mm][2] + p4[mm][3]); t += __shfl_xor(t, 16); t += __shfl_xor(t, 32); sc = rsqrtf(t * inv_indim + 1e-6f); }
                float ss = 0.f;
#pragma unroll
                for (int bj = 0; bj < 2; ++bj) { const f32x4 o0 = xv[mm][bj][0] + acc[ai][bj][m][0] * sc, o1 = xv[mm][bj][1] + acc[ai][bj][m][1] * sc;
                    ss += ((o0[0] * o0[0] + o0[1] * o0[1]) + (o0[2] * o0[2] + o0[3] * o0[3])) + ((o1[0] * o1[0] + o1[1] * o1[1]) + (o1[2] * o1[2] + o1[3] * o1[3]));
                    u32x4 w; w.x = cvt_pk_bf16(o0[0], o0[1]); w.y = cvt_pk_bf16(o0[2], o0[3]); w.z = cvt_pk_bf16(o1[0], o1[1]); w.w = cvt_pk_bf16(o1[2], o1[3]);
                    *(u32x4*)(OB + off + bj * HALF) = w; }
                if (outsq) { ss += __shfl_xor(ss, 16); ss += __shfl_xor(ss, 32); if (fq == 0) outsq[(size_t)row * 32 + u.pn * 4 + wc] = ss; } }
        }
    }
};
struct EpiSwiGlu {
    static constexpr bool PERM = true, AFTER_DRAIN = false;
    bf16_t* O; int ldc; const float* insq; float inv_indim; const float* rs_lds; int pm_lds;
    __device__ __forceinline__ void operator()(const f32x4 (&acc)[2][2][4][2], const Unit& u, int wr, int wc, int fr, int fq) const {
        const int row0 = u.pm * BM + wr * 64 + fr, col0 = u.pn * HALF + wc * 32 + 8 * fq;
        float scv[2][4];
        if (u.pm == pm_lds) {
#pragma unroll
          for (int ai = 0; ai < 2; ++ai)
#pragma unroll
              for (int m = 0; m < 4; ++m) scv[ai][m] = rs_lds[wr * 64 + fr + ai * HALF + m * 16];
        } else { f32x4 pa[2][4], pb[2][4];
#pragma unroll
          for (int ai = 0; ai < 2; ++ai)
#pragma unroll
              for (int m = 0; m < 4; ++m) { const float* pp = insq + (size_t)(row0 + ai * HALF + m * 16) * 32 + 8 * fq; pa[ai][m] = *(const f32x4*)pp; pb[ai][m] = *(const f32x4*)(pp + 4); }
#pragma unroll
          for (int ai = 0; ai < 2; ++ai)
#pragma unroll
              for (int m = 0; m < 4; ++m) { float t = ((pa[ai][m][0] + pa[ai][m][1]) + (pa[ai][m][2] + pa[ai][m][3])) + ((pb[ai][m][0] + pb[ai][m][1]) + (pb[ai][m][2] + pb[ai][m][3]));
                  t += __shfl_xor(t, 16); t += __shfl_xor(t, 32); scv[ai][m] = rsqrtf(t * inv_indim + 1e-6f); } }
#pragma unroll
        for (int ai = 0; ai < 2; ++ai)
#pragma unroll
            for (int m = 0; m < 4; ++m) { const int row = row0 + ai * HALF + m * 16; bf16_t* rowp = O + (size_t)row * ldc + col0;
                const float sc = scv[ai][m];
                f32x4 r0, r1;
#pragma unroll
                for (int j = 0; j < 4; ++j) { const float g0 = acc[ai][0][m][0][j] * sc, g1 = acc[ai][0][m][1][j] * sc;
                    r0[j] = g0 * sigmoid_f(g0) * (acc[ai][1][m][0][j] * sc); r1[j] = g1 * sigmoid_f(g1) * (acc[ai][1][m][1][j] * sc); }
                u32x4 w; w.x = cvt_pk_bf16(r0[0], r0[1]); w.y = cvt_pk_bf16(r0[2], r0[3]); w.z = cvt_pk_bf16(r1[0], r1[1]); w.w = cvt_pk_bf16(r1[2], r1[3]);
                *(u32x4*)rowp = w; }
    }
};


template <class Epi, class Sched, bool ALIGN_EPI = false, bool SP2 = false>
__device__ __forceinline__ void gemm_phase(PG8_LAS unsigned char* lds, const Gemm g, const Sched& S, const Epi& E) {
    int tid_ = threadIdx.x; asm volatile("" : "+v"(tid_));
    const int tid = tid_, wid = __builtin_amdgcn_readfirstlane(tid >> 6), lane = tid & 63, wr = wid >> 2, wc = wid & 3, fr = lane & 15, fq = lane >> 4;
    const int K = g.K, nt = K / BK;
    unsigned voffA[2], voffB[2];
#pragma unroll
    for (int i = 0; i < 2; ++i) { int R, C; stage_rc(tid * 16 + i * 8192, R, C); const int Rb = Epi::PERM ? ((R & ~31) + perm32(R & 31)) : R;
        voffA[i] = (unsigned)(R * K + C) * 2u; voffB[i] = (unsigned)(Rb * K + C) * 2u; }
    const size_t kstep = (size_t)(BK * 2);
    const size_t hstep = (size_t)HALF * K * 2;
    const size_t tstep = 2 * hstep;
    const unsigned ldsw = (unsigned)wid * 1024u;
    const int aoff = lds_byte(wr * 64 + fr, fq * 8), boff = lds_byte(wc * 32 + fr, fq * 8);
#define PG8_SA(b, h) (((b) * 2 + (h)) * HTB)
#define PG8_SB(b, h) ((4 + (b) * 2 + (h)) * HTB)
#define PG8_STAGE(bufoff, gbase, voff) do { _Pragma("unroll") for (int _i = 0; _i < 2; ++_i) \
        __builtin_amdgcn_global_load_lds((const unsigned*)((const char*)(gbase) + (voff)[_i]), (PG8_LAS unsigned*)(lds + (bufoff) + ldsw + _i * 8192), 16, 0, 0); } while (0)
#define PG8_LDA(dst, b, h) do { _Pragma("unroll") for (int m = 0; m < 4; ++m) _Pragma("unroll") for (int k = 0; k < 2; ++k) dst[m][k] = *(const PG8_LAS bf16x8*)(lds + PG8_SA(b, h) + aoff + m * 2048 + k * 1024); } while (0)
#define PG8_LDB(dst, b, h) do { _Pragma("unroll") for (int n = 0; n < 2; ++n) _Pragma("unroll") for (int k = 0; k < 2; ++k) dst[n][k] = *(const PG8_LAS bf16x8*)(lds + PG8_SB(b, h) + boff + n * 2048 + k * 1024); } while (0)
#define PG8_MMA(ai, bj, At, Bt) do { __builtin_amdgcn_s_setprio(1); _Pragma("unroll") for (int m = 0; m < 4; ++m) _Pragma("unroll") for (int n = 0; n < 2; ++n) _Pragma("unroll") for (int k = 0; k < 2; ++k) \
        acc[ai][bj][m][n] = __builtin_amdgcn_mfma_f32_16x16x32_bf16(Bt[n][k], At[m][k], acc[ai][bj][m][n], 0, 0, 0); __builtin_amdgcn_s_setprio(0); } while (0)
#define PG8_WAIT_V(n) asm volatile("s_waitcnt vmcnt(" #n ")" ::: "memory")
#define PG8_WAIT_L(n) asm volatile("s_waitcnt lgkmcnt(" #n ")" ::: "memory")
#define PG8_BAR __builtin_amdgcn_s_barrier()
#define PG8_SCHED __builtin_amdgcn_sched_barrier(0)
    Unit cur, nxt; int ui = 0;
    if (!S.next(0, cur)) return;
    f32x4 acc[2][2][4][2];
#pragma unroll
    for (int a = 0; a < 2; ++a)
#pragma unroll
        for (int b = 0; b < 2; ++b)
#pragma unroll
            for (int m = 0; m < 4; ++m)
#pragma unroll
                for (int n = 0; n < 2; ++n) acc[a][b][m][n] = (f32x4){0.f, 0.f, 0.f, 0.f};
    bf16x8 At[4][2], B0[2][2], B1[2][2];
    const char* cA = (const char*)g.A + (size_t)cur.pm * tstep; const char* cB = (const char*)g.Bt + (size_t)cur.pn * tstep;
    S.a_ready(cur);
    if constexpr (SP2) {
        PG8_STAGE(PG8_SB(0, 0), cB, voffB); PG8_STAGE(PG8_SB(0, 1), cB + hstep, voffB); PG8_STAGE(PG8_SA(0, 0), cA, voffA); PG8_STAGE(PG8_SA(0, 1), cA + hstep, voffA);
        if (wr == 1) PG8_BAR;
        PG8_WAIT_V(2); PG8_BAR;
        PG8_STAGE(PG8_SB(1, 0), cB + kstep, voffB); PG8_STAGE(PG8_SA(1, 0), cA + kstep, voffA); PG8_STAGE(PG8_SB(1, 1), cB + hstep + kstep, voffB);
        PG8_WAIT_V(6); PG8_BAR;
    } else {
        PG8_STAGE(PG8_SB(0, 0), cB, voffB); PG8_STAGE(PG8_SA(0, 0), cA, voffA); PG8_STAGE(PG8_SB(0, 1), cB + hstep, voffB); PG8_STAGE(PG8_SA(0, 1), cA + hstep, voffA);
        if (wr == 1) PG8_BAR;
        PG8_WAIT_V(4); PG8_BAR;
        PG8_STAGE(PG8_SB(1, 0), cB + kstep, voffB); PG8_STAGE(PG8_SA(1, 0), cA + kstep, voffA); PG8_STAGE(PG8_SB(1, 1), cB + hstep + kstep, voffB);
        PG8_WAIT_V(6); PG8_BAR;
    }
    for (;;) {
        const bool has_next = S.next(ui + 1, nxt);
        const char* nA = has_next ? (const char*)g.A + (size_t)nxt.pm * tstep : cA; const char* nB = has_next ? (const char*)g.Bt + (size_t)nxt.pn * tstep : cB;
        for (int t = 0; t < nt; t += 2) {
            const bool last = (t == nt - 2);
            const char* a1 = cA + (size_t)(t + 1) * kstep;
            const char* a2 = last ? nA : cA + (size_t)(t + 2) * kstep; const char* b2 = last ? nB : cB + (size_t)(t + 2) * kstep;
            const char* a3 = a2 + kstep; const char* b3 = b2 + kstep;
            if (last && has_next) S.a_ready(nxt);
            if constexpr (SP2) {
            PG8_LDB(B0, 0, 0); PG8_LDB(B1, 0, 1); PG8_SCHED; PG8_LDA(At, 0, 0); PG8_STAGE(PG8_SA(1, 1), a1 + hstep, voffA);
            PG8_WAIT_V(8); PG8_WAIT_L(0); PG8_BAR; PG8_MMA(0, 0, At, B0); PG8_MMA(0, 1, At, B1); PG8_BAR; PG8_SCHED;
            PG8_LDA(At, 0, 1); PG8_STAGE(PG8_SB(0, 0), b2, voffB); PG8_STAGE(PG8_SB(0, 1), b2 + hstep, voffB); PG8_STAGE(PG8_SA(0, 0), a2, voffA);
            PG8_WAIT_V(8); PG8_WAIT_L(0); PG8_BAR; PG8_MMA(1, 0, At, B0); PG8_MMA(1, 1, At, B1); PG8_BAR; PG8_SCHED;
            PG8_LDB(B0, 1, 0); PG8_LDB(B1, 1, 1); PG8_SCHED; PG8_LDA(At, 1, 0); PG8_STAGE(PG8_SA(0, 1), a2 + hstep, voffA);
            PG8_WAIT_V(8); PG8_WAIT_L(0); PG8_BAR; PG8_MMA(0, 0, At, B0); PG8_MMA(0, 1, At, B1); PG8_BAR; PG8_SCHED;
            PG8_LDA(At, 1, 1); PG8_STAGE(PG8_SB(1, 0), b3, voffB); PG8_STAGE(PG8_SB(1, 1), b3 + hstep, voffB); PG8_STAGE(PG8_SA(1, 0), a3, voffA);
            PG8_WAIT_V(8); PG8_WAIT_L(0); PG8_BAR; PG8_MMA(1, 0, At, B0); PG8_MMA(1, 1, At, B1); PG8_BAR; PG8_SCHED;
            } else {
            PG8_LDB(B0, 0, 0); PG8_SCHED; PG8_LDA(At, 0, 0); PG8_STAGE(PG8_SA(1, 1), a1 + hstep, voffA);
            PG8_WAIT_L(8); PG8_BAR; PG8_WAIT_L(0); PG8_MMA(0, 0, At, B0); PG8_BAR; PG8_SCHED;
            PG8_LDB(B1, 0, 1); PG8_STAGE(PG8_SB(0, 0), b2, voffB);
            PG8_BAR; PG8_WAIT_L(0); PG8_MMA(0, 1, At, B1); PG8_BAR;
            PG8_LDA(At, 0, 1); PG8_STAGE(PG8_SA(0, 0), a2, voffA);
            PG8_BAR; PG8_WAIT_L(0); PG8_MMA(1, 0, At, B0); PG8_BAR; PG8_SCHED;
            PG8_STAGE(PG8_SB(0, 1), b2 + hstep, voffB);
            PG8_WAIT_V(6); PG8_BAR; PG8_MMA(1, 1, At, B1); PG8_BAR;
            PG8_LDB(B0, 1, 0); PG8_SCHED; PG8_LDA(At, 1, 0); PG8_STAGE(PG8_SA(0, 1), a2 + hstep, voffA);
            PG8_WAIT_L(8); PG8_BAR; PG8_WAIT_L(0); PG8_MMA(0, 0, At, B0); PG8_BAR; PG8_SCHED;
            PG8_LDB(B1, 1, 1); PG8_STAGE(PG8_SB(1, 0), b3, voffB);
            PG8_BAR; PG8_WAIT_L(0); PG8_MMA(0, 1, At, B1); PG8_BAR;
            PG8_LDA(At, 1, 1); PG8_STAGE(PG8_SA(1, 0), a3, voffA);
            PG8_BAR; PG8_WAIT_L(0); PG8_MMA(1, 0, At, B0); PG8_BAR; PG8_SCHED;
            PG8_STAGE(PG8_SB(1, 1), b3 + hstep, voffB);
            PG8_WAIT_V(6); PG8_BAR; PG8_MMA(1, 1, At, B1); PG8_BAR;
            }
        }
        if constexpr (ALIGN_EPI) { if (wr == 0) PG8_BAR; }
        if constexpr (!Epi::AFTER_DRAIN) { E(acc, cur, wr, wc, fr, fq); S.done(cur); }
        if (!has_next) break;
#pragma unroll
        for (int a = 0; a < 2; ++a)
#pragma unroll
            for (int b = 0; b < 2; ++b)
#pragma unroll
                for (int m = 0; m < 4; ++m)
#pragma unroll
                    for (int n = 0; n < 2; ++n) acc[a][b][m][n] = (f32x4){0.f, 0.f, 0.f, 0.f};
        cur = nxt; cA = nA; cB = nB; ++ui;
        if constexpr (ALIGN_EPI) { if (wr == 1) PG8_BAR; }
    }
    PG8_WAIT_V(0);
    if constexpr (!ALIGN_EPI) { if (wr == 0) PG8_BAR; }
    PG8_BAR;
    if constexpr (Epi::AFTER_DRAIN) { E.fused(acc, cur, wr, wc, fr, fq, lds, wid, lane); S.done(cur); }
#undef PG8_SA
#undef PG8_SB
#undef PG8_STAGE
#undef PG8_LDA
#undef PG8_LDB
#undef PG8_MMA
#undef PG8_WAIT_V
#undef PG8_WAIT_L
#undef PG8_BAR
#undef PG8_SCHED
}
}

typedef unsigned short bf16;
typedef short bf16x8 __attribute__((ext_vector_type(8)));
typedef float f32x4 __attribute__((ext_vector_type(4)));
typedef float f32x2 __attribute__((ext_vector_type(2)));
typedef float f32x16 __attribute__((ext_vector_type(16)));
typedef unsigned u32x4 __attribute__((ext_vector_type(4)));
typedef unsigned u32x2 __attribute__((ext_vector_type(2)));

constexpr int DM = 2048, SEQ = 8192, MTOK = 16384, INW = 5120, RW = 1024, NH = 8, HD = 128, SW = 1024, NG = 64, NP = 64, DFF = 5632;
constexpr float EPS = 1e-6f;
constexpr size_t MiB = 1u << 20;
constexpr size_t WS_WIN = 0, WS_WGLU = 20 * MiB, WS_WOUT = 22 * MiB, WS_WGU = 30 * MiB, WS_WD = 74 * MiB, WS_ROPE = 96 * MiB, WS_S5P = 100 * MiB, WS_S5ST = 101 * MiB,
                 WS_BUFA = 102 * MiB, WS_PROJ = 166 * MiB, WS_KV = 326 * MiB, WS_XB = 390 * MiB, WS_CTL = 454 * MiB, WS_SQ1 = 455 * MiB, WS_SQ2 = 457 * MiB, WS_TOT = 458 * MiB, WS_Y1 = 466 * MiB, WS_RS0 = 498 * MiB, WS_END = 499 * MiB, WS_ACT = WS_PROJ, WS_X1B = WS_XB, WS_Y2 = WS_Y1;
constexpr size_t CTL_XID = 16384, CTL_GRP = 32768, CTL_ZERO = 131072;
constexpr size_t S5P_BBT = 0, S5P_CMT = 256 * 1024, S5P_LAM = 512 * 1024, S5P_LAML = 544 * 1024;
constexpr int LDS_BYTES = 137216, LDS_KEEP = 135168, S5_WLDS = 16896;
constexpr int NPHASE = 12;

__device__ __forceinline__ int panel_of(int c) { return 8 * (c & 7) + ((c >> 3) & 7); }

struct Params { const float* in[21]; float* out; unsigned char* ws; };

#define MFMA32(a, b, c) __builtin_amdgcn_mfma_f32_32x32x16_bf16((a), (b), (c), 0, 0, 0)
#define MFMA16(a, b, c) __builtin_amdgcn_mfma_f32_16x16x32_bf16((a), (b), (c), 0, 0, 0)
#define LDS_FENCE() asm volatile("s_waitcnt lgkmcnt(0)" ::: "memory")

__device__ __forceinline__ float bflo(unsigned w) { return __uint_as_float(w << 16); }
__device__ __forceinline__ float bfhi(unsigned w) { return __uint_as_float(w & 0xffff0000u); }
__device__ __forceinline__ unsigned pk2(float lo, float hi) { return pg8::cvt_pk_bf16(lo, hi); }
__device__ __forceinline__ float wave_sum(float v) {
#pragma unroll
    for (int o = 1; o < 64; o <<= 1) v += __shfl_xor(v, o);
    return v;
}
__device__ __forceinline__ void sincos_d(double x, double& s, double& c) {
    const double k = rint(x * 0.63661977236758134308);
    double r = fma(-k, 1.57079632679489655800e+00, x); r = fma(-k, 6.12323399573676603587e-17, r);
    const int q = ((int)(long long)k) & 3;
    const double r2 = r * r;
    const double sn = r * (1.0 + r2 * (-1.0 / 6.0 + r2 * (1.0 / 120.0 + r2 * (-1.0 / 5040.0 + r2 * (1.0 / 362880.0 + r2 * (-1.0 / 39916800.0 + r2 * (1.0 / 6227020800.0 + r2 * (-1.0 / 1307674368000.0))))))));
    const double cs = 1.0 + r2 * (-0.5 + r2 * (1.0 / 24.0 + r2 * (-1.0 / 720.0 + r2 * (1.0 / 40320.0 + r2 * (-1.0 / 3628800.0 + r2 * (1.0 / 479001600.0 + r2 * (-1.0 / 87178291200.0 + r2 * (1.0 / 20922789888000.0))))))));
    s = (q == 0) ? sn : (q == 1) ? cs : (q == 2) ? -sn : -cs;
    c = (q == 0) ? cs : (q == 1) ? -sn : (q == 2) ? -cs : sn;
}

__device__ __forceinline__ void p0_transpose_item(const float* W, int K, int N, bf16* WT, int k0, int n0, int dst_row0, float* scr, int lane, const float* kscale = nullptr) {
#pragma unroll 8
    for (int i = 0; i < 32; ++i) { const int kk = 2 * i + (lane >> 5); scr[kk * 33 + (lane & 31)] = __builtin_nontemporal_load(W + (size_t)(k0 + kk) * N + n0 + (lane & 31)); }
    const int c = lane & 7;
    f32x4 ks0 = (f32x4){1.f, 1.f, 1.f, 1.f}, ks1 = ks0;
    if (kscale) { ks0 = *(const f32x4*)(kscale + k0 + 8 * c); ks1 = *(const f32x4*)(kscale + k0 + 8 * c + 4); }
    LDS_FENCE();
#pragma unroll
    for (int j = 0; j < 4; ++j) { const int n = (lane >> 3) + 8 * j; const float* s = scr + (8 * c) * 33 + n;
        u32x4 o; o.x = pk2(s[0 * 33] * ks0.x, s[1 * 33] * ks0.y); o.y = pk2(s[2 * 33] * ks0.z, s[3 * 33] * ks0.w); o.z = pk2(s[4 * 33] * ks1.x, s[5 * 33] * ks1.y); o.w = pk2(s[6 * 33] * ks1.z, s[7 * 33] * ks1.w);
        *(u32x4*)(WT + (size_t)(dst_row0 + n) * K + k0 + 8 * c) = o; }
    LDS_FENCE();
}
__device__ __forceinline__ void rms_row_to_bf16(const float* xrow, const float* g, bf16* orow, int lane) {
    const f32x4* xr = (const f32x4*)xrow + lane; const f32x4* gr = (const f32x4*)g + lane;
    f32x4 v[8]; float s = 0.f;
#pragma unroll
    for (int j = 0; j < 8; ++j) { v[j] = xr[64 * j]; s += (v[j].x * v[j].x + v[j].y * v[j].y) + (v[j].z * v[j].z + v[j].w * v[j].w); }
    const float r = rsqrtf(wave_sum(s) * (1.f / DM) + EPS);
    u32x2* o8 = (u32x2*)orow + lane;
#pragma unroll
    for (int j = 0; j < 8; ++j) { const f32x4 gg = gr[64 * j]; u32x2 w; w.x = pk2(v[j].x * r * gg.x, v[j].y * r * gg.y); w.y = pk2(v[j].z * r * gg.z, v[j].w * r * gg.w); o8[64 * j] = w; }
}
__device__ __forceinline__ void p0_phase(const Params& P, unsigned char* lds, int tid, int lane, int wave) {
    unsigned char* ws = P.ws;
    const int gw = blockIdx.x * 8 + wave, NGW = gridDim.x * 8;
    float* scr = (float*)(lds + wave * 16384);
    constexpr int I_IN = 32 * 160;
    for (int it = gw; it < I_IN; it += NGW) { const int kb = it / 160, nb = it % 160; p0_transpose_item(P.in[2], DM, INW, (bf16*)(ws + WS_WIN), kb * 64, nb * 32, nb * 32, scr, lane, P.in[1]); }
    for (int m = gw; m < MTOK; m += NGW) {
        const f32x4* xr = (const f32x4*)(P.in[0] + (size_t)m * DM) + lane; u32x2* o8 = (u32x2*)((bf16*)(ws + WS_XB) + (size_t)m * DM) + lane;
        f32x4 v[8]; float ss = 0.f;
#pragma unroll
        for (int j = 0; j < 8; ++j) { v[j] = __builtin_nontemporal_load(xr + 64 * j); ss += (v[j].x * v[j].x + v[j].y * v[j].y) + (v[j].z * v[j].z + v[j].w * v[j].w); }
#pragma unroll
        for (int j = 0; j < 8; ++j) { u32x2 w; w.x = pk2(v[j].x, v[j].y); w.y = pk2(v[j].z, v[j].w); o8[64 * j] = w; }
        ss = wave_sum(ss);
        if (lane == 0) ((float*)(ws + WS_RS0))[m] = rsqrtf(ss * (1.f / DM) + EPS);
    }
    const int gt = blockIdx.x * 512 + tid, NGT = gridDim.x * 512;
    for (int idx = gt; idx < SEQ * 64; idx += NGT) {
        const int pos = idx >> 6, i = idx & 63;
        const double freq = exp(-(double)i * (9.210340371976184 / 64.0));
        double s, c; sincos_d((double)pos * freq, s, c);
        ((f32x2*)(ws + WS_ROPE))[idx] = (f32x2){(float)c, (float)s};
    }
    if (gt < NG * NP) {
        const int g = gt >> 6, p = gt & 63;
        const double dt = exp((double)P.in[6][g]);
        const double ar = (double)P.in[4][gt], ai = (double)P.in[5][gt];
        double sn, cs; sincos_d(ai * dt, sn, cs);
        const double mag = exp(ar * dt), lbr = mag * cs, lbi = mag * sn;
        const double d2 = ar * ar + ai * ai, nr = lbr - 1.0, ni = lbi;
        const double cr = (nr * ar + ni * ai) / d2, ci = (ni * ar - nr * ai) / d2;
        bf16* BbT = (bf16*)(ws + WS_S5P + S5P_BBT); bf16* CmT = (bf16*)(ws + WS_S5P + S5P_CMT);
        const float* bre = P.in[7] + (size_t)gt * 16; const float* bim = P.in[8] + (size_t)gt * 16;
#pragma unroll
        for (int c2 = 0; c2 < 16; c2 += 2) {
            const double br0 = bre[c2], bi0 = bim[c2], br1 = bre[c2 + 1], bi1 = bim[c2 + 1];
            *(unsigned*)(BbT + ((size_t)g * 128 + p) * 16 + c2) = pk2((float)(cr * br0 - ci * bi0), (float)(cr * br1 - ci * bi1));
            *(unsigned*)(BbT + ((size_t)g * 128 + 64 + p) * 16 + c2) = pk2((float)(cr * bi0 + ci * br0), (float)(cr * bi1 + ci * br1));
        }
        ((f32x2*)(ws + WS_S5P + S5P_LAM))[gt] = (f32x2){(float)lbr, (float)lbi};
        double sL, cL; sincos_d(ai * dt * 512.0, sL, cL); const double mL = exp(ar * dt * 512.0);
        ((f32x2*)(ws + WS_S5P + S5P_LAML))[gt] = (f32x2){(float)(mL * cL), (float)(mL * sL)};
        const int n = p & 31, blk = p >> 5;
#pragma unroll
        for (int c = 0; c < 16; ++c) {
            const float cre = P.in[9][((size_t)g * 16 + c) * 64 + p], cim = P.in[10][((size_t)g * 16 + c) * 64 + p];
            *(unsigned*)(CmT + ((size_t)g * 16 + c) * 128 + 4 * n + 2 * blk) = pk2(cre, -cim);
        }
    }
}

constexpr int RA_KT = 0, RA_VT = 16384;
constexpr int RC_QS = 0, RC_KS = 17408, RC_VT = 34816, RC_PS = 53248, RC_OS = 62464;

__device__ __forceinline__ float head_lg2(int h) { const float t[8] = {-4.5803689613e-02f, -2.2720076500e-02f, -1.1315313228e-02f, -5.6465631411e-03f, -2.8205190624e-03f, -1.4095702547e-03f, -7.0461297659e-04f, -3.5226347163e-04f}; float r = t[0];
#pragma unroll
    for (int i = 1; i < 8; ++i) r = (h == i) ? t[i] : r;
    return r; }

__device__ __forceinline__ int tsw(int r, int tok) { return r * 64 + ((((tok >> 3) ^ ((r ^ (r >> 3)) & 7)) << 3) | (tok & 7)); }
__device__ __forceinline__ int sidx(int e, int d) { return ((((e >> 5) * 8 + (d >> 4)) * 32 + (e & 31)) << 4) + (d & 15); }
__device__ __forceinline__ void rope8(const u32x4 a, const u32x4 b, const f32x2* cs, float (&o1)[8], float (&o2)[8]) {
    const unsigned aw[4] = {a.x, a.y, a.z, a.w}, bw[4] = {b.x, b.y, b.z, b.w};
#pragma unroll
    for (int j = 0; j < 4; ++j) {
        const f32x2 c0 = cs[2 * j], c1 = cs[2 * j + 1];
        const float x1a = bflo(aw[j]), x1b = bfhi(aw[j]), x2a = bflo(bw[j]), x2b = bfhi(bw[j]);
        o1[2 * j] = x1a * c0.x - x2a * c0.y; o2[2 * j] = x2a * c0.x + x1a * c0.y;
        o1[2 * j + 1] = x1b * c1.x - x2b * c1.y; o2[2 * j + 1] = x2b * c1.x + x1b * c1.y;
    }
}

__device__ __forceinline__ void ret_pass_a(const Params& P, unsigned char* lds, int tid, int lane, int wave) {
    unsigned char* ws = P.ws;
    const bf16* proj = (const bf16*)(ws + WS_PROJ); const u32x4* rope = (const u32x4*)(ws + WS_ROPE); bf16* KV = (bf16*)(ws + WS_KV);
    bf16* KT = (bf16*)(lds + RA_KT); bf16* VT = (bf16*)(lds + RA_VT);
    const int tok = tid >> 3, dg = tid & 7;
    u32x4 k1, k2, v1, v2, c0, c1, c2, c3;
#define RA_LOAD(uu) do { const int bh_ = (uu) >> 7, n_ = (uu) & 127; const size_t row_ = (size_t)(bh_ >> 3) * SEQ + n_ * 64 + tok; \
        const bf16* kp_ = proj + row_ * INW + RW + (bh_ & 7) * HD + dg * 8; const u32x4* cp_ = rope + ((size_t)(n_ * 64 + tok) * 64 + dg * 8) / 2; \
        k1 = __builtin_nontemporal_load((const u32x4*)kp_); k2 = __builtin_nontemporal_load((const u32x4*)(kp_ + 64)); v1 = __builtin_nontemporal_load((const u32x4*)(kp_ + RW)); v2 = __builtin_nontemporal_load((const u32x4*)(kp_ + RW + 64)); c0 = cp_[0]; c1 = cp_[1]; c2 = cp_[2]; c3 = cp_[3]; } while (0)
    f32x16 R0, R1;
#pragma unroll
    for (int i = 0; i < 16; ++i) { R0[i] = 0.f; R1[i] = 0.f; }
    int u = (int)blockIdx.x * 8;
    RA_LOAD(u);
    for (int ui = 0; ui < 8; ++ui, ++u) {
        const int bh = u >> 7, h = bh & 7;
        const float lg2 = head_lg2(h);
        const f32x2 cs[8] = {(f32x2){__uint_as_float(c0.x), __uint_as_float(c0.y)}, (f32x2){__uint_as_float(c0.z), __uint_as_float(c0.w)}, (f32x2){__uint_as_float(c1.x), __uint_as_float(c1.y)}, (f32x2){__uint_as_float(c1.z), __uint_as_float(c1.w)},
                             (f32x2){__uint_as_float(c2.x), __uint_as_float(c2.y)}, (f32x2){__uint_as_float(c2.z), __uint_as_float(c2.w)}, (f32x2){__uint_as_float(c3.x), __uint_as_float(c3.y)}, (f32x2){__uint_as_float(c3.z), __uint_as_float(c3.w)}};
        float o1[8], o2[8]; rope8(k1, k2, cs, o1, o2);
        const float ksc = 0.08838834764831845f * __builtin_amdgcn_exp2f(lg2 * (float)(63 - tok));
#pragma unroll
        for (int j = 0; j < 8; ++j) { KT[tsw(dg * 8 + j, tok)] = (bf16)(pk2(o1[j] * ksc, 0.f) & 0xffffu); KT[tsw(64 + dg * 8 + j, tok)] = (bf16)(pk2(o2[j] * ksc, 0.f) & 0xffffu); }
        const unsigned vw1[4] = {v1.x, v1.y, v1.z, v1.w}, vw2[4] = {v2.x, v2.y, v2.z, v2.w};
#pragma unroll
        for (int j = 0; j < 4; ++j) {
            VT[tsw(dg * 8 + 2 * j, tok)] = (bf16)(vw1[j] & 0xffffu); VT[tsw(dg * 8 + 2 * j + 1, tok)] = (bf16)(vw1[j] >> 16);
            VT[tsw(64 + dg * 8 + 2 * j, tok)] = (bf16)(vw2[j] & 0xffffu); VT[tsw(64 + dg * 8 + 2 * j + 1, tok)] = (bf16)(vw2[j] >> 16);
        }
        if (ui < 7) RA_LOAD(u + 1);
        __syncthreads();
        const int dt = wave & 3, et0 = (wave >> 2) * 2, l31 = lane & 31, hh = lane >> 5;
        f32x16 acc0, acc1;
#pragma unroll
        for (int i = 0; i < 16; ++i) { acc0[i] = 0.f; acc1[i] = 0.f; }
#pragma unroll
        for (int ks = 0; ks < 4; ++ks) {
            const bf16x8 a = *(const bf16x8*)(KT + tsw(dt * 32 + l31, ks * 16 + 8 * hh));
            const bf16x8 b0 = *(const bf16x8*)(VT + tsw(et0 * 32 + l31, ks * 16 + 8 * hh));
            const bf16x8 b1 = *(const bf16x8*)(VT + tsw((et0 + 1) * 32 + l31, ks * 16 + 8 * hh));
            acc0 = MFMA32(a, b0, acc0); acc1 = MFMA32(a, b1, acc1);
        }
        bf16* kvu = KV + (size_t)u * 16384;
        const float cdec = __builtin_amdgcn_exp2f(lg2 * 64.f);
        if (ui > 0)
#pragma unroll
        for (int q = 0; q < 4; ++q) {
            const int d0 = dt * 32 + 8 * q + 4 * hh;
            u32x2 w0; w0.x = pk2(R0[4 * q], R0[4 * q + 1]); w0.y = pk2(R0[4 * q + 2], R0[4 * q + 3]);
            u32x2 w1; w1.x = pk2(R1[4 * q], R1[4 * q + 1]); w1.y = pk2(R1[4 * q + 2], R1[4 * q + 3]);
            *(u32x2*)(kvu + sidx(et0 * 32 + l31, d0)) = w0; *(u32x2*)(kvu + sidx((et0 + 1) * 32 + l31, d0)) = w1;
        }
#pragma unroll
        for (int i = 0; i < 16; ++i) { R0[i] = fmaf(R0[i], cdec, acc0[i]); R1[i] = fmaf(R1[i], cdec, acc1[i]); }
        if (ui == 7) {
            bf16* tot = (bf16*)(ws + WS_TOT) + (size_t)blockIdx.x * 16384;
#pragma unroll
            for (int q = 0; q < 4; ++q) {
                const int d0 = dt * 32 + 8 * q + 4 * hh;
                u32x2 w0; w0.x = pk2(R0[4 * q], R0[4 * q + 1]); w0.y = pk2(R0[4 * q + 2], R0[4 * q + 3]);
                u32x2 w1; w1.x = pk2(R1[4 * q], R1[4 * q + 1]); w1.y = pk2(R1[4 * q + 2], R1[4 * q + 3]);
                *(u32x2*)(tot + sidx(et0 * 32 + l31, d0)) = w0; *(u32x2*)(tot + sidx((et0 + 1) * 32 + l31, d0)) = w1;
            }
        }
        __syncthreads();
    }
#undef RA_LOAD
}

__device__ __forceinline__ void ret_pass_c(const Params& P, unsigned char* lds, int tid, int lane, int wave) {
    unsigned char* ws = P.ws;
    const bf16* proj = (const bf16*)(ws + WS_PROJ); const u32x4* rope = (const u32x4*)(ws + WS_ROPE); const bf16* KV = (const bf16*)(ws + WS_KV);
    bf16* mix = (bf16*)(ws + WS_BUFA);
    bf16* Qs = (bf16*)(lds + RC_QS); bf16* Ks = (bf16*)(lds + RC_KS); bf16* VT = (bf16*)(lds + RC_VT); bf16* Ps = (bf16*)(lds + RC_PS); float* Os = (float*)(lds + RC_OS);
    const int tok = tid >> 3, dg = tid & 7, l31 = lane & 31, hh = lane >> 5, l15 = lane & 15, l4 = lane >> 4;
    const int rt = wave & 1, ct = wave >> 1;
    u32x4 q1, q2, k1, k2, v1, v2, c0, c1, c2, c3;
    bf16x8 st[8];
#define RC_LOAD(uu) do { const int bh_ = (uu) >> 7, n_ = (uu) & 127; const size_t row_ = (size_t)(bh_ >> 3) * SEQ + n_ * 64 + tok; \
        const bf16* qp_ = proj + row_ * INW + (bh_ & 7) * HD + dg * 8; const u32x4* cp_ = rope + ((size_t)(n_ * 64 + tok) * 64 + dg * 8) / 2; \
        q1 = __builtin_nontemporal_load((const u32x4*)qp_); q2 = __builtin_nontemporal_load((const u32x4*)(qp_ + 64)); k1 = __builtin_nontemporal_load((const u32x4*)(qp_ + RW)); k2 = __builtin_nontemporal_load((const u32x4*)(qp_ + RW + 64)); \
        c0 = cp_[0]; c1 = cp_[1]; c2 = cp_[2]; c3 = cp_[3]; } while (0)
#define RC_LOAD_ST(uu) do { const bf16* sp_ = KV + (size_t)(uu) * 16384 + sidx(ct * 32 + l31, 8 * hh); _Pragma("unroll") for (int ks_ = 0; ks_ < 8; ++ks_) st[ks_] = __builtin_nontemporal_load((const bf16x8*)(sp_ + ks_ * 512)); } while (0)
    const int rowb = panel_of((int)blockIdx.x) * 256 + ((int)blockIdx.x >> 6) * 64, ub = ((rowb >> 13) * 8) * 128 + ((rowb & 8191) >> 6);
    int u = ub;
    RC_LOAD(u);
    for (int hi = 0; hi < 8; ++hi, u += 128) {
        const int bh = u >> 7, n = u & 127, b = bh >> 3, h = bh & 7;
        const int un = (hi < 7) ? u + 128 : u;
        const float lg2 = head_lg2(h);
        { const bf16* cp_ = (const bf16*)(ws + WS_TOT) + ((size_t)bh * 16 + (n >> 3)) * 16384 + sidx(ct * 32 + l31, 8 * hh);
#pragma unroll
          for (int ks = 0; ks < 8; ++ks) st[ks] = *(const bf16x8*)(cp_ + ks * 512); }
        const int t3 = tid >> 3, part = tid & 7;
        const size_t row3 = (size_t)b * SEQ + n * 64 + t3;
        const bf16* gp = proj + row3 * INW + 3 * RW + h * HD + part * 16;
        { const bf16* vp_ = proj + ((size_t)b * SEQ + n * 64 + tok) * INW + 2 * RW + h * HD + dg * 8; v1 = __builtin_nontemporal_load((const u32x4*)vp_); v2 = __builtin_nontemporal_load((const u32x4*)(vp_ + 64)); }
        u32x4 g0, g1; f32x2 sq2p;
        {
            const f32x2 cs[8] = {(f32x2){__uint_as_float(c0.x), __uint_as_float(c0.y)}, (f32x2){__uint_as_float(c0.z), __uint_as_float(c0.w)}, (f32x2){__uint_as_float(c1.x), __uint_as_float(c1.y)}, (f32x2){__uint_as_float(c1.z), __uint_as_float(c1.w)},
                                 (f32x2){__uint_as_float(c2.x), __uint_as_float(c2.y)}, (f32x2){__uint_as_float(c2.z), __uint_as_float(c2.w)}, (f32x2){__uint_as_float(c3.x), __uint_as_float(c3.y)}, (f32x2){__uint_as_float(c3.z), __uint_as_float(c3.w)}};
            float o1[8], o2[8]; u32x4 w;
            rope8(q1, q2, cs, o1, o2);
            w.x = pk2(o1[0], o1[1]); w.y = pk2(o1[2], o1[3]); w.z = pk2(o1[4], o1[5]); w.w = pk2(o1[6], o1[7]); *(u32x4*)(Qs + tok * 136 + dg * 8) = w;
            w.x = pk2(o2[0], o2[1]); w.y = pk2(o2[2], o2[3]); w.z = pk2(o2[4], o2[5]); w.w = pk2(o2[6], o2[7]); *(u32x4*)(Qs + tok * 136 + 64 + dg * 8) = w;
            rope8(k1, k2, cs, o1, o2);
            w.x = pk2(o1[0], o1[1]); w.y = pk2(o1[2], o1[3]); w.z = pk2(o1[4], o1[5]); w.w = pk2(o1[6], o1[7]); *(u32x4*)(Ks + tok * 136 + dg * 8) = w;
            w.x = pk2(o2[0], o2[1]); w.y = pk2(o2[2], o2[3]); w.z = pk2(o2[4], o2[5]); w.w = pk2(o2[6], o2[7]); *(u32x4*)(Ks + tok * 136 + 64 + dg * 8) = w;
            const unsigned vw1[4] = {v1.x, v1.y, v1.z, v1.w}, vw2[4] = {v2.x, v2.y, v2.z, v2.w};
#pragma unroll
            for (int j = 0; j < 4; ++j) {
                VT[tsw(dg * 8 + 2 * j, tok)] = (bf16)(vw1[j] & 0xffffu); VT[tsw(dg * 8 + 2 * j + 1, tok)] = (bf16)(vw1[j] >> 16);
                VT[tsw(64 + dg * 8 + 2 * j, tok)] = (bf16)(vw2[j] & 0xffffu); VT[tsw(64 + dg * 8 + 2 * j + 1, tok)] = (bf16)(vw2[j] >> 16);
            }
        }
        RC_LOAD(un);
        __syncthreads();
#pragma unroll
        for (int tt = 0; tt < 2; ++tt) {
            const int T = wave * 2 + tt, kt = T & 3, qt = T >> 2;
            f32x4 acc = (f32x4){0.f, 0.f, 0.f, 0.f};
#pragma unroll
            for (int ks = 0; ks < 4; ++ks) {
                const bf16x8 a = *(const bf16x8*)(Ks + (kt * 16 + l15) * 136 + ks * 32 + 8 * l4);
                const bf16x8 bq = *(const bf16x8*)(Qs + (qt * 16 + l15) * 136 + ks * 32 + 8 * l4);
                acc = MFMA16(a, bq, acc);
            }
            const int q = qt * 16 + l15, key0 = kt * 16 + 4 * l4;
            float v[4];
#pragma unroll
            for (int r = 0; r < 4; ++r) { const int dist = q - (key0 + r); v[r] = acc[r] * 0.08838834764831845f * __builtin_amdgcn_exp2f(lg2 * (float)(dist < 0 ? -dist : dist)); }
            u32x2 w; w.x = pk2(v[0], v[1]); w.y = pk2(v[2], v[3]);
            *(u32x2*)(Ps + q * 72 + key0) = w;
        }
        asm volatile("" ::: "memory");
        f32x16 acc;
#pragma unroll
        for (int i = 0; i < 16; ++i) acc[i] = 0.f;
#pragma unroll
        for (int ks = 0; ks < 8; ++ks) { const bf16x8 a = *(const bf16x8*)(Qs + (rt * 32 + l31) * 136 + ks * 16 + 8 * hh); acc = MFMA32(a, st[ks], acc); }
        { const float dj = __builtin_amdgcn_exp2f(lg2 * (float)(64 * (n & 7)));
#pragma unroll
          for (int i = 0; i < 16; ++i) acc[i] *= dj; }
        if (n & 7) RC_LOAD_ST(u);
        __syncthreads();
        {
            if (n & 7) {
#pragma unroll
            for (int ks = 0; ks < 8; ++ks) { const bf16x8 a = *(const bf16x8*)(Qs + (rt * 32 + l31) * 136 + ks * 16 + 8 * hh); acc = MFMA32(a, st[ks], acc); }
            }
#pragma unroll
            for (int i = 0; i < 16; ++i) { const int c = rt * 32 + 8 * (i >> 2) + 4 * hh + (i & 3); acc[i] *= __builtin_amdgcn_exp2f(lg2 * (float)(c + 1)); }
#pragma unroll
            for (int ks = 0; ks < 4; ++ks) {
                const bf16x8 a = *(const bf16x8*)(Ps + (rt * 32 + l31) * 72 + ks * 16 + 8 * hh);
                const bf16x8 bv = *(const bf16x8*)(VT + tsw(ct * 32 + l31, ks * 16 + 8 * hh));
                acc = MFMA32(a, bv, acc);
            }
            g0 = __builtin_nontemporal_load((const u32x4*)gp); g1 = __builtin_nontemporal_load((const u32x4*)(gp + 8)); sq2p = *(const f32x2*)((const float*)(ws + WS_SQ2) + row3 * 16 + part * 2);
#pragma unroll
            for (int i = 0; i < 16; ++i) { const int c = rt * 32 + 8 * (i >> 2) + 4 * hh + (i & 3); Os[c * 132 + ct * 32 + l31] = acc[i]; }
        }
        __syncthreads();
        {
            const f32x4* op = (const f32x4*)(Os + t3 * 132 + part * 16);
            f32x4 x[4]; float s = 0.f;
#pragma unroll
            for (int j = 0; j < 4; ++j) { x[j] = op[j]; s += (x[j].x + x[j].y) + (x[j].z + x[j].w); }
            s += __shfl_xor(s, 1); s += __shfl_xor(s, 2); s += __shfl_xor(s, 4);
            const float mu = s * (1.f / 128.f); float q2s = 0.f;
#pragma unroll
            for (int j = 0; j < 4; ++j) { x[j] = x[j] - mu; q2s += (x[j].x * x[j].x + x[j].y * x[j].y) + (x[j].z * x[j].z + x[j].w * x[j].w); }
            q2s += __shfl_xor(q2s, 1); q2s += __shfl_xor(q2s, 2); q2s += __shfl_xor(q2s, 4);
            float sq2 = sq2p.x + sq2p.y; sq2 += __shfl_xor(sq2, 1); sq2 += __shfl_xor(sq2, 2); sq2 += __shfl_xor(sq2, 4);
            const float rstd = rsqrtf(q2s * (1.f / 128.f) + EPS) * sqrtf(sq2 * (1.f / SW) + EPS);
            const unsigned gw[8] = {g0.x, g0.y, g0.z, g0.w, g1.x, g1.y, g1.z, g1.w};
            const f32x4* gn = (const f32x4*)(P.in[3] + h * HD + part * 16);
            unsigned ow[8];
#pragma unroll
            for (int j = 0; j < 4; ++j) {
                const f32x4 gg = gn[j];
                const float ga = bflo(gw[2 * j]), gb = bfhi(gw[2 * j]), gc = bflo(gw[2 * j + 1]), gd = bfhi(gw[2 * j + 1]);
                const float ya = ga * pg8::sigmoid_f(ga) * (x[j].x * rstd * gg.x), yb = gb * pg8::sigmoid_f(gb) * (x[j].y * rstd * gg.y);
                const float yc = gc * pg8::sigmoid_f(gc) * (x[j].z * rstd * gg.z), yd = gd * pg8::sigmoid_f(gd) * (x[j].w * rstd * gg.w);
                ow[2 * j] = pk2(ya, yb); ow[2 * j + 1] = pk2(yc, yd);
            }
            bf16* mp = mix + row3 * DM + h * HD + part * 16;
            *(u32x4*)mp = (u32x4){ow[0], ow[1], ow[2], ow[3]}; *(u32x4*)(mp + 8) = (u32x4){ow[4], ow[5], ow[6], ow[7]};
        }
    }
    __syncthreads();
#undef RC_LOAD
#undef RC_LOAD_ST
}

struct ConvItem { const float* W; bf16* WT; const float* ks; int K, N, k0, n0, dst0; };
constexpr int CONV_ITEMS = 16 * 32 + 32 * 64 + 2 * 32 * 176 + 88 * 64;
__device__ __forceinline__ bool conv_decode(const Params& P, int id, ConvItem& c) {
    unsigned char* ws = P.ws;
    constexpr int I_GLU = 16 * 32, I_OUT = 32 * 64, I_GATE = 32 * 176, I_DOWN = 88 * 64;
    int r = id, kb, nb; c.ks = nullptr;
    if (r < 0 || r >= CONV_ITEMS) return false;
    if (r < I_GLU) { c.W = P.in[12]; c.WT = (bf16*)(ws + WS_WGLU); c.K = SW; c.N = SW; kb = r / 32; nb = r % 32; c.dst0 = nb * 32; }
    else if ((r -= I_GLU) < I_OUT) { c.W = P.in[15]; c.WT = (bf16*)(ws + WS_WOUT); c.K = DM; c.N = DM; kb = r / 64; nb = r % 64; c.dst0 = nb * 32; }
    else if ((r -= I_OUT) < I_GATE) { c.W = P.in[17]; c.WT = (bf16*)(ws + WS_WGU); c.K = DM; c.N = DFF; kb = r / 176; nb = r % 176; c.dst0 = ((nb * 32) >> 7) * 256 + ((nb * 32) & 127); c.ks = P.in[16]; }
    else if ((r -= I_GATE) < I_GATE) { c.W = P.in[18]; c.WT = (bf16*)(ws + WS_WGU); c.K = DM; c.N = DFF; kb = r / 176; nb = r % 176; c.dst0 = ((nb * 32) >> 7) * 256 + 128 + ((nb * 32) & 127); c.ks = P.in[16]; }
    else { r -= I_GATE; c.W = P.in[19]; c.WT = (bf16*)(ws + WS_WD); c.K = DFF; c.N = DM; kb = r / 64; nb = r % 64; c.dst0 = nb * 32; }
    c.k0 = kb * 64; c.n0 = nb * 32; return true;
}
__device__ __forceinline__ void conv_issue(const ConvItem& c, unsigned char* scr, int lane) {
    const int kr = lane >> 3, p = lane & 7;
    const float* src = c.W + (size_t)(c.k0 + kr) * c.N + c.n0;
#pragma unroll
    for (int i = 0; i < 8; ++i) { const int sc = p ^ ((kr ^ i) & 7);
        __builtin_amdgcn_global_load_lds((const unsigned*)(src + (size_t)(8 * i) * c.N + 4 * sc), (PG8_LAS unsigned*)(scr + i * 1024), 16, 0, 2); }
}
__device__ __forceinline__ void conv_consume(const ConvItem& c, const unsigned char* scr, int lane) {
    asm volatile("s_waitcnt vmcnt(0)" ::: "memory");
    const int cc = lane & 7;
    f32x4 ks0 = (f32x4){1.f, 1.f, 1.f, 1.f}, ks1 = ks0;
    if (c.ks) { ks0 = *(const f32x4*)(c.ks + c.k0 + 8 * cc); ks1 = *(const f32x4*)(c.ks + c.k0 + 8 * cc + 4); }
#pragma unroll
    for (int j = 0; j < 4; ++j) { const int n = (lane >> 3) + 8 * j; float v[8];
#pragma unroll
        for (int t = 0; t < 8; ++t) v[t] = *(const float*)(scr + (8 * cc + t) * 128 + (((n >> 2) ^ ((t ^ cc) & 7)) * 16) + (n & 3) * 4);
        u32x4 o; o.x = pk2(v[0] * ks0.x, v[1] * ks0.y); o.y = pk2(v[2] * ks0.z, v[3] * ks0.w); o.z = pk2(v[4] * ks1.x, v[5] * ks1.y); o.w = pk2(v[6] * ks1.z, v[7] * ks1.w);
        *(u32x4*)(c.WT + (size_t)(c.dst0 + n) * c.K + c.k0 + 8 * cc) = o; }
    LDS_FENCE();
}

#define CMUL_ADD(or_, oi_, ar_, ai_, br_, bi_, cr_, ci_) do { const float _r = fmaf((ar_), (br_), fmaf(-(ai_), (bi_), (cr_))); const float _i = fmaf((ar_), (bi_), fmaf((ai_), (br_), (ci_))); (or_) = _r; (oi_) = _i; } while (0)
template <bool FULL>
__device__ __forceinline__ void s5_wave(const Params& P, unsigned char* wlds, int b, int g, int ch, int lane, int gw) {
    unsigned char* ws = P.ws;
    const bf16* proj = (const bf16*)(ws + WS_PROJ);
    const bf16* BbT = (const bf16*)(ws + WS_S5P + S5P_BBT); const bf16* CmT = (const bf16*)(ws + WS_S5P + S5P_CMT);
    const f32x2* lamp = (const f32x2*)(ws + WS_S5P + S5P_LAM);
    f32x2* ST = (f32x2*)(ws + WS_S5ST);
    const int n = lane & 31, hh = lane >> 5, l15 = lane & 15, l4 = lane >> 4;
    bf16x8 Bb[4];
#pragma unroll
    for (int v = 0; v < 4; ++v) Bb[v] = *(const bf16x8*)(BbT + ((size_t)g * 128 + (v & 1) * 64 + (v >> 1) * 32 + n) * 16 + 8 * hh);
    float lr[2][4], li[2][4];
#pragma unroll
    for (int k = 0; k < 2; ++k) {
        const f32x2 l1 = lamp[g * 64 + k * 32 + n]; lr[k][0] = l1.x; li[k][0] = l1.y;
#pragma unroll
        for (int e = 1; e < 4; ++e) { lr[k][e] = lr[k][e - 1] * l1.x - li[k][e - 1] * l1.y; li[k][e] = lr[k][e - 1] * l1.y + li[k][e - 1] * l1.x; }
    }
    float car[2], cai[2];
    const size_t stbase = (((size_t)b * 16 + ch) * 64 + g) * 64;
    car[0] = cai[0] = car[1] = cai[1] = 0.f;
    if (FULL) {
        const f32x2* lamL = (const f32x2*)(ws + WS_S5P + S5P_LAML);
        const f32x2 L0 = lamL[g * 64 + n], L1 = lamL[g * 64 + 32 + n];
        for (int c = 0; c < ch; ++c) { const size_t eb = (((size_t)b * 16 + c) * 64 + g) * 64; const f32x2 e0 = ST[eb + n], e1 = ST[eb + 32 + n];
            CMUL_ADD(car[0], cai[0], L0.x, L0.y, car[0], cai[0], e0.x, e0.y); CMUL_ADD(car[1], cai[1], L1.x, L1.y, car[1], cai[1], e1.x, e1.y); }
    }
    bf16x8 Cm[4];
    f32x4 dsk = (f32x4){0.f, 0.f, 0.f, 0.f};
    if (FULL) {
#pragma unroll
        for (int ks = 0; ks < 4; ++ks) Cm[ks] = *(const bf16x8*)(CmT + ((size_t)g * 16 + l15) * 128 + ks * 32 + 8 * l4);
        dsk = *(const f32x4*)(P.in[11] + g * 16 + 4 * l4);
    }
    bf16* y1 = (bf16*)(ws + WS_Y1);
    for (int sb = 0; sb < 16; ++sb) {
        const size_t row0 = (size_t)b * SEQ + ch * 512 + sb * 32;
        const bf16x8 U = *(const bf16x8*)(proj + (row0 + n) * INW + 4 * RW + g * 16 + 8 * hh);
        f32x16 bu[4];
#pragma unroll
        for (int v = 0; v < 4; ++v) {
#pragma unroll
            for (int i = 0; i < 16; ++i) bu[v][i] = 0.f;
            bu[v] = MFMA32(U, Bb[v], bu[v]);
        }
        ConvItem cvi; bool cvok = false;
        if (FULL && sb < 10) { cvok = conv_decode(P, sb * 2048 + gw, cvi); if (cvok) conv_issue(cvi, wlds + 8704, lane); }
        float er[2][4], ei[2][4];
#pragma unroll
        for (int k = 0; k < 2; ++k)
#pragma unroll
            for (int q = 0; q < 4; ++q) {
                float sr = bu[2 * k][4 * q], si = bu[2 * k + 1][4 * q];
#pragma unroll
                for (int j = 1; j < 4; ++j) { CMUL_ADD(sr, si, lr[k][0], li[k][0], sr, si, bu[2 * k][4 * q + j], bu[2 * k + 1][4 * q + j]); bu[2 * k][4 * q + j] = sr; bu[2 * k + 1][4 * q + j] = si; }
                er[k][q] = sr; ei[k][q] = si;
            }
        float mr[2][4], mi[2][4];
#pragma unroll
        for (int k = 0; k < 2; ++k) {
            float cr = car[k], ci = cai[k];
#pragma unroll
            for (int q = 0; q < 4; ++q) {
                const float pr = __shfl_xor(er[k][q], 32), pi = __shfl_xor(ei[k][q], 32);
                const float ear = hh ? pr : er[k][q], eai = hh ? pi : ei[k][q];
                const float ebr = hh ? er[k][q] : pr, ebi = hh ? ei[k][q] : pi;
                float c1r, c1i, c2r, c2i;
                CMUL_ADD(c1r, c1i, lr[k][3], li[k][3], cr, ci, ear, eai);
                CMUL_ADD(c2r, c2i, lr[k][3], li[k][3], c1r, c1i, ebr, ebi);
                mr[k][q] = hh ? c1r : cr; mi[k][q] = hh ? c1i : ci;
                cr = c2r; ci = c2i;
            }
            car[k] = cr; cai[k] = ci;
        }
        if (FULL) {
#pragma unroll
            for (int q = 0; q < 4; ++q)
#pragma unroll
                for (int j = 0; j < 4; ++j) {
                    float s0r, s0i, s1r, s1i;
                    CMUL_ADD(s0r, s0i, lr[0][j], li[0][j], mr[0][q], mi[0][q], bu[0][4 * q + j], bu[1][4 * q + j]);
                    CMUL_ADD(s1r, s1i, lr[1][j], li[1][j], mr[1][q], mi[1][q], bu[2][4 * q + j], bu[3][4 * q + j]);
                    u32x2 w; w.x = pk2(s0r, s0i); w.y = pk2(s1r, s1i);
                    *(u32x2*)(wlds + (8 * q + 4 * hh + j) * 272 + n * 8) = w;
                }
            LDS_FENCE();
            f32x4 yt[2];
#pragma unroll
            for (int tt = 0; tt < 2; ++tt) {
                yt[tt] = (f32x4){0.f, 0.f, 0.f, 0.f};
#pragma unroll
                for (int ks = 0; ks < 4; ++ks) { const bf16x8 sv = *(const bf16x8*)(wlds + (tt * 16 + l15) * 272 + (ks * 32 + 8 * l4) * 2); yt[tt] = MFMA16(Cm[ks], sv, yt[tt]); }
            }
            LDS_FENCE();
#pragma unroll
            for (int tt = 0; tt < 2; ++tt) {
                const size_t row = row0 + tt * 16 + l15;
                const u32x2 uw = *(const u32x2*)(proj + row * INW + 4 * RW + g * 16 + 4 * l4);
                const float uu[4] = {bflo(uw.x), bfhi(uw.x), bflo(uw.y), bfhi(uw.y)};
                float o[4];
#pragma unroll
                for (int r = 0; r < 4; ++r) { const float y = yt[tt][r] + dsk[r] * uu[r]; const float z = 1.5957691216057308f * (y + 0.044715f * y * y * y); o[r] = y * pg8::sigmoid_f(z); }
                u32x2 w; w.x = pk2(o[0], o[1]); w.y = pk2(o[2], o[3]);
                *(u32x2*)(y1 + row * SW + g * 16 + 4 * l4) = w;
            }
            if (cvok) conv_consume(cvi, wlds + 8704, lane);
        }
    }
    if (!FULL) { if (hh == 0) { ST[stbase + n] = (f32x2){car[0], cai[0]}; ST[stbase + 32 + n] = (f32x2){car[1], cai[1]}; } }
}

__device__ __forceinline__ void scan_phase(const Params& P, int tid) {
    unsigned char* ws = P.ws;
    const int gt = blockIdx.x * 512 + tid, NGT = gridDim.x * 512;
    for (int e = gt; e < 16 * 8192; e += NGT) {
        const int bh = e >> 13, off = (e & 8191) * 2, h = bh & 7;
        const float dec = __builtin_amdgcn_exp2f(head_lg2(h) * 512.f);
        unsigned* p = (unsigned*)((bf16*)(ws + WS_TOT) + (size_t)bh * 16 * 16384 + off);
        unsigned kv[16];
#pragma unroll
        for (int j = 0; j < 16; ++j) kv[j] = p[(size_t)j * 8192];
        float s0 = 0.f, s1 = 0.f;
#pragma unroll
        for (int j = 0; j < 16; ++j) { p[(size_t)j * 8192] = pk2(s0, s1); s0 = fmaf(s0, dec, bflo(kv[j])); s1 = fmaf(s1, dec, bfhi(kv[j])); }
    }
}

__device__ __forceinline__ void ssm_norm_phase(const Params& P, int lane, int wave) {
    unsigned char* ws = P.ws; const bf16* y2 = (const bf16*)(ws + WS_Y2); bf16* mix = (bf16*)(ws + WS_BUFA);
    const int gw = blockIdx.x * 8 + wave, NGW = gridDim.x * 8;
    for (int m = gw; m < MTOK; m += NGW) {
        const u32x4 a = *(const u32x4*)(y2 + (size_t)m * SW + lane * 8), c = *(const u32x4*)(y2 + (size_t)m * SW + 512 + lane * 8);
        const unsigned w[8] = {a.x, a.y, a.z, a.w, c.x, c.y, c.z, c.w};
        float v[16]; float s = 0.f;
#pragma unroll
        for (int j = 0; j < 8; ++j) { v[2 * j] = bflo(w[j]); v[2 * j + 1] = bfhi(w[j]); s += v[2 * j] * v[2 * j] + v[2 * j + 1] * v[2 * j + 1]; }
        const float r = rsqrtf(wave_sum(s) * (1.f / SW) + EPS);
        const f32x4* g0 = (const f32x4*)(P.in[14] + lane * 8); const f32x4* g1 = (const f32x4*)(P.in[14] + 512 + lane * 8);
        const f32x4 ga = g0[0], gb = g0[1], gc = g1[0], gd = g1[1];
        u32x4 o0, o1;
        o0.x = pk2(v[0] * r * ga.x, v[1] * r * ga.y); o0.y = pk2(v[2] * r * ga.z, v[3] * r * ga.w); o0.z = pk2(v[4] * r * gb.x, v[5] * r * gb.y); o0.w = pk2(v[6] * r * gb.z, v[7] * r * gb.w);
        o1.x = pk2(v[8] * r * gc.x, v[9] * r * gc.y); o1.y = pk2(v[10] * r * gc.z, v[11] * r * gc.w); o1.z = pk2(v[12] * r * gd.x, v[13] * r * gd.y); o1.w = pk2(v[14] * r * gd.z, v[15] * r * gd.w);
        *(u32x4*)(mix + (size_t)m * DM + RW + lane * 8) = o0; *(u32x4*)(mix + (size_t)m * DM + RW + 512 + lane * 8) = o1;
    }
}
__device__ __forceinline__ void final_norm_phase(const Params& P, int lane, int wave) {
    const bf16* x2 = (const bf16*)(P.ws + WS_BUFA);
    const int mb = panel_of((int)blockIdx.x) * 256 + ((int)blockIdx.x >> 6) * 64 + wave * 8;
    for (int m = mb; m < mb + 8; ++m) {
        const bf16* xr = x2 + (size_t)m * DM + lane * 8;
        u32x4 w[4]; float s = 0.f;
#pragma unroll
        for (int j = 0; j < 4; ++j) w[j] = __builtin_nontemporal_load((const u32x4*)(xr + 512 * j));
        float v[4][8];
#pragma unroll
        for (int j = 0; j < 4; ++j) { const unsigned ww[4] = {w[j].x, w[j].y, w[j].z, w[j].w};
#pragma unroll
            for (int k = 0; k < 4; ++k) { v[j][2 * k] = bflo(ww[k]); v[j][2 * k + 1] = bfhi(ww[k]); s += v[j][2 * k] * v[j][2 * k] + v[j][2 * k + 1] * v[j][2 * k + 1]; } }
        const float r = rsqrtf(wave_sum(s) * (1.f / DM) + EPS);
        float* orow = P.out + (size_t)m * DM + lane * 8; const float* gr = P.in[20] + lane * 8;
#pragma unroll
        for (int j = 0; j < 4; ++j) { const f32x4 g0 = *(const f32x4*)(gr + 512 * j), g1 = *(const f32x4*)(gr + 512 * j + 4);
            __builtin_nontemporal_store((f32x4){v[j][0] * r * g0.x, v[j][1] * r * g0.y, v[j][2] * r * g0.z, v[j][3] * r * g0.w}, (f32x4*)(orow + 512 * j));
            __builtin_nontemporal_store((f32x4){v[j][4] * r * g1.x, v[j][5] * r * g1.y, v[j][6] * r * g1.z, v[j][7] * r * g1.w}, (f32x4*)(orow + 512 * j + 4)); }
    }
}

#define LAS __attribute__((address_space(3)))
#define XB_TMO      128
#define XB_XCNT(j)  (256  + 64 * (j))
#define XB_XSUB(j)  (1280 + 64 * (j))
#define XB_XGEN(j)  (2304 + 64 * (j))
#define XB_TOP      3328
#define XB_TOPGEN   3392
#define XCD_BAR_WORDS 3456
#define XB_SPIN_CAP (1u << 18)

__device__ __forceinline__ unsigned xb_ld(unsigned* p)              { return __hip_atomic_load(p, __ATOMIC_RELAXED, __HIP_MEMORY_SCOPE_AGENT); }
__device__ __forceinline__ unsigned xb_add(unsigned* p, unsigned v) { return __hip_atomic_fetch_add(p, v, __ATOMIC_RELAXED, __HIP_MEMORY_SCOPE_AGENT); }
__device__ __forceinline__ unsigned xb_xcc_id() { return (unsigned)__builtin_amdgcn_s_getreg((3 << 11) | 20) & 0xFu; }
#define XB_SPIN(cond, bar) do { unsigned _sp = 0; while (cond) { __builtin_amdgcn_s_sleep(1); \
    if ((++_sp & 255u) == 0u) { if (xb_ld(&(bar)[XB_TMO])) break; if (_sp > XB_SPIN_CAP) { atomicAdd(&(bar)[XB_TMO], 1u); break; } } } } while (0)

struct XcdBarrier {
    unsigned* bar; unsigned x;
    volatile LAS unsigned* st;
};

__device__ __forceinline__ XcdBarrier xcd_barrier_post(unsigned* bar, volatile LAS unsigned* st) {
    XcdBarrier b; b.bar = bar; b.x = xb_xcc_id(); b.st = st;
    if (threadIdx.x == 0) (void)xb_add(&bar[XB_XCNT(b.x)], 1u);
    return b;
}
__device__ __forceinline__ void xcd_barrier_complete(unsigned* bar, unsigned x, unsigned& nloc, unsigned& nx) {
    const unsigned G = gridDim.x * gridDim.y * gridDim.z;
    unsigned sum, cnt, mine, sp = 0u;
    for (;;) {
        sum = 0u; cnt = 0u; mine = 0u;
#pragma unroll
        for (unsigned j = 0; j < 16; ++j) { const unsigned c = xb_ld(&bar[XB_XCNT(j)]); sum += c; cnt += (c > 0u) ? 1u : 0u; mine = (j == x) ? c : mine; }
        if (sum == G) break;
        __builtin_amdgcn_s_sleep(1);
        if ((++sp & 255u) == 0u) { if (xb_ld(&bar[XB_TMO])) break; if (sp > XB_SPIN_CAP) { atomicAdd(&bar[XB_TMO], 1u); break; } }
    }
    nloc = mine > 0u ? mine : 1u; nx = cnt > 0u ? cnt : 1u;
}

__device__ __forceinline__ void xcd_barrier(const XcdBarrier& b) {
    asm volatile("s_waitcnt vmcnt(0)" ::: "memory");
    __syncthreads();
    if (threadIdx.x == 0) {
        unsigned* bar = b.bar;
        __builtin_amdgcn_s_waitcnt(0);
        unsigned nloc = b.st[0], nx = b.st[1];
        if (nloc == 0u) { xcd_barrier_complete(bar, b.x, nloc, nx); b.st[0] = nloc; b.st[1] = nx; }
        const unsigned old = xb_add(&bar[XB_XSUB(b.x)], 1u);
        const unsigned gen = old / nloc;
        if (old + 1u == (gen + 1u) * nloc) {
            __builtin_amdgcn_fence(__ATOMIC_RELEASE, "agent");
            asm volatile("s_waitcnt vmcnt(0)" ::: "memory");
            const unsigned og = xb_add(&bar[XB_TOP], 1u);
            const unsigned tg = og / nx;
            if (og + 1u == (tg + 1u) * nx) xb_add(&bar[XB_TOPGEN], 1u);
            else XB_SPIN(xb_ld(&bar[XB_TOPGEN]) == tg, bar);
            __builtin_amdgcn_fence(__ATOMIC_ACQUIRE, "agent");
            xb_add(&bar[XB_XGEN(b.x)], 1u);
            asm volatile("s_waitcnt vmcnt(0)" ::: "memory");
        } else {
            XB_SPIN(xb_ld(&bar[XB_XGEN(b.x)]) == gen, bar);
            __builtin_amdgcn_fence(__ATOMIC_ACQUIRE, "agent");
            asm volatile("s_waitcnt vmcnt(0)" ::: "memory");
        }
    }
    __syncthreads();
}

__device__ __forceinline__ void group_barrier(unsigned* ctl, int seam, int pm, bool samex) {
    asm volatile("s_waitcnt vmcnt(0)" ::: "memory");
    __syncthreads();
    if (threadIdx.x == 0) {
        unsigned* cnt = ctl + (CTL_GRP / 4) + (seam * 64 + pm) * 64;
        if (!samex) { __builtin_amdgcn_fence(__ATOMIC_RELEASE, "agent"); asm volatile("s_waitcnt vmcnt(0)" ::: "memory"); }
        xb_add(cnt, 1u);
        unsigned sp = 0u;
        while (xb_ld(cnt) < 4u) { __builtin_amdgcn_s_sleep(1); if (++sp > (1u << 22)) break; }
        __builtin_amdgcn_fence(__ATOMIC_ACQUIRE, "agent");
        asm volatile("s_waitcnt vmcnt(0)" ::: "memory");
    }
    __syncthreads();
}
template <int PH>
__device__ __forceinline__ void run_phase(const Params& P, unsigned char* lds, int tid, int lane, int wave) {
    unsigned char* ws = P.ws;
    PG8_LAS unsigned char* glds = (PG8_LAS unsigned char*)lds;
    if constexpr (PH == 0) p0_phase(P, lds, tid, lane, wave);
    if constexpr (PH == 1) {
        pg8::Gemm g{(const bf16*)(ws + WS_XB), (const bf16*)(ws + WS_WIN), MTOK, INW, DM}; pg8::StaticOrder S; S.init(MTOK, INW, gridDim.x, blockIdx.x);
        pg8::EpiStoreBf16 E{(bf16*)(ws + WS_PROJ), INW, (const float*)(ws + WS_RS0)};
        pg8::gemm_phase<pg8::EpiStoreBf16, pg8::StaticOrder, true, true>(glds, g, S, E);
    }
    if constexpr (PH == 2) {
        ret_pass_a(P, lds, tid, lane, wave);
        { const int id = blockIdx.x * 8 + wave; if (id < 2048) s5_wave<false>(P, lds + wave * S5_WLDS, id >> 10, id & 63, (id >> 6) & 15, lane, id); }
    }
    if constexpr (PH == 3) {
        scan_phase(P, tid);
        const int id = blockIdx.x * 8 + wave; if (id < 2048) s5_wave<true>(P, lds + wave * S5_WLDS, id >> 10, id & 63, (id >> 6) & 15, lane, id);
    }
    if constexpr (PH == 5) {
        pg8::Gemm g{(const bf16*)(ws + WS_Y1), (const bf16*)(ws + WS_WGLU), MTOK, SW, SW}; pg8::StaticOrder S; S.init(MTOK, SW, gridDim.x, blockIdx.x);
        pg8::EpiGlu E{(const bf16*)(ws + WS_Y1), P.in[13], P.in[14], (bf16*)(ws + WS_BUFA) + RW, (float*)(ws + WS_SQ2), SW, DM};
        pg8::gemm_phase<pg8::EpiGlu, pg8::StaticOrder, false, true>(glds, g, S, E);
    }
    if constexpr (PH == 6) ret_pass_c(P, lds, tid, lane, wave);
    if constexpr (PH == 7) {
        pg8::Gemm g{(const bf16*)(ws + WS_BUFA), (const bf16*)(ws + WS_WOUT), MTOK, DM, DM}; pg8::StaticOrder S; S.init(MTOK, DM, gridDim.x, blockIdx.x);
        pg8::EpiResB E{nullptr, (const bf16*)(ws + WS_XB), (bf16*)(ws + WS_X1B), DM, (const float*)(ws + WS_SQ2), 1.f / SW, (float*)(ws + WS_SQ1), true};
        pg8::gemm_phase<pg8::EpiResB, pg8::StaticOrder, false, true>(glds, g, S, E);
    }
    if constexpr (PH == 9) {
        pg8::Gemm g{(const bf16*)(ws + WS_X1B), (const bf16*)(ws + WS_WGU), MTOK, 2 * DFF, DM}; pg8::StaticOrder S; S.init(MTOK, 2 * DFF, gridDim.x, blockIdx.x);
        pg8::Unit u0; int pm0 = -1; if (S.next(0, u0)) pm0 = u0.pm;
        float* rsl = (float*)(lds + LDS_KEEP + 64);
        if (pm0 >= 0 && tid < 256) { const f32x4* pp = (const f32x4*)((const float*)(ws + WS_SQ1) + (size_t)(pm0 * 256 + tid) * 32); float t = 0.f;
#pragma unroll
            for (int j = 0; j < 8; ++j) { const f32x4 p4 = pp[j]; t += (p4[0] + p4[1]) + (p4[2] + p4[3]); }
            rsl[tid] = rsqrtf(t * (1.f / DM) + EPS); }
        __syncthreads();
        pg8::EpiSwiGlu E{(bf16*)(ws + WS_ACT), DFF, (const float*)(ws + WS_SQ1), 1.f / DM, rsl, pm0};
        pg8::gemm_phase<pg8::EpiSwiGlu, pg8::StaticOrder, true, true>(glds, g, S, E);
    }
    if constexpr (PH == 10) {
        pg8::Gemm g{(const bf16*)(ws + WS_ACT), (const bf16*)(ws + WS_WD), MTOK, DM, DFF}; pg8::StaticOrder S; S.init(MTOK, DM, gridDim.x, blockIdx.x);
        pg8::EpiResB E{nullptr, (const bf16*)(ws + WS_X1B), (bf16*)(ws + WS_BUFA), DM, nullptr, 0.f, nullptr, false};
        pg8::gemm_phase<pg8::EpiResB, pg8::StaticOrder, false, true>(glds, g, S, E);
    }
    if constexpr (PH == 11) final_norm_phase(P, lane, wave);
}
#define R(k) { int t_ = threadIdx.x; asm volatile("" : "+v"(t_)); run_phase<k>(P, lds, t_, t_ & 63, __builtin_amdgcn_readfirstlane(t_ >> 6)); }
#define BST ((volatile LAS unsigned*)((LAS unsigned char*)lds + LDS_KEEP))
#define S { XcdBarrier b_; b_.bar = (unsigned*)(P.ws + WS_CTL); b_.x = xb_xcc_id(); b_.st = BST; xcd_barrier(b_); }
#define G(k) group_barrier((unsigned*)(P.ws + WS_CTL), k, panel_of((int)blockIdx.x), BST[2] != 0u);
#define PHASE_PROGRAM R(0) S R(1) S R(2) S R(3) S GROUP_CHECK R(5) G(0) R(6) S R(7) G(1) R(9) G(2) R(10) G(3) R(11)
__global__ void __launch_bounds__(512, 2) hybrid_fwd(Params P) {
    extern __shared__ __attribute__((aligned(16))) unsigned char lds[];
    cg::grid_group grid = cg::this_grid();
    const int tid = threadIdx.x, lane = tid & 63, wave = __builtin_amdgcn_readfirstlane(tid >> 6);
    if (P.ws == nullptr) grid.sync();
    if (tid < 3) BST[tid] = 0u;
    __syncthreads();
    { XcdBarrier bar = xcd_barrier_post((unsigned*)(P.ws + WS_CTL), BST); (void)bar; }
    if (tid == 0) __hip_atomic_store((unsigned*)(P.ws + WS_CTL + CTL_XID) + blockIdx.x, xb_xcc_id() + 1u, __ATOMIC_RELAXED, __HIP_MEMORY_SCOPE_AGENT);
#define GROUP_CHECK { unsigned ok_ = 1u; const unsigned* xid_ = (const unsigned*)(P.ws + WS_CTL + CTL_XID); _Pragma("unroll") for (int k_ = 0; k_ < 4; ++k_) ok_ &= (xb_ld((unsigned*)xid_ + ((blockIdx.x & 63) + 64 * k_)) == xb_xcc_id() + 1u) ? 1u : 0u; if (threadIdx.x == 0) BST[2] = ok_; __syncthreads(); }
    PHASE_PROGRAM
}
#undef R
#undef S

extern "C" void kernel_launch(void* const* d_in, const int* in_sizes, int n_in, void* d_out, int out_size, void* d_ws, size_t ws_size, hipStream_t stream) {
    static int grid = 0;
    if (grid == 0) {
        if (n_in != 21 || out_size != MTOK * DM || ws_size < WS_END) { fprintf(stderr, "kernel_launch: unexpected shapes (n_in %d out %d ws %zu)\n", n_in, out_size, ws_size); grid = -1; return; }
        int dev = 0, cus = 0, per_cu = 0;
        (void)hipGetDevice(&dev); (void)hipDeviceGetAttribute(&cus, hipDeviceAttributeMultiprocessorCount, dev);
        if (hipFuncSetAttribute((const void*)hybrid_fwd, hipFuncAttributeMaxDynamicSharedMemorySize, LDS_BYTES) != hipSuccess) { fprintf(stderr, "kernel_launch: hipFuncSetAttribute failed\n"); grid = -1; return; }
        if (hipOccupancyMaxActiveBlocksPerMultiprocessor(&per_cu, (const void*)hybrid_fwd, 512, LDS_BYTES) != hipSuccess || per_cu < 1) { fprintf(stderr, "kernel_launch: occupancy query says %d\n", per_cu); per_cu = 1; }
        (void)hipGetLastError();
        grid = cus * 1;
        if (grid != 256) { fprintf(stderr, "kernel_launch: built for a 256-CU device (got %d)\n", cus); grid = -1; return; }
    }
    if (grid < 0) return;
    Params p{};
    for (int i = 0; i < 21; ++i) p.in[i] = (const float*)d_in[i];
    p.out = (float*)d_out; p.ws = (unsigned char*)d_ws;
    if (hipMemsetAsync((unsigned char*)d_ws + WS_CTL, 0, CTL_ZERO, stream) != hipSuccess) { fprintf(stderr, "kernel_launch: memset of the barrier words failed\n"); return; }
    void* args[] = {&p};
    hipError_t e = hipLaunchCooperativeKernel((const void*)hybrid_fwd, dim3(grid), dim3(512), args, LDS_BYTES, stream);
    if (e != hipSuccess) fprintf(stderr, "cooperative launch failed: %s (grid %d)\n", hipGetErrorString(e), grid);
}
```
